# Optimizing an MI355X kernel written in HIP

```python
import jax, jax.numpy as jnp
from jax import lax
import numpy as np

D_MODEL = 2048
BATCH = 4
SEQ = 8192
DEPTH = 1

LRU_WIDTH = 1024
LRU_BLOCKS = 8
LRU_BLOCK_DIM = LRU_WIDTH // LRU_BLOCKS
CONV_WIDTH = 4
LRU_C = 8.0
ATTN_HEADS = 8
HEAD_DIM = 128
ATTN_WIDTH = ATTN_HEADS * HEAD_DIM
MOBA_BLOCK = 256
MOBA_TOPK = 3
QUERY_CHUNK = 32
N_GROUPS = 4
EXPERTS_PER_GROUP = 8
N_EXPERTS = N_GROUPS * EXPERTS_PER_GROUP
TOPK_IN_GROUP = 2
EXPERT_HIDDEN = 512
RMS_EPS = 1e-6

IN_WIDTH = 2 * LRU_WIDTH + 3 * ATTN_WIDTH + 2 * D_MODEL
SPLIT_POINTS = (LRU_WIDTH, 2 * LRU_WIDTH, 2 * LRU_WIDTH + ATTN_WIDTH, 2 * LRU_WIDTH + 2 * ATTN_WIDTH, 2 * LRU_WIDTH + 3 * ATTN_WIDTH, 2 * LRU_WIDTH + 3 * ATTN_WIDTH + D_MODEL)

kernel_name = "hybrid_rglru_moba_hmoe_block"


def rms_norm(x, g):
    xf = x.astype(jnp.float32)
    y = xf * lax.rsqrt(jnp.mean(xf * xf, axis=-1, keepdims=True) + RMS_EPS)
    return (y * g.astype(jnp.float32)).astype(x.dtype)


def causal_conv(x, w, b):
    S = x.shape[1]
    xp = jnp.pad(x, ((0, 0), (CONV_WIDTH - 1, 0), (0, 0)))
    y = b
    for k in range(CONV_WIDTH):
        y = y + xp[:, k:k + S] * w[k]
    return y


def _lin_rec_combine(c1, c2):
    a1, b1 = c1
    a2, b2 = c2
    return a1 * a2, a2 * b1 + b2


def rglru(x, wa, ba, wx, bx, lam):
    B, S, W = x.shape
    xb = x.reshape(B, S, LRU_BLOCKS, LRU_BLOCK_DIM)
    r = jax.nn.sigmoid(jnp.einsum('bsnc,ncd->bsnd', xb, wa).reshape(B, S, W) + ba)
    i = jax.nn.sigmoid(jnp.einsum('bsnc,ncd->bsnd', xb, wx).reshape(B, S, W) + bx)
    log_a = LRU_C * r.astype(jnp.float32) * jax.nn.log_sigmoid(lam.astype(jnp.float32))
    a = jnp.exp(log_a)
    b_in = jnp.sqrt(-jnp.expm1(2.0 * log_a)) * (i * x).astype(jnp.float32)
    _, h = lax.associative_scan(_lin_rec_combine, (a, b_in), axis=1)
    return h.astype(x.dtype)


def alibi_slopes(n_heads):
    return 2.0 ** (-8.0 * jnp.arange(1, n_heads + 1, dtype=jnp.float32) / n_heads)


def moba_attention(q, k, v):
    B, S, H, dh = q.shape
    nb = -(-S // MOBA_BLOCK)
    s_pad = nb * MOBA_BLOCK
    pad = ((0, 0), (0, s_pad - S), (0, 0), (0, 0))
    q, k, v = [jnp.pad(t, pad).transpose(0, 2, 1, 3) for t in (q, k, v)]
    k_blocks = k.reshape(B, H, nb, MOBA_BLOCK, dh)
    v_blocks = v.reshape(B, H, nb, MOBA_BLOCK, dh)
    k_mean = jnp.mean(k_blocks.astype(jnp.float32), axis=3)
    n_sel = min(MOBA_TOPK, nb)
    slopes = alibi_slopes(H)
    scale = HEAD_DIM ** -0.5
    b_idx = jnp.arange(B)[:, None, None, None]
    h_idx = jnp.arange(H)[None, :, None, None]
    blk_pos = jnp.arange(MOBA_BLOCK)
    f32 = jnp.float32

    def chunk(c):
        start = c * QUERY_CHUNK
        j = start // MOBA_BLOCK
        q_c = lax.dynamic_slice_in_dim(q, start, QUERY_CHUNK, axis=2)
        t = start + jnp.arange(QUERY_CHUNK)
        gate = jnp.einsum('bhqd,bhnd->bhqn', q_c.astype(f32), k_mean)
        gate = jnp.where(jnp.arange(nb) < j, gate, -jnp.inf)
        _, idx = lax.top_k(gate, n_sel)
        valid = idx < j
        k_g = k_blocks[b_idx, h_idx, idx]
        v_g = v_blocks[b_idx, h_idx, idx]
        s_sel = jnp.einsum('bhqd,bhqnkd->bhqnk', q_c, k_g, preferred_element_type=f32) * scale
        dist_sel = (t[:, None, None] - (idx[..., None] * MOBA_BLOCK + blk_pos)).astype(f32)
        s_sel = s_sel - slopes[:, None, None, None] * dist_sel
        s_sel = jnp.where(valid[..., None], s_sel, -jnp.inf)
        k_own = lax.dynamic_index_in_dim(k_blocks, j, axis=2, keepdims=False)
        v_own = lax.dynamic_index_in_dim(v_blocks, j, axis=2, keepdims=False)
        s_own = jnp.einsum('bhqd,bhkd->bhqk', q_c, k_own, preferred_element_type=f32) * scale
        dist_own = (t[:, None] - (j * MOBA_BLOCK + blk_pos)).astype(f32)
        s_own = jnp.where(dist_own >= 0, s_own - slopes[:, None, None] * dist_own, -jnp.inf)
        scores = jnp.concatenate([s_sel.reshape(B, H, QUERY_CHUNK, n_sel * MOBA_BLOCK), s_own], axis=-1)
        p = jax.nn.softmax(scores, axis=-1)
        p_sel = p[..., :n_sel * MOBA_BLOCK].reshape(B, H, QUERY_CHUNK, n_sel, MOBA_BLOCK).astype(v.dtype)
        p_own = p[..., n_sel * MOBA_BLOCK:].astype(v.dtype)
        out = (jnp.einsum('bhqnk,bhqnkd->bhqd', p_sel, v_g, preferred_element_type=f32)
               + jnp.einsum('bhqk,bhkd->bhqd', p_own, v_own, preferred_element_type=f32))
        return out.astype(q.dtype)

    out = lax.map(chunk, jnp.arange(s_pad // QUERY_CHUNK))
    out = out.transpose(1, 0, 3, 2, 4).reshape(B, s_pad, H * dh)
    return out[:, :S]


def hier_moe(h, wg_r, bg_r, we_r, be_r, w_gate, w_up, w_down):
    B, S, D = h.shape
    tok = h.reshape(B * S, D)
    f32 = jnp.float32
    grp_p = jax.nn.softmax((tok @ wg_r).astype(f32) + bg_r.astype(f32), axis=-1)
    grp_w, grp_i = lax.top_k(grp_p, 1)
    exp_logits = ((tok @ we_r).astype(f32) + be_r.astype(f32)).reshape(-1, N_GROUPS, EXPERTS_PER_GROUP)
    in_grp = jnp.take_along_axis(exp_logits, grp_i[:, :, None], axis=1)[:, 0]
    ew, ei = lax.top_k(jax.nn.softmax(in_grp, axis=-1), TOPK_IN_GROUP)
    ew = ew / jnp.sum(ew, axis=-1, keepdims=True)
    weights = grp_w * ew
    global_i = grp_i * EXPERTS_PER_GROUP + ei
    combine = jnp.sum(jax.nn.one_hot(global_i, N_EXPERTS, dtype=f32) * weights[..., None], axis=1)

    def body(acc, xs):
        wg, wu, wd, c = xs
        y = (jax.nn.silu(tok @ wg) * (tok @ wu)) @ wd
        return acc + c[:, None] * y.astype(f32), None

    acc, _ = lax.scan(body, jnp.zeros((B * S, D), f32), (w_gate, w_up, w_down, combine.T))
    return acc.astype(h.dtype).reshape(B, S, D)


def setup_inputs(seed: int = 0) -> dict:
    key = jax.random.key(seed)
    ks = jax.random.split(key, 24)
    L, D = DEPTH, D_MODEL
    nrm = lambda k, shape, s: jax.random.normal(k, shape, jnp.float32) * s
    u = jax.random.uniform(ks[9], (L, LRU_WIDTH), jnp.float32, 0.9, 0.999)
    a0 = u ** (1.0 / LRU_C)
    lam = jnp.log(a0) - jnp.log1p(-a0)
    return {
        "x": nrm(ks[0], (BATCH, SEQ, D), 1.0),
        "norm_attn_g": 1.0 + nrm(ks[1], (L, D), 0.02),
        "w_in": nrm(ks[2], (L, D, IN_WIDTH), D ** -0.5),
        "conv_w": nrm(ks[3], (L, CONV_WIDTH, LRU_WIDTH), CONV_WIDTH ** -0.5),
        "conv_b": nrm(ks[4], (L, LRU_WIDTH), 0.01),
        "lru_wa": nrm(ks[5], (L, LRU_BLOCKS, LRU_BLOCK_DIM, LRU_BLOCK_DIM), LRU_BLOCK_DIM ** -0.5),
        "lru_ba": nrm(ks[6], (L, LRU_WIDTH), 0.01),
        "lru_wx": nrm(ks[7], (L, LRU_BLOCKS, LRU_BLOCK_DIM, LRU_BLOCK_DIM), LRU_BLOCK_DIM ** -0.5),
        "lru_bx": nrm(ks[8], (L, LRU_WIDTH), 0.01),
        "lru_lambda": lam,
        "proj_rec": nrm(ks[10], (L, LRU_WIDTH, D), LRU_WIDTH ** -0.5),
        "proj_attn": nrm(ks[11], (L, ATTN_WIDTH, D), ATTN_WIDTH ** -0.5),
        "w_out": nrm(ks[12], (L, D, D), D ** -0.5),
        "norm_ffn_g": 1.0 + nrm(ks[13], (L, D), 0.02),
        "router_group_w": nrm(ks[14], (L, D, N_GROUPS), D ** -0.5),
        "router_group_b": nrm(ks[15], (L, N_GROUPS), 0.01),
        "router_expert_w": nrm(ks[16], (L, D, N_EXPERTS), D ** -0.5),
        "router_expert_b": nrm(ks[17], (L, N_EXPERTS), 0.01),
        "expert_w_gate": nrm(ks[18], (L, N_EXPERTS, D, EXPERT_HIDDEN), D ** -0.5),
        "expert_w_up": nrm(ks[19], (L, N_EXPERTS, D, EXPERT_HIDDEN), D ** -0.5),
        "expert_w_down": nrm(ks[20], (L, N_EXPERTS, EXPERT_HIDDEN, D), EXPERT_HIDDEN ** -0.5),
        "norm_final_g": 1.0 + nrm(ks[21], (D,), 0.02),
    }


def reference(x, norm_attn_g, w_in, conv_w, conv_b, lru_wa, lru_ba, lru_wx, lru_bx, lru_lambda, proj_rec, proj_attn, w_out, norm_ffn_g, router_group_w, router_group_b, router_expert_w, router_expert_b, expert_w_gate, expert_w_up, expert_w_down, norm_final_g):
    B, S, _ = x.shape
    for l in range(DEPTH):
        h = rms_norm(x, norm_attn_g[l])
        u = h @ w_in[l]
        x_rec, g_rec, q, k, v, gate_rec, gate_attn = jnp.split(u, SPLIT_POINTS, axis=-1)
        y_rec = rglru(causal_conv(x_rec, conv_w[l], conv_b[l]), lru_wa[l], lru_ba[l], lru_wx[l], lru_bx[l], lru_lambda[l])
        y_rec = y_rec * jax.nn.gelu(g_rec, approximate=True)
        y_attn = moba_attention(q.reshape(B, S, ATTN_HEADS, HEAD_DIM), k.reshape(B, S, ATTN_HEADS, HEAD_DIM), v.reshape(B, S, ATTN_HEADS, HEAD_DIM))
        merged = jax.nn.sigmoid(gate_rec) * (y_rec @ proj_rec[l]) + jax.nn.sigmoid(gate_attn) * (y_attn @ proj_attn[l])
        x = x + merged @ w_out[l]
        x = x + hier_moe(rms_norm(x, norm_ffn_g[l]), router_group_w[l], router_group_b[l], router_expert_w[l], router_expert_b[l], expert_w_gate[l], expert_w_up[l], expert_w_down[l])
    return rms_norm(x, norm_final_g)
```

```cpp
#include <hip/hip_runtime.h>
#include <stdint.h>
#include <cstdio>

#ifndef MK_N_LAUNCHES
#define MK_N_LAUNCHES 1
#endif
#ifndef EN_ATTN
#define EN_ATTN 1
#endif
#ifndef EN_MOE
#define EN_MOE 1
#endif

#define LAS __attribute__((address_space(3)))
#define GAS __attribute__((address_space(1)))
typedef unsigned short bf16_t;
typedef short bf16x8 __attribute__((ext_vector_type(8)));
typedef short s16x4 __attribute__((ext_vector_type(4)));
typedef float f32x2 __attribute__((ext_vector_type(2)));
typedef float f32x4 __attribute__((ext_vector_type(4)));
typedef float f32x16 __attribute__((ext_vector_type(16)));
typedef unsigned u32x2 __attribute__((ext_vector_type(2)));
typedef unsigned u32x4 __attribute__((ext_vector_type(4)));
typedef int i32x4 __attribute__((ext_vector_type(4)));
typedef int i32x8 __attribute__((ext_vector_type(8)));

constexpr int NB = 4, S = 8192, T = NB * S, D = 2048;
constexpr int LW = 1024, NLB = 8, LBD = 128;
constexpr int NH = 8, HD = 128, AW = NH * HD, MBLK = 256, NBLK = S / MBLK;
constexpr int NE = 32, NG = 4, EPG = 8, EH = 512;
constexpr int INW = 2 * LW + 3 * AW + 2 * D;
constexpr float RMS_EPS = 1e-6f;
constexpr int NWAVES = 8, NTHR = 512;

constexpr size_t MiB = (size_t)1 << 20;
constexpr size_t WS_CTL = 0, CTL_ZERO_BYTES = 128 * 1024;
constexpr size_t WS_WA_T = 1 * MiB;
constexpr size_t WS_WX_T = WS_WA_T + 256 * 1024;
constexpr size_t WS_WR_T = WS_WX_T + 256 * 1024;
constexpr size_t WS_KMEAN = 2 * MiB;
constexpr size_t WS_SSUM = WS_KMEAN + 512 * 1024;
constexpr size_t WS_KNORM = WS_SSUM + 1024 * 1024;
constexpr size_t WS_KMH = WS_KNORM + 64 * 1024, WS_KML = WS_KMH + 256 * 1024;
constexpr size_t WS_WIN_T = 8 * MiB;
constexpr size_t WS_WP_T = 44 * MiB;
constexpr size_t WS_WOUT_T = 52 * MiB;
constexpr size_t WS_WGU_T = 60 * MiB;
constexpr size_t WS_WD_T = 188 * MiB;
constexpr size_t WS_ALIST = 252 * MiB;
constexpr size_t WS_MTOK = 268 * MiB, WS_MDST = 272 * MiB, WS_MW = 276 * MiB, WS_MRS = 280 * MiB;
constexpr size_t WS_XN = 284 * MiB;
constexpr size_t WS_YCAT = WS_XN, WS_H2 = WS_XN;
constexpr size_t WS_XREC = 412 * MiB, WS_GREC = 476 * MiB;
constexpr size_t WS_MERGED = WS_XREC;
constexpr size_t WS_LSE = 988 * MiB;
constexpr size_t WS_Q = 540 * MiB, WS_K = 604 * MiB, WS_V = 668 * MiB;
constexpr size_t WS_HID = WS_Q;
constexpr size_t WS_YC8 = WS_Q;
constexpr size_t WS_RS1 = WS_K, WS_RS2 = WS_K + 1 * MiB;
constexpr size_t WS_MG8 = WS_V;
constexpr size_t WS_SGR = 732 * MiB, WS_SGA = 860 * MiB;
constexpr size_t WS_Y = WS_SGR;
constexpr size_t WS_DELTA = WS_SGA;
constexpr size_t WS_WIN8 = 988 * MiB;
constexpr size_t WS_END = 1008 * MiB;
constexpr size_t OUT_PART = 0, OUT_LSE = 192 * MiB;
constexpr int ALIST_PER_BH = 256 * 496;
__host__ __device__ constexpr int alist_off(int n) { return 256 * (31 * n - (n * (n - 1)) / 2); }

constexpr int CW_TMO = 0;
constexpr int CW_BAR = 4096;
constexpr int CW_ACNT = 16384;
constexpr int CW_ECNT = 20480;
constexpr int CW_SFLAG = 24576;

constexpr int RING_BYTES = 131072;
constexpr int MISC_OFF = 139264;
constexpr int TAB_OFF = MISC_OFF + 256;
constexpr int LDS_BYTES = 163840;

__device__ __forceinline__ unsigned cvt_pk_bf16(float lo, float hi) { unsigned r; asm volatile("v_cvt_pk_bf16_f32 %0, %1, %2" : "=v"(r) : "v"(lo), "v"(hi)); return r; }
__device__ __forceinline__ float bf_lo(unsigned w) { return __uint_as_float(w << 16); }
__device__ __forceinline__ float bf_hi(unsigned w) { return __uint_as_float(w & 0xffff0000u); }
__device__ __forceinline__ float bf2f(bf16_t v) { return __uint_as_float(((unsigned)v) << 16); }
__device__ __forceinline__ float fsigmoid(float z) { return __builtin_amdgcn_rcpf(1.0f + __builtin_amdgcn_exp2f(-1.4426950408889634f * z)); }
__device__ __forceinline__ float gelu_tanh(float x) { const float u = 1.5957691216057308f * (x + 0.044715f * x * x * x); return x * fsigmoid(u); }
__device__ __forceinline__ float wave_sum(float v) {
#pragma unroll
    for (int o = 1; o < 64; o <<= 1) v += __shfl_xor(v, o);
    return v;
}
#define LDS_WAIT() asm volatile("s_waitcnt lgkmcnt(0)" ::: "memory")
#define VM_WAIT() asm volatile("s_waitcnt vmcnt(0)" ::: "memory")

#define XB_TMO      128
#define XB_XCNT(j)  (256  + 64 * (j))
#define XB_XSUB(j)  (1280 + 64 * (j))
#define XB_XGEN(j)  (2304 + 64 * (j))
#define XB_TOP      3328
#define XB_TOPGEN   3392
#define XCD_BAR_WORDS 3456
#define XB_SPIN_CAP (1u << 18)
__device__ __forceinline__ unsigned xb_ld(unsigned* p)              { return __hip_atomic_load(p, __ATOMIC_RELAXED, __HIP_MEMORY_SCOPE_AGENT); }
__device__ __forceinline__ unsigned xb_add(unsigned* p, unsigned v) { return __hip_atomic_fetch_add(p, v, __ATOMIC_RELAXED, __HIP_MEMORY_SCOPE_AGENT); }
__device__ __forceinline__ unsigned xb_xcc_id() { return (unsigned)__builtin_amdgcn_s_getreg((3 << 11) | 20) & 0xFu; }
#define XB_SPIN(cond, bar) do { unsigned _sp = 0; while (cond) { __builtin_amdgcn_s_sleep(1); \
    if ((++_sp & 255u) == 0u) { if (xb_ld(&(bar)[XB_TMO])) break; if (_sp > XB_SPIN_CAP) { atomicAdd(&(bar)[XB_TMO], 1u); break; } } } } while (0)
struct XcdBarrier { unsigned* bar; unsigned x; volatile LAS unsigned* st; };
__device__ __forceinline__ XcdBarrier xcd_barrier_post(unsigned* bar, volatile LAS unsigned* st) {
    XcdBarrier b; b.bar = bar; b.x = xb_xcc_id(); b.st = st;
    if (threadIdx.x == 0) (void)xb_add(&bar[XB_XCNT(b.x)], 1u);
    return b;
}
__device__ __forceinline__ void xcd_barrier_complete(unsigned* bar, unsigned x, unsigned& nloc, unsigned& nx) {
    const unsigned G = gridDim.x * gridDim.y * gridDim.z;
    unsigned sum, cnt, mine, sp = 0u;
    for (;;) {
        sum = 0u; cnt = 0u; mine = 0u;
#pragma unroll
        for (unsigned j = 0; j < 16; ++j) { const unsigned c = xb_ld(&bar[XB_XCNT(j)]); sum += c; cnt += (c > 0u) ? 1u : 0u; mine = (j == x) ? c : mine; }
        if (sum == G) break;
        __builtin_amdgcn_s_sleep(1);
        if ((++sp & 255u) == 0u) { if (xb_ld(&bar[XB_TMO])) break; if (sp > XB_SPIN_CAP) { atomicAdd(&bar[XB_TMO], 1u); break; } }
    }
    nloc = mine > 0u ? mine : 1u; nx = cnt > 0u ? cnt : 1u;
}
__device__ __forceinline__ void xcd_barrier(const XcdBarrier& b) {
    asm volatile("s_waitcnt vmcnt(0)" ::: "memory");
    __syncthreads();
    if (threadIdx.x == 0) {
        unsigned* bar = b.bar;
        __builtin_amdgcn_s_waitcnt(0);
        unsigned nloc = b.st[0], nx = b.st[1];
        if (nloc == 0u) { xcd_barrier_complete(bar, b.x, nloc, nx); b.st[0] = nloc; b.st[1] = nx; }
        const unsigned old = xb_add(&bar[XB_XSUB(b.x)], 1u);
        const unsigned gen = old / nloc;
        if (old + 1u == (gen + 1u) * nloc) {
            __builtin_amdgcn_fence(__ATOMIC_RELEASE, "agent");
            asm volatile("s_waitcnt vmcnt(0)" ::: "memory");
            const unsigned og = xb_add(&bar[XB_TOP], 1u);
            const unsigned tg = og / nx;
            if (og + 1u == (tg + 1u) * nx) xb_add(&bar[XB_TOPGEN], 1u);
            else XB_SPIN(xb_ld(&bar[XB_TOPGEN]) == tg, bar);
            __builtin_amdgcn_fence(__ATOMIC_ACQUIRE, "agent");
            xb_add(&bar[XB_XGEN(b.x)], 1u);
            asm volatile("s_waitcnt vmcnt(0)" ::: "memory");
        } else {
            XB_SPIN(xb_ld(&bar[XB_XGEN(b.x)]) == gen, bar);
            __builtin_amdgcn_fence(__ATOMIC_ACQUIRE, "agent");
            asm volatile("s_waitcnt vmcnt(0)" ::: "memory");
        }
    }
    __syncthreads();
}

namespace pg8 {
constexpr int BM = 256, BK = 64, HALF = 128, HTB = HALF * BK * 2, STAGE_BYTES = 8 * HTB, NXCD = 8, WGM = 4;
__host__ __device__ __forceinline__ int lds_byte(int r, int c) { const int st = (r >> 4) * 2 + (c >> 5), rr = r & 15, cc = c & 31, ob = rr * 64 + cc * 2; return st * 1024 + (ob ^ (((ob >> 9) & 1) << 5)); }
__host__ __device__ __forceinline__ void stage_rc(int b, int& R, int& C) { const int st = b / 1024, sb = b % 1024, swz = sb ^ (((sb >> 9) & 1) << 5); R = (st >> 1) * 16 + swz / 64; C = (st & 1) * 32 + (swz % 64) / 2; }
__host__ __device__ __forceinline__ int perm32(int rho) { const int n = rho >> 4, i = rho & 15; return 8 * (i >> 2) + 4 * n + (i & 3); }

struct Unit { int pm, pn, e, n, rb; };

struct StaticOrder {
    int nM, nN, nwg, G, c;
    __device__ void init(int M, int N, int G_, int c_) { nM = M / BM; nN = N / BM; nwg = nM * nN; G = G_; c = c_; }
    __device__ bool next(int i, Unit& u) const {
        const long L = (long)i * G + c; if (L >= nwg) return false;
        int wgid = (int)L; { const int q = nwg / NXCD, r = nwg % NXCD, xcd = wgid % NXCD, off = wgid / NXCD; wgid = (xcd < r ? xcd * (q + 1) : r * (q + 1) + (xcd - r) * q) + off; }
        const int nig = WGM * nN, gid = wgid / nig, fm = gid * WGM, gsz = (nM - fm) < WGM ? (nM - fm) : WGM;
        u.pm = fm + ((wgid % nig) % gsz); u.pn = (wgid % nig) / gsz; u.e = 0; u.n = 0; u.rb = 0; return true;
    }
};
struct GroupedOrder {
    const LAS int* tpre; const LAS int* cnt; int nct, G, c;
    __device__ bool next(int i, Unit& u) const {
        const int L = i * G + c; const int rt = L / nct; if (rt >= tpre[NE]) return false;
        int e = 0;
#pragma unroll 1
        while (tpre[e + 1] <= rt) ++e;
        u.e = e; u.pm = rt - tpre[e]; u.pn = L - rt * nct; u.n = cnt[e]; u.rb = tpre[e] * BM; return true;
    }
};

template <int QM> struct DenseProbT {
    static constexpr bool GATHER = false; static constexpr int QMODE = QM, EB = QM ? 1 : 2;
    const void* A; const void* Bt; int K, lda, ldb;
    __device__ __forceinline__ const char* a_base(const Unit& u) const { return (const char*)A + (size_t)u.pm * BM * lda * EB; }
    __device__ __forceinline__ const char* b_base(const Unit& u) const { return (const char*)Bt + (size_t)u.pn * BM * ldb * EB; }
    __device__ __forceinline__ void a_off(const Unit&, const int (&R)[2], const int (&C)[2], unsigned (&vo)[2][2]) const {
#pragma unroll
        for (int h = 0; h < 2; ++h)
#pragma unroll
            for (int i = 0; i < 2; ++i) vo[h][i] = (unsigned)((h * HALF + R[i]) * lda) * (unsigned)EB + (unsigned)C[i] * 2u;
    }
};
typedef DenseProbT<0> DenseProb;
template <int QM> struct MoeUpProbT {
    static constexpr bool GATHER = true; static constexpr int QMODE = QM, EB = QM ? 1 : 2;
    const void* A; const void* Bt; const int* tok; int K, lda, ldb;
    __device__ __forceinline__ const char* a_base(const Unit&) const { return (const char*)A; }
    __device__ __forceinline__ const char* b_base(const Unit& u) const { return (const char*)Bt + ((size_t)u.e * 1024 + (size_t)u.pn * BM) * ldb * EB; }
    __device__ __forceinline__ void a_off(const Unit& u, const int (&R)[2], const int (&C)[2], unsigned (&vo)[2][2]) const {
#pragma unroll
        for (int h = 0; h < 2; ++h)
#pragma unroll
            for (int i = 0; i < 2; ++i) { const int s = u.pm * BM + h * HALF + R[i]; const int tl = tok[(size_t)u.e * T + s]; const int t = (s < u.n) ? tl : 0; vo[h][i] = (unsigned)(t * lda) * (unsigned)EB + (unsigned)C[i] * 2u; }
    }
};
template <int QM> struct MoeDownProbT {
    static constexpr bool GATHER = false; static constexpr int QMODE = QM, EB = QM ? 1 : 2;
    const void* A; const void* Bt; int K, lda, ldb;
    __device__ __forceinline__ const char* a_base(const Unit& u) const { return (const char*)A + ((size_t)u.rb + (size_t)u.pm * BM) * lda * EB; }
    __device__ __forceinline__ const char* b_base(const Unit& u) const { return (const char*)Bt + ((size_t)u.e * 2048 + (size_t)u.pn * BM) * ldb * EB; }
    __device__ __forceinline__ void a_off(const Unit&, const int (&R)[2], const int (&C)[2], unsigned (&vo)[2][2]) const {
#pragma unroll
        for (int h = 0; h < 2; ++h)
#pragma unroll
            for (int i = 0; i < 2; ++i) vo[h][i] = (unsigned)((h * HALF + R[i]) * lda) * (unsigned)EB + (unsigned)C[i] * 2u;
    }
};

template <class Prob, class Epi, class Sched, bool ALIGN_EPI>
__device__ __forceinline__ void gemm_phase(LAS unsigned char* lds, const Prob& P, const Sched& S, const Epi& E) {
    const int tid = threadIdx.x, wid = __builtin_amdgcn_readfirstlane(tid >> 6), lane = tid & 63, wr = wid >> 2, wc = wid & 3, fr = lane & 15, fq = lane >> 4;
    constexpr bool FP8 = Prob::QMODE == 1, I8 = Prob::QMODE == 2; constexpr int EB = Prob::QMODE ? 1 : 2;
    const int K = P.K, nt = K / (Prob::QMODE ? 2 * BK : BK);
    const int sc1 = 0x7F7F7F7F;
    int Rr[2], Cc[2]; unsigned voffB[2];
#pragma unroll
    for (int i = 0; i < 2; ++i) { int R, C; stage_rc(tid * 16 + i * 8192, R, C); Rr[i] = R; Cc[i] = C; const int Rb = Epi::PERM ? ((R & ~31) + perm32(R & 31)) : R; voffB[i] = (unsigned)(Rb * P.ldb) * (unsigned)EB + (unsigned)C * 2u; }
    const size_t kstep = (size_t)(BK * 2);
    const size_t hstepB = (size_t)HALF * P.ldb * EB;
    const unsigned ldsw = (unsigned)wid * 1024u;
    const int aoff = lds_byte(wr * 64 + fr, fq * 8), boff = lds_byte(wc * 32 + fr, fq * 8);
#define PG8_SA(b, h) (((b) * 2 + (h)) * HTB)
#define PG8_SB(b, h) ((4 + (b) * 2 + (h)) * HTB)
#define PG8_STAGE(bufoff, gbase, voff) do { _Pragma("unroll") for (int _i = 0; _i < 2; ++_i) \
        __builtin_amdgcn_global_load_lds((const unsigned*)((const char*)(gbase) + (voff)[_i]), (LAS unsigned*)(lds + (bufoff) + ldsw + _i * 8192), 16, 0, 0); } while (0)
#define PG8_LDA(dst, b, h) do { _Pragma("unroll") for (int m = 0; m < 4; ++m) _Pragma("unroll") for (int k = 0; k < 2; ++k) dst[m][k] = *(const LAS bf16x8*)(lds + PG8_SA(b, h) + aoff + m * 2048 + k * 1024); } while (0)
#define PG8_LDB(dst, b, h) do { _Pragma("unroll") for (int n = 0; n < 2; ++n) _Pragma("unroll") for (int k = 0; k < 2; ++k) dst[n][k] = *(const LAS bf16x8*)(lds + PG8_SB(b, h) + boff + n * 2048 + k * 1024); } while (0)
#define PG8_MMA(ai, bj, At, Bt) do { __builtin_amdgcn_s_setprio(1); _Pragma("unroll") for (int m = 0; m < 4; ++m) _Pragma("unroll") for (int n = 0; n < 2; ++n) { \
        if constexpr (FP8) { const i32x8 fb = __builtin_shufflevector(__builtin_bit_cast(i32x4, Bt[n][0]), __builtin_bit_cast(i32x4, Bt[n][1]), 0, 1, 2, 3, 4, 5, 6, 7); \
            const i32x8 fa = __builtin_shufflevector(__builtin_bit_cast(i32x4, At[m][0]), __builtin_bit_cast(i32x4, At[m][1]), 0, 1, 2, 3, 4, 5, 6, 7); \
            asm volatile("s_nop 1\n\tv_mfma_scale_f32_16x16x128_f8f6f4 %0, %1, %2, %0, %3, %3 op_sel_hi:[0,0,0]" : "+v"(acc[ai][bj][m][n]) : "v"(fb), "v"(fa), "v"(sc1)); } \
        else if constexpr (I8) { _Pragma("unroll") for (int k = 0; k < 2; ++k) acc[ai][bj][m][n] = __builtin_bit_cast(f32x4, __builtin_amdgcn_mfma_i32_16x16x64_i8(__builtin_bit_cast(i32x4, Bt[n][k]), __builtin_bit_cast(i32x4, At[m][k]), __builtin_bit_cast(i32x4, acc[ai][bj][m][n]), 0, 0, 0)); } \
        else { _Pragma("unroll") for (int k = 0; k < 2; ++k) acc[ai][bj][m][n] = __builtin_amdgcn_mfma_f32_16x16x32_bf16(Bt[n][k], At[m][k], acc[ai][bj][m][n], 0, 0, 0); } } \
        __builtin_amdgcn_s_setprio(0); } while (0)
#define PG8_WAIT_V(n) asm volatile("s_waitcnt vmcnt(" #n ")" ::: "memory")
#define PG8_WAIT_L(n) asm volatile("s_waitcnt lgkmcnt(" #n ")" ::: "memory")
#define PG8_BAR __builtin_amdgcn_s_barrier()
#define PG8_SCHED __builtin_amdgcn_sched_barrier(0)
    Unit cur, nxt; int ui = 0;
    if (!S.next(0, cur)) return;
    f32x4 acc[2][2][4][2];
#pragma unroll
    for (int a = 0; a < 2; ++a)
#pragma unroll
        for (int b = 0; b < 2; ++b)
#pragma unroll
            for (int m = 0; m < 4; ++m)
#pragma unroll
                for (int n = 0; n < 2; ++n) acc[a][b][m][n] = (f32x4){0.f, 0.f, 0.f, 0.f};
    bf16x8 At[4][2], B0[2][2], B1[2][2];
    unsigned vA[2][2], vN[2][2];
    P.a_off(cur, Rr, Cc, vA);
#pragma unroll
    for (int h = 0; h < 2; ++h) { vN[h][0] = vA[h][0]; vN[h][1] = vA[h][1]; }
    const char* cA = P.a_base(cur); const char* cB = P.b_base(cur);
    PG8_STAGE(PG8_SB(0, 0), cB, voffB); PG8_STAGE(PG8_SB(0, 1), cB + hstepB, voffB); PG8_STAGE(PG8_SA(0, 0), cA, vA[0]); PG8_STAGE(PG8_SA(0, 1), cA, vA[1]);
    if (wr == 1) PG8_BAR;
    PG8_WAIT_V(2); PG8_BAR;
    PG8_STAGE(PG8_SB(1, 0), cB + kstep, voffB); PG8_STAGE(PG8_SA(1, 0), cA + kstep, vA[0]); PG8_STAGE(PG8_SB(1, 1), cB + hstepB + kstep, voffB);
    PG8_WAIT_V(6); PG8_BAR;
    for (;;) {
        const bool has_next = S.next(ui + 1, nxt);
        const char* nA = has_next ? P.a_base(nxt) : cA; const char* nB = has_next ? P.b_base(nxt) : cB;
        for (int t = 0; t < nt; t += 2) {
            const bool last = (t == nt - 2);
            const char* a1 = cA + (size_t)(t + 1) * kstep;
            const char* a2 = last ? nA : cA + (size_t)(t + 2) * kstep; const char* b2 = last ? nB : cB + (size_t)(t + 2) * kstep;
            const char* a3 = a2 + kstep; const char* b3 = b2 + kstep;
            if constexpr (Prob::GATHER) { if (last && has_next) P.a_off(nxt, Rr, Cc, vN); }
            unsigned vS[2][2];
#pragma unroll
            for (int h = 0; h < 2; ++h) { vS[h][0] = (Prob::GATHER && last) ? vN[h][0] : vA[h][0]; vS[h][1] = (Prob::GATHER && last) ? vN[h][1] : vA[h][1]; }
            PG8_LDB(B0, 0, 0); PG8_LDB(B1, 0, 1); PG8_SCHED; PG8_LDA(At, 0, 0); PG8_STAGE(PG8_SA(1, 1), a1, vA[1]);
            PG8_WAIT_V(8); PG8_WAIT_L(0); PG8_BAR; PG8_MMA(0, 0, At, B0); PG8_MMA(0, 1, At, B1); PG8_BAR; PG8_SCHED;
            PG8_LDA(At, 0, 1); PG8_STAGE(PG8_SB(0, 0), b2, voffB); PG8_STAGE(PG8_SB(0, 1), b2 + hstepB, voffB); PG8_STAGE(PG8_SA(0, 0), a2, vS[0]);
            PG8_WAIT_V(8); PG8_WAIT_L(0); PG8_BAR; PG8_MMA(1, 0, At, B0); PG8_MMA(1, 1, At, B1); PG8_BAR; PG8_SCHED;
            PG8_LDB(B0, 1, 0); PG8_LDB(B1, 1, 1); PG8_SCHED; PG8_LDA(At, 1, 0); PG8_STAGE(PG8_SA(0, 1), a2, vS[1]);
            PG8_WAIT_V(8); PG8_WAIT_L(0); PG8_BAR; PG8_MMA(0, 0, At, B0); PG8_MMA(0, 1, At, B1); PG8_BAR; PG8_SCHED;
            PG8_LDA(At, 1, 1); PG8_STAGE(PG8_SB(1, 0), b3, voffB); PG8_STAGE(PG8_SB(1, 1), b3 + hstepB, voffB); PG8_STAGE(PG8_SA(1, 0), a3, vS[0]);
            PG8_WAIT_V(8); PG8_WAIT_L(0); PG8_BAR; PG8_MMA(1, 0, At, B0); PG8_MMA(1, 1, At, B1); PG8_BAR; PG8_SCHED;
        }
        if constexpr (ALIGN_EPI) { if (wr == 0) PG8_BAR; }
        if constexpr (FP8) asm volatile("s_nop 15\n\ts_nop 15" ::: "memory");
        if constexpr (I8) {
#pragma unroll
            for (int a = 0; a < 2; ++a)
#pragma unroll
                for (int b = 0; b < 2; ++b)
#pragma unroll
                    for (int m = 0; m < 4; ++m)
#pragma unroll
                        for (int n = 0; n < 2; ++n) { const i32x4 iv = __builtin_bit_cast(i32x4, acc[a][b][m][n]); acc[a][b][m][n] = (f32x4){(float)iv[0], (float)iv[1], (float)iv[2], (float)iv[3]}; } }
        E(acc, cur, wr, wc, fr, fq);
        if constexpr (Epi::SIDE) E.side_work(ui, wid, lane);
        if (!has_next) break;
#pragma unroll
        for (int a = 0; a < 2; ++a)
#pragma unroll
            for (int b = 0; b < 2; ++b)
#pragma unroll
                for (int m = 0; m < 4; ++m)
#pragma unroll
                    for (int n = 0; n < 2; ++n) acc[a][b][m][n] = (f32x4){0.f, 0.f, 0.f, 0.f};
        cur = nxt; cA = nA; cB = nB; ++ui;
        if constexpr (Prob::GATHER) {
#pragma unroll
            for (int h = 0; h < 2; ++h) { vA[h][0] = vN[h][0]; vA[h][1] = vN[h][1]; }
        }
        if constexpr (ALIGN_EPI) { if (wr == 1) PG8_BAR; }
    }
    PG8_WAIT_V(0);
    if constexpr (!ALIGN_EPI) { if (wr == 0) PG8_BAR; }
    PG8_BAR;
#undef PG8_SA
#undef PG8_SB
#undef PG8_STAGE
#undef PG8_LDA
#undef PG8_LDB
#undef PG8_MMA
#undef PG8_WAIT_V
#undef PG8_WAIT_L
#undef PG8_BAR
#undef PG8_SCHED
}
}

#ifndef Q_MASK
#define Q_MASK 0xFFFFFFFFFull
#endif
#ifndef QM_IN
#define QM_IN 2
#endif
#ifndef QM_UP
#define QM_UP 2
#endif
#ifndef QM_DOWN
#define QM_DOWN 1
#endif
constexpr unsigned long long IN_F8 = Q_MASK & 0xFFFFFFFFFull, IN_BF = ~IN_F8 & 0xFFFFFFFFFull;
constexpr int IN_NF8 = __builtin_popcountll(IN_F8), IN_NBF = 36 - IN_NF8;
constexpr float FP8_SA = 32.f, FP8_SB = 1024.f;
constexpr float I8_SA = 32.f, I8_SB = 1448.f, I8_SH2 = 26.f;
__device__ __forceinline__ unsigned pk4_fp8(float a, float b, float c, float d) {
    a = fminf(fmaxf(a, -448.f), 448.f); b = fminf(fmaxf(b, -448.f), 448.f); c = fminf(fmaxf(c, -448.f), 448.f); d = fminf(fmaxf(d, -448.f), 448.f);
    int w = __builtin_amdgcn_cvt_pk_fp8_f32(a, b, 0, false); w = __builtin_amdgcn_cvt_pk_fp8_f32(c, d, w, true); return (unsigned)w;
}
__device__ __forceinline__ unsigned pk4_i8(float a, float b, float c, float d) {
    const int ia = (int)__builtin_rintf(fminf(fmaxf(a, -127.f), 127.f)), ib = (int)__builtin_rintf(fminf(fmaxf(b, -127.f), 127.f));
    const int ic = (int)__builtin_rintf(fminf(fmaxf(c, -127.f), 127.f)), id = (int)__builtin_rintf(fminf(fmaxf(d, -127.f), 127.f));
    return (unsigned)(ia & 0xff) | ((unsigned)(ib & 0xff) << 8) | ((unsigned)(ic & 0xff) << 16) | ((unsigned)(id & 0xff) << 24);
}
__device__ __forceinline__ unsigned pk4_u8(float a, float b, float c, float d) {
    const unsigned ia = (unsigned)__builtin_rintf(a), ib = (unsigned)__builtin_rintf(b), ic = (unsigned)__builtin_rintf(c), id = (unsigned)__builtin_rintf(d);
    return ia | (ib << 8) | (ic << 16) | (id << 24);
}
template <int QM> __device__ __forceinline__ unsigned pk4_q(float a, float b, float c, float d) { if (QM == 2) return pk4_i8(a, b, c, d); else return pk4_fp8(a, b, c, d); }
constexpr float I8_SP = 1024.f;
constexpr float Q_SA_IN = QM_IN == 2 ? I8_SA : FP8_SA, Q_SB_IN = QM_IN == 2 ? I8_SB : FP8_SB;
constexpr float Q_SA_UP = QM_UP == 2 ? I8_SH2 : FP8_SA, Q_SB_UP = QM_UP == 2 ? I8_SB : FP8_SB;
#define FP8_UP (QM_UP != 0)
#define FP8_DOWN (QM_DOWN != 0)
constexpr float FP8_SH = 16.f, FP8_SD = 512.f, FP8_SY = 64.f;
struct TrDesc { const float* W; unsigned char* WT; int ldw, k0, n0, ldt, drow0, dk0, qm; float sc; };
constexpr int TR_I_IN = 32 * 144, TR_I_PR = 16 * 32, TR_I_OUT = 32 * 32, TR_I_EXG = NE * 32 * 8, TR_I_EXD = NE * 8 * 32;
constexpr int TR_NITEMS = TR_I_IN + 2 * TR_I_PR + TR_I_OUT + 2 * TR_I_EXG + TR_I_EXD;
struct TrSrc { const float *w_in, *p_rec, *p_attn, *w_out, *w_gate, *w_up, *w_down; unsigned char* ws; };
__device__ __forceinline__ TrDesc tr_decode(const TrSrc& F, int r) {
    TrDesc d; d.dk0 = 0;
    if (r < TR_I_IN) { d.n0 = 64 * (r % 144); d.k0 = 64 * (r / 144); d.W = F.w_in; d.ldw = INW; d.ldt = 2048; d.qm = QM_IN; d.sc = Q_SB_IN; d.WT = F.ws + WS_WIN8; d.drow0 = d.n0; return d; } r -= TR_I_IN;
    if (r < 2 * TR_I_PR) { const int at = r >= TR_I_PR; if (at) r -= TR_I_PR; d.W = at ? F.p_attn : F.p_rec; d.ldw = 2048; d.k0 = 64 * (r / 32); d.n0 = 64 * (r % 32); d.WT = F.ws + WS_WP_T; d.ldt = 2048; d.drow0 = d.n0; d.dk0 = at ? 1024 : 0; d.qm = 2; d.sc = I8_SP; return d; } r -= 2 * TR_I_PR;
    if (r < TR_I_OUT) { d.W = F.w_out; d.ldw = 2048; d.k0 = 64 * (r / 32); d.n0 = 64 * (r % 32); d.WT = F.ws + WS_WOUT_T; d.ldt = 2048; d.drow0 = d.n0; d.qm = 2; d.sc = I8_SB; return d; } r -= TR_I_OUT;
    if (r < 2 * TR_I_EXG) { const int up = r >= TR_I_EXG; if (up) r -= TR_I_EXG; const int e = r / 256, rr = r % 256; d.n0 = 64 * (rr % 8); d.k0 = 64 * (rr / 8);
        d.W = (up ? F.w_up : F.w_gate) + (size_t)e * D * EH; d.ldw = EH; d.ldt = 2048; d.drow0 = (d.n0 >> 7) * 256 + (d.n0 & 127) + (up ? 128 : 0);
        d.qm = QM_UP; d.sc = Q_SB_UP; d.WT = F.ws + WS_WGU_T + (size_t)e * 1024 * 2048; return d; } r -= 2 * TR_I_EXG;
    { const int e = r / 256, rr = r % 256; d.W = F.w_down + (size_t)e * EH * D; d.ldw = D; d.k0 = 64 * (rr / 32); d.n0 = 64 * (rr % 32); d.ldt = 512; d.drow0 = d.n0;
      d.qm = QM_DOWN; d.sc = FP8_SD; d.WT = F.ws + WS_WD_T + (size_t)e * 2048 * 512; }
    return d;
}
__device__ __forceinline__ void tr_load(const TrDesc& d, f32x4 (&v)[16], int lane) {
    const float* p = d.W + (size_t)(d.k0 + 16 * (lane >> 4)) * d.ldw + d.n0 + 4 * (lane & 15);
#pragma unroll
    for (int i = 0; i < 16; ++i) v[i] = *(const f32x4*)(p + (size_t)i * d.ldw);
}
__device__ __forceinline__ void tr_store(const TrDesc& d, const f32x4 (&v)[16], int lane) {
    unsigned char* q = d.WT + (size_t)(d.drow0 + 4 * (lane & 15)) * d.ldt + d.dk0 + d.k0 + 16 * (lane >> 4); const float sc = d.sc;
#pragma unroll
    for (int c = 0; c < 4; ++c) { u32x4 o;
        if (d.qm == 2) { o.x = pk4_i8(v[0][c] * sc, v[1][c] * sc, v[2][c] * sc, v[3][c] * sc); o.y = pk4_i8(v[4][c] * sc, v[5][c] * sc, v[6][c] * sc, v[7][c] * sc); o.z = pk4_i8(v[8][c] * sc, v[9][c] * sc, v[10][c] * sc, v[11][c] * sc); o.w = pk4_i8(v[12][c] * sc, v[13][c] * sc, v[14][c] * sc, v[15][c] * sc); }
        else { o.x = pk4_fp8(v[0][c] * sc, v[1][c] * sc, v[2][c] * sc, v[3][c] * sc); o.y = pk4_fp8(v[4][c] * sc, v[5][c] * sc, v[6][c] * sc, v[7][c] * sc); o.z = pk4_fp8(v[8][c] * sc, v[9][c] * sc, v[10][c] * sc, v[11][c] * sc); o.w = pk4_fp8(v[12][c] * sc, v[13][c] * sc, v[14][c] * sc, v[15][c] * sc); }
        *(u32x4*)(q + (size_t)c * d.ldt) = o; }
}

namespace pg8 {
struct EpiIn {
    static constexpr bool PERM = true, SIDE = true;
    bf16_t *xrec, *grec, *q, *k, *v, *sgr, *sga; float osc; unsigned long long mask; TrSrc src; int side_c, side_stride;
    __device__ __forceinline__ void side_work(int ui, int wid, int lane) const {
        const int item = TR_I_IN + side_c + (ui * 8 + wid) * side_stride; if (item >= TR_NITEMS) return;
        const TrDesc d = tr_decode(src, item); f32x4 v[16]; tr_load(d, v, lane); tr_store(d, v, lane); }
    __device__ __forceinline__ void operator()(const f32x4 (&acc)[2][2][4][2], const Unit& u, int wr, int wc, int fr, int fq) const {
        int pn = 0; { int left = u.pn; unsigned long long mm = mask; for (;;) { const int b = __builtin_ctzll(mm); if (left == 0) { pn = b; break; } mm &= mm - 1; --left; } }
        bf16_t* base; int ldc, ct, act;
        if (pn < 4) { base = xrec; ldc = 1024; ct = pn; act = 0; }
        else if (pn < 8) { base = grec; ldc = 1024; ct = pn - 4; act = 1; }
        else if (pn < 12) { base = q; ldc = 1024; ct = pn - 8; act = 0; }
        else if (pn < 16) { base = k; ldc = 1024; ct = pn - 12; act = 0; }
        else if (pn < 20) { base = v; ldc = 1024; ct = pn - 16; act = 0; }
        else if (pn < 28) { base = sgr; ldc = 2048; ct = pn - 20; act = 2; }
        else { base = sga; ldc = 2048; ct = pn - 28; act = 2; }
        const int row0 = u.pm * BM + wr * 64 + fr, col0 = ct * BM + wc * 32 + 8 * fq;
#pragma unroll
        for (int ai = 0; ai < 2; ++ai)
#pragma unroll
            for (int m = 0; m < 4; ++m) { bf16_t* rowp = base + (size_t)(row0 + ai * HALF + m * 16) * ldc + col0;
#pragma unroll
                for (int bj = 0; bj < 2; ++bj) { f32x4 v0 = acc[ai][bj][m][0] * osc, v1 = acc[ai][bj][m][1] * osc;
                    if (act == 1) {
#pragma unroll
                        for (int j = 0; j < 4; ++j) { v0[j] = gelu_tanh(v0[j]); v1[j] = gelu_tanh(v1[j]); } }
                    if (act == 2) {
#pragma unroll
                        for (int j = 0; j < 4; ++j) { v0[j] = 255.f * fsigmoid(v0[j]); v1[j] = 255.f * fsigmoid(v1[j]); }
                        u32x2 w; w.x = pk4_u8(v0[0], v0[1], v0[2], v0[3]); w.y = pk4_u8(v1[0], v1[1], v1[2], v1[3]);
                        *(u32x2*)((unsigned char*)base + (size_t)(row0 + ai * HALF + m * 16) * 2048 + col0 + bj * HALF) = w; }
                    else { u32x4 w; w.x = cvt_pk_bf16(v0[0], v0[1]); w.y = cvt_pk_bf16(v0[2], v0[3]); w.z = cvt_pk_bf16(v1[0], v1[1]); w.w = cvt_pk_bf16(v1[2], v1[3]);
                        *(u32x4*)(rowp + bj * HALF) = w; } } }
    }
};
template <bool ADD> struct EpiGate {
    static constexpr bool PERM = true, SIDE = false;
    const unsigned char* gate; bf16_t* out; const float* rs; int rss; float osc;
    __device__ __forceinline__ void operator()(const f32x4 (&acc)[2][2][4][2], const Unit& u, int wr, int wc, int fr, int fq) const {
        const int row0 = u.pm * BM + wr * 64 + fr, col0 = u.pn * BM + wc * 32 + 8 * fq;
#pragma unroll
        for (int ai = 0; ai < 2; ++ai) {
            u32x2 gv[4][2]; u32x4 pv[4]; float scv[4];
#pragma unroll
            for (int m = 0; m < 4; ++m) { scv[m] = rs[(size_t)(row0 + ai * HALF + m * 16) * rss];
#pragma unroll
                for (int bj = 0; bj < 2; ++bj) gv[m][bj] = *(const u32x2*)(gate + ((unsigned)(row0 + ai * HALF + m * 16) * 2048u + (unsigned)(col0 + bj * HALF))); }
#pragma unroll
            for (int bj = 0; bj < 2; ++bj) {
                if (ADD) {
#pragma unroll
                    for (int m = 0; m < 4; ++m) pv[m] = *(const u32x4*)(out + ((unsigned)(row0 + ai * HALF + m * 16) * 2048u + (unsigned)(col0 + bj * HALF))); }
                __builtin_amdgcn_sched_barrier(0);
#pragma unroll
                for (int m = 0; m < 4; ++m) { const unsigned off = (unsigned)(row0 + ai * HALF + m * 16) * 2048u + (unsigned)(col0 + bj * HALF); const float sc = scv[m] * osc;
                    const f32x4 a0 = acc[ai][bj][m][0] * sc, a1 = acc[ai][bj][m][1] * sc;
                    const u32x2 g = gv[m][bj];
                    float r[8];
                    r[0] = (float)(g.x & 0xffu) * a0[0]; r[1] = (float)((g.x >> 8) & 0xffu) * a0[1]; r[2] = (float)((g.x >> 16) & 0xffu) * a0[2]; r[3] = (float)(g.x >> 24) * a0[3];
                    r[4] = (float)(g.y & 0xffu) * a1[0]; r[5] = (float)((g.y >> 8) & 0xffu) * a1[1]; r[6] = (float)((g.y >> 16) & 0xffu) * a1[2]; r[7] = (float)(g.y >> 24) * a1[3];
                    if (ADD) { const u32x4 p = pv[m];
                        r[0] += bf_lo(p.x); r[1] += bf_hi(p.x); r[2] += bf_lo(p.y); r[3] += bf_hi(p.y); r[4] += bf_lo(p.z); r[5] += bf_hi(p.z); r[6] += bf_lo(p.w); r[7] += bf_hi(p.w); }
                    u32x4 w; w.x = cvt_pk_bf16(r[0], r[1]); w.y = cvt_pk_bf16(r[2], r[3]); w.z = cvt_pk_bf16(r[4], r[5]); w.w = cvt_pk_bf16(r[6], r[7]);
                    *(u32x4*)(out + off) = w; } } }
    }
};
struct EpiResid {
    static constexpr bool PERM = true, SIDE = false;
    bf16_t* out; const float* rs; float osc;
    __device__ __forceinline__ void operator()(const f32x4 (&acc)[2][2][4][2], const Unit& u, int wr, int wc, int fr, int fq) const {
        const int row0 = u.pm * BM + wr * 64 + fr, col0 = u.pn * BM + wc * 32 + 8 * fq;
        float scv[2][4];
#pragma unroll
        for (int ai = 0; ai < 2; ++ai)
#pragma unroll
            for (int m = 0; m < 4; ++m) scv[ai][m] = rs[row0 + ai * HALF + m * 16] * osc;
        __builtin_amdgcn_sched_barrier(0);
#pragma unroll
        for (int ai = 0; ai < 2; ++ai)
#pragma unroll
            for (int m = 0; m < 4; ++m) { const int row = row0 + ai * HALF + m * 16; const float sc = scv[ai][m]; bf16_t* rowp = out + (size_t)row * D + col0;
#pragma unroll
                for (int bj = 0; bj < 2; ++bj) { const f32x4 v0 = acc[ai][bj][m][0] * sc, v1 = acc[ai][bj][m][1] * sc;
                    u32x4 w; w.x = cvt_pk_bf16(v0[0], v0[1]); w.y = cvt_pk_bf16(v0[2], v0[3]); w.z = cvt_pk_bf16(v1[0], v1[1]); w.w = cvt_pk_bf16(v1[2], v1[3]);
                    *(u32x4*)(rowp + bj * HALF) = w; } }
    }
};
struct EpiHid {
    static constexpr bool PERM = true, SIDE = false;
    const float* rs; void* hid; float osc;
    __device__ __forceinline__ void operator()(const f32x4 (&acc)[2][2][4][2], const Unit& u, int wr, int wc, int fr, int fq) const {
        const int s0 = u.pm * BM + wr * 64 + fr, col0 = u.pn * HALF + wc * 32 + 8 * fq;
        float sclv[2][4];
#pragma unroll
        for (int ai = 0; ai < 2; ++ai)
#pragma unroll
            for (int m = 0; m < 4; ++m) sclv[ai][m] = rs[(size_t)u.e * T + s0 + ai * HALF + m * 16];
        __builtin_amdgcn_sched_barrier(0);
#pragma unroll
        for (int ai = 0; ai < 2; ++ai)
#pragma unroll
            for (int m = 0; m < 4; ++m) { const int s = s0 + ai * HALF + m * 16; const float scl = sclv[ai][m]; const float sc = (s < u.n) ? scl * osc : 0.f;
                float r[8];
#pragma unroll
                for (int n = 0; n < 2; ++n)
#pragma unroll
                    for (int j = 0; j < 4; ++j) { const float g = acc[ai][0][m][n][j] * sc, up = acc[ai][1][m][n][j] * sc; r[n * 4 + j] = g * fsigmoid(g) * up; }
#if FP8_DOWN
                u32x2 w; w.x = pk4_fp8(r[0] * FP8_SH, r[1] * FP8_SH, r[2] * FP8_SH, r[3] * FP8_SH); w.y = pk4_fp8(r[4] * FP8_SH, r[5] * FP8_SH, r[6] * FP8_SH, r[7] * FP8_SH);
                *(u32x2*)((unsigned char*)hid + (size_t)(u.rb + s) * EH + col0) = w;
#else
                u32x4 w; w.x = cvt_pk_bf16(r[0], r[1]); w.y = cvt_pk_bf16(r[2], r[3]); w.z = cvt_pk_bf16(r[4], r[5]); w.w = cvt_pk_bf16(r[6], r[7]);
                *(u32x4*)((bf16_t*)hid + (size_t)(u.rb + s) * EH + col0) = w;
#endif
            }
    }
};
struct EpiDown {
    static constexpr bool PERM = true, SIDE = false;
    const int* dst; const float* w; unsigned char* y; float osc;
    __device__ __forceinline__ void operator()(const f32x4 (&acc)[2][2][4][2], const Unit& u, int wr, int wc, int fr, int fq) const {
        const int s0 = u.pm * BM + wr * 64 + fr, col0 = u.pn * BM + wc * 32 + 8 * fq;
        int dlv[2][4]; float scv[2][4];
#pragma unroll
        for (int ai = 0; ai < 2; ++ai)
#pragma unroll
            for (int m = 0; m < 4; ++m) { const int s = s0 + ai * HALF + m * 16; dlv[ai][m] = dst[(size_t)u.e * T + s]; scv[ai][m] = w[(size_t)u.e * T + s] * osc * FP8_SY; }
        __builtin_amdgcn_sched_barrier(0);
#pragma unroll
        for (int ai = 0; ai < 2; ++ai)
#pragma unroll
            for (int m = 0; m < 4; ++m) { const int s = s0 + ai * HALF + m * 16;
                const int dl = dlv[ai][m]; const float sc = scv[ai][m];
                if (s < u.n) { unsigned char* rowp = y + (size_t)dl * D + col0;
#pragma unroll
                    for (int bj = 0; bj < 2; ++bj) { const f32x4 v0 = acc[ai][bj][m][0] * sc, v1 = acc[ai][bj][m][1] * sc;
                        u32x2 o; o.x = pk4_fp8(v0[0], v0[1], v0[2], v0[3]); o.y = pk4_fp8(v1[0], v1[1], v1[2], v1[3]);
                        *(u32x2*)(rowp + bj * HALF) = o; } } }
    }
};
}

struct Frame {
    LAS unsigned char* lds; volatile LAS unsigned* MISC; unsigned* ctl;
    int tid, lane, wave, vcu, G;
    const float* in[22]; float* out; unsigned char* ws;
};

__device__ __forceinline__ void tr_item(const float* W, int ldw, int k0, int n0, bf16_t* WT, int ldt, int drow0, int dk0, LAS float* scr, int lane) {
#pragma unroll 8
    for (int i = 0; i < 32; ++i) { const int kk = 2 * i + (lane >> 5); scr[kk * 33 + (lane & 31)] = W[(size_t)(k0 + kk) * ldw + n0 + (lane & 31)]; }
    LDS_WAIT(); asm volatile("" ::: "memory");
    const int c = lane & 7;
#pragma unroll
    for (int j = 0; j < 4; ++j) { const int n = (lane >> 3) + 8 * j; const LAS float* s = scr + (8 * c) * 33 + n;
        u32x4 o; o.x = cvt_pk_bf16(s[0 * 33], s[1 * 33]); o.y = cvt_pk_bf16(s[2 * 33], s[3 * 33]); o.z = cvt_pk_bf16(s[4 * 33], s[5 * 33]); o.w = cvt_pk_bf16(s[6 * 33], s[7 * 33]);
        *(u32x4*)(WT + (size_t)(drow0 + n) * ldt + dk0 + k0 + 8 * c) = o; }
    LDS_WAIT(); asm volatile("" ::: "memory");
}

__device__ __forceinline__ void tr_item8(const float* W, int ldw, int k0, int n0, unsigned char* WT, int ldt, int drow0, int dk0, float sc, LAS float* scr, int lane) {
#pragma unroll 8
    for (int i = 0; i < 32; ++i) { const int kk = 2 * i + (lane >> 5); scr[kk * 33 + (lane & 31)] = W[(size_t)(k0 + kk) * ldw + n0 + (lane & 31)] * sc; }
    LDS_WAIT(); asm volatile("" ::: "memory");
    const int c = lane & 3;
#pragma unroll
    for (int j = 0; j < 2; ++j) { const int n = (lane >> 2) + 16 * j; const LAS float* s = scr + (16 * c) * 33 + n;
        u32x4 o; o.x = pk4_fp8(s[0 * 33], s[1 * 33], s[2 * 33], s[3 * 33]); o.y = pk4_fp8(s[4 * 33], s[5 * 33], s[6 * 33], s[7 * 33]);
        o.z = pk4_fp8(s[8 * 33], s[9 * 33], s[10 * 33], s[11 * 33]); o.w = pk4_fp8(s[12 * 33], s[13 * 33], s[14 * 33], s[15 * 33]);
        *(u32x4*)(WT + (size_t)(drow0 + n) * ldt + dk0 + k0 + 16 * c) = o; }
    LDS_WAIT(); asm volatile("" ::: "memory");
}

__device__ __forceinline__ void p0_prologue(Frame& F) {
    LAS float* scr = (LAS float*)(F.lds + F.wave * 16384);
    const int gw = F.vcu * NWAVES + F.wave, NGW = F.G * NWAVES, lane = F.lane;
    bf16_t* WIN_T = (bf16_t*)(F.ws + WS_WIN_T); bf16_t* WP_T = (bf16_t*)(F.ws + WS_WP_T); bf16_t* WOUT_T = (bf16_t*)(F.ws + WS_WOUT_T);
    bf16_t* WGU_T = (bf16_t*)(F.ws + WS_WGU_T); bf16_t* WD_T = (bf16_t*)(F.ws + WS_WD_T); bf16_t* WA_T = (bf16_t*)(F.ws + WS_WA_T); bf16_t* WX_T = (bf16_t*)(F.ws + WS_WX_T);
    constexpr int I_IN = 32 * 288, I_PR = 16 * 64, I_OUT = 32 * 64, I_EX = 512 * NE, I_LRU = 128;
    constexpr int NITEMS = I_IN + 2 * I_PR + I_OUT + 3 * I_EX + I_LRU;
    const TrSrc src{F.in[2], F.in[10], F.in[11], F.in[12], F.in[18], F.in[19], F.in[20], F.ws};
    for (int it = gw; it < TR_I_IN; it += 2 * NGW) {
        const int it2 = it + NGW; const bool two = it2 < TR_I_IN;
        TrDesc d0 = tr_decode(src, it), d1 = d0; f32x4 v0[16], v1[16];
        tr_load(d0, v0, lane);
        if (two) { d1 = tr_decode(src, it2); tr_load(d1, v1, lane); }
        tr_store(d0, v0, lane);
        if (two) tr_store(d1, v1, lane);
    }
    for (int r = gw; r < 128; r += NGW) { const int which = r / 64, rr = r % 64, nb = rr / 8, r8 = rr % 8;
        tr_item(F.in[which ? 7 : 5] + (size_t)nb * LBD * LBD, LBD, 64 * (r8 / 4), 32 * (r8 % 4), (which ? WX_T : WA_T) + (size_t)nb * LBD * LBD, LBD, 32 * (r8 % 4), 0, scr, lane); }
    { float* WR_T = (float*)(F.ws + WS_WR_T); const float* gf = F.in[13]; const float* wg = F.in[14]; const float* we = F.in[16];
      for (int i = (F.vcu * NTHR + F.tid); i < 64 * D; i += F.G * NTHR) { const int col = i / D, k = i % D;
          float v = 0.f; if (col < 32) v = we[(size_t)k * NE + col] * gf[k]; else if (col < 36) v = wg[(size_t)k * NG + (col - 32)] * gf[k];
          WR_T[i] = v; } }
    { const float* x = F.in[0]; const float* g = F.in[1]; bf16_t* XN = (bf16_t*)(F.ws + WS_XN);
      f32x4 gv[8];
#pragma unroll
      for (int j = 0; j < 8; ++j) gv[j] = ((const f32x4*)g)[lane + 64 * j];
      for (int m0 = gw; m0 < T; m0 += 2 * NGW) {
          f32x4 va[8], vb[8];
          { const f32x4* xa = (const f32x4*)(x + (size_t)m0 * D) + lane; const f32x4* xb = (const f32x4*)(x + (size_t)(m0 + NGW) * D) + lane;
#pragma unroll
            for (int j = 0; j < 8; ++j) va[j] = xa[64 * j];
#pragma unroll
            for (int j = 0; j < 8; ++j) vb[j] = xb[64 * j]; }
#pragma unroll
          for (int half = 0; half < 2; ++half) { const int m = m0 + half * NGW; f32x4 (&v)[8] = half ? vb : va; float s = 0.f;
#pragma unroll
              for (int j = 0; j < 8; ++j) s += (v[j].x * v[j].x + v[j].y * v[j].y) + (v[j].z * v[j].z + v[j].w * v[j].w);
              const float r = rsqrtf(wave_sum(s) * (1.f / D) + RMS_EPS);
              if (IN_NF8 > 0) { unsigned* o = (unsigned*)((unsigned char*)F.out + (size_t)m * D) + lane; const float r8 = r * Q_SA_IN;
#pragma unroll
                  for (int j = 0; j < 8; ++j) o[64 * j] = pk4_q<QM_IN>(v[j].x * r8 * gv[j].x, v[j].y * r8 * gv[j].y, v[j].z * r8 * gv[j].z, v[j].w * r8 * gv[j].w); }
              if (IN_NBF > 0) { u32x2* o = (u32x2*)(XN + (size_t)m * D) + lane;
#pragma unroll
                  for (int j = 0; j < 8; ++j) { u32x2 w; w.x = cvt_pk_bf16(v[j].x * r * gv[j].x, v[j].y * r * gv[j].y); w.y = cvt_pk_bf16(v[j].z * r * gv[j].z, v[j].w * r * gv[j].w); o[64 * j] = w; } }
          }
      } }
}


template <bool SPLIT> __device__ __forceinline__ void quant_row(Frame& F, const bf16_t* src, unsigned char* dst, float* rs, int t) {
    const int lane = F.lane; const u32x4* p = (const u32x4*)(src + (size_t)t * 2048) + lane; u32x4 v[4];
#pragma unroll
    for (int j = 0; j < 4; ++j) v[j] = p[64 * j];
    float mx[2] = {0.f, 0.f};
#pragma unroll
    for (int j = 0; j < 4; ++j) { const unsigned w[4] = {v[j].x, v[j].y, v[j].z, v[j].w}; float m = 0.f;
#pragma unroll
        for (int e = 0; e < 4; ++e) m = fmaxf(m, fmaxf(fabsf(bf_lo(w[e])), fabsf(bf_hi(w[e]))));
        mx[j >> 1] = fmaxf(mx[j >> 1], m); }
#pragma unroll
    for (int o = 1; o < 64; o <<= 1) { mx[0] = fmaxf(mx[0], __shfl_xor(mx[0], o)); mx[1] = fmaxf(mx[1], __shfl_xor(mx[1], o)); }
    if (!SPLIT) { mx[0] = fmaxf(mx[0], mx[1]); mx[1] = mx[0]; }
    const float q0 = 127.f / fmaxf(mx[0], 1e-30f), q1 = 127.f / fmaxf(mx[1], 1e-30f);
    if (lane == 0) { if (SPLIT) { rs[2 * (size_t)t] = mx[0] * (1.f / 127.f); rs[2 * (size_t)t + 1] = mx[1] * (1.f / 127.f); } else rs[t] = mx[0] * (1.f / 127.f); }
    u32x2* o = (u32x2*)(dst + (size_t)t * 2048) + lane;
#pragma unroll
    for (int j = 0; j < 4; ++j) { const float q = (j >> 1) ? q1 : q0; u32x2 w;
        w.x = pk4_i8(bf_lo(v[j].x) * q, bf_hi(v[j].x) * q, bf_lo(v[j].y) * q, bf_hi(v[j].y) * q); w.y = pk4_i8(bf_lo(v[j].z) * q, bf_hi(v[j].z) * q, bf_lo(v[j].w) * q, bf_hi(v[j].w) * q);
        o[64 * j] = w; }
}

__device__ __forceinline__ void final_norm(Frame& F) {
    const int gw = F.vcu * NWAVES + F.wave, NGW = F.G * NWAVES, lane = F.lane;
    const float* g = F.in[21]; const bf16_t* Y = (const bf16_t*)(F.ws + WS_Y);
    f32x4 gv[8];
#pragma unroll
    for (int j = 0; j < 8; ++j) gv[j] = ((const f32x4*)g)[lane + 64 * j];
    for (int m = gw; m < T; m += NGW) {
        f32x4* xr = (f32x4*)(F.out + (size_t)m * D) + lane; f32x4 v[8]; float s = 0.f;
        { const u32x2* dl = (const u32x2*)((const bf16_t*)(F.ws + WS_DELTA) + (size_t)m * D) + lane;
#pragma unroll
          for (int j = 0; j < 8; ++j) { const u32x2 dd = dl[64 * j]; v[j].x = bf_lo(dd.x); v[j].y = bf_hi(dd.x); v[j].z = bf_lo(dd.y); v[j].w = bf_hi(dd.y); } }
#if EN_MOE
        const unsigned* y0 = (const unsigned*)((const unsigned char*)Y + (size_t)m * D) + lane; const unsigned* y1 = (const unsigned*)((const unsigned char*)Y + (size_t)(T + m) * D) + lane;
#pragma unroll
        for (int j = 0; j < 8; ++j) { const int a = (int)y0[64 * j], b = (int)y1[64 * j];
            const f32x2 al = __builtin_amdgcn_cvt_pk_f32_fp8(a, false), ah = __builtin_amdgcn_cvt_pk_f32_fp8(a, true), bl = __builtin_amdgcn_cvt_pk_f32_fp8(b, false), bh = __builtin_amdgcn_cvt_pk_f32_fp8(b, true);
            v[j].x += (al.x + bl.x) * (1.f / FP8_SY); v[j].y += (al.y + bl.y) * (1.f / FP8_SY); v[j].z += (ah.x + bh.x) * (1.f / FP8_SY); v[j].w += (ah.y + bh.y) * (1.f / FP8_SY); }
#endif
#pragma unroll
        for (int j = 0; j < 8; ++j) s += (v[j].x * v[j].x + v[j].y * v[j].y) + (v[j].z * v[j].z + v[j].w * v[j].w);
        const float r = rsqrtf(wave_sum(s) * (1.f / D) + RMS_EPS);
#pragma unroll
        for (int j = 0; j < 8; ++j) { f32x4 o; o.x = v[j].x * r * gv[j].x; o.y = v[j].y * r * gv[j].y; o.z = v[j].z * r * gv[j].z; o.w = v[j].w * r * gv[j].w; xr[64 * j] = o; }
    }
}
__device__ __forceinline__ int xc_addr(int bl, int row, int c16) { return bl * 65536 + row * 256 + ((c16 ^ (row & 15)) << 4); }
template <bool FINAL>
__device__ __forceinline__ void scan_unit(Frame& F, int b, int chunk, int cq) {
    const int tid = F.tid, lane = F.lane, wave = F.wave;
    const bf16_t* XREC = (const bf16_t*)(F.ws + WS_XREC);
    const size_t t0 = (size_t)b * S + (size_t)chunk * 256; const int ch0 = cq * 256;
    {
        const int cg = tid & 31, tg = tid >> 5, ch = ch0 + 8 * cg, r0 = 16 * tg;
        const float* cw = F.in[3]; const float* cb = F.in[4];
        float w[4][8], bias[8];
#pragma unroll
        for (int k = 0; k < 4; ++k) { const f32x4 a = *(const f32x4*)(cw + k * LW + ch), c = *(const f32x4*)(cw + k * LW + ch + 4);
            w[k][0] = a.x; w[k][1] = a.y; w[k][2] = a.z; w[k][3] = a.w; w[k][4] = c.x; w[k][5] = c.y; w[k][6] = c.z; w[k][7] = c.w; }
        { const f32x4 a = *(const f32x4*)(cb + ch), c = *(const f32x4*)(cb + ch + 4); bias[0] = a.x; bias[1] = a.y; bias[2] = a.z; bias[3] = a.w; bias[4] = c.x; bias[5] = c.y; bias[6] = c.z; bias[7] = c.w; }
        float xm[3][8];
#pragma unroll
        for (int i = 0; i < 3; ++i) { const int rr = r0 - 3 + i; const bool live = chunk > 0 || rr >= 0;
            u32x4 v = *(const u32x4*)(XREC + (size_t)((long)t0 + (live ? rr : 0)) * LW + ch); if (!live) v = (u32x4){0u, 0u, 0u, 0u};
            xm[i][0] = bf_lo(v.x); xm[i][1] = bf_hi(v.x); xm[i][2] = bf_lo(v.y); xm[i][3] = bf_hi(v.y); xm[i][4] = bf_lo(v.z); xm[i][5] = bf_hi(v.z); xm[i][6] = bf_lo(v.w); xm[i][7] = bf_hi(v.w); }
        const int bl = cg >> 4, c16 = cg & 15;
        u32x4 xv[16];
#pragma unroll
        for (int r = 0; r < 16; ++r) xv[r] = *(const u32x4*)(XREC + (t0 + r0 + r) * LW + ch);
#pragma unroll
        for (int r = 0; r < 16; ++r) {
            const u32x4 v = xv[r];
            float x0[8]; x0[0] = bf_lo(v.x); x0[1] = bf_hi(v.x); x0[2] = bf_lo(v.y); x0[3] = bf_hi(v.y); x0[4] = bf_lo(v.z); x0[5] = bf_hi(v.z); x0[6] = bf_lo(v.w); x0[7] = bf_hi(v.w);
            float y[8];
#pragma unroll
            for (int c = 0; c < 8; ++c) { y[c] = bias[c] + w[0][c] * xm[0][c] + w[1][c] * xm[1][c] + w[2][c] * xm[2][c] + w[3][c] * x0[c]; xm[0][c] = xm[1][c]; xm[1][c] = xm[2][c]; xm[2][c] = x0[c]; }
            u32x4 o; o.x = cvt_pk_bf16(y[0], y[1]); o.y = cvt_pk_bf16(y[2], y[3]); o.z = cvt_pk_bf16(y[4], y[5]); o.w = cvt_pk_bf16(y[6], y[7]);
            *(LAS u32x4*)(F.lds + xc_addr(bl, r0 + r, c16)) = o;
        }
    }
    __syncthreads();
    {
        const int r32 = lane & 31, hi = lane >> 5, bl = wave >> 2, nb = 2 * cq + bl, dl = 32 * (wave & 3) + r32, d = nb * LBD + dl;
        const bf16_t* WA_T = (const bf16_t*)(F.ws + WS_WA_T); const bf16_t* WX_T = (const bf16_t*)(F.ws + WS_WX_T);
        bf16x8 wa[8], wx[8];
#pragma unroll
        for (int ks = 0; ks < 8; ++ks) { wa[ks] = *(const bf16x8*)(WA_T + ((size_t)nb * LBD + dl) * LBD + 16 * ks + 8 * hi); wx[ks] = *(const bf16x8*)(WX_T + ((size_t)nb * LBD + dl) * LBD + 16 * ks + 8 * hi); }
        const float ba = F.in[6][d], bx = F.in[8][d], lam = F.in[9][d];
        const float cl = -8.0f * log1pf(expf(-lam));
        float hc = 0.f, Atot = 1.f;
        float* SSUM = (float*)(F.ws + WS_SSUM);
        if (FINAL) {
#pragma unroll 1
            for (int j0 = 0; j0 < chunk; j0 += 8) { f32x2 sv[8];
#pragma unroll
                for (int j = 0; j < 8; ++j) sv[j] = *(const f32x2*)(SSUM + (((size_t)b * NBLK + j0 + j) * LW + d) * 2);
#pragma unroll
                for (int j = 0; j < 8; ++j) { const bool ok = (j0 + j) < chunk; hc = ok ? (sv[j].x * hc + sv[j].y) : hc; } } }
        const bf16_t* GREC = (const bf16_t*)(F.ws + WS_GREC); bf16_t* YCAT = (bf16_t*)(F.ws + WS_YCAT);
#pragma unroll 1
        for (int tt = 0; tt < 8; ++tt) {
            f32x16 ar = {}, ai = {};
            bf16x8 am[8]; bf16_t xcr[16];
#pragma unroll
            for (int ks = 0; ks < 8; ++ks) am[ks] = *(const LAS bf16x8*)(F.lds + xc_addr(bl, 32 * tt + r32, 2 * ks + hi));
#pragma unroll
            for (int r = 0; r < 16; ++r) { const int row = 32 * tt + (r & 3) + 8 * (r >> 2) + 4 * hi; xcr[r] = *(const LAS bf16_t*)(F.lds + xc_addr(bl, row, dl >> 3) + (dl & 7) * 2); }
            __builtin_amdgcn_sched_barrier(0);
#pragma unroll
            for (int ks = 0; ks < 8; ++ks) { ar = __builtin_amdgcn_mfma_f32_32x32x16_bf16(am[ks], wa[ks], ar, 0, 0, 0); ai = __builtin_amdgcn_mfma_f32_32x32x16_bf16(am[ks], wx[ks], ai, 0, 0, 0); }
            float av[16], bv[16], lav[16];
#pragma unroll
            for (int r = 0; r < 16; ++r) {
                const float xc = bf2f(xcr[r]);
                const float rg = fsigmoid(ar[r] + ba), ig = fsigmoid(ai[r] + bx);
                const float la = cl * rg; av[r] = __builtin_amdgcn_exp2f(la * 1.4426950408889634f); lav[r] = la; const float x2 = 2.0f * la;
                const float em = -x2 * (1.0f + x2 * (0.5f + x2 * (0.16666667f + x2 * (0.041666668f + x2 * 0.0083333338f))));
                bv[r] = __builtin_amdgcn_sqrtf(em) * ig * xc; }
            if (!FINAL) {
                int ttv = tt; asm volatile("" : "+v"(ttv));
                const unsigned rl = 32u * (unsigned)ttv + 4u * (unsigned)hi; unsigned* AB = (unsigned*)F.out + (size_t)F.vcu * 65536 + (unsigned)(d & 255);
#pragma unroll
                for (int r = 0; r < 16; ++r) AB[(rl + (unsigned)((r & 3) + 8 * (r >> 2))) * 256u] = cvt_pk_bf16(lav[r], bv[r]);
            }
            float Ag[4], Hg[4], hl[16], Ac[16];
#pragma unroll
            for (int g = 0; g < 4; ++g) { float A = 1.f, H = 0.f;
#pragma unroll
                for (int j = 0; j < 4; ++j) { const int r = 4 * g + j; H = av[r] * H + bv[r]; A *= av[r]; hl[r] = H; Ac[r] = A; }
                Ag[g] = A; Hg[g] = H; }
            float hin[4];
#pragma unroll
            for (int g = 0; g < 4; ++g) { const float Ao = __shfl_xor(Ag[g], 32), Ho = __shfl_xor(Hg[g], 32);
                const float A0 = hi ? Ao : Ag[g], H0 = hi ? Ho : Hg[g], A1 = hi ? Ag[g] : Ao, H1 = hi ? Hg[g] : Ho;
                const float h0 = hc; hc = A0 * hc + H0; const float h1 = hc; hc = A1 * hc + H1; hin[g] = hi ? h1 : h0; Atot *= A0 * A1; }
            if (FINAL) {
                int ttv = tt; asm volatile("" : "+v"(ttv));
                const unsigned rb = (unsigned)t0 + 32u * (unsigned)ttv + 4u * (unsigned)hi;
#pragma unroll
                for (int r = 0; r < 16; ++r) { const unsigned t = rb + (unsigned)((r & 3) + 8 * (r >> 2)); const float hf = hl[r] + Ac[r] * hin[r >> 2];
                    const float gr = bf2f(GREC[t * (unsigned)LW + (unsigned)d]);
                    YCAT[t * 2048u + (unsigned)d] = (bf16_t)(cvt_pk_bf16(hf * gr, 0.f) & 0xffffu);
                    if ((r & 3) == 3) asm volatile("" ::: "memory"); }
            }
        }
        if (!FINAL && hi == 0) {
            const unsigned long long sv = ((unsigned long long)__float_as_uint(hc) << 32) | (unsigned long long)__float_as_uint(Atot);
            __hip_atomic_store((unsigned long long*)(SSUM + (((size_t)b * NBLK + chunk) * LW + d) * 2), sv, __ATOMIC_RELAXED, __HIP_MEMORY_SCOPE_AGENT); }
    }
    __syncthreads();
}


__device__ __forceinline__ void scan_fix(Frame& F, int task) {
    const int lane = F.lane, r32 = lane & 31, hi = lane >> 5;
    const int cg = task & 31, chunk = (task >> 5) & 31, b = task >> 10, d = cg * 32 + r32;
    const size_t t0 = (size_t)b * S + (size_t)chunk * 256;
    const float* SSUM = (const float*)(F.ws + WS_SSUM); const unsigned* AB = (const unsigned*)F.out + (size_t)F.vcu * 65536 + (unsigned)(d & 255);
    const bf16_t* GREC = (const bf16_t*)(F.ws + WS_GREC); bf16_t* YCAT = (bf16_t*)(F.ws + WS_YCAT);
    float hc = 0.f;
    unsigned abA[16]; bf16_t grA[16];
    { const unsigned rb = (unsigned)t0 + 4u * (unsigned)hi;
#pragma unroll
      for (int r = 0; r < 16; ++r) { const unsigned ro = (unsigned)((r & 3) + 8 * (r >> 2)); const unsigned t = rb + ro; abA[r] = AB[(4u * (unsigned)hi + ro) * 256u]; grA[r] = GREC[t * (unsigned)LW + (unsigned)d]; } }
#pragma unroll 1
    for (int j0 = 0; j0 < chunk; j0 += 16) { f32x2 sv[16];
#pragma unroll
        for (int j = 0; j < 16; ++j) { const unsigned long long q = __hip_atomic_load((const unsigned long long*)(SSUM + (((size_t)b * NBLK + j0 + j) * LW + d) * 2), __ATOMIC_RELAXED, __HIP_MEMORY_SCOPE_AGENT);
            sv[j].x = __uint_as_float((unsigned)q); sv[j].y = __uint_as_float((unsigned)(q >> 32)); }
#pragma unroll
        for (int j = 0; j < 16; ++j) { const bool ok = (j0 + j) < chunk; hc = ok ? (sv[j].x * hc + sv[j].y) : hc; } }
#define SF_LOAD(TT, ABV, GRV) do { int ttv = (TT); asm volatile("" : "+v"(ttv)); const unsigned rb = (unsigned)t0 + 32u * (unsigned)ttv + 4u * (unsigned)hi; \
        _Pragma("unroll") for (int r = 0; r < 16; ++r) { const unsigned ro = (unsigned)((r & 3) + 8 * (r >> 2)); const unsigned t = rb + ro; ABV[r] = AB[(32u * (unsigned)ttv + 4u * (unsigned)hi + ro) * 256u]; GRV[r] = GREC[t * (unsigned)LW + (unsigned)d]; } } while (0)
#define SF_STEP(TT, ABV, GRV) do { int ttv = (TT); asm volatile("" : "+v"(ttv)); const unsigned rb = (unsigned)t0 + 32u * (unsigned)ttv + 4u * (unsigned)hi; \
        float av[16], bv[16]; \
        _Pragma("unroll") for (int r = 0; r < 16; ++r) { av[r] = __builtin_amdgcn_exp2f(bf_lo(ABV[r]) * 1.4426950408889634f); bv[r] = bf_hi(ABV[r]); } \
        float Ag[4], Hg[4], hl[16], Ac[16]; \
        _Pragma("unroll") for (int g = 0; g < 4; ++g) { float A = 1.f, H = 0.f; \
            _Pragma("unroll") for (int j = 0; j < 4; ++j) { const int r = 4 * g + j; H = av[r] * H + bv[r]; A *= av[r]; hl[r] = H; Ac[r] = A; } \
            Ag[g] = A; Hg[g] = H; } \
        float hin[4]; \
        _Pragma("unroll") for (int g = 0; g < 4; ++g) { const float Ao = __shfl_xor(Ag[g], 32), Ho = __shfl_xor(Hg[g], 32); \
            const float A0 = hi ? Ao : Ag[g], H0 = hi ? Ho : Hg[g], A1 = hi ? Ag[g] : Ao, H1 = hi ? Hg[g] : Ho; \
            const float h0 = hc; hc = A0 * hc + H0; const float h1 = hc; hc = A1 * hc + H1; hin[g] = hi ? h1 : h0; } \
        _Pragma("unroll") for (int r = 0; r < 16; ++r) { const unsigned t = rb + (unsigned)((r & 3) + 8 * (r >> 2)); const float hf = hl[r] + Ac[r] * hin[r >> 2]; \
            YCAT[t * 2048u + (unsigned)d] = (bf16_t)(cvt_pk_bf16(hf * bf2f(GRV[r]), 0.f) & 0xffffu); } } while (0)
    unsigned abB[16]; bf16_t grB[16];
#pragma unroll 1
    for (int tt = 0; tt < 8; tt += 2) {
        SF_LOAD(tt + 1, abB, grB);
        SF_STEP(tt, abA, grA);
        if (tt + 2 < 8) SF_LOAD(tt + 2, abA, grA);
        SF_STEP(tt + 1, abB, grB);
    }
#undef SF_LOAD
#undef SF_STEP
}

__device__ __forceinline__ void kmean_unit(Frame& F, int u) {
    const int tid = F.tid; const int bh = u >> 5, n = u & 31, b = bh >> 3, h = bh & 7;
    const bf16_t* Kp = (const bf16_t*)(F.ws + WS_K) + ((size_t)b * S + (size_t)n * 256) * AW + h * HD;
    const int rg = tid >> 4, cc = tid & 15; float s[8] = {0.f, 0.f, 0.f, 0.f, 0.f, 0.f, 0.f, 0.f}; float sq[8][8];
#pragma unroll
    for (int i = 0; i < 8; ++i) { const u32x4 v = *(const u32x4*)(Kp + (size_t)(rg + 32 * i) * AW + 8 * cc);
        const float e[8] = {bf_lo(v.x), bf_hi(v.x), bf_lo(v.y), bf_hi(v.y), bf_lo(v.z), bf_hi(v.z), bf_lo(v.w), bf_hi(v.w)};
#pragma unroll
        for (int c = 0; c < 8; ++c) { s[c] += e[c]; sq[i][c] = e[c] * e[c]; } }
    LAS float* part = (LAS float*)F.lds; LAS float* nmx = part + 32 * 128;
#pragma unroll
    for (int c = 0; c < 8; ++c) part[rg * 128 + 8 * cc + c] = s[c];
    { float mx = 0.f;
#pragma unroll
      for (int i = 0; i < 8; ++i) { float q = 0.f;
#pragma unroll
          for (int c = 0; c < 8; ++c) q += sq[i][c];
          q += __shfl_xor(q, 1); q += __shfl_xor(q, 2); q += __shfl_xor(q, 4); q += __shfl_xor(q, 8); mx = fmaxf(mx, q); }
      if (cc == 0) nmx[rg] = mx; }
    __syncthreads();
    if (tid == 0) { float m = 0.f; for (int r = 0; r < 32; ++r) m = fmaxf(m, nmx[r]); ((float*)(F.ws + WS_KNORM))[u] = m; }
    if (tid < 128) { float a = 0.f;
#pragma unroll 8
        for (int r = 0; r < 32; ++r) a += part[r * 128 + tid];
        const float mean = a * (1.f / 256.f); ((float*)(F.ws + WS_KMEAN))[(size_t)u * 128 + tid] = mean;
        const unsigned hb = cvt_pk_bf16(mean, 0.f) & 0xffffu; const float lo = mean - __uint_as_float(hb << 16);
        ((bf16_t*)(F.ws + WS_KMH))[(size_t)u * 128 + tid] = (bf16_t)hb; ((bf16_t*)(F.ws + WS_KML))[(size_t)u * 128 + tid] = (bf16_t)(cvt_pk_bf16(lo, 0.f) & 0xffffu); }
    __syncthreads();
}

__device__ __forceinline__ void route_phase(Frame& F) {
    const int tid = F.tid, lane = F.lane, wave = F.wave, r32 = lane & 31, hi = lane >> 5;
    constexpr int NU = NB * NH * 16;
    LAS int* lcnt = (LAS int*)(F.lds + 16384); LAS int* lbase = lcnt + 32; LAS float* knl = (LAS float*)(lbase + 32);
    constexpr int GPP = 35;
    LAS float* gp = (LAS float*)(F.lds + 32768);
    bf16x8 qa[2][8], ka[2][8], bhv[8], blv[8]; float knv = 0.f;
#define ROUTE_LOAD(U) do { const int _bh = (U) >> 4, _j0 = 1 + 2 * ((U) & 15), _b = _bh >> 3, _h = _bh & 7; \
        const bf16_t* mh = (const bf16_t*)(F.ws + WS_KMH) + ((size_t)_bh * 32 + r32) * 128 + 8 * hi; const bf16_t* ml = (const bf16_t*)(F.ws + WS_KML) + ((size_t)_bh * 32 + r32) * 128 + 8 * hi; \
        _Pragma("unroll") for (int hf = 0; hf < 2; ++hf) { const int _jj = (_j0 + hf <= 31) ? _j0 + hf : _j0; \
            const size_t trow = (size_t)_b * S + (size_t)_jj * 256 + wave * 32 + r32; \
            const bf16_t* qp = (const bf16_t*)(F.ws + WS_Q) + trow * AW + _h * HD + 8 * hi; const bf16_t* kp = (const bf16_t*)(F.ws + WS_K) + trow * AW + _h * HD + 8 * hi; \
            _Pragma("unroll") for (int ks = 0; ks < 8; ++ks) { qa[hf][ks] = *(const bf16x8*)(qp + 16 * ks); ka[hf][ks] = *(const bf16x8*)(kp + 16 * ks); } } \
        _Pragma("unroll") for (int ks = 0; ks < 8; ++ks) { bhv[ks] = *(const bf16x8*)(mh + 16 * ks); blv[ks] = *(const bf16x8*)(ml + 16 * ks); } \
        knv = ((const float*)(F.ws + WS_KNORM))[_bh * 32 + r32]; } while (0)
    int u = F.vcu; if (u >= NU) return;
    ROUTE_LOAD(u);
    for (;;) {
        const int un = u + F.G; const int bh = u >> 4, j0 = 1 + 2 * (u & 15), b = bh >> 3, h = bh & 7; const int jmax = (j0 + 1 <= 31) ? j0 + 1 : j0;
        if (tid < 32) { lcnt[tid] = 0; knl[tid] = knv; }
#pragma unroll
        for (int hf = 0; hf < 2; ++hf) {
            f32x16 acc = {};
#pragma unroll
            for (int ks = 0; ks < 8; ++ks) { acc = __builtin_amdgcn_mfma_f32_32x32x16_bf16(qa[hf][ks], bhv[ks], acc, 0, 0, 0); acc = __builtin_amdgcn_mfma_f32_32x32x16_bf16(qa[hf][ks], blv[ks], acc, 0, 0, 0); }
            float qq = 0.f, qk = 0.f;
#pragma unroll
            for (int ks = 0; ks < 8; ++ks)
#pragma unroll
                for (int e = 0; e < 8; ++e) { const float qv = bf2f((bf16_t)qa[hf][ks][e]), kv = bf2f((bf16_t)ka[hf][ks][e]); qq += qv * qv; qk += qv * kv; }
            qq += __shfl_xor(qq, 32); qk += __shfl_xor(qk, 32);
            const int qb = hf * 256 + wave * 32;
#pragma unroll
            for (int r = 0; r < 16; ++r) gp[(qb + (r & 3) + 8 * (r >> 2) + 4 * hi) * GPP + r32] = acc[r];
            if (hi == 0) { gp[(qb + r32) * GPP + 32] = qq; gp[(qb + r32) * GPP + 33] = qk; }
        }
        __syncthreads();
        if (un < NU) ROUTE_LOAD(un);
        int sel[3] = {-1, -1, -1}, slot[3] = {0, 0, 0};
        const int j = j0 + (tid >> 8), qi = tid & 255; const bool live = j <= 31;
        if (live) {
            float bv[3] = {-3.0e38f, -3.0e38f, -3.0e38f};
#pragma unroll 1
            for (int n = 0; n < j; ++n) {
                const float g = gp[tid * GPP + n];
                if (g > bv[0]) { bv[2] = bv[1]; sel[2] = sel[1]; bv[1] = bv[0]; sel[1] = sel[0]; bv[0] = g; sel[0] = n; }
                else if (g > bv[1]) { bv[2] = bv[1]; sel[2] = sel[1]; bv[1] = g; sel[1] = n; }
                else if (g > bv[2]) { bv[2] = g; sel[2] = n; }
            }
            { const float qn = sqrtf(gp[tid * GPP + 32]), sself = 0.088388347648318440f * gp[tid * GPP + 33];
              const float slope = exp2f(-(float)(h + 1)); float* LSE = (float*)(F.ws + WS_LSE);
#pragma unroll
              for (int k = 0; k < 3; ++k) if (sel[k] >= 0) { const int n = sel[k]; const float dmin = (float)((j - n - 1) * 256 + qi + 1);
                  const float ub = 0.088388347648318440f * qn * sqrtf(knl[n]) * 1.0001f - slope * dmin;
                  if (ub < sself - 110.f) { LSE[(((size_t)b * S + (size_t)j * 256 + qi) * NH + h) * 4 + k] = -3.0e38f; sel[k] = -1 - n; } } }
#pragma unroll
            for (int k = 0; k < 3; ++k) if (sel[k] >= 0) slot[k] = __hip_atomic_fetch_add(lcnt + sel[k], 1, __ATOMIC_RELAXED, __HIP_MEMORY_SCOPE_WORKGROUP);
        }
        __syncthreads();
        if (tid < jmax) lbase[tid] = (int)atomicAdd(F.ctl + CW_ACNT + bh * 32 + tid, (unsigned)lcnt[tid]);
        __syncthreads();
        if (live) { unsigned* AL = (unsigned*)(F.ws + WS_ALIST) + (size_t)bh * ALIST_PER_BH;
#pragma unroll
            for (int k = 0; k < 3; ++k) if (sel[k] >= 0) AL[alist_off(sel[k]) + lbase[sel[k]] + slot[k]] = ((unsigned)(j * 256 + qi) << 2) | (unsigned)k; }
        __syncthreads();
        if (un >= NU) break;
        u = un;
    }
#undef ROUTE_LOAD
}
namespace att {
constexpr int KVBLK = 64, LDK = AW;
constexpr float SCALE = 0.088388347648318440f;
constexpr float THR = 8.f;
constexpr size_t SHM_V = KVBLK * HD * 2, SHM_K = KVBLK * HD * 2;
#define KSWZ(row, colB) ((row) * 256 + ((colB) ^ (((row) & 7) << 4)))
#define SBAR() __builtin_amdgcn_sched_barrier(0)
__device__ __forceinline__ int crow(int r, int hi) { return (r & 3) + 8 * (r >> 2) + 4 * hi; }
__device__ __forceinline__ void partialSM(f32x16& p0, f32x16& p1, float& m_reg, float& mn, float& alpha) {
  constexpr float C = SCALE * 1.4426950408889634f;
  float pmax = p0[0];
#pragma unroll
  for (int r = 1; r < 16; ++r) pmax = fmaxf(pmax, p0[r]);
#pragma unroll
  for (int r = 0; r < 16; ++r) pmax = fmaxf(pmax, p1[r]);
  { auto rr = __builtin_amdgcn_permlane32_swap(__float_as_uint(pmax), __float_as_uint(pmax), false, false);
    pmax = fmaxf(__uint_as_float(rr[0]), __uint_as_float(rr[1])); }
  if (__builtin_expect(__all(pmax - m_reg <= THR / SCALE), 1)) { mn = m_reg; alpha = 1.f; }
  else { mn = fmaxf(m_reg, pmax); alpha = __builtin_amdgcn_exp2f((m_reg - mn) * C); m_reg = mn; }
  const float mnC = -mn * C;
#pragma unroll
  for (int r = 0; r < 16; ++r) p0[r] = fmaf(p0[r], C, mnC);
#pragma unroll
  for (int r = 0; r < 16; ++r) p1[r] = fmaf(p1[r], C, mnC);
#pragma unroll
  for (int r = 0; r < 16; ++r) p0[r] = __builtin_amdgcn_exp2f(p0[r]);
}
__device__ __forceinline__ void finishSM(f32x16& p0, f32x16& p1, float alpha, float& l_reg, bf16x8& pa0, bf16x8& pa1, bf16x8& pa2, bf16x8& pa3) {
#pragma unroll
  for (int r = 0; r < 16; ++r) p1[r] = __builtin_amdgcn_exp2f(p1[r]);
  float ps = 0;
#pragma unroll
  for (int r = 0; r < 16; ++r) ps += p0[r];
#pragma unroll
  for (int r = 0; r < 16; ++r) ps += p1[r];
  { auto rr = __builtin_amdgcn_permlane32_swap(__float_as_uint(ps), __float_as_uint(ps), false, false);
    ps = __uint_as_float(rr[0]) + __uint_as_float(rr[1]); }
  l_reg = l_reg * alpha + ps;
#define PK4(P, BASE, OUT) do { unsigned a0 = cvt_pk_bf16(P[BASE + 0], P[BASE + 1]), a1 = cvt_pk_bf16(P[BASE + 2], P[BASE + 3]);   \
    unsigned b0 = cvt_pk_bf16(P[BASE + 4], P[BASE + 5]), b1 = cvt_pk_bf16(P[BASE + 6], P[BASE + 7]);                              \
    auto r0 = __builtin_amdgcn_permlane32_swap(a0, b0, false, false); auto r1 = __builtin_amdgcn_permlane32_swap(a1, b1, false, false); \
    u32x4 w = {r0[0], r1[0], r0[1], r1[1]}; OUT = *reinterpret_cast<bf16x8*>(&w); } while (0)
  PK4(p0, 0, pa0); PK4(p0, 8, pa1); PK4(p1, 0, pa2); PK4(p1, 8, pa3);
#undef PK4
}
__device__ __forceinline__ void qkt_init(f32x16& p0, f32x16& p1, float bq, float slr) {
#pragma unroll
  for (int r = 0; r < 16; ++r) { const int c0 = (r & 3) + 8 * (r >> 2); p0[r] = fmaf(slr, (float)c0, bq); p1[r] = fmaf(slr, (float)(c0 + 32), bq); }
}
__device__ __forceinline__ void qkt_mask(f32x16& p0, f32x16& p1, int lim) {
#pragma unroll
  for (int r = 0; r < 16; ++r) { const int c0 = (r & 3) + 8 * (r >> 2); if (c0 > lim) p0[r] = -1e30f; if (c0 + 32 > lim) p1[r] = -1e30f; }
}
__device__ __forceinline__ void qkt_mma(f32x16& p0, f32x16& p1, const char* Ks, const bf16x8* qr, int r32, int hi) {
#pragma unroll
  for (int d0 = 0; d0 < 8; ++d0) { const int cb = (d0 * 16 + hi * 8) * 2;
    const bf16x8 b0 = *reinterpret_cast<const bf16x8*>(Ks + KSWZ(r32, cb));
    const bf16x8 b1 = *reinterpret_cast<const bf16x8*>(Ks + KSWZ(32 + r32, cb));
    p0 = __builtin_amdgcn_mfma_f32_32x32x16_bf16(b0, qr[d0], p0, 0, 0, 0);
    p1 = __builtin_amdgcn_mfma_f32_32x32x16_bf16(b1, qr[d0], p1, 0, 0, 0); }
}
template <bool OWN>
__device__ __forceinline__ void qkt(f32x16& p0, f32x16& p1, const char* Ks, const bf16x8* qr, int r32, int hi, float bq, float slr, int lim) {
  qkt_init(p0, p1, bq, slr); if (OWN) qkt_mask(p0, p1, lim); qkt_mma(p0, p1, Ks, qr, r32, hi);
}
__device__ __forceinline__ int v_st(int k, int c) { const int kk = (k & ~0xC) | ((k & 4) << 1) | ((k & 8) >> 1); return ((kk >> 3) * 4 + (c >> 5)) * 512 + ((kk & 7) * 32 + (c & 31)) * 2; }
__device__ __forceinline__ int v_rd_base(int lane) { return ((lane & 3) << 3) | (((lane >> 2) & 3) << 6) | (((lane >> 4) & 1) << 5) | (((lane >> 5) & 1) << 8); }
constexpr int v_rd_off(int d0, int ks, int half) { return d0 * 512 + ks * 4096 + half * 2048; }
template <int OFF> __device__ __forceinline__ s16x4 tr_read(int vb) {
  s16x4 r; asm volatile("ds_read_b64_tr_b16 %0, %1 offset:%2" : "=&v"(r) : "v"(vb), "i"(OFF) : "memory"); return r;
}
template <int D0> __device__ __forceinline__ void pv_one(f32x16& od, int vb, bf16x8 pa0, bf16x8 pa1, bf16x8 pa2, bf16x8 pa3) {
  const s16x4 l0 = tr_read<v_rd_off(D0, 0, 0)>(vb), h0 = tr_read<v_rd_off(D0, 0, 1)>(vb), l1 = tr_read<v_rd_off(D0, 1, 0)>(vb), h1 = tr_read<v_rd_off(D0, 1, 1)>(vb);
  const s16x4 l2 = tr_read<v_rd_off(D0, 2, 0)>(vb), h2 = tr_read<v_rd_off(D0, 2, 1)>(vb), l3 = tr_read<v_rd_off(D0, 3, 0)>(vb), h3 = tr_read<v_rd_off(D0, 3, 1)>(vb);
  asm volatile("s_waitcnt lgkmcnt(0)" ::: "memory"); SBAR();
#define PK(L, H) (bf16x8){L[0], L[1], L[2], L[3], H[0], H[1], H[2], H[3]}
  od = __builtin_amdgcn_mfma_f32_32x32x16_bf16(pa0, PK(l0, h0), od, 0, 0, 0);
  od = __builtin_amdgcn_mfma_f32_32x32x16_bf16(pa1, PK(l1, h1), od, 0, 0, 0);
  od = __builtin_amdgcn_mfma_f32_32x32x16_bf16(pa2, PK(l2, h2), od, 0, 0, 0);
  od = __builtin_amdgcn_mfma_f32_32x32x16_bf16(pa3, PK(l3, h3), od, 0, 0, 0);
#undef PK
}
__device__ __forceinline__ void pv_d0(f32x16* o, int vb, bf16x8 pa0, bf16x8 pa1, bf16x8 pa2, bf16x8 pa3) {
  pv_one<0>(o[0], vb, pa0, pa1, pa2, pa3); pv_one<1>(o[1], vb, pa0, pa1, pa2, pa3); pv_one<2>(o[2], vb, pa0, pa1, pa2, pa3); pv_one<3>(o[3], vb, pa0, pa1, pa2, pa3);
}

}
namespace att {
struct Desc { int b, h, n, chunk, cnt, own; };
__device__ __forceinline__ Desc decode(int i, const LAS int* ipre, int nsel, const unsigned* ac) {
  Desc d; int bhn;
  if (i < nsel) { int lo = 0, hi = 1024; while (hi - lo > 1) { const int mid = (lo + hi) >> 1; if (ipre[mid] <= i) lo = mid; else hi = mid; } bhn = lo; d.chunk = i - ipre[lo]; d.cnt = (int)ac[bhn]; d.own = 0; }
  else { bhn = i - nsel; d.chunk = 0; d.cnt = 256; d.own = 1; }
  d.b = bhn >> 8; d.h = (bhn >> 5) & 7; d.n = bhn & 31; return d;
}
__device__ __forceinline__ void phase(Frame& F, const LAS int* ipre, int nsel, const unsigned* ac) {
  char* lds = (char*)(unsigned char*)F.lds;
  const int tid = F.tid, wid = F.wave, lane = F.lane, r32 = lane & 31, hi = lane >> 5;
  const int ntot = nsel + NB * NH * NBLK;
  int it = F.vcu; if (it >= ntot) return;
  const bf16_t* Qg = (const bf16_t*)(F.ws + WS_Q); const bf16_t* Kg = (const bf16_t*)(F.ws + WS_K); const bf16_t* Vg = (const bf16_t*)(F.ws + WS_V);
  const unsigned* AL = (const unsigned*)(F.ws + WS_ALIST);
  bf16_t* PART = (bf16_t*)((unsigned char*)F.out); float* LSE = (float*)(F.ws + WS_LSE);
  bf16_t* V_lds = (bf16_t*)lds; bf16_t* K_lds = (bf16_t*)(lds + 2 * SHM_V);
  float* wsf = (float*)(lds + 2 * SHM_V + 2 * SHM_K) + wid * 64; float* li_l = wsf; float* al_l = wsf + 32;
  const int sr = tid >> 4, sc = (tid & 15) * 8, vst0 = v_st(sr, sc), vst1 = v_st(32 + sr, sc);
  const int vb0 = (int)(uintptr_t)V_lds + v_rd_base(lane);
  struct { bf16x8 vs0, vs1, ks0, ks1; } sr_[2];
  constexpr float C = SCALE * 1.4426950408889634f;
#define SLOADX(i, d, j) do { const size_t _o = ((size_t)(d).b * S + (size_t)(d).n * 256 + 64 * (j) + sr) * AW + (d).h * HD + sc; \
    sr_[i].vs0 = *(const bf16x8*)(Vg + _o); sr_[i].vs1 = *(const bf16x8*)(Vg + _o + (size_t)32 * AW); sr_[i].ks0 = *(const bf16x8*)(Kg + _o); sr_[i].ks1 = *(const bf16x8*)(Kg + _o + (size_t)32 * AW); } while (0)
#define SWRITE(bb, i) do { *(bf16x8*)((char*)V_lds + (bb) * SHM_V + vst0) = sr_[i].vs0;          \
    *(bf16x8*)((char*)V_lds + (bb) * SHM_V + vst1) = sr_[i].vs1; const int kc = sc * 2;               \
    *(bf16x8*)((char*)K_lds + (bb) * SHM_K + KSWZ(sr, kc)) = sr_[i].ks0;                       \
    *(bf16x8*)((char*)K_lds + (bb) * SHM_K + KSWZ(32 + sr, kc)) = sr_[i].ks1; } while (0)
#define RESC(a) do { if (__any((a) < 1.f)) { if (hi == 0) al_l[r32] = (a); asm volatile("s_waitcnt lgkmcnt(0)" ::: "memory"); \
    _Pragma("unroll") for (int d = 0; d < 4; ++d) _Pragma("unroll") for (int r = 0; r < 16; ++r) o[d][r] *= al_l[crow(r, hi)]; } } while (0)
#define LANEQ(d, tq, prow) do { int _ks = 3; bool _v = true; \
    if ((d).own) tq = (d).n * 256 + wid * 32 + r32; \
    else { const int _idx = (d).chunk * 256 + wid * 32 + r32; _v = _idx < (d).cnt; \
      const unsigned _e = AL[(size_t)((d).b * NH + (d).h) * ALIST_PER_BH + alist_off((d).n) + (_v ? _idx : (d).chunk * 256)]; tq = (int)(_e >> 2); _ks = (int)(_e & 3u); } \
    prow = _v ? (int)((((size_t)(d).b * S + tq) * NH + (d).h) * 4 + _ks) : -1; } while (0)
#define QLOAD(d, tq) do { const bf16_t* _q = Qg + ((size_t)(d).b * S + (size_t)(tq)) * AW + (d).h * HD + hi * 8; \
    _Pragma("unroll") for (int d0 = 0; d0 < 8; ++d0) qr[d0] = *(const bf16x8*)(_q + d0 * 16); } while (0)
#define SLR(d) (exp2f(-(float)((d).h + 1)) / SCALE)
#define TJ(d, j) ((d).own ? (j) : 3 - (j))
#define BQ(j) (slr * (float)(dc.n * 256 + 64 * TJ(dc, j) + 4 * hi - tq_c))
#define LIM(j) (wid * 32 + r32 - 64 * (j) - 4 * hi)
#define QKT(p0, p1, buf, j) do { qkt_init(p0, p1, BQ(j), slr); if (dc.own) { int _lim = LIM(j); asm volatile("" : "+v"(_lim)); qkt_mask(p0, p1, _lim); } qkt_mma(p0, p1, buf, qr, r32, hi); } while (0)
#define EPILOGUE() do { const float _lse = m_reg * C + __builtin_amdgcn_logf(l_reg); int* dst_l = (int*)al_l; \
    if (hi == 0) { li_l[r32] = l_reg; dst_l[r32] = prow_p; if (prow_p >= 0) LSE[prow_p] = _lse; } \
    asm volatile("s_waitcnt lgkmcnt(0)" ::: "memory"); \
    _Pragma("unroll") for (int r = 0; r < 16; ++r) { const int rr = crow(r, hi); const float rl = __builtin_amdgcn_rcpf(li_l[rr]); const int pr = dst_l[rr]; \
      if (pr >= 0) { _Pragma("unroll") for (int d0 = 0; d0 < 4; ++d0) PART[(size_t)pr * HD + d0 * 32 + r32] = (bf16_t)cvt_pk_bf16(o[d0][r] * rl, 0.f); } } \
    asm volatile("s_waitcnt lgkmcnt(0)" ::: "memory"); \
    m_reg = -1e30f; l_reg = 0.f; _Pragma("unroll") for (int d = 0; d < 4; ++d) _Pragma("unroll") for (int r = 0; r < 16; ++r) o[d][r] = 0.f; } while (0)

  Desc dc = decode(it, ipre, nsel, ac), dn = dc;
  int tq_c, prow_c, tq_n = 0, prow_n = -1, prow_p = -1;
  LANEQ(dc, tq_c, prow_c);
  float m_reg = -1e30f, l_reg = 0.f; f32x16 o[4] = {}; bf16x8 qr[8];
  QLOAD(dc, tq_c);
  float slr = SLR(dc);
  f32x16 pA0, pA1, pB0, pB1; float mnA, mnB, alA = 1.f, alB = 1.f; bf16x8 pa0, pa1, pa2, pa3;
  constexpr int SE = 0, SO = 1;
  SLOADX(SE, dc, TJ(dc, 0)); SLOADX(SO, dc, TJ(dc, 1));
  SWRITE(0, SE); __syncthreads();
  bool first = true;
  for (;;) {
    const bool has_next = (it + F.G) < ntot;
    SBAR(); QKT(pA0, pA1, (const char*)K_lds, 0);
    if (!first) finishSM(pB0, pB1, alB, l_reg, pa0, pa1, pa2, pa3);
    SBAR(); SLOADX(SE, dc, TJ(dc, 2)); SBAR();
    if (!first) { pv_d0(o, vb0 + (int)SHM_V, pa0, pa1, pa2, pa3); EPILOGUE(); }
    partialSM(pA0, pA1, m_reg, mnA, alA);
    __syncthreads(); SWRITE(1, SO);
    __syncthreads();
    SBAR(); QKT(pB0, pB1, (const char*)K_lds + SHM_K, 1);
    finishSM(pA0, pA1, alA, l_reg, pa0, pa1, pa2, pa3);
    SBAR(); SLOADX(SO, dc, TJ(dc, 3));
    if (has_next) { dn = decode(it + F.G, ipre, nsel, ac); LANEQ(dn, tq_n, prow_n); }
    SBAR();
    pv_d0(o, vb0, pa0, pa1, pa2, pa3); partialSM(pB0, pB1, m_reg, mnB, alB);
    __syncthreads(); SWRITE(0, SE);
    RESC(alB); __syncthreads();
    SBAR(); QKT(pA0, pA1, (const char*)K_lds, 2);
    finishSM(pB0, pB1, alB, l_reg, pa0, pa1, pa2, pa3);
    SBAR(); if (has_next) SLOADX(SE, dn, TJ(dn, 0)); SBAR();
    pv_d0(o, vb0 + (int)SHM_V, pa0, pa1, pa2, pa3); partialSM(pA0, pA1, m_reg, mnA, alA);
    __syncthreads(); SWRITE(1, SO);
    RESC(alA); __syncthreads();
    SBAR(); QKT(pB0, pB1, (const char*)K_lds + SHM_K, 3);
    finishSM(pA0, pA1, alA, l_reg, pa0, pa1, pa2, pa3);
    SBAR(); if (has_next) { SLOADX(SO, dn, TJ(dn, 1)); QLOAD(dn, tq_n); } SBAR();
    pv_d0(o, vb0, pa0, pa1, pa2, pa3); partialSM(pB0, pB1, m_reg, mnB, alB);
    __syncthreads(); if (has_next) SWRITE(0, SE);
    RESC(alB); __syncthreads();
    prow_p = prow_c;
    if (!has_next) break;
    dc = dn; tq_c = tq_n; prow_c = prow_n; slr = SLR(dc); first = false; it += F.G;
  }
  finishSM(pB0, pB1, alB, l_reg, pa0, pa1, pa2, pa3); SBAR();
  pv_d0(o, vb0 + (int)SHM_V, pa0, pa1, pa2, pa3);
  EPILOGUE();
  __syncthreads();
#undef SLOADX
#undef SWRITE
#undef RESC
#undef LANEQ
#undef QLOAD
#undef SLR
#undef BQ
#undef LIM
#undef TJ
#undef QKT
#undef EPILOGUE
}

__device__ __forceinline__ void combine_token(Frame& F, int t, const f32x4 ls, const float* lse_next, f32x4& lsn) {
  const int lane = F.lane, h = lane >> 3, c8 = lane & 7;
  const bf16_t* PART = (const bf16_t*)((unsigned char*)F.out) + ((size_t)t * NH + h) * 4 * HD + 16 * c8;
  const int j = (t & (S - 1)) >> 8;
  float l[4]; bool ok[4]; float M = -3.0e38f;
#pragma unroll
  for (int k = 0; k < 4; ++k) { ok[k] = ((k == 3) || (k < j)) && ls[k] > -1.0e37f; l[k] = ok[k] ? ls[k] : -3.0e38f; M = fmaxf(M, l[k]); }
  u32x4 v[4][2];
#pragma unroll
  for (int k = 0; k < 4; ++k) { v[k][0] = (u32x4){0u, 0u, 0u, 0u}; v[k][1] = (u32x4){0u, 0u, 0u, 0u}; if (ok[k]) { v[k][0] = *(const u32x4*)(PART + (size_t)k * HD); v[k][1] = *(const u32x4*)(PART + (size_t)k * HD + 8); } }
  const u32x4* yr = (const u32x4*)((const bf16_t*)(F.ws + WS_YCAT) + (size_t)t * 2048) + lane; const u32x4 r0 = yr[0], r1 = yr[64];
  lsn = *(const f32x4*)lse_next;
  float acc[16]; float den = 0.f;
#pragma unroll
  for (int e = 0; e < 16; ++e) acc[e] = 0.f;
#pragma unroll
  for (int k = 0; k < 4; ++k) { const float w = ok[k] ? __builtin_amdgcn_exp2f(l[k] - M) : 0.f; den += w;
    const u32x4 a = v[k][0], b = v[k][1];
    acc[0] += w * bf_lo(a.x); acc[1] += w * bf_hi(a.x); acc[2] += w * bf_lo(a.y); acc[3] += w * bf_hi(a.y); acc[4] += w * bf_lo(a.z); acc[5] += w * bf_hi(a.z); acc[6] += w * bf_lo(a.w); acc[7] += w * bf_hi(a.w);
    acc[8] += w * bf_lo(b.x); acc[9] += w * bf_hi(b.x); acc[10] += w * bf_lo(b.y); acc[11] += w * bf_hi(b.y); acc[12] += w * bf_lo(b.z); acc[13] += w * bf_hi(b.z); acc[14] += w * bf_lo(b.w); acc[15] += w * bf_hi(b.w); }
  const float rd = __builtin_amdgcn_rcpf(den); float mxa = 0.f;
#pragma unroll
  for (int e = 0; e < 16; ++e) { acc[e] *= rd; mxa = fmaxf(mxa, fabsf(acc[e])); }
  float mxr = 0.f;
  { const unsigned w[8] = {r0.x, r0.y, r0.z, r0.w, r1.x, r1.y, r1.z, r1.w};
#pragma unroll
    for (int e = 0; e < 8; ++e) mxr = fmaxf(mxr, fmaxf(fabsf(bf_lo(w[e])), fabsf(bf_hi(w[e])))); }
#pragma unroll
  for (int o = 1; o < 64; o <<= 1) { mxa = fmaxf(mxa, __shfl_xor(mxa, o)); mxr = fmaxf(mxr, __shfl_xor(mxr, o)); }
  const float qa = 127.f / fmaxf(mxa, 1e-30f), qr = 127.f / fmaxf(mxr, 1e-30f);
  unsigned char* yc = F.ws + WS_YC8 + (size_t)t * 2048; float* rs = (float*)(F.ws + WS_RS1) + 2 * (size_t)t;
  if (lane == 0) { rs[0] = mxr * (1.f / 127.f); rs[1] = mxa * (1.f / 127.f); }
  { u32x2 w; w.x = pk4_i8(bf_lo(r0.x) * qr, bf_hi(r0.x) * qr, bf_lo(r0.y) * qr, bf_hi(r0.y) * qr); w.y = pk4_i8(bf_lo(r0.z) * qr, bf_hi(r0.z) * qr, bf_lo(r0.w) * qr, bf_hi(r0.w) * qr); *((u32x2*)yc + lane) = w;
    w.x = pk4_i8(bf_lo(r1.x) * qr, bf_hi(r1.x) * qr, bf_lo(r1.y) * qr, bf_hi(r1.y) * qr); w.y = pk4_i8(bf_lo(r1.z) * qr, bf_hi(r1.z) * qr, bf_lo(r1.w) * qr, bf_hi(r1.w) * qr); *((u32x2*)yc + 64 + lane) = w; }
  { u32x4 w; w.x = pk4_i8(acc[0] * qa, acc[1] * qa, acc[2] * qa, acc[3] * qa); w.y = pk4_i8(acc[4] * qa, acc[5] * qa, acc[6] * qa, acc[7] * qa);
    w.z = pk4_i8(acc[8] * qa, acc[9] * qa, acc[10] * qa, acc[11] * qa); w.w = pk4_i8(acc[12] * qa, acc[13] * qa, acc[14] * qa, acc[15] * qa);
    *(u32x4*)(yc + 1024 + h * HD + 16 * c8) = w; }
}
}
__device__ __forceinline__ void router_iter(Frame& F, int it) {
    const int lane = F.lane, wave = F.wave, r16 = lane & 15, q4 = lane >> 4;
    const int tok0 = it * 128 + wave * 16, tok = tok0 + r16;
    const float* WR = (const float*)(F.ws + WS_WR_T); const float* gf = F.in[13];
    LAS float* stg = (LAS float*)(F.lds + wave * 8192);
    constexpr int WRB_OFF = 65536, WRB_BYTES = 48 * 512;
    f32x4 c0 = {0.f, 0.f, 0.f, 0.f}, c1 = c0, c2 = c0; float ss = 0.f;
    const int hrow = lane >> 5, u32i = lane & 31;
    f32x4 xv[8]; u32x2 dv[8]; f32x4 gq;
#define RT_ROWS(C) do { _Pragma("unroll") for (int j = 0; j < 8; ++j) { const size_t off = (size_t)(tok0 + 2 * j + hrow) * D + 128 * (C) + 4 * u32i; \
        xv[j] = *(const f32x4*)(F.in[0] + off); dv[j] = *(const u32x2*)((const bf16_t*)(F.ws + WS_DELTA) + off); } gq = *(const f32x4*)(gf + 128 * (C) + 4 * u32i); } while (0)
#define RT_WDMA(C, BUF) do { _Pragma("unroll") for (int i = 0; i < 3; ++i) { const int q = wave * 3 + i, p = 64 * q + lane, row = p >> 5, c16 = p & 31; \
        __builtin_amdgcn_global_load_lds((const unsigned*)(WR + (size_t)row * D + 128 * (C) + 4 * (c16 ^ (row & 15))), (LAS unsigned*)(F.lds + WRB_OFF + (BUF) * WRB_BYTES + q * 1024), 16, 0, 0); } } while (0)
    RT_ROWS(0); RT_WDMA(0, 0);
#pragma unroll 1
    for (int c = 0; c < 16; ++c) {
        asm volatile("s_waitcnt vmcnt(0)" ::: "memory");
        __syncthreads();
        const f32x4 g = gq;
#pragma unroll
        for (int j = 0; j < 8; ++j) { const int r = 2 * j + hrow; const size_t off = (size_t)(tok0 + r) * D + 128 * c + 4 * u32i;
            f32x4 a = xv[j]; a.x += bf_lo(dv[j].x); a.y += bf_hi(dv[j].x); a.z += bf_lo(dv[j].y); a.w += bf_hi(dv[j].y);
            u32x2 xw; xw.x = cvt_pk_bf16(a.x, a.y); xw.y = cvt_pk_bf16(a.z, a.w);
            *(u32x2*)((bf16_t*)(F.ws + WS_DELTA) + off) = xw;
            *(unsigned*)((unsigned char*)(F.ws + WS_H2) + off) = pk4_q<QM_UP>(a.x * g.x * Q_SA_UP, a.y * g.y * Q_SA_UP, a.z * g.z * Q_SA_UP, a.w * g.w * Q_SA_UP);
            *(LAS f32x4*)(stg + r * 128 + 4 * (u32i ^ (r & 15))) = a; }
        { const int cn = (c < 15) ? c + 1 : 15; RT_ROWS(cn); RT_WDMA(cn, (c + 1) & 1); }
        __builtin_amdgcn_sched_barrier(0);
        const LAS float* wb = (const LAS float*)(F.lds + WRB_OFF + (c & 1) * WRB_BYTES);
#pragma unroll
        for (int s4 = 0; s4 < 4; ++s4) { const int u = 8 * s4 + 2 * q4, ua = 4 * (u ^ r16), ub = 4 * ((u + 1) ^ r16);
            const f32x4 a0 = *(const LAS f32x4*)(stg + r16 * 128 + ua), a1 = *(const LAS f32x4*)(stg + r16 * 128 + ub);
            ss += (a0.x * a0.x + a0.y * a0.y) + (a0.z * a0.z + a0.w * a0.w) + (a1.x * a1.x + a1.y * a1.y) + (a1.z * a1.z + a1.w * a1.w);
            const f32x4 w00 = *(const LAS f32x4*)(wb + r16 * 128 + ua), w01 = *(const LAS f32x4*)(wb + r16 * 128 + ub);
            const f32x4 w10 = *(const LAS f32x4*)(wb + (16 + r16) * 128 + ua), w11 = *(const LAS f32x4*)(wb + (16 + r16) * 128 + ub);
            const f32x4 w20 = *(const LAS f32x4*)(wb + (32 + r16) * 128 + ua), w21 = *(const LAS f32x4*)(wb + (32 + r16) * 128 + ub);
#pragma unroll
            for (int e = 0; e < 4; ++e) { c0 = __builtin_amdgcn_mfma_f32_16x16x4f32(a0[e], w00[e], c0, 0, 0, 0); c1 = __builtin_amdgcn_mfma_f32_16x16x4f32(a0[e], w10[e], c1, 0, 0, 0); c2 = __builtin_amdgcn_mfma_f32_16x16x4f32(a0[e], w20[e], c2, 0, 0, 0); }
#pragma unroll
            for (int e = 0; e < 4; ++e) { c0 = __builtin_amdgcn_mfma_f32_16x16x4f32(a1[e], w01[e], c0, 0, 0, 0); c1 = __builtin_amdgcn_mfma_f32_16x16x4f32(a1[e], w11[e], c1, 0, 0, 0); c2 = __builtin_amdgcn_mfma_f32_16x16x4f32(a1[e], w21[e], c2, 0, 0, 0); } }
    }
    asm volatile("s_waitcnt vmcnt(0)" ::: "memory");
    __syncthreads();
#undef RT_ROWS
#undef RT_WDMA
    ss += __shfl_xor(ss, 16); ss += __shfl_xor(ss, 32);
    const float rinv = rsqrtf(ss * (1.f / D) + RMS_EPS);
    LAS float* lg = stg; LAS int* hist = (LAS int*)(F.lds + TAB_OFF); LAS int* gbase = hist + 32;
    if (F.tid < 32) hist[F.tid] = 0;
#pragma unroll
    for (int r = 0; r < 4; ++r) { const int trow = 4 * q4 + r; lg[trow * 40 + r16] = c0[r]; lg[trow * 40 + 16 + r16] = c1[r]; if (r16 < 4) lg[trow * 40 + 32 + r16] = c2[r]; }
    __syncthreads();
    int ex[2] = {0, 0}, sl[2] = {0, 0}; float wt[2] = {0.f, 0.f};
    if (lane < 16) {
        const float* bg = F.in[15]; const float* be = F.in[17];
        float gl[4]; int gi = 0;
#pragma unroll
        for (int g = 0; g < 4; ++g) gl[g] = rinv * lg[lane * 40 + 32 + g] + bg[g];
        float gm = gl[0];
#pragma unroll
        for (int g = 1; g < 4; ++g) if (gl[g] > gm) { gm = gl[g]; gi = g; }
        float gs = 0.f;
#pragma unroll
        for (int g = 0; g < 4; ++g) gs += __expf(gl[g] - gm);
        const float gw = 1.0f / gs;
        float el[8];
#pragma unroll
        for (int e = 0; e < 8; ++e) el[e] = rinv * lg[lane * 40 + gi * 8 + e] + be[gi * 8 + e];
        int i1 = 0; float m1 = el[0];
#pragma unroll
        for (int e = 1; e < 8; ++e) if (el[e] > m1) { m1 = el[e]; i1 = e; }
        int i2 = -1; float m2 = -3.0e38f;
#pragma unroll
        for (int e = 0; e < 8; ++e) if (e != i1 && el[e] > m2) { m2 = el[e]; i2 = e; }
        const float e2 = __expf(m2 - m1), w1 = 1.0f / (1.0f + e2), w2 = e2 * w1;
        ex[0] = gi * 8 + i1; ex[1] = gi * 8 + i2; wt[0] = gw * w1; wt[1] = gw * w2;
        sl[0] = __hip_atomic_fetch_add(hist + ex[0], 1, __ATOMIC_RELAXED, __HIP_MEMORY_SCOPE_WORKGROUP);
        sl[1] = __hip_atomic_fetch_add(hist + ex[1], 1, __ATOMIC_RELAXED, __HIP_MEMORY_SCOPE_WORKGROUP);
    }
    __syncthreads();
    if (F.tid < 32) gbase[F.tid] = (int)atomicAdd(F.ctl + CW_ECNT + F.tid, (unsigned)hist[F.tid]);
    __syncthreads();
    if (lane < 16) {
        int* MTOK = (int*)(F.ws + WS_MTOK); int* MDST = (int*)(F.ws + WS_MDST); float* MW = (float*)(F.ws + WS_MW); float* MRS = (float*)(F.ws + WS_MRS);
#pragma unroll
        for (int k = 0; k < 2; ++k) { const size_t p = (size_t)ex[k] * T + gbase[ex[k]] + sl[k]; MTOK[p] = tok; MDST[p] = k * T + tok; MW[p] = wt[k]; MRS[p] = rinv; }
    }
    __syncthreads();
}
constexpr int N_PHASES = 14;
struct Args { const float* in[22]; float* out; unsigned char* ws; int ph_lo, ph_hi, use_bar, pad; };
__global__ void __launch_bounds__(NTHR, 2) fwd(Args args) {
    extern __shared__ __attribute__((aligned(16))) unsigned char lds[];
    Frame F;
    F.lds = (LAS unsigned char*)lds; F.MISC = (volatile LAS unsigned*)(F.lds + MISC_OFF);
    F.tid = threadIdx.x; F.lane = F.tid & 63; F.wave = __builtin_amdgcn_readfirstlane(F.tid >> 6);
    F.G = gridDim.x; { const int bx = blockIdx.x; F.vcu = (F.G % 8 == 0) ? (bx % 8) * (F.G / 8) + bx / 8 : bx; }
    F.ws = args.ws; F.out = args.out; F.ctl = (unsigned*)(args.ws + WS_CTL);
#pragma unroll
    for (int i = 0; i < 22; ++i) F.in[i] = args.in[i];
    if (F.tid < 64) F.MISC[F.tid] = 0u;
    __syncthreads();
    XcdBarrier bar; bar.bar = F.ctl + CW_BAR; bar.x = 0; bar.st = nullptr;
    if (args.use_bar) bar = xcd_barrier_post(F.ctl + CW_BAR, F.MISC + 8);
    const int lo = args.ph_lo, hi = args.ph_hi;
#define IN(k) (lo <= (k) && (k) < hi)
#define SEAM(k) do { if (IN(k) && IN((k) + 1)) xcd_barrier(bar); } while (0)

    if (IN(0)) { p0_prologue(F); __syncthreads(); }
    SEAM(0);
    if (IN(1)) {
        const pg8::EpiIn E0{(bf16_t*)(F.ws + WS_XREC), (bf16_t*)(F.ws + WS_GREC), (bf16_t*)(F.ws + WS_Q), (bf16_t*)(F.ws + WS_K), (bf16_t*)(F.ws + WS_V), (bf16_t*)(F.ws + WS_SGR), (bf16_t*)(F.ws + WS_SGA), 1.0f, IN_BF,
            TrSrc{F.in[2], F.in[10], F.in[11], F.in[12], F.in[18], F.in[19], F.in[20], F.ws}, F.vcu, F.G};
        if (IN_NBF > 0) {
            pg8::DenseProbT<0> P{(const void*)(F.ws + WS_XN), (const void*)(F.ws + WS_WIN_T), D, D, D};
            pg8::StaticOrder So; So.init(T, IN_NBF * 256, F.G, (int)blockIdx.x);
            pg8::gemm_phase<pg8::DenseProbT<0>, pg8::EpiIn, pg8::StaticOrder, true>(F.lds, P, So, E0);
        }
        if (IN_NF8 > 0) {
            pg8::DenseProbT<QM_IN> P{(const void*)F.out, (const void*)(F.ws + WS_WIN8), D, D, D};
            pg8::StaticOrder So; So.init(T, IN_NF8 * 256, F.G, (int)blockIdx.x);
            pg8::EpiIn E = E0; E.osc = 1.0f / (Q_SA_IN * Q_SB_IN); E.mask = IN_F8;
            pg8::gemm_phase<pg8::DenseProbT<QM_IN>, pg8::EpiIn, pg8::StaticOrder, true>(F.lds, P, So, E);
        }
    }
    SEAM(1);
    if (IN(2)) {
#if EN_ATTN
        for (int u = F.vcu; u < NB * NH * NBLK; u += F.G) kmean_unit(F, u);
#endif
        for (int u = F.vcu; u < NB * NBLK * 4; u += F.G) { const int b = u >> 7, chunk = (u >> 2) & 31, cq = u & 3;
            scan_unit<false>(F, b, chunk, cq);
            asm volatile("s_waitcnt vmcnt(0)" ::: "memory");
            __syncthreads();
            unsigned* fl = F.ctl + CW_SFLAG + (b * NBLK) * 4 + cq;
            if (F.tid == 0) (void)xb_add(fl + chunk * 4, 1u);
            if (F.lane < chunk) { unsigned sp = 0u; while (xb_ld(fl + F.lane * 4) == 0u) { __builtin_amdgcn_s_sleep(1); if (++sp > (1u << 22)) break; } }
            asm volatile("s_waitcnt vmcnt(0)" ::: "memory");
            scan_fix(F, (((b * NBLK) + chunk) << 5) | (cq * 8 + F.wave));
            asm volatile("s_waitcnt vmcnt(0)" ::: "memory"); __syncthreads();
        }
    }
    SEAM(2);
    if (IN(3)) {
#if EN_ATTN
        route_phase(F);
#endif
        __syncthreads();
    }
    SEAM(3);
    if (IN(4)) {
#if EN_ATTN
        LAS int* ipre = (LAS int*)(F.lds + TAB_OFF); LAS int* tmp = ipre + 1040; LAS int* lb = tmp + 512;
        const int t = F.tid; const unsigned* ac = F.ctl + CW_ACNT;
        const int v0 = ((int)ac[2 * t] + 255) >> 8, v1 = ((int)ac[2 * t + 1] + 255) >> 8;
        tmp[t] = v0 + v1;
        __syncthreads();
        if (t < 64) { int w = 0;
#pragma unroll
            for (int i = 0; i < 8; ++i) w += tmp[t * 8 + i];
            int inc = w;
#pragma unroll
            for (int o = 1; o < 64; o <<= 1) { const int y = __shfl_up(inc, o); if (t >= o) inc += y; }
            lb[t] = inc - w; }
        __syncthreads();
        { int base = lb[t >> 3]; for (int u2 = (t & ~7); u2 < t; ++u2) base += tmp[u2];
          ipre[2 * t] = base; ipre[2 * t + 1] = base + v0; if (t == NTHR - 1) ipre[1024] = base + v0 + v1; }
        __syncthreads();
        const int nitems = ipre[1024];
        att::phase(F, ipre, nitems, ac);
#endif
    }
    SEAM(4);
    if (IN(5)) {
#if EN_ATTN
        { const float* LSE = (const float*)(F.ws + WS_LSE) + (size_t)(F.lane >> 3) * 4; int t = F.vcu * NWAVES + F.wave;
          f32x4 ls = *(const f32x4*)(LSE + (size_t)t * NH * 4); asm volatile("" : "+v"(ls));
          for (; t < T; t += F.G * NWAVES) { const int tn = (t + F.G * NWAVES < T) ? t + F.G * NWAVES : t; f32x4 lsn; att::combine_token(F, t, ls, LSE + (size_t)tn * NH * 4, lsn); ls = lsn; } }
#endif
    }
    SEAM(5);
    if (IN(7)) {
        pg8::StaticOrder So; So.init(T, D, F.G, (int)blockIdx.x);
        { pg8::DenseProbT<2> P{(const void*)(F.ws + WS_YC8), (const void*)(F.ws + WS_WP_T), 1024, 2048, 2048};
          pg8::EpiGate<false> E{(const unsigned char*)(F.ws + WS_SGR), (bf16_t*)(F.ws + WS_MERGED), (const float*)(F.ws + WS_RS1), 2, 1.0f / (I8_SP * 255.f)};
          pg8::gemm_phase<pg8::DenseProbT<2>, pg8::EpiGate<false>, pg8::StaticOrder, true>(F.lds, P, So, E); }
#if EN_ATTN
        { pg8::DenseProbT<2> P{(const void*)(F.ws + WS_YC8 + 1024), (const void*)(F.ws + WS_WP_T + 1024), 1024, 2048, 2048};
          pg8::EpiGate<true> E{(const unsigned char*)(F.ws + WS_SGA), (bf16_t*)(F.ws + WS_MERGED), (const float*)(F.ws + WS_RS1) + 1, 2, 1.0f / (I8_SP * 255.f)};
          pg8::gemm_phase<pg8::DenseProbT<2>, pg8::EpiGate<true>, pg8::StaticOrder, true>(F.lds, P, So, E); }
#endif
    }
    SEAM(7);
    if (IN(8)) {
        for (int t = F.vcu * NWAVES + F.wave; t < T; t += F.G * NWAVES) quant_row<false>(F, (const bf16_t*)(F.ws + WS_MERGED), F.ws + WS_MG8, (float*)(F.ws + WS_RS2), t);
    }
    SEAM(8);
    if (IN(9)) {
        pg8::DenseProbT<2> P{(const void*)(F.ws + WS_MG8), (const void*)(F.ws + WS_WOUT_T), D, D, D};
        pg8::StaticOrder So; So.init(T, D, F.G, (int)blockIdx.x);
        pg8::EpiResid E{(bf16_t*)(F.ws + WS_DELTA), (const float*)(F.ws + WS_RS2), 1.0f / I8_SB};
        pg8::gemm_phase<pg8::DenseProbT<2>, pg8::EpiResid, pg8::StaticOrder, true>(F.lds, P, So, E);
    }
    SEAM(9);
    if (IN(10)) {
#if EN_MOE
        for (int it = F.vcu; it < T / 128; it += F.G) router_iter(F, it);
#endif
    }
    SEAM(10);
#if EN_MOE
    LAS int* tpre = (LAS int*)(F.lds + TAB_OFF); LAS int* ecnt = tpre + 40;
    if (IN(11) || IN(12)) {
        if (F.tid < 64) { const int c = (F.tid < NE) ? (int)F.ctl[CW_ECNT + (F.tid & 31)] : 0; const int tl = (F.tid < NE) ? ((c + 255) >> 8) : 0; int inc = tl;
#pragma unroll
            for (int o = 1; o < 32; o <<= 1) { const int y = __shfl_up(inc, o); if ((F.tid & 63) >= o) inc += y; }
            if (F.tid < NE) { ecnt[F.tid] = c; tpre[F.tid] = inc - tl; } if (F.tid == NE - 1) tpre[NE] = inc; }
        __syncthreads();
    }
#endif
    if (IN(11)) {
#if EN_MOE
        pg8::MoeUpProbT<QM_UP> P{(const void*)(F.ws + WS_H2), (const void*)(F.ws + WS_WGU_T), (const int*)(F.ws + WS_MTOK), D, D, D};
        pg8::GroupedOrder So{tpre, ecnt, 4, F.G, F.vcu};
        pg8::EpiHid E{(const float*)(F.ws + WS_MRS), (void*)(F.ws + WS_HID), QM_UP ? 1.0f / (Q_SA_UP * Q_SB_UP) : 1.0f};
        pg8::gemm_phase<pg8::MoeUpProbT<QM_UP>, pg8::EpiHid, pg8::GroupedOrder, true>(F.lds, P, So, E);
#endif
    }
    SEAM(11);
    if (IN(12)) {
#if EN_MOE
        pg8::MoeDownProbT<QM_DOWN> P{(const void*)(F.ws + WS_HID), (const void*)(F.ws + WS_WD_T), EH, EH, EH};
        pg8::GroupedOrder So{tpre, ecnt, 8, F.G, F.vcu};
        pg8::EpiDown E{(const int*)(F.ws + WS_MDST), (const float*)(F.ws + WS_MW), (unsigned char*)(F.ws + WS_Y), FP8_DOWN ? 1.0f / (FP8_SH * FP8_SD) : 1.0f};
        pg8::gemm_phase<pg8::MoeDownProbT<QM_DOWN>, pg8::EpiDown, pg8::GroupedOrder, true>(F.lds, P, So, E);
#endif
    }
    SEAM(12);
    if (IN(13)) final_norm(F);
#undef IN
#undef SEAM
}

extern "C" void kernel_launch(void* const* d_in, const int* in_sizes, int n_in, void* d_out, int out_size, void* d_ws, size_t ws_size, hipStream_t stream) {
    static int grid = 0;
    if (grid == 0) {
        if (n_in != 22 || in_sizes[0] != T * D || out_size != T * D || ws_size < WS_END) { fprintf(stderr, "kernel_launch: shape / workspace mismatch (n_in %d, ws %zu)\n", n_in, ws_size); grid = -1; return; }
        int dev = 0, cus = 0, per_cu = 0;
        if (hipGetDevice(&dev) != hipSuccess || hipDeviceGetAttribute(&cus, hipDeviceAttributeMultiprocessorCount, dev) != hipSuccess) { grid = -1; return; }
        if (hipFuncSetAttribute((const void*)fwd, hipFuncAttributeMaxDynamicSharedMemorySize, LDS_BYTES) != hipSuccess) { fprintf(stderr, "kernel_launch: hipFuncSetAttribute failed\n"); grid = -1; return; }
        if (hipOccupancyMaxActiveBlocksPerMultiprocessor(&per_cu, (const void*)fwd, NTHR, LDS_BYTES) != hipSuccess || per_cu < 1) { fprintf(stderr, "kernel_launch: occupancy query says %d blocks per CU\n", per_cu); }
        (void)hipGetLastError();
        grid = cus;
    }
    if (grid < 0) return;
    (void)hipMemsetAsync((char*)d_ws + WS_CTL, 0, CTL_ZERO_BYTES, stream);
    Args a{};
    for (int i = 0; i < 22; ++i) a.in[i] = (const float*)d_in[i];
    a.out = (float*)d_out; a.ws = (unsigned char*)d_ws; a.pad = 0;
#if MK_N_LAUNCHES == 1
    a.ph_lo = 0; a.ph_hi = N_PHASES; a.use_bar = 1;
    hipLaunchKernelGGL(fwd, dim3(grid), dim3(NTHR), LDS_BYTES, stream, a);
#else
    for (int p = 0; p < N_PHASES; ++p) { a.ph_lo = p; a.ph_hi = p + 1; a.use_bar = 0; hipLaunchKernelGGL(fwd, dim3(grid), dim3(NTHR), LDS_BYTES, stream, a); }
#endif
}
```

```cpp
#include <hip/hip_runtime.h>
#include <stdint.h>
#include <cstdio>

#ifndef MK_N_LAUNCHES
#define MK_N_LAUNCHES 1
#endif
#ifndef EN_ATTN
#define EN_ATTN 1
#endif
#ifndef EN_MOE
#define EN_MOE 1
#endif

#define LAS __attribute__((address_space(3)))
#define GAS __attribute__((address_space(1)))
typedef unsigned short bf16_t;
typedef short bf16x8 __attribute__((ext_vector_type(8)));
typedef short s16x4 __attribute__((ext_vector_type(4)));
typedef float f32x2 __attribute__((ext_vector_type(2)));
typedef float f32x4 __attribute__((ext_vector_type(4)));
typedef float f32x16 __attribute__((ext_vector_type(16)));
typedef unsigned u32x2 __attribute__((ext_vector_type(2)));
typedef unsigned u32x4 __attribute__((ext_vector_type(4)));
typedef int i32x4 __attribute__((ext_vector_type(4)));
typedef int i32x8 __attribute__((ext_vector_type(8)));

constexpr int NB = 4, S = 8192, T = NB * S, D = 2048;
constexpr int LW = 1024, NLB = 8, LBD = 128;
constexpr int NH = 8, HD = 128, AW = NH * HD, MBLK = 256, NBLK = S / MBLK;
constexpr int NE = 32, NG = 4, EPG = 8, EH = 512;
constexpr int INW = 2 * LW + 3 * AW + 2 * D;
constexpr float RMS_EPS = 1e-6f;
constexpr int NWAVES = 8, NTHR = 512;

constexpr size_t MiB = (size_t)1 << 20;
constexpr size_t WS_CTL = 0, CTL_ZERO_BYTES = 128 * 1024;
constexpr size_t WS_WA_T = 1 * MiB;
constexpr size_t WS_WX_T = WS_WA_T + 256 * 1024;
constexpr size_t WS_WR_T = WS_WX_T + 256 * 1024;
constexpr size_t WS_KMEAN = 2 * MiB;
constexpr size_t WS_SSUM = WS_KMEAN + 512 * 1024;
constexpr size_t WS_KNORM = WS_SSUM + 1024 * 1024;
constexpr size_t WS_KMH = WS_KNORM + 64 * 1024, WS_KML = WS_KMH + 256 * 1024;
constexpr size_t WS_WIN_T = 8 * MiB;
constexpr size_t WS_WP_T = 44 * MiB;
constexpr size_t WS_WOUT_T = 52 * MiB;
constexpr size_t WS_WGU_T = 60 * MiB;
constexpr size_t WS_WD_T = 188 * MiB;
constexpr size_t WS_ALIST = 252 * MiB;
constexpr size_t WS_MTOK = 268 * MiB, WS_MDST = 272 * MiB, WS_MW = 276 * MiB, WS_MRS = 280 * MiB;
constexpr size_t WS_XN = 284 * MiB;
constexpr size_t WS_YCAT = WS_XN, WS_H2 = WS_XN;
constexpr size_t WS_XREC = 412 * MiB, WS_GREC = 476 * MiB;
constexpr size_t WS_MERGED = WS_XREC;
constexpr size_t WS_LSE = 988 * MiB;
constexpr size_t WS_Q = 540 * MiB, WS_K = 604 * MiB, WS_V = 668 * MiB;
constexpr size_t WS_HID = WS_Q;
constexpr size_t WS_YC8 = WS_Q;
constexpr size_t WS_RS1 = WS_K, WS_RS2 = WS_K + 1 * MiB;
constexpr size_t WS_MG8 = WS_V;
constexpr size_t WS_SGR = 732 * MiB, WS_SGA = 860 * MiB;
constexpr size_t WS_Y = WS_SGR;
constexpr size_t WS_DELTA = WS_SGA;
constexpr size_t WS_WIN8 = 988 * MiB;
constexpr size_t WS_END = 1008 * MiB;
constexpr size_t OUT_PART = 0, OUT_LSE = 192 * MiB;
constexpr int ALIST_PER_BH = 256 * 496;
__host__ __device__ constexpr int alist_off(int n) { return 256 * (31 * n - (n * (n - 1)) / 2); }

constexpr int CW_TMO = 0;
constexpr int CW_BAR = 4096;
constexpr int CW_ACNT = 16384;
constexpr int CW_ECNT = 20480;
constexpr int CW_SFLAG = 24576;

constexpr int RING_BYTES = 131072;
constexpr int MISC_OFF = 139264;
constexpr int TAB_OFF = MISC_OFF + 256;
constexpr int LDS_BYTES = 163840;

__device__ __forceinline__ unsigned cvt_pk_bf16(float lo, float hi) { unsigned r; asm volatile("v_cvt_pk_bf16_f32 %0, %1, %2" : "=v"(r) : "v"(lo), "v"(hi)); return r; }
__device__ __forceinline__ float bf_lo(unsigned w) { return __uint_as_float(w << 16); }
__device__ __forceinline__ float bf_hi(unsigned w) { return __uint_as_float(w & 0xffff0000u); }
__device__ __forceinline__ float bf2f(bf16_t v) { return __uint_as_float(((unsigned)v) << 16); }
__device__ __forceinline__ float fsigmoid(float z) { return __builtin_amdgcn_rcpf(1.0f + __builtin_amdgcn_exp2f(-1.4426950408889634f * z)); }
__device__ __forceinline__ float gelu_tanh(float x) { const float u = 1.5957691216057308f * (x + 0.044715f * x * x * x); return x * fsigmoid(u); }
__device__ __forceinline__ float wave_sum(float v) {
#pragma unroll
    for (int o = 1; o < 64; o <<= 1) v += __shfl_xor(v, o);
    return v;
}
#define LDS_WAIT() asm volatile("s_waitcnt lgkmcnt(0)" ::: "memory")
#define VM_WAIT() asm volatile("s_waitcnt vmcnt(0)" ::: "memory")

#define XB_TMO      128
#define XB_XCNT(j)  (256  + 64 * (j))
#define XB_XSUB(j)  (1280 + 64 * (j))
#define XB_XGEN(j)  (2304 + 64 * (j))
#define XB_TOP      3328
#define XB_TOPGEN   3392
#define XCD_BAR_WORDS 3456
#define XB_SPIN_CAP (1u << 18)
__device__ __forceinline__ unsigned xb_ld(unsigned* p)              { return __hip_atomic_load(p, __ATOMIC_RELAXED, __HIP_MEMORY_SCOPE_AGENT); }
__device__ __forceinline__ unsigned xb_add(unsigned* p, unsigned v) { return __hip_atomic_fetch_add(p, v, __ATOMIC_RELAXED, __HIP_MEMORY_SCOPE_AGENT); }
__device__ __forceinline__ unsigned xb_xcc_id() { return (unsigned)__builtin_amdgcn_s_getreg((3 << 11) | 20) & 0xFu; }
#define XB_SPIN(cond, bar) do { unsigned _sp = 0; while (cond) { __builtin_amdgcn_s_sleep(1); \
    if ((++_sp & 255u) == 0u) { if (xb_ld(&(bar)[XB_TMO])) break; if (_sp > XB_SPIN_CAP) { atomicAdd(&(bar)[XB_TMO], 1u); break; } } } } while (0)
struct XcdBarrier { unsigned* bar; unsigned x; volatile LAS unsigned* st; };
__device__ __forceinline__ XcdBarrier xcd_barrier_post(unsigned* bar, volatile LAS unsigned* st) {
    XcdBarrier b; b.bar = bar; b.x = xb_xcc_id(); b.st = st;
    if (threadIdx.x == 0) (void)xb_add(&bar[XB_XCNT(b.x)], 1u);
    return b;
}
__device__ __forceinline__ void xcd_barrier_complete(unsigned* bar, unsigned x, unsigned& nloc, unsigned& nx) {
    const unsigned G = gridDim.x * gridDim.y * gridDim.z;
    unsigned sum, cnt, mine, sp = 0u;
    for (;;) {
        sum = 0u; cnt = 0u; mine = 0u;
#pragma unroll
        for (unsigned j = 0; j < 16; ++j) { const unsigned c = xb_ld(&bar[XB_XCNT(j)]); sum += c; cnt += (c > 0u) ? 1u : 0u; mine = (j == x) ? c : mine; }
        if (sum == G) break;
        __builtin_amdgcn_s_sleep(1);
        if ((++sp & 255u) == 0u) { if (xb_ld(&bar[XB_TMO])) break; if (sp > XB_SPIN_CAP) { atomicAdd(&bar[XB_TMO], 1u); break; } }
    }
    nloc = mine > 0u ? mine : 1u; nx = cnt > 0u ? cnt : 1u;
}
__device__ __forceinline__ void xcd_barrier(const XcdBarrier& b) {
    asm volatile("s_waitcnt vmcnt(0)" ::: "memory");
    __syncthreads();
    if (threadIdx.x == 0) {
        unsigned* bar = b.bar;
        __builtin_amdgcn_s_waitcnt(0);
        unsigned nloc = b.st[0], nx = b.st[1];
        if (nloc == 0u) { xcd_barrier_complete(bar, b.x, nloc, nx); b.st[0] = nloc; b.st[1] = nx; }
        const unsigned old = xb_add(&bar[XB_XSUB(b.x)], 1u);
        const unsigned gen = old / nloc;
        if (old + 1u == (gen + 1u) * nloc) {
            __builtin_amdgcn_fence(__ATOMIC_RELEASE, "agent");
            asm volatile("s_waitcnt vmcnt(0)" ::: "memory");
            const unsigned og = xb_add(&bar[XB_TOP], 1u);
            const unsigned tg = og / nx;
            if (og + 1u == (tg + 1u) * nx) xb_add(&bar[XB_TOPGEN], 1u);
            else XB_SPIN(xb_ld(&bar[XB_TOPGEN]) == tg, bar);
            __builtin_amdgcn_fence(__ATOMIC_ACQUIRE, "agent");
            xb_add(&bar[XB_XGEN(b.x)], 1u);
            asm volatile("s_waitcnt vmcnt(0)" ::: "memory");
        } else {
            XB_SPIN(xb_ld(&bar[XB_XGEN(b.x)]) == gen, bar);
            __builtin_amdgcn_fence(__ATOMIC_ACQUIRE, "agent");
            asm volatile("s_waitcnt vmcnt(0)" ::: "memory");
        }
    }
    __syncthreads();
}

namespace pg8 {
constexpr int BM = 256, BK = 64, HALF = 128, HTB = HALF * BK * 2, STAGE_BYTES = 8 * HTB, NXCD = 8, WGM = 4;
__host__ __device__ __forceinline__ int lds_byte(int r, int c) { const int st = (r >> 4) * 2 + (c >> 5), rr = r & 15, cc = c & 31, ob = rr * 64 + cc * 2; return st * 1024 + (ob ^ (((ob >> 9) & 1) << 5)); }
__host__ __device__ __forceinline__ void stage_rc(int b, int& R, int& C) { const int st = b / 1024, sb = b % 1024, swz = sb ^ (((sb >> 9) & 1) << 5); R = (st >> 1) * 16 + swz / 64; C = (st & 1) * 32 + (swz % 64) / 2; }
__host__ __device__ __forceinline__ int perm32(int rho) { const int n = rho >> 4, i = rho & 15; return 8 * (i >> 2) + 4 * n + (i & 3); }

struct Unit { int pm, pn, e, n, rb; };

struct StaticOrder {
    int nM, nN, nwg, G, c;
    __device__ void init(int M, int N, int G_, int c_) { nM = M / BM; nN = N / BM; nwg = nM * nN; G = G_; c = c_; }
    __device__ bool next(int i, Unit& u) const {
        const long L = (long)i * G + c; if (L >= nwg) return false;
        int wgid = (int)L; { const int q = nwg / NXCD, r = nwg % NXCD, xcd = wgid % NXCD, off = wgid / NXCD; wgid = (xcd < r ? xcd * (q + 1) : r * (q + 1) + (xcd - r) * q) + off; }
        const int nig = WGM * nN, gid = wgid / nig, fm = gid * WGM, gsz = (nM - fm) < WGM ? (nM - fm) : WGM;
        u.pm = fm + ((wgid % nig) % gsz); u.pn = (wgid % nig) / gsz; u.e = 0; u.n = 0; u.rb = 0; return true;
    }
};
struct GroupedOrder {
    const LAS int* tpre; const LAS int* cnt; int nct, G, c;
    __device__ bool next(int i, Unit& u) const {
        const int L = i * G + c; const int rt = L / nct; if (rt >= tpre[NE]) return false;
        int e = 0;
#pragma unroll 1
        while (tpre[e + 1] <= rt) ++e;
        u.e = e; u.pm = rt - tpre[e]; u.pn = L - rt * nct; u.n = cnt[e]; u.rb = tpre[e] * BM; return true;
    }
};

template <int QM> struct DenseProbT {
    static constexpr bool GATHER = false; static constexpr int QMODE = QM, EB = QM ? 1 : 2;
    const void* A; const void* Bt; int K, lda, ldb;
    __device__ __forceinline__ const char* a_base(const Unit& u) const { return (const char*)A + (size_t)u.pm * BM * lda * EB; }
    __device__ __forceinline__ const char* b_base(const Unit& u) const { return (const char*)Bt + (size_t)u.pn * BM * ldb * EB; }
    __device__ __forceinline__ void a_off(const Unit&, const int (&R)[2], const int (&C)[2], unsigned (&vo)[2][2]) const {
#pragma unroll
        for (int h = 0; h < 2; ++h)
#pragma unroll
            for (int i = 0; i < 2; ++i) vo[h][i] = (unsigned)((h * HALF + R[i]) * lda) * (unsigned)EB + (unsigned)C[i] * 2u;
    }
};
typedef DenseProbT<0> DenseProb;
template <int QM> struct MoeUpProbT {
    static constexpr bool GATHER = true; static constexpr int QMODE = QM, EB = QM ? 1 : 2;
    const void* A; const void* Bt; const int* tok; int K, lda, ldb;
    __device__ __forceinline__ const char* a_base(const Unit&) const { return (const char*)A; }
    __device__ __forceinline__ const char* b_base(const Unit& u) const { return (const char*)Bt + ((size_t)u.e * 1024 + (size_t)u.pn * BM) * ldb * EB; }
    __device__ __forceinline__ void a_off(const Unit& u, const int (&R)[2], const int (&C)[2], unsigned (&vo)[2][2]) const {
#pragma unroll
        for (int h = 0; h < 2; ++h)
#pragma unroll
            for (int i = 0; i < 2; ++i) { const int s = u.pm * BM + h * HALF + R[i]; const int tl = tok[(size_t)u.e * T + s]; const int t = (s < u.n) ? tl : 0; vo[h][i] = (unsigned)(t * lda) * (unsigned)EB + (unsigned)C[i] * 2u; }
    }
};
template <int QM> struct MoeDownProbT {
    static constexpr bool GATHER = false; static constexpr int QMODE = QM, EB = QM ? 1 : 2;
    const void* A; const void* Bt; int K, lda, ldb;
    __device__ __forceinline__ const char* a_base(const Unit& u) const { return (const char*)A + ((size_t)u.rb + (size_t)u.pm * BM) * lda * EB; }
    __device__ __forceinline__ const char* b_base(const Unit& u) const { return (const char*)Bt + ((size_t)u.e * 2048 + (size_t)u.pn * BM) * ldb * EB; }
    __device__ __forceinline__ void a_off(const Unit&, const int (&R)[2], const int (&C)[2], unsigned (&vo)[2][2]) const {
#pragma unroll
        for (int h = 0; h < 2; ++h)
#pragma unroll
            for (int i = 0; i < 2; ++i) vo[h][i] = (unsigned)((h * HALF + R[i]) * lda) * (unsigned)EB + (unsigned)C[i] * 2u;
    }
};

template <class Prob, class Epi, class Sched, bool ALIGN_EPI>
__device__ __forceinline__ void gemm_phase(LAS unsigned char* lds, const Prob& P, const Sched& S, const Epi& E) {
    const int tid = threadIdx.x, wid = __builtin_amdgcn_readfirstlane(tid >> 6), lane = tid & 63, wr = wid >> 2, wc = wid & 3, fr = lane & 15, fq = lane >> 4;
    constexpr bool FP8 = Prob::QMODE == 1, I8 = Prob::QMODE == 2; constexpr int EB = Prob::QMODE ? 1 : 2;
    const int K = P.K, nt = K / (Prob::QMODE ? 2 * BK : BK);
    const int sc1 = 0x7F7F7F7F;
    int Rr[2], Cc[2]; unsigned voffB[2];
#pragma unroll
    for (int i = 0; i < 2; ++i) { int R, C; stage_rc(tid * 16 + i * 8192, R, C); Rr[i] = R; Cc[i] = C; const int Rb = Epi::PERM ? ((R & ~31) + perm32(R & 31)) : R; voffB[i] = (unsigned)(Rb * P.ldb) * (unsigned)EB + (unsigned)C * 2u; }
    const size_t kstep = (size_t)(BK * 2);
    const size_t hstepB = (size_t)HALF * P.ldb * EB;
    const unsigned ldsw = (unsigned)wid * 1024u;
    const int aoff = lds_byte(wr * 64 + fr, fq * 8), boff = lds_byte(wc * 32 + fr, fq * 8);
#define PG8_SA(b, h) (((b) * 2 + (h)) * HTB)
#define PG8_SB(b, h) ((4 + (b) * 2 + (h)) * HTB)
#define PG8_STAGE(bufoff, gbase, voff) do { _Pragma("unroll") for (int _i = 0; _i < 2; ++_i) \
        __builtin_amdgcn_global_load_lds((const unsigned*)((const char*)(gbase) + (voff)[_i]), (LAS unsigned*)(lds + (bufoff) + ldsw + _i * 8192), 16, 0, 0); } while (0)
#define PG8_LDA(dst, b, h) do { _Pragma("unroll") for (int m = 0; m < 4; ++m) _Pragma("unroll") for (int k = 0; k < 2; ++k) dst[m][k] = *(const LAS bf16x8*)(lds + PG8_SA(b, h) + aoff + m * 2048 + k * 1024); } while (0)
#define PG8_LDB(dst, b, h) do { _Pragma("unroll") for (int n = 0; n < 2; ++n) _Pragma("unroll") for (int k = 0; k < 2; ++k) dst[n][k] = *(const LAS bf16x8*)(lds + PG8_SB(b, h) + boff + n * 2048 + k * 1024); } while (0)
#define PG8_MMA(ai, bj, At, Bt) do { __builtin_amdgcn_s_setprio(1); _Pragma("unroll") for (int m = 0; m < 4; ++m) _Pragma("unroll") for (int n = 0; n < 2; ++n) { \
        if constexpr (FP8) { const i32x8 fb = __builtin_shufflevector(__builtin_bit_cast(i32x4, Bt[n][0]), __builtin_bit_cast(i32x4, Bt[n][1]), 0, 1, 2, 3, 4, 5, 6, 7); \
            const i32x8 fa = __builtin_shufflevector(__builtin_bit_cast(i32x4, At[m][0]), __builtin_bit_cast(i32x4, At[m][1]), 0, 1, 2, 3, 4, 5, 6, 7); \
            asm volatile("s_nop 1\n\tv_mfma_scale_f32_16x16x128_f8f6f4 %0, %1, %2, %0, %3, %3 op_sel_hi:[0,0,0]" : "+v"(acc[ai][bj][m][n]) : "v"(fb), "v"(fa), "v"(sc1)); } \
        else if constexpr (I8) { _Pragma("unroll") for (int k = 0; k < 2; ++k) acc[ai][bj][m][n] = __builtin_bit_cast(f32x4, __builtin_amdgcn_mfma_i32_16x16x64_i8(__builtin_bit_cast(i32x4, Bt[n][k]), __builtin_bit_cast(i32x4, At[m][k]), __builtin_bit_cast(i32x4, acc[ai][bj][m][n]), 0, 0, 0)); } \
        else { _Pragma("unroll") for (int k = 0; k < 2; ++k) acc[ai][bj][m][n] = __builtin_amdgcn_mfma_f32_16x16x32_bf16(Bt[n][k], At[m][k], acc[ai][bj][m][n], 0, 0, 0); } } \
        __builtin_amdgcn_s_setprio(0); } while (0)
#define PG8_WAIT_V(n) asm volatile("s_waitcnt vmcnt(" #n ")" ::: "memory")
#define PG8_WAIT_L(n) asm volatile("s_waitcnt lgkmcnt(" #n ")" ::: "memory")
#define PG8_BAR __builtin_amdgcn_s_barrier()
#define PG8_SCHED __builtin_amdgcn_sched_barrier(0)
    Unit cur, nxt; int ui = 0;
    if (!S.next(0, cur)) return;
    f32x4 acc[2][2][4][2];
#pragma unroll
    for (int a = 0; a < 2; ++a)
#pragma unroll
        for (int b = 0; b < 2; ++b)
#pragma unroll
            for (int m = 0; m < 4; ++m)
#pragma unroll
                for (int n = 0; n < 2; ++n) acc[a][b][m][n] = (f32x4){0.f, 0.f, 0.f, 0.f};
    bf16x8 At[4][2], B0[2][2], B1[2][2];
    unsigned vA[2][2], vN[2][2];
    P.a_off(cur, Rr, Cc, vA);
#pragma unroll
    for (int h = 0; h < 2; ++h) { vN[h][0] = vA[h][0]; vN[h][1] = vA[h][1]; }
    const char* cA = P.a_base(cur); const char* cB = P.b_base(cur);
    PG8_STAGE(PG8_SB(0, 0), cB, voffB); PG8_STAGE(PG8_SB(0, 1), cB + hstepB, voffB); PG8_STAGE(PG8_SA(0, 0), cA, vA[0]); PG8_STAGE(PG8_SA(0, 1), cA, vA[1]);
    if (wr == 1) PG8_BAR;
    PG8_WAIT_V(2); PG8_BAR;
    PG8_STAGE(PG8_SB(1, 0), cB + kstep, voffB); PG8_STAGE(PG8_SA(1, 0), cA + kstep, vA[0]); PG8_STAGE(PG8_SB(1, 1), cB + hstepB + kstep, voffB);
    PG8_WAIT_V(6); PG8_BAR;
    for (;;) {
        const bool has_next = S.next(ui + 1, nxt);
        const char* nA = has_next ? P.a_base(nxt) : cA; const char* nB = has_next ? P.b_base(nxt) : cB;
        for (int t = 0; t < nt; t += 2) {
            const bool last = (t == nt - 2);
            const char* a1 = cA + (size_t)(t + 1) * kstep;
            const char* a2 = last ? nA : cA + (size_t)(t + 2) * kstep; const char* b2 = last ? nB : cB + (size_t)(t + 2) * kstep;
            const char* a3 = a2 + kstep; const char* b3 = b2 + kstep;
            if constexpr (Prob::GATHER) { if (last && has_next) P.a_off(nxt, Rr, Cc, vN); }
            unsigned vS[2][2];
#pragma unroll
            for (int h = 0; h < 2; ++h) { vS[h][0] = (Prob::GATHER && last) ? vN[h][0] : vA[h][0]; vS[h][1] = (Prob::GATHER && last) ? vN[h][1] : vA[h][1]; }
            PG8_LDB(B0, 0, 0); PG8_LDB(B1, 0, 1); PG8_SCHED; PG8_LDA(At, 0, 0); PG8_STAGE(PG8_SA(1, 1), a1, vA[1]);
            PG8_WAIT_V(8); PG8_WAIT_L(0); PG8_BAR; PG8_MMA(0, 0, At, B0); PG8_MMA(0, 1, At, B1); PG8_BAR; PG8_SCHED;
            PG8_LDA(At, 0, 1); PG8_STAGE(PG8_SB(0, 0), b2, voffB); PG8_STAGE(PG8_SB(0, 1), b2 + hstepB, voffB); PG8_STAGE(PG8_SA(0, 0), a2, vS[0]);
            PG8_WAIT_V(8); PG8_WAIT_L(0); PG8_BAR; PG8_MMA(1, 0, At, B0); PG8_MMA(1, 1, At, B1); PG8_BAR; PG8_SCHED;
            PG8_LDB(B0, 1, 0); PG8_LDB(B1, 1, 1); PG8_SCHED; PG8_LDA(At, 1, 0); PG8_STAGE(PG8_SA(0, 1), a2, vS[1]);
            PG8_WAIT_V(8); PG8_WAIT_L(0); PG8_BAR; PG8_MMA(0, 0, At, B0); PG8_MMA(0, 1, At, B1); PG8_BAR; PG8_SCHED;
            PG8_LDA(At, 1, 1); PG8_STAGE(PG8_SB(1, 0), b3, voffB); PG8_STAGE(PG8_SB(1, 1), b3 + hstepB, voffB); PG8_STAGE(PG8_SA(1, 0), a3, vS[0]);
            PG8_WAIT_V(8); PG8_WAIT_L(0); PG8_BAR; PG8_MMA(1, 0, At, B0); PG8_MMA(1, 1, At, B1); PG8_BAR; PG8_SCHED;
        }
        if constexpr (ALIGN_EPI) { if (wr == 0) PG8_BAR; }
        if constexpr (FP8) asm volatile("s_nop 15\n\ts_nop 15" ::: "memory");
        if constexpr (I8) {
#pragma unroll
            for (int a = 0; a < 2; ++a)
#pragma unroll
                for (int b = 0; b < 2; ++b)
#pragma unroll
                    for (int m = 0; m < 4; ++m)
#pragma unroll
                        for (int n = 0; n < 2; ++n) { const i32x4 iv = __builtin_bit_cast(i32x4, acc[a][b][m][n]); acc[a][b][m][n] = (f32x4){(float)iv[0], (float)iv[1], (float)iv[2], (float)iv[3]}; } }
        E(acc, cur, wr, wc, fr, fq);
        if constexpr (Epi::SIDE) E.side_work(ui, wid, lane);
        if (!has_next) break;
#pragma unroll
        for (int a = 0; a < 2; ++a)
#pragma unroll
            for (int b = 0; b < 2; ++b)
#pragma unroll
                for (int m = 0; m < 4; ++m)
#pragma unroll
                    for (int n = 0; n < 2; ++n) acc[a][b][m][n] = (f32x4){0.f, 0.f, 0.f, 0.f};
        cur = nxt; cA = nA; cB = nB; ++ui;
        if constexpr (Prob::GATHER) {
#pragma unroll
            for (int h = 0; h < 2; ++h) { vA[h][0] = vN[h][0]; vA[h][1] = vN[h][1]; }
        }
        if constexpr (ALIGN_EPI) { if (wr == 1) PG8_BAR; }
    }
    PG8_WAIT_V(0);
    if constexpr (!ALIGN_EPI) { if (wr == 0) PG8_BAR; }
    PG8_BAR;
#undef PG8_SA
#undef PG8_SB
#undef PG8_STAGE
#undef PG8_LDA
#undef PG8_LDB
#undef PG8_MMA
#undef PG8_WAIT_V
#undef PG8_WAIT_L
#undef PG8_BAR
#undef PG8_SCHED
}
}

#ifndef Q_MASK
#define Q_MASK 0xFFFFFFFFFull
#endif
#ifndef QM_IN
#define QM_IN 2
#endif
#ifndef QM_UP
#define QM_UP 2
#endif
#ifndef QM_DOWN
#define QM_DOWN 1
#endif
constexpr unsigned long long IN_F8 = Q_MASK & 0xFFFFFFFFFull, IN_BF = ~IN_F8 & 0xFFFFFFFFFull;
constexpr int IN_NF8 = __builtin_popcountll(IN_F8), IN_NBF = 36 - IN_NF8;
constexpr float FP8_SA = 32.f, FP8_SB = 1024.f;
constexpr float I8_SA = 32.f, I8_SB = 1448.f, I8_SH2 = 26.f;
__device__ __forceinline__ unsigned pk4_fp8(float a, float b, float c, float d) {
    a = fminf(fmaxf(a, -448.f), 448.f); b = fminf(fmaxf(b, -448.f), 448.f); c = fminf(fmaxf(c, -448.f), 448.f); d = fminf(fmaxf(d, -448.f), 448.f);
    int w = __builtin_amdgcn_cvt_pk_fp8_f32(a, b, 0, false); w = __builtin_amdgcn_cvt_pk_fp8_f32(c, d, w, true); return (unsigned)w;
}
__device__ __forceinline__ unsigned pk4_i8(float a, float b, float c, float d) {
    const int ia = (int)__builtin_rintf(fminf(fmaxf(a, -127.f), 127.f)), ib = (int)__builtin_rintf(fminf(fmaxf(b, -127.f), 127.f));
    const int ic = (int)__builtin_rintf(fminf(fmaxf(c, -127.f), 127.f)), id = (int)__builtin_rintf(fminf(fmaxf(d, -127.f), 127.f));
    return (unsigned)(ia & 0xff) | ((unsigned)(ib & 0xff) << 8) | ((unsigned)(ic & 0xff) << 16) | ((unsigned)(id & 0xff) << 24);
}
__device__ __forceinline__ unsigned pk4_u8(float a, float b, float c, float d) {
    const unsigned ia = (unsigned)__builtin_rintf(a), ib = (unsigned)__builtin_rintf(b), ic = (unsigned)__builtin_rintf(c), id = (unsigned)__builtin_rintf(d);
    return ia | (ib << 8) | (ic << 16) | (id << 24);
}
template <int QM> __device__ __forceinline__ unsigned pk4_q(float a, float b, float c, float d) { if (QM == 2) return pk4_i8(a, b, c, d); else return pk4_fp8(a, b, c, d); }
constexpr float I8_SP = 1024.f;
constexpr float Q_SA_IN = QM_IN == 2 ? I8_SA : FP8_SA, Q_SB_IN = QM_IN == 2 ? I8_SB : FP8_SB;
constexpr float Q_SA_UP = QM_UP == 2 ? I8_SH2 : FP8_SA, Q_SB_UP = QM_UP == 2 ? I8_SB : FP8_SB;
#define FP8_UP (QM_UP != 0)
#define FP8_DOWN (QM_DOWN != 0)
constexpr float FP8_SH = 16.f, FP8_SD = 512.f, FP8_SY = 64.f;
struct TrDesc { const float* W; unsigned char* WT; int ldw, k0, n0, ldt, drow0, dk0, qm; float sc; };
constexpr int TR_I_IN = 32 * 144, TR_I_PR = 16 * 32, TR_I_OUT = 32 * 32, TR_I_EXG = NE * 32 * 8, TR_I_EXD = NE * 8 * 32;
constexpr int TR_NITEMS = TR_I_IN + 2 * TR_I_PR + TR_I_OUT + 2 * TR_I_EXG + TR_I_EXD;
struct TrSrc { const float *w_in, *p_rec, *p_attn, *w_out, *w_gate, *w_up, *w_down; unsigned char* ws; };
__device__ __forceinline__ TrDesc tr_decode(const TrSrc& F, int r) {
    TrDesc d; d.dk0 = 0;
    if (r < TR_I_IN) { d.n0 = 64 * (r % 144); d.k0 = 64 * (r / 144); d.W = F.w_in; d.ldw = INW; d.ldt = 2048; d.qm = QM_IN; d.sc = Q_SB_IN; d.WT = F.ws + WS_WIN8; d.drow0 = d.n0; return d; } r -= TR_I_IN;
    if (r < 2 * TR_I_PR) { const int at = r >= TR_I_PR; if (at) r -= TR_I_PR; d.W = at ? F.p_attn : F.p_rec; d.ldw = 2048; d.k0 = 64 * (r / 32); d.n0 = 64 * (r % 32); d.WT = F.ws + WS_WP_T; d.ldt = 2048; d.drow0 = d.n0; d.dk0 = at ? 1024 : 0; d.qm = 2; d.sc = I8_SP; return d; } r -= 2 * TR_I_PR;
    if (r < TR_I_OUT) { d.W = F.w_out; d.ldw = 2048; d.k0 = 64 * (r / 32); d.n0 = 64 * (r % 32); d.WT = F.ws + WS_WOUT_T; d.ldt = 2048; d.drow0 = d.n0; d.qm = 2; d.sc = I8_SB; return d; } r -= TR_I_OUT;
    if (r < 2 * TR_I_EXG) { const int up = r >= TR_I_EXG; if (up) r -= TR_I_EXG; const int e = r / 256, rr = r % 256; d.n0 = 64 * (rr % 8); d.k0 = 64 * (rr / 8);
        d.W = (up ? F.w_up : F.w_gate) + (size_t)e * D * EH; d.ldw = EH; d.ldt = 2048; d.drow0 = (d.n0 >> 7) * 256 + (d.n0 & 127) + (up ? 128 : 0);
        d.qm = QM_UP; d.sc = Q_SB_UP; d.WT = F.ws + WS_WGU_T + (size_t)e * 1024 * 2048; return d; } r -= 2 * TR_I_EXG;
    { const int e = r / 256, rr = r % 256; d.W = F.w_down + (size_t)e * EH * D; d.ldw = D; d.k0 = 64 * (rr / 32); d.n0 = 64 * (rr % 32); d.ldt = 512; d.drow0 = d.n0;
      d.qm = QM_DOWN; d.sc = FP8_SD; d.WT = F.ws + WS_WD_T + (size_t)e * 2048 * 512; }
    return d;
}
__device__ __forceinline__ void tr_load(const TrDesc& d, f32x4 (&v)[16], int lane) {
    const float* p = d.W + (size_t)(d.k0 + 16 * (lane >> 4)) * d.ldw + d.n0 + 4 * (lane & 15);
#pragma unroll
    for (int i = 0; i < 16; ++i) v[i] = *(const f32x4*)(p + (size_t)i * d.ldw);
}
__device__ __forceinline__ void tr_store(const TrDesc& d, const f32x4 (&v)[16], int lane) {
    unsigned char* q = d.WT + (size_t)(d.drow0 + 4 * (lane & 15)) * d.ldt + d.dk0 + d.k0 + 16 * (lane >> 4); const float sc = d.sc;
#pragma unroll
    for (int c = 0; c < 4; ++c) { u32x4 o;
        if (d.qm == 2) { o.x = pk4_i8(v[0][c] * sc, v[1][c] * sc, v[2][c] * sc, v[3][c] * sc); o.y = pk4_i8(v[4][c] * sc, v[5][c] * sc, v[6][c] * sc, v[7][c] * sc); o.z = pk4_i8(v[8][c] * sc, v[9][c] * sc, v[10][c] * sc, v[11][c] * sc); o.w = pk4_i8(v[12][c] * sc, v[13][c] * sc, v[14][c] * sc, v[15][c] * sc); }
        else { o.x = pk4_fp8(v[0][c] * sc, v[1][c] * sc, v[2][c] * sc, v[3][c] * sc); o.y = pk4_fp8(v[4][c] * sc, v[5][c] * sc, v[6][c] * sc, v[7][c] * sc); o.z = pk4_fp8(v[8][c] * sc, v[9][c] * sc, v[10][c] * sc, v[11][c] * sc); o.w = pk4_fp8(v[12][c] * sc, v[13][c] * sc, v[14][c] * sc, v[15][c] * sc); }
        *(u32x4*)(q + (size_t)c * d.ldt) = o; }
}

namespace pg8 {
struct EpiIn {
    static constexpr bool PERM = true, SIDE = true;
    bf16_t *xrec, *grec, *q, *k, *v, *sgr, *sga; float osc; unsigned long long mask; TrSrc src; int side_c, side_stride;
    __device__ __forceinline__ void side_work(int ui, int wid, int lane) const {
        const int item = TR_I_IN + side_c + (ui * 8 + wid) * side_stride; if (item >= TR_NITEMS) return;
        const TrDesc d = tr_decode(src, item); f32x4 v[16]; tr_load(d, v, lane); tr_store(d, v, lane); }
    __device__ __forceinline__ void operator()(const f32x4 (&acc)[2][2][4][2], const Unit& u, int wr, int wc, int fr, int fq) const {
        int pn = 0; { int left = u.pn; unsigned long long mm = mask; for (;;) { const int b = __builtin_ctzll(mm); if (left == 0) { pn = b; break; } mm &= mm - 1; --left; } }
        bf16_t* base; int ldc, ct, act;
        if (pn < 4) { base = xrec; ldc = 1024; ct = pn; act = 0; }
        else if (pn < 8) { base = grec; ldc = 1024; ct = pn - 4; act = 1; }
        else if (pn < 12) { base = q; ldc = 1024; ct = pn - 8; act = 0; }
        else if (pn < 16) { base = k; ldc = 1024; ct = pn - 12; act = 0; }
        else if (pn < 20) { base = v; ldc = 1024; ct = pn - 16; act = 0; }
        else if (pn < 28) { base = sgr; ldc = 2048; ct = pn - 20; act = 2; }
        else { base = sga; ldc = 2048; ct = pn - 28; act = 2; }
        const int row0 = u.pm * BM + wr * 64 + fr, col0 = ct * BM + wc * 32 + 8 * fq;
#pragma unroll
        for (int ai = 0; ai < 2; ++ai)
#pragma unroll
            for (int m = 0; m < 4; ++m) { bf16_t* rowp = base + (size_t)(row0 + ai * HALF + m * 16) * ldc + col0;
#pragma unroll
                for (int bj = 0; bj < 2; ++bj) { f32x4 v0 = acc[ai][bj][m][0] * osc, v1 = acc[ai][bj][m][1] * osc;
                    if (act == 1) {
#pragma unroll
                        for (int j = 0; j < 4; ++j) { v0[j] = gelu_tanh(v0[j]); v1[j] = gelu_tanh(v1[j]); } }
                    if (act == 2) {
#pragma unroll
                        for (int j = 0; j < 4; ++j) { v0[j] = 255.f * fsigmoid(v0[j]); v1[j] = 255.f * fsigmoid(v1[j]); }
                        u32x2 w; w.x = pk4_u8(v0[0], v0[1], v0[2], v0[3]); w.y = pk4_u8(v1[0], v1[1], v1[2], v1[3]);
                        *(u32x2*)((unsigned char*)base + (size_t)(row0 + ai * HALF + m * 16) * 2048 + col0 + bj * HALF) = w; }
                    else { u32x4 w; w.x = cvt_pk_bf16(v0[0], v0[1]); w.y = cvt_pk_bf16(v0[2], v0[3]); w.z = cvt_pk_bf16(v1[0], v1[1]); w.w = cvt_pk_bf16(v1[2], v1[3]);
                        *(u32x4*)(rowp + bj * HALF) = w; } } }
    }
};
template <bool ADD> struct EpiGate {
    static constexpr bool PERM = true, SIDE = false;
    const unsigned char* gate; bf16_t* out; const float* rs; int rss; float osc;
    __device__ __forceinline__ void operator()(const f32x4 (&acc)[2][2][4][2], const Unit& u, int wr, int wc, int fr, int fq) const {
        const int row0 = u.pm * BM + wr * 64 + fr, col0 = u.pn * BM + wc * 32 + 8 * fq;
#pragma unroll
        for (int ai = 0; ai < 2; ++ai) {
            u32x2 gv[4][2]; u32x4 pv[4]; float scv[4];
#pragma unroll
            for (int m = 0; m < 4; ++m) { scv[m] = rs[(size_t)(row0 + ai * HALF + m * 16) * rss];
#pragma unroll
                for (int bj = 0; bj < 2; ++bj) gv[m][bj] = *(const u32x2*)(gate + ((unsigned)(row0 + ai * HALF + m * 16) * 2048u + (unsigned)(col0 + bj * HALF))); }
#pragma unroll
            for (int bj = 0; bj < 2; ++bj) {
                if (ADD) {
#pragma unroll
                    for (int m = 0; m < 4; ++m) pv[m] = *(const u32x4*)(out + ((unsigned)(row0 + ai * HALF + m * 16) * 2048u + (unsigned)(col0 + bj * HALF))); }
                __builtin_amdgcn_sched_barrier(0);
#pragma unroll
                for (int m = 0; m < 4; ++m) { const unsigned off = (unsigned)(row0 + ai * HALF + m * 16) * 2048u + (unsigned)(col0 + bj * HALF); const float sc = scv[m] * osc;
                    const f32x4 a0 = acc[ai][bj][m][0] * sc, a1 = acc[ai][bj][m][1] * sc;
                    const u32x2 g = gv[m][bj];
                    float r[8];
                    r[0] = (float)(g.x & 0xffu) * a0[0]; r[1] = (float)((g.x >> 8) & 0xffu) * a0[1]; r[2] = (float)((g.x >> 16) & 0xffu) * a0[2]; r[3] = (float)(g.x >> 24) * a0[3];
                    r[4] = (float)(g.y & 0xffu) * a1[0]; r[5] = (float)((g.y >> 8) & 0xffu) * a1[1]; r[6] = (float)((g.y >> 16) & 0xffu) * a1[2]; r[7] = (float)(g.y >> 24) * a1[3];
                    if (ADD) { const u32x4 p = pv[m];
                        r[0] += bf_lo(p.x); r[1] += bf_hi(p.x); r[2] += bf_lo(p.y); r[3] += bf_hi(p.y); r[4] += bf_lo(p.z); r[5] += bf_hi(p.z); r[6] += bf_lo(p.w); r[7] += bf_hi(p.w); }
                    u32x4 w; w.x = cvt_pk_bf16(r[0], r[1]); w.y = cvt_pk_bf16(r[2], r[3]); w.z = cvt_pk_bf16(r[4], r[5]); w.w = cvt_pk_bf16(r[6], r[7]);
                    *(u32x4*)(out + off) = w; } } }
    }
};
struct EpiResid {
    static constexpr bool PERM = true, SIDE = false;
    bf16_t* out; const float* rs; float osc;
    __device__ __forceinline__ void operator()(const f32x4 (&acc)[2][2][4][2], const Unit& u, int wr, int wc, int fr, int fq) const {
        const int row0 = u.pm * BM + wr * 64 + fr, col0 = u.pn * BM + wc * 32 + 8 * fq;
        float scv[2][4];
#pragma unroll
        for (int ai = 0; ai < 2; ++ai)
#pragma unroll
            for (int m = 0; m < 4; ++m) scv[ai][m] = rs[row0 + ai * HALF + m * 16] * osc;
        __builtin_amdgcn_sched_barrier(0);
#pragma unroll
        for (int ai = 0; ai < 2; ++ai)
#pragma unroll
            for (int m = 0; m < 4; ++m) { const int row = row0 + ai * HALF + m * 16; const float sc = scv[ai][m]; bf16_t* rowp = out + (size_t)row * D + col0;
#pragma unroll
                for (int bj = 0; bj < 2; ++bj) { const f32x4 v0 = acc[ai][bj][m][0] * sc, v1 = acc[ai][bj][m][1] * sc;
                    u32x4 w; w.x = cvt_pk_bf16(v0[0], v0[1]); w.y = cvt_pk_bf16(v0[2], v0[3]); w.z = cvt_pk_bf16(v1[0], v1[1]); w.w = cvt_pk_bf16(v1[2], v1[3]);
                    *(u32x4*)(rowp + bj * HALF) = w; } }
    }
};
struct EpiHid {
    static constexpr bool PERM = true, SIDE = false;
    const float* rs; void* hid; float osc;
    __device__ __forceinline__ void operator()(const f32x4 (&acc)[2][2][4][2], const Unit& u, int wr, int wc, int fr, int fq) const {
        const int s0 = u.pm * BM + wr * 64 + fr, col0 = u.pn * HALF + wc * 32 + 8 * fq;
        float sclv[2][4];
#pragma unroll
        for (int ai = 0; ai < 2; ++ai)
#pragma unroll
            for (int m = 0; m < 4; ++m) sclv[ai][m] = rs[(size_t)u.e * T + s0 + ai * HALF + m * 16];
        __builtin_amdgcn_sched_barrier(0);
#pragma unroll
        for (int ai = 0; ai < 2; ++ai)
#pragma unroll
            for (int m = 0; m < 4; ++m) { const int s = s0 + ai * HALF + m * 16; const float scl = sclv[ai][m]; const float sc = (s < u.n) ? scl * osc : 0.f;
                float r[8];
#pragma unroll
                for (int n = 0; n < 2; ++n)
#pragma unroll
                    for (int j = 0; j < 4; ++j) { const float g = acc[ai][0][m][n][j] * sc, up = acc[ai][1][m][n][j] * sc; r[n * 4 + j] = g * fsigmoid(g) * up; }
#if FP8_DOWN
                u32x2 w; w.x = pk4_fp8(r[0] * FP8_SH, r[1] * FP8_SH, r[2] * FP8_SH, r[3] * FP8_SH); w.y = pk4_fp8(r[4] * FP8_SH, r[5] * FP8_SH, r[6] * FP8_SH, r[7] * FP8_SH);
                *(u32x2*)((unsigned char*)hid + (size_t)(u.rb + s) * EH + col0) = w;
#else
                u32x4 w; w.x = cvt_pk_bf16(r[0], r[1]); w.y = cvt_pk_bf16(r[2], r[3]); w.z = cvt_pk_bf16(r[4], r[5]); w.w = cvt_pk_bf16(r[6], r[7]);
                *(u32x4*)((bf16_t*)hid + (size_t)(u.rb + s) * EH + col0) = w;
#endif
            }
    }
};
struct EpiDown {
    static constexpr bool PERM = true, SIDE = false;
    const int* dst; const float* w; unsigned char* y; float osc;
    __device__ __forceinline__ void operator()(const f32x4 (&acc)[2][2][4][2], const Unit& u, int wr, int wc, int fr, int fq) const {
        const int s0 = u.pm * BM + wr * 64 + fr, col0 = u.pn * BM + wc * 32 + 8 * fq;
        int dlv[2][4]; float scv[2][4];
#pragma unroll
        for (int ai = 0; ai < 2; ++ai)
#pragma unroll
            for (int m = 0; m < 4; ++m) { const int s = s0 + ai * HALF + m * 16; dlv[ai][m] = dst[(size_t)u.e * T + s]; scv[ai][m] = w[(size_t)u.e * T + s] * osc * FP8_SY; }
        __builtin_amdgcn_sched_barrier(0);
#pragma unroll
        for (int ai = 0; ai < 2; ++ai)
#pragma unroll
            for (int m = 0; m < 4; ++m) asm volatile("" : "+v"(dlv[ai][m]), "+v"(scv[ai][m]));
#pragma unroll
        for (int ai = 0; ai < 2; ++ai)
#pragma unroll
            for (int m = 0; m < 4; ++m) { const int s = s0 + ai * HALF + m * 16;
                const int dl = dlv[ai][m]; const float sc = scv[ai][m];
                if (s < u.n) { unsigned char* rowp = y + (size_t)dl * D + col0;
#pragma unroll
                    for (int bj = 0; bj < 2; ++bj) { const f32x4 v0 = acc[ai][bj][m][0] * sc, v1 = acc[ai][bj][m][1] * sc;
                        u32x2 o; o.x = pk4_fp8(v0[0], v0[1], v0[2], v0[3]); o.y = pk4_fp8(v1[0], v1[1], v1[2], v1[3]);
                        *(u32x2*)(rowp + bj * HALF) = o; } } }
    }
};
}

struct Frame {
    LAS unsigned char* lds; volatile LAS unsigned* MISC; unsigned* ctl;
    int tid, lane, wave, vcu, G;
    const float* in[22]; float* out; unsigned char* ws;
};

__device__ __forceinline__ void tr_item(const float* W, int ldw, int k0, int n0, bf16_t* WT, int ldt, int drow0, int dk0, LAS float* scr, int lane) {
#pragma unroll 8
    for (int i = 0; i < 32; ++i) { const int kk = 2 * i + (lane >> 5); scr[kk * 33 + (lane & 31)] = W[(size_t)(k0 + kk) * ldw + n0 + (lane & 31)]; }
    LDS_WAIT(); asm volatile("" ::: "memory");
    const int c = lane & 7;
#pragma unroll
    for (int j = 0; j < 4; ++j) { const int n = (lane >> 3) + 8 * j; const LAS float* s = scr + (8 * c) * 33 + n;
        u32x4 o; o.x = cvt_pk_bf16(s[0 * 33], s[1 * 33]); o.y = cvt_pk_bf16(s[2 * 33], s[3 * 33]); o.z = cvt_pk_bf16(s[4 * 33], s[5 * 33]); o.w = cvt_pk_bf16(s[6 * 33], s[7 * 33]);
        *(u32x4*)(WT + (size_t)(drow0 + n) * ldt + dk0 + k0 + 8 * c) = o; }
    LDS_WAIT(); asm volatile("" ::: "memory");
}

__device__ __forceinline__ void tr_item8(const float* W, int ldw, int k0, int n0, unsigned char* WT, int ldt, int drow0, int dk0, float sc, LAS float* scr, int lane) {
#pragma unroll 8
    for (int i = 0; i < 32; ++i) { const int kk = 2 * i + (lane >> 5); scr[kk * 33 + (lane & 31)] = W[(size_t)(k0 + kk) * ldw + n0 + (lane & 31)] * sc; }
    LDS_WAIT(); asm volatile("" ::: "memory");
    const int c = lane & 3;
#pragma unroll
    for (int j = 0; j < 2; ++j) { const int n = (lane >> 2) + 16 * j; const LAS float* s = scr + (16 * c) * 33 + n;
        u32x4 o; o.x = pk4_fp8(s[0 * 33], s[1 * 33], s[2 * 33], s[3 * 33]); o.y = pk4_fp8(s[4 * 33], s[5 * 33], s[6 * 33], s[7 * 33]);
        o.z = pk4_fp8(s[8 * 33], s[9 * 33], s[10 * 33], s[11 * 33]); o.w = pk4_fp8(s[12 * 33], s[13 * 33], s[14 * 33], s[15 * 33]);
        *(u32x4*)(WT + (size_t)(drow0 + n) * ldt + dk0 + k0 + 16 * c) = o; }
    LDS_WAIT(); asm volatile("" ::: "memory");
}

__device__ __forceinline__ void p0_prologue(Frame& F) {
    LAS float* scr = (LAS float*)(F.lds + F.wave * 16384);
    const int gw = F.vcu * NWAVES + F.wave, NGW = F.G * NWAVES, lane = F.lane;
    bf16_t* WIN_T = (bf16_t*)(F.ws + WS_WIN_T); bf16_t* WP_T = (bf16_t*)(F.ws + WS_WP_T); bf16_t* WOUT_T = (bf16_t*)(F.ws + WS_WOUT_T);
    bf16_t* WGU_T = (bf16_t*)(F.ws + WS_WGU_T); bf16_t* WD_T = (bf16_t*)(F.ws + WS_WD_T); bf16_t* WA_T = (bf16_t*)(F.ws + WS_WA_T); bf16_t* WX_T = (bf16_t*)(F.ws + WS_WX_T);
    constexpr int I_IN = 32 * 288, I_PR = 16 * 64, I_OUT = 32 * 64, I_EX = 512 * NE, I_LRU = 128;
    constexpr int NITEMS = I_IN + 2 * I_PR + I_OUT + 3 * I_EX + I_LRU;
    const TrSrc src{F.in[2], F.in[10], F.in[11], F.in[12], F.in[18], F.in[19], F.in[20], F.ws};
    for (int it = gw; it < TR_I_IN; it += 2 * NGW) {
        const int it2 = it + NGW; const bool two = it2 < TR_I_IN;
        TrDesc d0 = tr_decode(src, it), d1 = d0; f32x4 v0[16], v1[16];
        tr_load(d0, v0, lane);
        if (two) { d1 = tr_decode(src, it2); tr_load(d1, v1, lane); }
        tr_store(d0, v0, lane);
        if (two) tr_store(d1, v1, lane);
    }
    for (int r = gw; r < 128; r += NGW) { const int which = r / 64, rr = r % 64, nb = rr / 8, r8 = rr % 8;
        tr_item(F.in[which ? 7 : 5] + (size_t)nb * LBD * LBD, LBD, 64 * (r8 / 4), 32 * (r8 % 4), (which ? WX_T : WA_T) + (size_t)nb * LBD * LBD, LBD, 32 * (r8 % 4), 0, scr, lane); }
    { float* WR_T = (float*)(F.ws + WS_WR_T); const float* gf = F.in[13]; const float* wg = F.in[14]; const float* we = F.in[16];
      for (int i = (F.vcu * NTHR + F.tid); i < 64 * D; i += F.G * NTHR) { const int col = i / D, k = i % D;
          float v = 0.f; if (col < 32) v = we[(size_t)k * NE + col] * gf[k]; else if (col < 36) v = wg[(size_t)k * NG + (col - 32)] * gf[k];
          WR_T[i] = v; } }
    { const float* x = F.in[0]; const float* g = F.in[1]; bf16_t* XN = (bf16_t*)(F.ws + WS_XN);
      f32x4 gv[8];
#pragma unroll
      for (int j = 0; j < 8; ++j) gv[j] = ((const f32x4*)g)[lane + 64 * j];
      for (int m0 = gw; m0 < T; m0 += 2 * NGW) {
          f32x4 va[8], vb[8];
          { const f32x4* xa = (const f32x4*)(x + (size_t)m0 * D) + lane; const f32x4* xb = (const f32x4*)(x + (size_t)(m0 + NGW) * D) + lane;
#pragma unroll
            for (int j = 0; j < 8; ++j) va[j] = xa[64 * j];
#pragma unroll
            for (int j = 0; j < 8; ++j) vb[j] = xb[64 * j]; }
#pragma unroll
          for (int half = 0; half < 2; ++half) { const int m = m0 + half * NGW; f32x4 (&v)[8] = half ? vb : va; float s = 0.f;
#pragma unroll
              for (int j = 0; j < 8; ++j) s += (v[j].x * v[j].x + v[j].y * v[j].y) + (v[j].z * v[j].z + v[j].w * v[j].w);
              const float r = rsqrtf(wave_sum(s) * (1.f / D) + RMS_EPS);
              if (IN_NF8 > 0) { unsigned* o = (unsigned*)((unsigned char*)F.out + (size_t)m * D) + lane; const float r8 = r * Q_SA_IN;
#pragma unroll
                  for (int j = 0; j < 8; ++j) o[64 * j] = pk4_q<QM_IN>(v[j].x * r8 * gv[j].x, v[j].y * r8 * gv[j].y, v[j].z * r8 * gv[j].z, v[j].w * r8 * gv[j].w); }
              if (IN_NBF > 0) { u32x2* o = (u32x2*)(XN + (size_t)m * D) + lane;
#pragma unroll
                  for (int j = 0; j < 8; ++j) { u32x2 w; w.x = cvt_pk_bf16(v[j].x * r * gv[j].x, v[j].y * r * gv[j].y); w.y = cvt_pk_bf16(v[j].z * r * gv[j].z, v[j].w * r * gv[j].w); o[64 * j] = w; } }
          }
      } }
}


template <bool SPLIT> __device__ __forceinline__ void quant_row(Frame& F, const bf16_t* src, unsigned char* dst, float* rs, int t) {
    const int lane = F.lane; const u32x4* p = (const u32x4*)(src + (size_t)t * 2048) + lane; u32x4 v[4];
#pragma unroll
    for (int j = 0; j < 4; ++j) v[j] = p[64 * j];
    float mx[2] = {0.f, 0.f};
#pragma unroll
    for (int j = 0; j < 4; ++j) { const unsigned w[4] = {v[j].x, v[j].y, v[j].z, v[j].w}; float m = 0.f;
#pragma unroll
        for (int e = 0; e < 4; ++e) m = fmaxf(m, fmaxf(fabsf(bf_lo(w[e])), fabsf(bf_hi(w[e]))));
        mx[j >> 1] = fmaxf(mx[j >> 1], m); }
#pragma unroll
    for (int o = 1; o < 64; o <<= 1) { mx[0] = fmaxf(mx[0], __shfl_xor(mx[0], o)); mx[1] = fmaxf(mx[1], __shfl_xor(mx[1], o)); }
    if (!SPLIT) { mx[0] = fmaxf(mx[0], mx[1]); mx[1] = mx[0]; }
    const float q0 = 127.f / fmaxf(mx[0], 1e-30f), q1 = 127.f / fmaxf(mx[1], 1e-30f);
    if (lane == 0) { if (SPLIT) { rs[2 * (size_t)t] = mx[0] * (1.f / 127.f); rs[2 * (size_t)t + 1] = mx[1] * (1.f / 127.f); } else rs[t] = mx[0] * (1.f / 127.f); }
    u32x2* o = (u32x2*)(dst + (size_t)t * 2048) + lane;
#pragma unroll
    for (int j = 0; j < 4; ++j) { const float q = (j >> 1) ? q1 : q0; u32x2 w;
        w.x = pk4_i8(bf_lo(v[j].x) * q, bf_hi(v[j].x) * q, bf_lo(v[j].y) * q, bf_hi(v[j].y) * q); w.y = pk4_i8(bf_lo(v[j].z) * q, bf_hi(v[j].z) * q, bf_lo(v[j].w) * q, bf_hi(v[j].w) * q);
        o[64 * j] = w; }
}

__device__ __forceinline__ void final_norm(Frame& F) {
    const int gw = F.vcu * NWAVES + F.wave, NGW = F.G * NWAVES, lane = F.lane;
    const float* g = F.in[21]; const bf16_t* Y = (const bf16_t*)(F.ws + WS_Y);
    f32x4 gv[8];
#pragma unroll
    for (int j = 0; j < 8; ++j) gv[j] = ((const f32x4*)g)[lane + 64 * j];
    for (int m = gw; m < T; m += NGW) {
        f32x4* xr = (f32x4*)(F.out + (size_t)m * D) + lane; f32x4 v[8]; float s = 0.f;
        { const u32x2* dl = (const u32x2*)((const bf16_t*)(F.ws + WS_DELTA) + (size_t)m * D) + lane;
#pragma unroll
          for (int j = 0; j < 8; ++j) { const u32x2 dd = dl[64 * j]; v[j].x = bf_lo(dd.x); v[j].y = bf_hi(dd.x); v[j].z = bf_lo(dd.y); v[j].w = bf_hi(dd.y); } }
#if EN_MOE
        const unsigned* y0 = (const unsigned*)((const unsigned char*)Y + (size_t)m * D) + lane; const unsigned* y1 = (const unsigned*)((const unsigned char*)Y + (size_t)(T + m) * D) + lane;
#pragma unroll
        for (int j = 0; j < 8; ++j) { const int a = (int)y0[64 * j], b = (int)y1[64 * j];
            const f32x2 al = __builtin_amdgcn_cvt_pk_f32_fp8(a, false), ah = __builtin_amdgcn_cvt_pk_f32_fp8(a, true), bl = __builtin_amdgcn_cvt_pk_f32_fp8(b, false), bh = __builtin_amdgcn_cvt_pk_f32_fp8(b, true);
            v[j].x += (al.x + bl.x) * (1.f / FP8_SY); v[j].y += (al.y + bl.y) * (1.f / FP8_SY); v[j].z += (ah.x + bh.x) * (1.f / FP8_SY); v[j].w += (ah.y + bh.y) * (1.f / FP8_SY); }
#endif
#pragma unroll
        for (int j = 0; j < 8; ++j) s += (v[j].x * v[j].x + v[j].y * v[j].y) + (v[j].z * v[j].z + v[j].w * v[j].w);
        const float r = rsqrtf(wave_sum(s) * (1.f / D) + RMS_EPS);
#pragma unroll
        for (int j = 0; j < 8; ++j) { f32x4 o; o.x = v[j].x * r * gv[j].x; o.y = v[j].y * r * gv[j].y; o.z = v[j].z * r * gv[j].z; o.w = v[j].w * r * gv[j].w; xr[64 * j] = o; }
    }
}
__device__ __forceinline__ int xc_addr(int bl, int row, int c16) { return bl * 65536 + row * 256 + ((c16 ^ (row & 15)) << 4); }
template <bool FINAL>
__device__ __forceinline__ void scan_unit(Frame& F, int b, int chunk, int cq) {
    const int tid = F.tid, lane = F.lane, wave = F.wave;
    const bf16_t* XREC = (const bf16_t*)(F.ws + WS_XREC);
    const size_t t0 = (size_t)b * S + (size_t)chunk * 256; const int ch0 = cq * 256;
    {
        const int cg = tid & 31, tg = tid >> 5, ch = ch0 + 8 * cg, r0 = 16 * tg;
        const float* cw = F.in[3]; const float* cb = F.in[4];
        float w[4][8], bias[8];
#pragma unroll
        for (int k = 0; k < 4; ++k) { const f32x4 a = *(const f32x4*)(cw + k * LW + ch), c = *(const f32x4*)(cw + k * LW + ch + 4);
            w[k][0] = a.x; w[k][1] = a.y; w[k][2] = a.z; w[k][3] = a.w; w[k][4] = c.x; w[k][5] = c.y; w[k][6] = c.z; w[k][7] = c.w; }
        { const f32x4 a = *(const f32x4*)(cb + ch), c = *(const f32x4*)(cb + ch + 4); bias[0] = a.x; bias[1] = a.y; bias[2] = a.z; bias[3] = a.w; bias[4] = c.x; bias[5] = c.y; bias[6] = c.z; bias[7] = c.w; }
        float xm[3][8];
#pragma unroll
        for (int i = 0; i < 3; ++i) { const int rr = r0 - 3 + i; u32x4 v = (u32x4){0u, 0u, 0u, 0u};
            if (chunk > 0 || rr >= 0) v = *(const u32x4*)(XREC + (size_t)((long)t0 + rr) * LW + ch);
            xm[i][0] = bf_lo(v.x); xm[i][1] = bf_hi(v.x); xm[i][2] = bf_lo(v.y); xm[i][3] = bf_hi(v.y); xm[i][4] = bf_lo(v.z); xm[i][5] = bf_hi(v.z); xm[i][6] = bf_lo(v.w); xm[i][7] = bf_hi(v.w); }
        const int bl = cg >> 4, c16 = cg & 15;
        u32x4 xv[16];
#pragma unroll
        for (int r = 0; r < 16; ++r) xv[r] = *(const u32x4*)(XREC + (t0 + r0 + r) * LW + ch);
#pragma unroll
        for (int r = 0; r < 16; ++r) {
            const u32x4 v = xv[r];
            float x0[8]; x0[0] = bf_lo(v.x); x0[1] = bf_hi(v.x); x0[2] = bf_lo(v.y); x0[3] = bf_hi(v.y); x0[4] = bf_lo(v.z); x0[5] = bf_hi(v.z); x0[6] = bf_lo(v.w); x0[7] = bf_hi(v.w);
            float y[8];
#pragma unroll
            for (int c = 0; c < 8; ++c) { y[c] = bias[c] + w[0][c] * xm[0][c] + w[1][c] * xm[1][c] + w[2][c] * xm[2][c] + w[3][c] * x0[c]; xm[0][c] = xm[1][c]; xm[1][c] = xm[2][c]; xm[2][c] = x0[c]; }
            u32x4 o; o.x = cvt_pk_bf16(y[0], y[1]); o.y = cvt_pk_bf16(y[2], y[3]); o.z = cvt_pk_bf16(y[4], y[5]); o.w = cvt_pk_bf16(y[6], y[7]);
            *(LAS u32x4*)(F.lds + xc_addr(bl, r0 + r, c16)) = o;
        }
    }
    __syncthreads();
    {
        const int r32 = lane & 31, hi = lane >> 5, bl = wave >> 2, nb = 2 * cq + bl, dl = 32 * (wave & 3) + r32, d = nb * LBD + dl;
        const bf16_t* WA_T = (const bf16_t*)(F.ws + WS_WA_T); const bf16_t* WX_T = (const bf16_t*)(F.ws + WS_WX_T);
        bf16x8 wa[8], wx[8];
#pragma unroll
        for (int ks = 0; ks < 8; ++ks) { wa[ks] = *(const bf16x8*)(WA_T + ((size_t)nb * LBD + dl) * LBD + 16 * ks + 8 * hi); wx[ks] = *(const bf16x8*)(WX_T + ((size_t)nb * LBD + dl) * LBD + 16 * ks + 8 * hi); }
        const float ba = F.in[6][d], bx = F.in[8][d], lam = F.in[9][d];
        const float cl = -8.0f * log1pf(expf(-lam));
        float hc = 0.f, Atot = 1.f;
        float* SSUM = (float*)(F.ws + WS_SSUM);
        if (FINAL) {
#pragma unroll 1
            for (int j0 = 0; j0 < chunk; j0 += 8) { f32x2 sv[8];
#pragma unroll
                for (int j = 0; j < 8; ++j) sv[j] = *(const f32x2*)(SSUM + (((size_t)b * NBLK + j0 + j) * LW + d) * 2);
#pragma unroll
                for (int j = 0; j < 8; ++j) { const bool ok = (j0 + j) < chunk; hc = ok ? (sv[j].x * hc + sv[j].y) : hc; } } }
        const bf16_t* GREC = (const bf16_t*)(F.ws + WS_GREC); bf16_t* YCAT = (bf16_t*)(F.ws + WS_YCAT);
#pragma unroll 1
        for (int tt = 0; tt < 8; ++tt) {
            f32x16 ar = {}, ai = {};
            bf16x8 am[8]; bf16_t xcr[16];
#pragma unroll
            for (int ks = 0; ks < 8; ++ks) am[ks] = *(const LAS bf16x8*)(F.lds + xc_addr(bl, 32 * tt + r32, 2 * ks + hi));
#pragma unroll
            for (int r = 0; r < 16; ++r) { const int row = 32 * tt + (r & 3) + 8 * (r >> 2) + 4 * hi; xcr[r] = *(const LAS bf16_t*)(F.lds + xc_addr(bl, row, dl >> 3) + (dl & 7) * 2); }
            __builtin_amdgcn_sched_barrier(0);
#pragma unroll
            for (int ks = 0; ks < 8; ++ks) { ar = __builtin_amdgcn_mfma_f32_32x32x16_bf16(am[ks], wa[ks], ar, 0, 0, 0); ai = __builtin_amdgcn_mfma_f32_32x32x16_bf16(am[ks], wx[ks], ai, 0, 0, 0); }
            float av[16], bv[16], lav[16];
#pragma unroll
            for (int r = 0; r < 16; ++r) {
                const float xc = bf2f(xcr[r]);
                const float rg = fsigmoid(ar[r] + ba), ig = fsigmoid(ai[r] + bx);
                const float la = cl * rg; av[r] = __builtin_amdgcn_exp2f(la * 1.4426950408889634f); lav[r] = la; const float x2 = 2.0f * la;
                const float em = -x2 * (1.0f + x2 * (0.5f + x2 * (0.16666667f + x2 * (0.041666668f + x2 * 0.0083333338f))));
                bv[r] = __builtin_amdgcn_sqrtf(em) * ig * xc; }
            if (!FINAL) {
                int ttv = tt; asm volatile("" : "+v"(ttv));
                const unsigned rl = 32u * (unsigned)ttv + 4u * (unsigned)hi; unsigned* AB = (unsigned*)F.out + (size_t)F.vcu * 65536 + (unsigned)(d & 255);
#pragma unroll
                for (int r = 0; r < 16; ++r) AB[(rl + (unsigned)((r & 3) + 8 * (r >> 2))) * 256u] = cvt_pk_bf16(lav[r], bv[r]);
            }
            float Ag[4], Hg[4], hl[16], Ac[16];
#pragma unroll
            for (int g = 0; g < 4; ++g) { float A = 1.f, H = 0.f;
#pragma unroll
                for (int j = 0; j < 4; ++j) { const int r = 4 * g + j; H = av[r] * H + bv[r]; A *= av[r]; hl[r] = H; Ac[r] = A; }
                Ag[g] = A; Hg[g] = H; }
            float hin[4];
#pragma unroll
            for (int g = 0; g < 4; ++g) { const float Ao = __shfl_xor(Ag[g], 32), Ho = __shfl_xor(Hg[g], 32);
                const float A0 = hi ? Ao : Ag[g], H0 = hi ? Ho : Hg[g], A1 = hi ? Ag[g] : Ao, H1 = hi ? Hg[g] : Ho;
                const float h0 = hc; hc = A0 * hc + H0; const float h1 = hc; hc = A1 * hc + H1; hin[g] = hi ? h1 : h0; Atot *= A0 * A1; }
            if (FINAL) {
                int ttv = tt; asm volatile("" : "+v"(ttv));
                const unsigned rb = (unsigned)t0 + 32u * (unsigned)ttv + 4u * (unsigned)hi;
#pragma unroll
                for (int r = 0; r < 16; ++r) { const unsigned t = rb + (unsigned)((r & 3) + 8 * (r >> 2)); const float hf = hl[r] + Ac[r] * hin[r >> 2];
                    const float gr = bf2f(GREC[t * (unsigned)LW + (unsigned)d]);
                    YCAT[t * 2048u + (unsigned)d] = (bf16_t)(cvt_pk_bf16(hf * gr, 0.f) & 0xffffu);
                    if ((r & 3) == 3) asm volatile("" ::: "memory"); }
            }
        }
        if (!FINAL && hi == 0) {
            const unsigned long long sv = ((unsigned long long)__float_as_uint(hc) << 32) | (unsigned long long)__float_as_uint(Atot);
            __hip_atomic_store((unsigned long long*)(SSUM + (((size_t)b * NBLK + chunk) * LW + d) * 2), sv, __ATOMIC_RELAXED, __HIP_MEMORY_SCOPE_AGENT); }
    }
    __syncthreads();
}


__device__ __forceinline__ void scan_fix(Frame& F, int task) {
    const int lane = F.lane, r32 = lane & 31, hi = lane >> 5;
    const int cg = task & 31, chunk = (task >> 5) & 31, b = task >> 10, d = cg * 32 + r32;
    const size_t t0 = (size_t)b * S + (size_t)chunk * 256;
    const float* SSUM = (const float*)(F.ws + WS_SSUM); const unsigned* AB = (const unsigned*)F.out + (size_t)F.vcu * 65536 + (unsigned)(d & 255);
    const bf16_t* GREC = (const bf16_t*)(F.ws + WS_GREC); bf16_t* YCAT = (bf16_t*)(F.ws + WS_YCAT);
    float hc = 0.f;
    unsigned abA[16]; bf16_t grA[16];
    { const unsigned rb = (unsigned)t0 + 4u * (unsigned)hi;
#pragma unroll
      for (int r = 0; r < 16; ++r) { const unsigned ro = (unsigned)((r & 3) + 8 * (r >> 2)); const unsigned t = rb + ro; abA[r] = AB[(4u * (unsigned)hi + ro) * 256u]; grA[r] = GREC[t * (unsigned)LW + (unsigned)d]; } }
#pragma unroll 1
    for (int j0 = 0; j0 < chunk; j0 += 8) { f32x2 sv[8];
#pragma unroll
        for (int j = 0; j < 8; ++j) { const unsigned long long q = __hip_atomic_load((const unsigned long long*)(SSUM + (((size_t)b * NBLK + j0 + j) * LW + d) * 2), __ATOMIC_RELAXED, __HIP_MEMORY_SCOPE_AGENT);
            sv[j].x = __uint_as_float((unsigned)q); sv[j].y = __uint_as_float((unsigned)(q >> 32)); }
#pragma unroll
        for (int j = 0; j < 8; ++j) { const bool ok = (j0 + j) < chunk; hc = ok ? (sv[j].x * hc + sv[j].y) : hc; } }
#define SF_LOAD(TT, ABV, GRV) do { int ttv = (TT); asm volatile("" : "+v"(ttv)); const unsigned rb = (unsigned)t0 + 32u * (unsigned)ttv + 4u * (unsigned)hi; \
        _Pragma("unroll") for (int r = 0; r < 16; ++r) { const unsigned ro = (unsigned)((r & 3) + 8 * (r >> 2)); const unsigned t = rb + ro; ABV[r] = AB[(32u * (unsigned)ttv + 4u * (unsigned)hi + ro) * 256u]; GRV[r] = GREC[t * (unsigned)LW + (unsigned)d]; } } while (0)
#define SF_STEP(TT, ABV, GRV) do { int ttv = (TT); asm volatile("" : "+v"(ttv)); const unsigned rb = (unsigned)t0 + 32u * (unsigned)ttv + 4u * (unsigned)hi; \
        float av[16], bv[16]; \
        _Pragma("unroll") for (int r = 0; r < 16; ++r) { av[r] = __builtin_amdgcn_exp2f(bf_lo(ABV[r]) * 1.4426950408889634f); bv[r] = bf_hi(ABV[r]); } \
        float Ag[4], Hg[4], hl[16], Ac[16]; \
        _Pragma("unroll") for (int g = 0; g < 4; ++g) { float A = 1.f, H = 0.f; \
            _Pragma("unroll") for (int j = 0; j < 4; ++j) { const int r = 4 * g + j; H = av[r] * H + bv[r]; A *= av[r]; hl[r] = H; Ac[r] = A; } \
            Ag[g] = A; Hg[g] = H; } \
        float hin[4]; \
        _Pragma("unroll") for (int g = 0; g < 4; ++g) { const float Ao = __shfl_xor(Ag[g], 32), Ho = __shfl_xor(Hg[g], 32); \
            const float A0 = hi ? Ao : Ag[g], H0 = hi ? Ho : Hg[g], A1 = hi ? Ag[g] : Ao, H1 = hi ? Hg[g] : Ho; \
            const float h0 = hc; hc = A0 * hc + H0; const float h1 = hc; hc = A1 * hc + H1; hin[g] = hi ? h1 : h0; } \
        _Pragma("unroll") for (int r = 0; r < 16; ++r) { const unsigned t = rb + (unsigned)((r & 3) + 8 * (r >> 2)); const float hf = hl[r] + Ac[r] * hin[r >> 2]; \
            YCAT[t * 2048u + (unsigned)d] = (bf16_t)(cvt_pk_bf16(hf * bf2f(GRV[r]), 0.f) & 0xffffu); } } while (0)
    unsigned abB[16]; bf16_t grB[16];
#pragma unroll 1
    for (int tt = 0; tt < 8; tt += 2) {
        SF_LOAD(tt + 1, abB, grB);
        SF_STEP(tt, abA, grA);
        if (tt + 2 < 8) SF_LOAD(tt + 2, abA, grA);
        SF_STEP(tt + 1, abB, grB);
    }
#undef SF_LOAD
#undef SF_STEP
}

__device__ __forceinline__ void kmean_unit(Frame& F, int u) {
    const int tid = F.tid; const int bh = u >> 5, n = u & 31, b = bh >> 3, h = bh & 7;
    const bf16_t* Kp = (const bf16_t*)(F.ws + WS_K) + ((size_t)b * S + (size_t)n * 256) * AW + h * HD;
    const int rg = tid >> 4, cc = tid & 15; float s[8] = {0.f, 0.f, 0.f, 0.f, 0.f, 0.f, 0.f, 0.f}; float sq[8][8];
#pragma unroll
    for (int i = 0; i < 8; ++i) { const u32x4 v = *(const u32x4*)(Kp + (size_t)(rg + 32 * i) * AW + 8 * cc);
        const float e[8] = {bf_lo(v.x), bf_hi(v.x), bf_lo(v.y), bf_hi(v.y), bf_lo(v.z), bf_hi(v.z), bf_lo(v.w), bf_hi(v.w)};
#pragma unroll
        for (int c = 0; c < 8; ++c) { s[c] += e[c]; sq[i][c] = e[c] * e[c]; } }
    LAS float* part = (LAS float*)F.lds; LAS float* nmx = part + 32 * 128;
#pragma unroll
    for (int c = 0; c < 8; ++c) part[rg * 128 + 8 * cc + c] = s[c];
    { float mx = 0.f;
#pragma unroll
      for (int i = 0; i < 8; ++i) { float q = 0.f;
#pragma unroll
          for (int c = 0; c < 8; ++c) q += sq[i][c];
          q += __shfl_xor(q, 1); q += __shfl_xor(q, 2); q += __shfl_xor(q, 4); q += __shfl_xor(q, 8); mx = fmaxf(mx, q); }
      if (cc == 0) nmx[rg] = mx; }
    __syncthreads();
    if (tid == 0) { float m = 0.f; for (int r = 0; r < 32; ++r) m = fmaxf(m, nmx[r]); ((float*)(F.ws + WS_KNORM))[u] = m; }
    if (tid < 128) { float a = 0.f;
#pragma unroll 8
        for (int r = 0; r < 32; ++r) a += part[r * 128 + tid];
        const float mean = a * (1.f / 256.f); ((float*)(F.ws + WS_KMEAN))[(size_t)u * 128 + tid] = mean;
        const unsigned hb = cvt_pk_bf16(mean, 0.f) & 0xffffu; const float lo = mean - __uint_as_float(hb << 16);
        ((bf16_t*)(F.ws + WS_KMH))[(size_t)u * 128 + tid] = (bf16_t)hb; ((bf16_t*)(F.ws + WS_KML))[(size_t)u * 128 + tid] = (bf16_t)(cvt_pk_bf16(lo, 0.f) & 0xffffu); }
    __syncthreads();
}

__device__ __forceinline__ void route_phase(Frame& F) {
    const int tid = F.tid, lane = F.lane, wave = F.wave, r32 = lane & 31, hi = lane >> 5;
    constexpr int NU = NB * NH * 16;
    LAS int* lcnt = (LAS int*)(F.lds + 16384); LAS int* lbase = lcnt + 32; LAS float* knl = (LAS float*)(lbase + 32);
    constexpr int GPP = 35;
    LAS float* gp = (LAS float*)(F.lds + 32768);
    bf16x8 qa[2][8], ka[2][8], bhv[8], blv[8]; float knv = 0.f;
#define ROUTE_LOAD(U) do { const int _bh = (U) >> 4, _j0 = 1 + 2 * ((U) & 15), _b = _bh >> 3, _h = _bh & 7; \
        const bf16_t* mh = (const bf16_t*)(F.ws + WS_KMH) + ((size_t)_bh * 32 + r32) * 128 + 8 * hi; const bf16_t* ml = (const bf16_t*)(F.ws + WS_KML) + ((size_t)_bh * 32 + r32) * 128 + 8 * hi; \
        _Pragma("unroll") for (int hf = 0; hf < 2; ++hf) { const int _jj = (_j0 + hf <= 31) ? _j0 + hf : _j0; \
            const size_t trow = (size_t)_b * S + (size_t)_jj * 256 + wave * 32 + r32; \
            const bf16_t* qp = (const bf16_t*)(F.ws + WS_Q) + trow * AW + _h * HD + 8 * hi; const bf16_t* kp = (const bf16_t*)(F.ws + WS_K) + trow * AW + _h * HD + 8 * hi; \
            _Pragma("unroll") for (int ks = 0; ks < 8; ++ks) { qa[hf][ks] = *(const bf16x8*)(qp + 16 * ks); ka[hf][ks] = *(const bf16x8*)(kp + 16 * ks); } } \
        _Pragma("unroll") for (int ks = 0; ks < 8; ++ks) { bhv[ks] = *(const bf16x8*)(mh + 16 * ks); blv[ks] = *(const bf16x8*)(ml + 16 * ks); } \
        knv = ((const float*)(F.ws + WS_KNORM))[_bh * 32 + r32]; } while (0)
    int u = F.vcu; if (u >= NU) return;
    ROUTE_LOAD(u);
    for (;;) {
        const int un = u + F.G; const int bh = u >> 4, j0 = 1 + 2 * (u & 15), b = bh >> 3, h = bh & 7; const int jmax = (j0 + 1 <= 31) ? j0 + 1 : j0;
        if (tid < 32) { lcnt[tid] = 0; knl[tid] = knv; }
#pragma unroll
        for (int hf = 0; hf < 2; ++hf) {
            f32x16 acc = {};
#pragma unroll
            for (int ks = 0; ks < 8; ++ks) { acc = __builtin_amdgcn_mfma_f32_32x32x16_bf16(qa[hf][ks], bhv[ks], acc, 0, 0, 0); acc = __builtin_amdgcn_mfma_f32_32x32x16_bf16(qa[hf][ks], blv[ks], acc, 0, 0, 0); }
            float qq = 0.f, qk = 0.f;
#pragma unroll
            for (int ks = 0; ks < 8; ++ks)
#pragma unroll
                for (int e = 0; e < 8; ++e) { const float qv = bf2f((bf16_t)qa[hf][ks][e]), kv = bf2f((bf16_t)ka[hf][ks][e]); qq += qv * qv; qk += qv * kv; }
            qq += __shfl_xor(qq, 32); qk += __shfl_xor(qk, 32);
            const int qb = hf * 256 + wave * 32;
#pragma unroll
            for (int r = 0; r < 16; ++r) gp[(qb + (r & 3) + 8 * (r >> 2) + 4 * hi) * GPP + r32] = acc[r];
            if (hi == 0) { gp[(qb + r32) * GPP + 32] = qq; gp[(qb + r32) * GPP + 33] = qk; }
        }
        __syncthreads();
        if (un < NU) ROUTE_LOAD(un);
        int sel[3] = {-1, -1, -1}, slot[3] = {0, 0, 0};
        const int j = j0 + (tid >> 8), qi = tid & 255; const bool live = j <= 31;
        if (live) {
            float bv[3] = {-3.0e38f, -3.0e38f, -3.0e38f};
#pragma unroll 1
            for (int n = 0; n < j; ++n) {
                const float g = gp[tid * GPP + n];
                if (g > bv[0]) { bv[2] = bv[1]; sel[2] = sel[1]; bv[1] = bv[0]; sel[1] = sel[0]; bv[0] = g; sel[0] = n; }
                else if (g > bv[1]) { bv[2] = bv[1]; sel[2] = sel[1]; bv[1] = g; sel[1] = n; }
                else if (g > bv[2]) { bv[2] = g; sel[2] = n; }
            }
            { const float qn = sqrtf(gp[tid * GPP + 32]), sself = 0.088388347648318440f * gp[tid * GPP + 33];
              const float slope = exp2f(-(float)(h + 1)); float* LSE = (float*)(F.ws + WS_LSE);
#pragma unroll
              for (int k = 0; k < 3; ++k) if (sel[k] >= 0) { const int n = sel[k]; const float dmin = (float)((j - n - 1) * 256 + qi + 1);
                  const float ub = 0.088388347648318440f * qn * sqrtf(knl[n]) * 1.0001f - slope * dmin;
                  if (ub < sself - 110.f) { LSE[(((size_t)b * S + (size_t)j * 256 + qi) * NH + h) * 4 + k] = -3.0e38f; sel[k] = -1 - n; } } }
#pragma unroll
            for (int k = 0; k < 3; ++k) if (sel[k] >= 0) slot[k] = __hip_atomic_fetch_add(lcnt + sel[k], 1, __ATOMIC_RELAXED, __HIP_MEMORY_SCOPE_WORKGROUP);
        }
        __syncthreads();
        if (tid < jmax) lbase[tid] = (int)atomicAdd(F.ctl + CW_ACNT + bh * 32 + tid, (unsigned)lcnt[tid]);
        __syncthreads();
        if (live) { unsigned* AL = (unsigned*)(F.ws + WS_ALIST) + (size_t)bh * ALIST_PER_BH;
#pragma unroll
            for (int k = 0; k < 3; ++k) if (sel[k] >= 0) AL[alist_off(sel[k]) + lbase[sel[k]] + slot[k]] = ((unsigned)(j * 256 + qi) << 2) | (unsigned)k; }
        __syncthreads();
        if (un >= NU) break;
        u = un;
    }
#undef ROUTE_LOAD
}
namespace att {
constexpr int KVBLK = 64, LDK = AW;
constexpr float SCALE = 0.088388347648318440f;
constexpr float THR = 8.f;
constexpr size_t SHM_V = KVBLK * HD * 2, SHM_K = KVBLK * HD * 2;
#define KSWZ(row, colB) ((row) * 256 + ((colB) ^ (((row) & 7) << 4)))
#define SBAR() __builtin_amdgcn_sched_barrier(0)
__device__ __forceinline__ int crow(int r, int hi) { return (r & 3) + 8 * (r >> 2) + 4 * hi; }
__device__ __forceinline__ void partialSM(f32x16& p0, f32x16& p1, float& m_reg, float& mn, float& alpha) {
  constexpr float C = SCALE * 1.4426950408889634f;
  float pmax = p0[0];
#pragma unroll
  for (int r = 1; r < 16; ++r) pmax = fmaxf(pmax, p0[r]);
#pragma unroll
  for (int r = 0; r < 16; ++r) pmax = fmaxf(pmax, p1[r]);
  { auto rr = __builtin_amdgcn_permlane32_swap(__float_as_uint(pmax), __float_as_uint(pmax), false, false);
    pmax = fmaxf(__uint_as_float(rr[0]), __uint_as_float(rr[1])); }
  if (__builtin_expect(__all(pmax - m_reg <= THR / SCALE), 1)) { mn = m_reg; alpha = 1.f; }
  else { mn = fmaxf(m_reg, pmax); alpha = __builtin_amdgcn_exp2f((m_reg - mn) * C); m_reg = mn; }
  const float mnC = -mn * C;
#pragma unroll
  for (int r = 0; r < 16; ++r) p0[r] = fmaf(p0[r], C, mnC);
#pragma unroll
  for (int r = 0; r < 16; ++r) p1[r] = fmaf(p1[r], C, mnC);
#pragma unroll
  for (int r = 0; r < 16; ++r) p0[r] = __builtin_amdgcn_exp2f(p0[r]);
}
__device__ __forceinline__ void finishSM(f32x16& p0, f32x16& p1, float alpha, float& l_reg, bf16x8& pa0, bf16x8& pa1, bf16x8& pa2, bf16x8& pa3) {
#pragma unroll
  for (int r = 0; r < 16; ++r) p1[r] = __builtin_amdgcn_exp2f(p1[r]);
  float ps = 0;
#pragma unroll
  for (int r = 0; r < 16; ++r) ps += p0[r];
#pragma unroll
  for (int r = 0; r < 16; ++r) ps += p1[r];
  { auto rr = __builtin_amdgcn_permlane32_swap(__float_as_uint(ps), __float_as_uint(ps), false, false);
    ps = __uint_as_float(rr[0]) + __uint_as_float(rr[1]); }
  l_reg = l_reg * alpha + ps;
#define PK4(P, BASE, OUT) do { unsigned a0 = cvt_pk_bf16(P[BASE + 0], P[BASE + 1]), a1 = cvt_pk_bf16(P[BASE + 2], P[BASE + 3]);   \
    unsigned b0 = cvt_pk_bf16(P[BASE + 4], P[BASE + 5]), b1 = cvt_pk_bf16(P[BASE + 6], P[BASE + 7]);                              \
    auto r0 = __builtin_amdgcn_permlane32_swap(a0, b0, false, false); auto r1 = __builtin_amdgcn_permlane32_swap(a1, b1, false, false); \
    u32x4 w = {r0[0], r1[0], r0[1], r1[1]}; OUT = *reinterpret_cast<bf16x8*>(&w); } while (0)
  PK4(p0, 0, pa0); PK4(p0, 8, pa1); PK4(p1, 0, pa2); PK4(p1, 8, pa3);
#undef PK4
}
__device__ __forceinline__ void qkt_init(f32x16& p0, f32x16& p1, float bq, float slr) {
#pragma unroll
  for (int r = 0; r < 16; ++r) { const int c0 = (r & 3) + 8 * (r >> 2); p0[r] = fmaf(slr, (float)c0, bq); p1[r] = fmaf(slr, (float)(c0 + 32), bq); }
}
__device__ __forceinline__ void qkt_mask(f32x16& p0, f32x16& p1, int lim) {
#pragma unroll
  for (int r = 0; r < 16; ++r) { const int c0 = (r & 3) + 8 * (r >> 2); if (c0 > lim) p0[r] = -1e30f; if (c0 + 32 > lim) p1[r] = -1e30f; }
}
__device__ __forceinline__ void qkt_mma(f32x16& p0, f32x16& p1, const char* Ks, const bf16x8* qr, int r32, int hi) {
#pragma unroll
  for (int d0 = 0; d0 < 8; ++d0) { const int cb = (d0 * 16 + hi * 8) * 2;
    const bf16x8 b0 = *reinterpret_cast<const bf16x8*>(Ks + KSWZ(r32, cb));
    const bf16x8 b1 = *reinterpret_cast<const bf16x8*>(Ks + KSWZ(32 + r32, cb));
    p0 = __builtin_amdgcn_mfma_f32_32x32x16_bf16(b0, qr[d0], p0, 0, 0, 0);
    p1 = __builtin_amdgcn_mfma_f32_32x32x16_bf16(b1, qr[d0], p1, 0, 0, 0); }
}
template <bool OWN>
__device__ __forceinline__ void qkt(f32x16& p0, f32x16& p1, const char* Ks, const bf16x8* qr, int r32, int hi, float bq, float slr, int lim) {
  qkt_init(p0, p1, bq, slr); if (OWN) qkt_mask(p0, p1, lim); qkt_mma(p0, p1, Ks, qr, r32, hi);
}
__device__ __forceinline__ int v_st(int k, int c) { const int kk = (k & ~0xC) | ((k & 4) << 1) | ((k & 8) >> 1); return ((kk >> 3) * 4 + (c >> 5)) * 512 + ((kk & 7) * 32 + (c & 31)) * 2; }
__device__ __forceinline__ int v_rd_base(int lane) { return ((lane & 3) << 3) | (((lane >> 2) & 3) << 6) | (((lane >> 4) & 1) << 5) | (((lane >> 5) & 1) << 8); }
constexpr int v_rd_off(int d0, int ks, int half) { return d0 * 512 + ks * 4096 + half * 2048; }
template <int OFF> __device__ __forceinline__ s16x4 tr_read(int vb) {
  s16x4 r; asm volatile("ds_read_b64_tr_b16 %0, %1 offset:%2" : "=&v"(r) : "v"(vb), "i"(OFF) : "memory"); return r;
}
template <int D0> __device__ __forceinline__ void pv_one(f32x16& od, int vb, bf16x8 pa0, bf16x8 pa1, bf16x8 pa2, bf16x8 pa3) {
  const s16x4 l0 = tr_read<v_rd_off(D0, 0, 0)>(vb), h0 = tr_read<v_rd_off(D0, 0, 1)>(vb), l1 = tr_read<v_rd_off(D0, 1, 0)>(vb), h1 = tr_read<v_rd_off(D0, 1, 1)>(vb);
  const s16x4 l2 = tr_read<v_rd_off(D0, 2, 0)>(vb), h2 = tr_read<v_rd_off(D0, 2, 1)>(vb), l3 = tr_read<v_rd_off(D0, 3, 0)>(vb), h3 = tr_read<v_rd_off(D0, 3, 1)>(vb);
  asm volatile("s_waitcnt lgkmcnt(0)" ::: "memory"); SBAR();
#define PK(L, H) (bf16x8){L[0], L[1], L[2], L[3], H[0], H[1], H[2], H[3]}
  od = __builtin_amdgcn_mfma_f32_32x32x16_bf16(pa0, PK(l0, h0), od, 0, 0, 0);
  od = __builtin_amdgcn_mfma_f32_32x32x16_bf16(pa1, PK(l1, h1), od, 0, 0, 0);
  od = __builtin_amdgcn_mfma_f32_32x32x16_bf16(pa2, PK(l2, h2), od, 0, 0, 0);
  od = __builtin_amdgcn_mfma_f32_32x32x16_bf16(pa3, PK(l3, h3), od, 0, 0, 0);
#undef PK
}
__device__ __forceinline__ void pv_d0(f32x16* o, int vb, bf16x8 pa0, bf16x8 pa1, bf16x8 pa2, bf16x8 pa3) {
  pv_one<0>(o[0], vb, pa0, pa1, pa2, pa3); pv_one<1>(o[1], vb, pa0, pa1, pa2, pa3); pv_one<2>(o[2], vb, pa0, pa1, pa2, pa3); pv_one<3>(o[3], vb, pa0, pa1, pa2, pa3);
}

}
namespace att {
struct Desc { int b, h, n, chunk, cnt, own; };
__device__ __forceinline__ Desc decode(int i, const LAS int* ipre, int nsel, const unsigned* ac) {
  Desc d; int bhn;
  if (i < nsel) { int lo = 0, hi = 1024; while (hi - lo > 1) { const int mid = (lo + hi) >> 1; if (ipre[mid] <= i) lo = mid; else hi = mid; } bhn = lo; d.chunk = i - ipre[lo]; d.cnt = (int)ac[bhn]; d.own = 0; }
  else { bhn = i - nsel; d.chunk = 0; d.cnt = 256; d.own = 1; }
  d.b = bhn >> 8; d.h = (bhn >> 5) & 7; d.n = bhn & 31; return d;
}
__device__ __forceinline__ void phase(Frame& F, const LAS int* ipre, int nsel, const unsigned* ac) {
  char* lds = (char*)(unsigned char*)F.lds;
  const int tid = F.tid, wid = F.wave, lane = F.lane, r32 = lane & 31, hi = lane >> 5;
  const int ntot = nsel + NB * NH * NBLK;
  int it = F.vcu; if (it >= ntot) return;
  const bf16_t* Qg = (const bf16_t*)(F.ws + WS_Q); const bf16_t* Kg = (const bf16_t*)(F.ws + WS_K); const bf16_t* Vg = (const bf16_t*)(F.ws + WS_V);
  const unsigned* AL = (const unsigned*)(F.ws + WS_ALIST);
  bf16_t* PART = (bf16_t*)((unsigned char*)F.out); float* LSE = (float*)(F.ws + WS_LSE);
  bf16_t* V_lds = (bf16_t*)lds; bf16_t* K_lds = (bf16_t*)(lds + 2 * SHM_V);
  float* wsf = (float*)(lds + 2 * SHM_V + 2 * SHM_K) + wid * 64; float* li_l = wsf; float* al_l = wsf + 32;
  const int sr = tid >> 4, sc = (tid & 15) * 8, vst0 = v_st(sr, sc), vst1 = v_st(32 + sr, sc);
  const int vb0 = (int)(uintptr_t)V_lds + v_rd_base(lane);
  struct { bf16x8 vs0, vs1, ks0, ks1; } sr_[2];
  constexpr float C = SCALE * 1.4426950408889634f;
#define SLOADX(i, d, j) do { const size_t _o = ((size_t)(d).b * S + (size_t)(d).n * 256 + 64 * (j) + sr) * AW + (d).h * HD + sc; \
    sr_[i].vs0 = *(const bf16x8*)(Vg + _o); sr_[i].vs1 = *(const bf16x8*)(Vg + _o + (size_t)32 * AW); sr_[i].ks0 = *(const bf16x8*)(Kg + _o); sr_[i].ks1 = *(const bf16x8*)(Kg + _o + (size_t)32 * AW); } while (0)
#define SWRITE(bb, i) do { *(bf16x8*)((char*)V_lds + (bb) * SHM_V + vst0) = sr_[i].vs0;          \
    *(bf16x8*)((char*)V_lds + (bb) * SHM_V + vst1) = sr_[i].vs1; const int kc = sc * 2;               \
    *(bf16x8*)((char*)K_lds + (bb) * SHM_K + KSWZ(sr, kc)) = sr_[i].ks0;                       \
    *(bf16x8*)((char*)K_lds + (bb) * SHM_K + KSWZ(32 + sr, kc)) = sr_[i].ks1; } while (0)
#define RESC(a) do { if (__any((a) < 1.f)) { if (hi == 0) al_l[r32] = (a); asm volatile("s_waitcnt lgkmcnt(0)" ::: "memory"); \
    _Pragma("unroll") for (int d = 0; d < 4; ++d) _Pragma("unroll") for (int r = 0; r < 16; ++r) o[d][r] *= al_l[crow(r, hi)]; } } while (0)
#define LANEQ(d, tq, prow) do { int _ks = 3; bool _v = true; \
    if ((d).own) tq = (d).n * 256 + wid * 32 + r32; \
    else { const int _idx = (d).chunk * 256 + wid * 32 + r32; _v = _idx < (d).cnt; \
      const unsigned _e = AL[(size_t)((d).b * NH + (d).h) * ALIST_PER_BH + alist_off((d).n) + (_v ? _idx : (d).chunk * 256)]; tq = (int)(_e >> 2); _ks = (int)(_e & 3u); } \
    prow = _v ? (int)((((size_t)(d).b * S + tq) * NH + (d).h) * 4 + _ks) : -1; } while (0)
#define QLOAD(d, tq) do { const bf16_t* _q = Qg + ((size_t)(d).b * S + (size_t)(tq)) * AW + (d).h * HD + hi * 8; \
    _Pragma("unroll") for (int d0 = 0; d0 < 8; ++d0) qr[d0] = *(const bf16x8*)(_q + d0 * 16); } while (0)
#define SLR(d) (exp2f(-(float)((d).h + 1)) / SCALE)
#define TJ(d, j) ((d).own ? (j) : 3 - (j))
#define BQ(j) (slr * (float)(dc.n * 256 + 64 * TJ(dc, j) + 4 * hi - tq_c))
#define LIM(j) (wid * 32 + r32 - 64 * (j) - 4 * hi)
#define QKT(p0, p1, buf, j) do { qkt_init(p0, p1, BQ(j), slr); if (dc.own) { int _lim = LIM(j); asm volatile("" : "+v"(_lim)); qkt_mask(p0, p1, _lim); } qkt_mma(p0, p1, buf, qr, r32, hi); } while (0)
#define EPILOGUE() do { const float _lse = m_reg * C + __builtin_amdgcn_logf(l_reg); int* dst_l = (int*)al_l; \
    if (hi == 0) { li_l[r32] = l_reg; dst_l[r32] = prow_p; if (prow_p >= 0) LSE[prow_p] = _lse; } \
    asm volatile("s_waitcnt lgkmcnt(0)" ::: "memory"); \
    _Pragma("unroll") for (int r = 0; r < 16; ++r) { const int rr = crow(r, hi); const float rl = __builtin_amdgcn_rcpf(li_l[rr]); const int pr = dst_l[rr]; \
      if (pr >= 0) { _Pragma("unroll") for (int d0 = 0; d0 < 4; ++d0) PART[(size_t)pr * HD + d0 * 32 + r32] = (bf16_t)cvt_pk_bf16(o[d0][r] * rl, 0.f); } } \
    asm volatile("s_waitcnt lgkmcnt(0)" ::: "memory"); \
    m_reg = -1e30f; l_reg = 0.f; _Pragma("unroll") for (int d = 0; d < 4; ++d) _Pragma("unroll") for (int r = 0; r < 16; ++r) o[d][r] = 0.f; } while (0)

  Desc dc = decode(it, ipre, nsel, ac), dn = dc;
  int tq_c, prow_c, tq_n = 0, prow_n = -1, prow_p = -1;
  LANEQ(dc, tq_c, prow_c);
  float m_reg = -1e30f, l_reg = 0.f; f32x16 o[4] = {}; bf16x8 qr[8];
  QLOAD(dc, tq_c);
  float slr = SLR(dc);
  f32x16 pA0, pA1, pB0, pB1; float mnA, mnB, alA = 1.f, alB = 1.f; bf16x8 pa0, pa1, pa2, pa3;
  constexpr int SE = 0, SO = 1;
  SLOADX(SE, dc, TJ(dc, 0)); SLOADX(SO, dc, TJ(dc, 1));
  SWRITE(0, SE); __syncthreads();
  bool first = true;
  for (;;) {
    const bool has_next = (it + F.G) < ntot;
    SBAR(); QKT(pA0, pA1, (const char*)K_lds, 0);
    if (!first) finishSM(pB0, pB1, alB, l_reg, pa0, pa1, pa2, pa3);
    SBAR(); SLOADX(SE, dc, TJ(dc, 2)); SBAR();
    if (!first) { pv_d0(o, vb0 + (int)SHM_V, pa0, pa1, pa2, pa3); EPILOGUE(); }
    partialSM(pA0, pA1, m_reg, mnA, alA);
    __syncthreads(); SWRITE(1, SO);
    __syncthreads();
    SBAR(); QKT(pB0, pB1, (const char*)K_lds + SHM_K, 1);
    finishSM(pA0, pA1, alA, l_reg, pa0, pa1, pa2, pa3);
    SBAR(); SLOADX(SO, dc, TJ(dc, 3));
    if (has_next) { dn = decode(it + F.G, ipre, nsel, ac); LANEQ(dn, tq_n, prow_n); }
    SBAR();
    pv_d0(o, vb0, pa0, pa1, pa2, pa3); partialSM(pB0, pB1, m_reg, mnB, alB);
    __syncthreads(); SWRITE(0, SE);
    RESC(alB); __syncthreads();
    SBAR(); QKT(pA0, pA1, (const char*)K_lds, 2);
    finishSM(pB0, pB1, alB, l_reg, pa0, pa1, pa2, pa3);
    SBAR(); if (has_next) SLOADX(SE, dn, TJ(dn, 0)); SBAR();
    pv_d0(o, vb0 + (int)SHM_V, pa0, pa1, pa2, pa3); partialSM(pA0, pA1, m_reg, mnA, alA);
    __syncthreads(); SWRITE(1, SO);
    RESC(alA); __syncthreads();
    SBAR(); QKT(pB0, pB1, (const char*)K_lds + SHM_K, 3);
    finishSM(pA0, pA1, alA, l_reg, pa0, pa1, pa2, pa3);
    SBAR(); if (has_next) { SLOADX(SO, dn, TJ(dn, 1)); QLOAD(dn, tq_n); } SBAR();
    pv_d0(o, vb0, pa0, pa1, pa2, pa3); partialSM(pB0, pB1, m_reg, mnB, alB);
    __syncthreads(); if (has_next) SWRITE(0, SE);
    RESC(alB); __syncthreads();
    prow_p = prow_c;
    if (!has_next) break;
    dc = dn; tq_c = tq_n; prow_c = prow_n; slr = SLR(dc); first = false; it += F.G;
  }
  finishSM(pB0, pB1, alB, l_reg, pa0, pa1, pa2, pa3); SBAR();
  pv_d0(o, vb0 + (int)SHM_V, pa0, pa1, pa2, pa3);
  EPILOGUE();
  __syncthreads();
#undef SLOADX
#undef SWRITE
#undef RESC
#undef LANEQ
#undef QLOAD
#undef SLR
#undef BQ
#undef LIM
#undef TJ
#undef QKT
#undef EPILOGUE
}

__device__ __forceinline__ void combine_token(Frame& F, int t, const f32x4 ls, const float* lse_next, f32x4& lsn) {
  const int lane = F.lane, h = lane >> 3, c8 = lane & 7;
  const bf16_t* PART = (const bf16_t*)((unsigned char*)F.out) + ((size_t)t * NH + h) * 4 * HD + 16 * c8;
  const int j = (t & (S - 1)) >> 8;
  float l[4]; bool ok[4]; float M = -3.0e38f;
#pragma unroll
  for (int k = 0; k < 4; ++k) { ok[k] = ((k == 3) || (k < j)) && ls[k] > -1.0e37f; l[k] = ok[k] ? ls[k] : -3.0e38f; M = fmaxf(M, l[k]); }
  u32x4 v[4][2];
#pragma unroll
  for (int k = 0; k < 4; ++k) { v[k][0] = (u32x4){0u, 0u, 0u, 0u}; v[k][1] = (u32x4){0u, 0u, 0u, 0u}; if (ok[k]) { v[k][0] = *(const u32x4*)(PART + (size_t)k * HD); v[k][1] = *(const u32x4*)(PART + (size_t)k * HD + 8); } }
  const u32x4* yr = (const u32x4*)((const bf16_t*)(F.ws + WS_YCAT) + (size_t)t * 2048) + lane; const u32x4 r0 = yr[0], r1 = yr[64];
  lsn = *(const f32x4*)lse_next;
  float acc[16]; float den = 0.f;
#pragma unroll
  for (int e = 0; e < 16; ++e) acc[e] = 0.f;
#pragma unroll
  for (int k = 0; k < 4; ++k) { const float w = ok[k] ? __builtin_amdgcn_exp2f(l[k] - M) : 0.f; den += w;
    const u32x4 a = v[k][0], b = v[k][1];
    acc[0] += w * bf_lo(a.x); acc[1] += w * bf_hi(a.x); acc[2] += w * bf_lo(a.y); acc[3] += w * bf_hi(a.y); acc[4] += w * bf_lo(a.z); acc[5] += w * bf_hi(a.z); acc[6] += w * bf_lo(a.w); acc[7] += w * bf_hi(a.w);
    acc[8] += w * bf_lo(b.x); acc[9] += w * bf_hi(b.x); acc[10] += w * bf_lo(b.y); acc[11] += w * bf_hi(b.y); acc[12] += w * bf_lo(b.z); acc[13] += w * bf_hi(b.z); acc[14] += w * bf_lo(b.w); acc[15] += w * bf_hi(b.w); }
  const float rd = __builtin_amdgcn_rcpf(den); float mxa = 0.f;
#pragma unroll
  for (int e = 0; e < 16; ++e) { acc[e] *= rd; mxa = fmaxf(mxa, fabsf(acc[e])); }
  float mxr = 0.f;
  { const unsigned w[8] = {r0.x, r0.y, r0.z, r0.w, r1.x, r1.y, r1.z, r1.w};
#pragma unroll
    for (int e = 0; e < 8; ++e) mxr = fmaxf(mxr, fmaxf(fabsf(bf_lo(w[e])), fabsf(bf_hi(w[e])))); }
#pragma unroll
  for (int o = 1; o < 64; o <<= 1) { mxa = fmaxf(mxa, __shfl_xor(mxa, o)); mxr = fmaxf(mxr, __shfl_xor(mxr, o)); }
  const float qa = 127.f / fmaxf(mxa, 1e-30f), qr = 127.f / fmaxf(mxr, 1e-30f);
  unsigned char* yc = F.ws + WS_YC8 + (size_t)t * 2048; float* rs = (float*)(F.ws + WS_RS1) + 2 * (size_t)t;
  if (lane == 0) { rs[0] = mxr * (1.f / 127.f); rs[1] = mxa * (1.f / 127.f); }
  { u32x2 w; w.x = pk4_i8(bf_lo(r0.x) * qr, bf_hi(r0.x) * qr, bf_lo(r0.y) * qr, bf_hi(r0.y) * qr); w.y = pk4_i8(bf_lo(r0.z) * qr, bf_hi(r0.z) * qr, bf_lo(r0.w) * qr, bf_hi(r0.w) * qr); *((u32x2*)yc + lane) = w;
    w.x = pk4_i8(bf_lo(r1.x) * qr, bf_hi(r1.x) * qr, bf_lo(r1.y) * qr, bf_hi(r1.y) * qr); w.y = pk4_i8(bf_lo(r1.z) * qr, bf_hi(r1.z) * qr, bf_lo(r1.w) * qr, bf_hi(r1.w) * qr); *((u32x2*)yc + 64 + lane) = w; }
  { u32x4 w; w.x = pk4_i8(acc[0] * qa, acc[1] * qa, acc[2] * qa, acc[3] * qa); w.y = pk4_i8(acc[4] * qa, acc[5] * qa, acc[6] * qa, acc[7] * qa);
    w.z = pk4_i8(acc[8] * qa, acc[9] * qa, acc[10] * qa, acc[11] * qa); w.w = pk4_i8(acc[12] * qa, acc[13] * qa, acc[14] * qa, acc[15] * qa);
    *(u32x4*)(yc + 1024 + h * HD + 16 * c8) = w; }
}
}
__device__ __forceinline__ void router_iter(Frame& F, int it) {
    const int lane = F.lane, wave = F.wave, r16 = lane & 15, q4 = lane >> 4;
    const int tok0 = it * 128 + wave * 16, tok = tok0 + r16;
    const float* WR = (const float*)(F.ws + WS_WR_T); const float* gf = F.in[13];
    LAS float* stg = (LAS float*)(F.lds + wave * 8192);
    constexpr int WRB_OFF = 65536, WRB_BYTES = 48 * 512;
    f32x4 c0 = {0.f, 0.f, 0.f, 0.f}, c1 = c0, c2 = c0; float ss = 0.f;
    const int hrow = lane >> 5, u32i = lane & 31;
    f32x4 xv[8]; u32x2 dv[8]; f32x4 gq;
#define RT_ROWS(C) do { _Pragma("unroll") for (int j = 0; j < 8; ++j) { const size_t off = (size_t)(tok0 + 2 * j + hrow) * D + 128 * (C) + 4 * u32i; \
        xv[j] = *(const f32x4*)(F.in[0] + off); dv[j] = *(const u32x2*)((const bf16_t*)(F.ws + WS_DELTA) + off); } gq = *(const f32x4*)(gf + 128 * (C) + 4 * u32i); } while (0)
#define RT_WDMA(C, BUF) do { _Pragma("unroll") for (int i = 0; i < 3; ++i) { const int q = wave * 3 + i, p = 64 * q + lane, row = p >> 5, c16 = p & 31; \
        __builtin_amdgcn_global_load_lds((const unsigned*)(WR + (size_t)row * D + 128 * (C) + 4 * (c16 ^ (row & 15))), (LAS unsigned*)(F.lds + WRB_OFF + (BUF) * WRB_BYTES + q * 1024), 16, 0, 0); } } while (0)
    RT_ROWS(0); RT_WDMA(0, 0);
#pragma unroll 1
    for (int c = 0; c < 16; ++c) {
        asm volatile("s_waitcnt vmcnt(0)" ::: "memory");
        __syncthreads();
        const f32x4 g = gq;
#pragma unroll
        for (int j = 0; j < 8; ++j) { const int r = 2 * j + hrow; const size_t off = (size_t)(tok0 + r) * D + 128 * c + 4 * u32i;
            f32x4 a = xv[j]; a.x += bf_lo(dv[j].x); a.y += bf_hi(dv[j].x); a.z += bf_lo(dv[j].y); a.w += bf_hi(dv[j].y);
            u32x2 xw; xw.x = cvt_pk_bf16(a.x, a.y); xw.y = cvt_pk_bf16(a.z, a.w);
            *(u32x2*)((bf16_t*)(F.ws + WS_DELTA) + off) = xw;
            *(unsigned*)((unsigned char*)(F.ws + WS_H2) + off) = pk4_q<QM_UP>(a.x * g.x * Q_SA_UP, a.y * g.y * Q_SA_UP, a.z * g.z * Q_SA_UP, a.w * g.w * Q_SA_UP);
            *(LAS f32x4*)(stg + r * 128 + 4 * (u32i ^ (r & 15))) = a; }
        { const int cn = (c < 15) ? c + 1 : 15; RT_ROWS(cn); RT_WDMA(cn, (c + 1) & 1); }
        __builtin_amdgcn_sched_barrier(0);
        const LAS float* wb = (const LAS float*)(F.lds + WRB_OFF + (c & 1) * WRB_BYTES);
#pragma unroll
        for (int s4 = 0; s4 < 4; ++s4) { const int u = 8 * s4 + 2 * q4, ua = 4 * (u ^ r16), ub = 4 * ((u + 1) ^ r16);
            const f32x4 a0 = *(const LAS f32x4*)(stg + r16 * 128 + ua), a1 = *(const LAS f32x4*)(stg + r16 * 128 + ub);
            ss += (a0.x * a0.x + a0.y * a0.y) + (a0.z * a0.z + a0.w * a0.w) + (a1.x * a1.x + a1.y * a1.y) + (a1.z * a1.z + a1.w * a1.w);
            const f32x4 w00 = *(const LAS f32x4*)(wb + r16 * 128 + ua), w01 = *(const LAS f32x4*)(wb + r16 * 128 + ub);
            const f32x4 w10 = *(const LAS f32x4*)(wb + (16 + r16) * 128 + ua), w11 = *(const LAS f32x4*)(wb + (16 + r16) * 128 + ub);
            const f32x4 w20 = *(const LAS f32x4*)(wb + (32 + r16) * 128 + ua), w21 = *(const LAS f32x4*)(wb + (32 + r16) * 128 + ub);
#pragma unroll
            for (int e = 0; e < 4; ++e) { c0 = __builtin_amdgcn_mfma_f32_16x16x4f32(a0[e], w00[e], c0, 0, 0, 0); c1 = __builtin_amdgcn_mfma_f32_16x16x4f32(a0[e], w10[e], c1, 0, 0, 0); c2 = __builtin_amdgcn_mfma_f32_16x16x4f32(a0[e], w20[e], c2, 0, 0, 0); }
#pragma unroll
            for (int e = 0; e < 4; ++e) { c0 = __builtin_amdgcn_mfma_f32_16x16x4f32(a1[e], w01[e], c0, 0, 0, 0); c1 = __builtin_amdgcn_mfma_f32_16x16x4f32(a1[e], w11[e], c1, 0, 0, 0); c2 = __builtin_amdgcn_mfma_f32_16x16x4f32(a1[e], w21[e], c2, 0, 0, 0); } }
    }
    asm volatile("s_waitcnt vmcnt(0)" ::: "memory");
    __syncthreads();
#undef RT_ROWS
#undef RT_WDMA
    ss += __shfl_xor(ss, 16); ss += __shfl_xor(ss, 32);
    const float rinv = rsqrtf(ss * (1.f / D) + RMS_EPS);
    LAS float* lg = stg; LAS int* hist = (LAS int*)(F.lds + TAB_OFF); LAS int* gbase = hist + 32;
    if (F.tid < 32) hist[F.tid] = 0;
#pragma unroll
    for (int r = 0; r < 4; ++r) { const int trow = 4 * q4 + r; lg[trow * 40 + r16] = c0[r]; lg[trow * 40 + 16 + r16] = c1[r]; if (r16 < 4) lg[trow * 40 + 32 + r16] = c2[r]; }
    __syncthreads();
    int ex[2] = {0, 0}, sl[2] = {0, 0}; float wt[2] = {0.f, 0.f};
    if (lane < 16) {
        const float* bg = F.in[15]; const float* be = F.in[17];
        float gl[4]; int gi = 0;
#pragma unroll
        for (int g = 0; g < 4; ++g) gl[g] = rinv * lg[lane * 40 + 32 + g] + bg[g];
        float gm = gl[0];
#pragma unroll
        for (int g = 1; g < 4; ++g) if (gl[g] > gm) { gm = gl[g]; gi = g; }
        float gs = 0.f;
#pragma unroll
        for (int g = 0; g < 4; ++g) gs += __expf(gl[g] - gm);
        const float gw = 1.0f / gs;
        float el[8];
#pragma unroll
        for (int e = 0; e < 8; ++e) el[e] = rinv * lg[lane * 40 + gi * 8 + e] + be[gi * 8 + e];
        int i1 = 0; float m1 = el[0];
#pragma unroll
        for (int e = 1; e < 8; ++e) if (el[e] > m1) { m1 = el[e]; i1 = e; }
        int i2 = -1; float m2 = -3.0e38f;
#pragma unroll
        for (int e = 0; e < 8; ++e) if (e != i1 && el[e] > m2) { m2 = el[e]; i2 = e; }
        const float e2 = __expf(m2 - m1), w1 = 1.0f / (1.0f + e2), w2 = e2 * w1;
        ex[0] = gi * 8 + i1; ex[1] = gi * 8 + i2; wt[0] = gw * w1; wt[1] = gw * w2;
        sl[0] = __hip_atomic_fetch_add(hist + ex[0], 1, __ATOMIC_RELAXED, __HIP_MEMORY_SCOPE_WORKGROUP);
        sl[1] = __hip_atomic_fetch_add(hist + ex[1], 1, __ATOMIC_RELAXED, __HIP_MEMORY_SCOPE_WORKGROUP);
    }
    __syncthreads();
    if (F.tid < 32) gbase[F.tid] = (int)atomicAdd(F.ctl + CW_ECNT + F.tid, (unsigned)hist[F.tid]);
    __syncthreads();
    if (lane < 16) {
        int* MTOK = (int*)(F.ws + WS_MTOK); int* MDST = (int*)(F.ws + WS_MDST); float* MW = (float*)(F.ws + WS_MW); float* MRS = (float*)(F.ws + WS_MRS);
#pragma unroll
        for (int k = 0; k < 2; ++k) { const size_t p = (size_t)ex[k] * T + gbase[ex[k]] + sl[k]; MTOK[p] = tok; MDST[p] = k * T + tok; MW[p] = wt[k]; MRS[p] = rinv; }
    }
    __syncthreads();
}
constexpr int N_PHASES = 14;
struct Args { const float* in[22]; float* out; unsigned char* ws; int ph_lo, ph_hi, use_bar, pad; };
__global__ void __launch_bounds__(NTHR, 2) fwd(Args args) {
    extern __shared__ __attribute__((aligned(16))) unsigned char lds[];
    Frame F;
    F.lds = (LAS unsigned char*)lds; F.MISC = (volatile LAS unsigned*)(F.lds + MISC_OFF);
    F.tid = threadIdx.x; F.lane = F.tid & 63; F.wave = __builtin_amdgcn_readfirstlane(F.tid >> 6);
    F.G = gridDim.x; { const int bx = blockIdx.x; F.vcu = (F.G % 8 == 0) ? (bx % 8) * (F.G / 8) + bx / 8 : bx; }
    F.ws = args.ws; F.out = args.out; F.ctl = (unsigned*)(args.ws + WS_CTL);
#pragma unroll
    for (int i = 0; i < 22; ++i) F.in[i] = args.in[i];
    if (F.tid < 64) F.MISC[F.tid] = 0u;
    __syncthreads();
    XcdBarrier bar; bar.bar = F.ctl + CW_BAR; bar.x = 0; bar.st = nullptr;
    if (args.use_bar) bar = xcd_barrier_post(F.ctl + CW_BAR, F.MISC + 8);
    const int lo = args.ph_lo, hi = args.ph_hi;
#define IN(k) (lo <= (k) && (k) < hi)
#define SEAM(k) do { if (IN(k) && IN((k) + 1)) xcd_barrier(bar); } while (0)

    if (IN(0)) { p0_prologue(F); __syncthreads(); }
    SEAM(0);
    if (IN(1)) {
        const pg8::EpiIn E0{(bf16_t*)(F.ws + WS_XREC), (bf16_t*)(F.ws + WS_GREC), (bf16_t*)(F.ws + WS_Q), (bf16_t*)(F.ws + WS_K), (bf16_t*)(F.ws + WS_V), (bf16_t*)(F.ws + WS_SGR), (bf16_t*)(F.ws + WS_SGA), 1.0f, IN_BF,
            TrSrc{F.in[2], F.in[10], F.in[11], F.in[12], F.in[18], F.in[19], F.in[20], F.ws}, F.vcu, F.G};
        if (IN_NBF > 0) {
            pg8::DenseProbT<0> P{(const void*)(F.ws + WS_XN), (const void*)(F.ws + WS_WIN_T), D, D, D};
            pg8::StaticOrder So; So.init(T, IN_NBF * 256, F.G, (int)blockIdx.x);
            pg8::gemm_phase<pg8::DenseProbT<0>, pg8::EpiIn, pg8::StaticOrder, true>(F.lds, P, So, E0);
        }
        if (IN_NF8 > 0) {
            pg8::DenseProbT<QM_IN> P{(const void*)F.out, (const void*)(F.ws + WS_WIN8), D, D, D};
            pg8::StaticOrder So; So.init(T, IN_NF8 * 256, F.G, (int)blockIdx.x);
            pg8::EpiIn E = E0; E.osc = 1.0f / (Q_SA_IN * Q_SB_IN); E.mask = IN_F8;
            pg8::gemm_phase<pg8::DenseProbT<QM_IN>, pg8::EpiIn, pg8::StaticOrder, true>(F.lds, P, So, E);
        }
    }
    SEAM(1);
    if (IN(2)) {
#if EN_ATTN
        for (int u = F.vcu; u < NB * NH * NBLK; u += F.G) kmean_unit(F, u);
#endif
        for (int u = F.vcu; u < NB * NBLK * 4; u += F.G) { const int b = u >> 7, chunk = (u >> 2) & 31, cq = u & 3;
            scan_unit<false>(F, b, chunk, cq);
            asm volatile("s_waitcnt vmcnt(0)" ::: "memory");
            __syncthreads();
            unsigned* fl = F.ctl + CW_SFLAG + (b * NBLK) * 4 + cq;
            if (F.tid == 0) (void)xb_add(fl + chunk * 4, 1u);
            if (F.lane < chunk) { unsigned sp = 0u; while (xb_ld(fl + F.lane * 4) == 0u) { __builtin_amdgcn_s_sleep(1); if (++sp > (1u << 22)) break; } }
            asm volatile("s_waitcnt vmcnt(0)" ::: "memory");
            scan_fix(F, (((b * NBLK) + chunk) << 5) | (cq * 8 + F.wave));
            asm volatile("s_waitcnt vmcnt(0)" ::: "memory"); __syncthreads();
        }
    }
    SEAM(2);
    if (IN(3)) {
#if EN_ATTN
        route_phase(F);
#endif
        __syncthreads();
    }
    SEAM(3);
    if (IN(4)) {
#if EN_ATTN
        LAS int* ipre = (LAS int*)(F.lds + TAB_OFF); LAS int* tmp = ipre + 1040; LAS int* lb = tmp + 512;
        const int t = F.tid; const unsigned* ac = F.ctl + CW_ACNT;
        const int v0 = ((int)ac[2 * t] + 255) >> 8, v1 = ((int)ac[2 * t + 1] + 255) >> 8;
        tmp[t] = v0 + v1;
        __syncthreads();
        if (t < 64) { int w = 0;
#pragma unroll
            for (int i = 0; i < 8; ++i) w += tmp[t * 8 + i];
            int inc = w;
#pragma unroll
            for (int o = 1; o < 64; o <<= 1) { const int y = __shfl_up(inc, o); if (t >= o) inc += y; }
            lb[t] = inc - w; }
        __syncthreads();
        { int base = lb[t >> 3]; for (int u2 = (t & ~7); u2 < t; ++u2) base += tmp[u2];
          ipre[2 * t] = base; ipre[2 * t + 1] = base + v0; if (t == NTHR - 1) ipre[1024] = base + v0 + v1; }
        __syncthreads();
        const int nitems = ipre[1024];
        att::phase(F, ipre, nitems, ac);
#endif
    }
    SEAM(4);
    if (IN(5)) {
#if EN_ATTN
        { const float* LSE = (const float*)(F.ws + WS_LSE) + (size_t)(F.lane >> 3) * 4; int t = F.vcu * NWAVES + F.wave;
          f32x4 ls = *(const f32x4*)(LSE + (size_t)t * NH * 4); asm volatile("" : "+v"(ls));
          for (; t < T; t += F.G * NWAVES) { const int tn = (t + F.G * NWAVES < T) ? t + F.G * NWAVES : t; f32x4 lsn; att::combine_token(F, t, ls, LSE + (size_t)tn * NH * 4, lsn); ls = lsn; } }
#endif
    }
    SEAM(5);
    if (IN(7)) {
        pg8::StaticOrder So; So.init(T, D, F.G, (int)blockIdx.x);
        { pg8::DenseProbT<2> P{(const void*)(F.ws + WS_YC8), (const void*)(F.ws + WS_WP_T), 1024, 2048, 2048};
          pg8::EpiGate<false> E{(const unsigned char*)(F.ws + WS_SGR), (bf16_t*)(F.ws + WS_MERGED), (const float*)(F.ws + WS_RS1), 2, 1.0f / (I8_SP * 255.f)};
          pg8::gemm_phase<pg8::DenseProbT<2>, pg8::EpiGate<false>, pg8::StaticOrder, true>(F.lds, P, So, E); }
#if EN_ATTN
        { pg8::DenseProbT<2> P{(const void*)(F.ws + WS_YC8 + 1024), (const void*)(F.ws + WS_WP_T + 1024), 1024, 2048, 2048};
          pg8::EpiGate<true> E{(const unsigned char*)(F.ws + WS_SGA), (bf16_t*)(F.ws + WS_MERGED), (const float*)(F.ws + WS_RS1) + 1, 2, 1.0f / (I8_SP * 255.f)};
          pg8::gemm_phase<pg8::DenseProbT<2>, pg8::EpiGate<true>, pg8::StaticOrder, true>(F.lds, P, So, E); }
#endif
    }
    SEAM(7);
    if (IN(8)) {
        for (int t = F.vcu * NWAVES + F.wave; t < T; t += F.G * NWAVES) quant_row<false>(F, (const bf16_t*)(F.ws + WS_MERGED), F.ws + WS_MG8, (float*)(F.ws + WS_RS2), t);
    }
    SEAM(8);
    if (IN(9)) {
        pg8::DenseProbT<2> P{(const void*)(F.ws + WS_MG8), (const void*)(F.ws + WS_WOUT_T), D, D, D};
        pg8::StaticOrder So; So.init(T, D, F.G, (int)blockIdx.x);
        pg8::EpiResid E{(bf16_t*)(F.ws + WS_DELTA), (const float*)(F.ws + WS_RS2), 1.0f / I8_SB};
        pg8::gemm_phase<pg8::DenseProbT<2>, pg8::EpiResid, pg8::StaticOrder, true>(F.lds, P, So, E);
    }
    SEAM(9);
    if (IN(10)) {
#if EN_MOE
        for (int it = F.vcu; it < T / 128; it += F.G) router_iter(F, it);
#endif
    }
    SEAM(10);
#if EN_MOE
    LAS int* tpre = (LAS int*)(F.lds + TAB_OFF); LAS int* ecnt = tpre + 40;
    if (IN(11) || IN(12)) {
        if (F.tid == 0) { int a = 0; for (int e = 0; e < NE; ++e) { const int c = (int)F.ctl[CW_ECNT + e]; ecnt[e] = c; tpre[e] = a; a += (c + 255) >> 8; } tpre[NE] = a; }
        __syncthreads();
    }
#endif
    if (IN(11)) {
#if EN_MOE
        pg8::MoeUpProbT<QM_UP> P{(const void*)(F.ws + WS_H2), (const void*)(F.ws + WS_WGU_T), (const int*)(F.ws + WS_MTOK), D, D, D};
        pg8::GroupedOrder So{tpre, ecnt, 4, F.G, F.vcu};
        pg8::EpiHid E{(const float*)(F.ws + WS_MRS), (void*)(F.ws + WS_HID), QM_UP ? 1.0f / (Q_SA_UP * Q_SB_UP) : 1.0f};
        pg8::gemm_phase<pg8::MoeUpProbT<QM_UP>, pg8::EpiHid, pg8::GroupedOrder, true>(F.lds, P, So, E);
#endif
    }
    SEAM(11);
    if (IN(12)) {
#if EN_MOE
        pg8::MoeDownProbT<QM_DOWN> P{(const void*)(F.ws + WS_HID), (const void*)(F.ws + WS_WD_T), EH, EH, EH};
        pg8::GroupedOrder So{tpre, ecnt, 8, F.G, F.vcu};
        pg8::EpiDown E{(const int*)(F.ws + WS_MDST), (const float*)(F.ws + WS_MW), (unsigned char*)(F.ws + WS_Y), FP8_DOWN ? 1.0f / (FP8_SH * FP8_SD) : 1.0f};
        pg8::gemm_phase<pg8::MoeDownProbT<QM_DOWN>, pg8::EpiDown, pg8::GroupedOrder, true>(F.lds, P, So, E);
#endif
    }
    SEAM(12);
    if (IN(13)) final_norm(F);
#undef IN
#undef SEAM
}

extern "C" void kernel_launch(void* const* d_in, const int* in_sizes, int n_in, void* d_out, int out_size, void* d_ws, size_t ws_size, hipStream_t stream) {
    static int grid = 0;
    if (grid == 0) {
        if (n_in != 22 || in_sizes[0] != T * D || out_size != T * D || ws_size < WS_END) { fprintf(stderr, "kernel_launch: shape / workspace mismatch (n_in %d, ws %zu)\n", n_in, ws_size); grid = -1; return; }
        int dev = 0, cus = 0, per_cu = 0;
        if (hipGetDevice(&dev) != hipSuccess || hipDeviceGetAttribute(&cus, hipDeviceAttributeMultiprocessorCount, dev) != hipSuccess) { grid = -1; return; }
        if (hipFuncSetAttribute((const void*)fwd, hipFuncAttributeMaxDynamicSharedMemorySize, LDS_BYTES) != hipSuccess) { fprintf(stderr, "kernel_launch: hipFuncSetAttribute failed\n"); grid = -1; return; }
        if (hipOccupancyMaxActiveBlocksPerMultiprocessor(&per_cu, (const void*)fwd, NTHR, LDS_BYTES) != hipSuccess || per_cu < 1) { fprintf(stderr, "kernel_launch: occupancy query says %d blocks per CU\n", per_cu); }
        (void)hipGetLastError();
        grid = cus;
    }
    if (grid < 0) return;
    (void)hipMemsetAsync((char*)d_ws + WS_CTL, 0, CTL_ZERO_BYTES, stream);
    Args a{};
    for (int i = 0; i < 22; ++i) a.in[i] = (const float*)d_in[i];
    a.out = (float*)d_out; a.ws = (unsigned char*)d_ws; a.pad = 0;
#if MK_N_LAUNCHES == 1
    a.ph_lo = 0; a.ph_hi = N_PHASES; a.use_bar = 1;
    hipLaunchKernelGGL(fwd, dim3(grid), dim3(NTHR), LDS_BYTES, stream, a);
#else
    for (int p = 0; p < N_PHASES; ++p) { a.ph_lo = p; a.ph_hi = p + 1; a.use_bar = 0; hipLaunchKernelGGL(fwd, dim3(grid), dim3(NTHR), LDS_BYTES, stream, a); }
#endif
}
```

```cpp
#include <hip/hip_runtime.h>
#include <stdint.h>
#include <cstdio>

#ifndef MK_N_LAUNCHES
#define MK_N_LAUNCHES 1
#endif
#ifndef EN_ATTN
#define EN_ATTN 1
#endif
#ifndef EN_MOE
#define EN_MOE 1
#endif

#define LAS __attribute__((address_space(3)))
#define GAS __attribute__((address_space(1)))
typedef unsigned short bf16_t;
typedef short bf16x8 __attribute__((ext_vector_type(8)));
typedef short s16x4 __attribute__((ext_vector_type(4)));
typedef float f32x2 __attribute__((ext_vector_type(2)));
typedef float f32x4 __attribute__((ext_vector_type(4)));
typedef float f32x16 __attribute__((ext_vector_type(16)));
typedef unsigned u32x2 __attribute__((ext_vector_type(2)));
typedef unsigned u32x4 __attribute__((ext_vector_type(4)));
typedef int i32x4 __attribute__((ext_vector_type(4)));
typedef int i32x8 __attribute__((ext_vector_type(8)));

constexpr int NB = 4, S = 8192, T = NB * S, D = 2048;
constexpr int LW = 1024, NLB = 8, LBD = 128;
constexpr int NH = 8, HD = 128, AW = NH * HD, MBLK = 256, NBLK = S / MBLK;
constexpr int NE = 32, NG = 4, EPG = 8, EH = 512;
constexpr int INW = 2 * LW + 3 * AW + 2 * D;
constexpr float RMS_EPS = 1e-6f;
constexpr int NWAVES = 8, NTHR = 512;

constexpr size_t MiB = (size_t)1 << 20;
constexpr size_t WS_CTL = 0, CTL_ZERO_BYTES = 128 * 1024;
constexpr size_t WS_WA_T = 1 * MiB;
constexpr size_t WS_WX_T = WS_WA_T + 256 * 1024;
constexpr size_t WS_WR_T = WS_WX_T + 256 * 1024;
constexpr size_t WS_KMEAN = 2 * MiB;
constexpr size_t WS_SSUM = WS_KMEAN + 512 * 1024;
constexpr size_t WS_KNORM = WS_SSUM + 1024 * 1024;
constexpr size_t WS_KMH = WS_KNORM + 64 * 1024, WS_KML = WS_KMH + 256 * 1024;
constexpr size_t WS_WIN_T = 8 * MiB;
constexpr size_t WS_WP_T = 44 * MiB;
constexpr size_t WS_WOUT_T = 52 * MiB;
constexpr size_t WS_WGU_T = 60 * MiB;
constexpr size_t WS_WD_T = 188 * MiB;
constexpr size_t WS_ALIST = 252 * MiB;
constexpr size_t WS_MTOK = 268 * MiB, WS_MDST = 272 * MiB, WS_MW = 276 * MiB, WS_MRS = 280 * MiB;
constexpr size_t WS_XN = 284 * MiB;
constexpr size_t WS_YCAT = WS_XN, WS_H2 = WS_XN;
constexpr size_t WS_XREC = 412 * MiB, WS_GREC = 476 * MiB;
constexpr size_t WS_MERGED = WS_XREC;
constexpr size_t WS_LSE = 988 * MiB;
constexpr size_t WS_Q = 540 * MiB, WS_K = 604 * MiB, WS_V = 668 * MiB;
constexpr size_t WS_HID = WS_Q;
constexpr size_t WS_YC8 = WS_Q;
constexpr size_t WS_RS1 = WS_K, WS_RS2 = WS_K + 1 * MiB;
constexpr size_t WS_MG8 = WS_V;
constexpr size_t WS_SGR = 732 * MiB, WS_SGA = 860 * MiB;
constexpr size_t WS_Y = WS_SGR;
constexpr size_t WS_DELTA = WS_SGA;
constexpr size_t WS_WIN8 = 988 * MiB;
constexpr size_t WS_END = 1008 * MiB;
constexpr size_t OUT_PART = 0, OUT_LSE = 192 * MiB;
constexpr int ALIST_PER_BH = 256 * 496;
__host__ __device__ constexpr int alist_off(int n) { return 256 * (31 * n - (n * (n - 1)) / 2); }

constexpr int CW_TMO = 0;
constexpr int CW_BAR = 4096;
constexpr int CW_ACNT = 16384;
constexpr int CW_ECNT = 20480;
constexpr int CW_SFLAG = 24576;

constexpr int RING_BYTES = 131072;
constexpr int MISC_OFF = 139264;
constexpr int TAB_OFF = MISC_OFF + 256;
constexpr int LDS_BYTES = 163840;

__device__ __forceinline__ unsigned cvt_pk_bf16(float lo, float hi) { unsigned r; asm volatile("v_cvt_pk_bf16_f32 %0, %1, %2" : "=v"(r) : "v"(lo), "v"(hi)); return r; }
__device__ __forceinline__ float bf_lo(unsigned w) { return __uint_as_float(w << 16); }
__device__ __forceinline__ float bf_hi(unsigned w) { return __uint_as_float(w & 0xffff0000u); }
__device__ __forceinline__ float bf2f(bf16_t v) { return __uint_as_float(((unsigned)v) << 16); }
__device__ __forceinline__ float fsigmoid(float z) { return __builtin_amdgcn_rcpf(1.0f + __builtin_amdgcn_exp2f(-1.4426950408889634f * z)); }
__device__ __forceinline__ float gelu_tanh(float x) { const float u = 1.5957691216057308f * (x + 0.044715f * x * x * x); return x * fsigmoid(u); }
__device__ __forceinline__ float wave_sum(float v) {
#pragma unroll
    for (int o = 1; o < 64; o <<= 1) v += __shfl_xor(v, o);
    return v;
}
#define LDS_WAIT() asm volatile("s_waitcnt lgkmcnt(0)" ::: "memory")
#define VM_WAIT() asm volatile("s_waitcnt vmcnt(0)" ::: "memory")

#define XB_TMO      128
#define XB_XCNT(j)  (256  + 64 * (j))
#define XB_XSUB(j)  (1280 + 64 * (j))
#define XB_XGEN(j)  (2304 + 64 * (j))
#define XB_TOP      3328
#define XB_TOPGEN   3392
#define XCD_BAR_WORDS 3456
#define XB_SPIN_CAP (1u << 18)
__device__ __forceinline__ unsigned xb_ld(unsigned* p)              { return __hip_atomic_load(p, __ATOMIC_RELAXED, __HIP_MEMORY_SCOPE_AGENT); }
__device__ __forceinline__ unsigned xb_add(unsigned* p, unsigned v) { return __hip_atomic_fetch_add(p, v, __ATOMIC_RELAXED, __HIP_MEMORY_SCOPE_AGENT); }
__device__ __forceinline__ unsigned xb_xcc_id() { return (unsigned)__builtin_amdgcn_s_getreg((3 << 11) | 20) & 0xFu; }
#define XB_SPIN(cond, bar) do { unsigned _sp = 0; while (cond) { __builtin_amdgcn_s_sleep(1); \
    if ((++_sp & 255u) == 0u) { if (xb_ld(&(bar)[XB_TMO])) break; if (_sp > XB_SPIN_CAP) { atomicAdd(&(bar)[XB_TMO], 1u); break; } } } } while (0)
struct XcdBarrier { unsigned* bar; unsigned x; volatile LAS unsigned* st; };
__device__ __forceinline__ XcdBarrier xcd_barrier_post(unsigned* bar, volatile LAS unsigned* st) {
    XcdBarrier b; b.bar = bar; b.x = xb_xcc_id(); b.st = st;
    if (threadIdx.x == 0) (void)xb_add(&bar[XB_XCNT(b.x)], 1u);
    return b;
}
__device__ __forceinline__ void xcd_barrier_complete(unsigned* bar, unsigned x, unsigned& nloc, unsigned& nx) {
    const unsigned G = gridDim.x * gridDim.y * gridDim.z;
    unsigned sum, cnt, mine, sp = 0u;
    for (;;) {
        sum = 0u; cnt = 0u; mine = 0u;
#pragma unroll
        for (unsigned j = 0; j < 16; ++j) { const unsigned c = xb_ld(&bar[XB_XCNT(j)]); sum += c; cnt += (c > 0u) ? 1u : 0u; mine = (j == x) ? c : mine; }
        if (sum == G) break;
        __builtin_amdgcn_s_sleep(1);
        if ((++sp & 255u) == 0u) { if (xb_ld(&bar[XB_TMO])) break; if (sp > XB_SPIN_CAP) { atomicAdd(&bar[XB_TMO], 1u); break; } }
    }
    nloc = mine > 0u ? mine : 1u; nx = cnt > 0u ? cnt : 1u;
}
__device__ __forceinline__ void xcd_barrier(const XcdBarrier& b) {
    asm volatile("s_waitcnt vmcnt(0)" ::: "memory");
    __syncthreads();
    if (threadIdx.x == 0) {
        unsigned* bar = b.bar;
        __builtin_amdgcn_s_waitcnt(0);
        unsigned nloc = b.st[0], nx = b.st[1];
        if (nloc == 0u) { xcd_barrier_complete(bar, b.x, nloc, nx); b.st[0] = nloc; b.st[1] = nx; }
        const unsigned old = xb_add(&bar[XB_XSUB(b.x)], 1u);
        const unsigned gen = old / nloc;
        if (old + 1u == (gen + 1u) * nloc) {
            __builtin_amdgcn_fence(__ATOMIC_RELEASE, "agent");
            asm volatile("s_waitcnt vmcnt(0)" ::: "memory");
            const unsigned og = xb_add(&bar[XB_TOP], 1u);
            const unsigned tg = og / nx;
            if (og + 1u == (tg + 1u) * nx) xb_add(&bar[XB_TOPGEN], 1u);
            else XB_SPIN(xb_ld(&bar[XB_TOPGEN]) == tg, bar);
            __builtin_amdgcn_fence(__ATOMIC_ACQUIRE, "agent");
            xb_add(&bar[XB_XGEN(b.x)], 1u);
            asm volatile("s_waitcnt vmcnt(0)" ::: "memory");
        } else {
            XB_SPIN(xb_ld(&bar[XB_XGEN(b.x)]) == gen, bar);
            __builtin_amdgcn_fence(__ATOMIC_ACQUIRE, "agent");
            asm volatile("s_waitcnt vmcnt(0)" ::: "memory");
        }
    }
    __syncthreads();
}

namespace pg8 {
constexpr int BM = 256, BK = 64, HALF = 128, HTB = HALF * BK * 2, STAGE_BYTES = 8 * HTB, NXCD = 8, WGM = 4;
__host__ __device__ __forceinline__ int lds_byte(int r, int c) { const int st = (r >> 4) * 2 + (c >> 5), rr = r & 15, cc = c & 31, ob = rr * 64 + cc * 2; return st * 1024 + (ob ^ (((ob >> 9) & 1) << 5)); }
__host__ __device__ __forceinline__ void stage_rc(int b, int& R, int& C) { const int st = b / 1024, sb = b % 1024, swz = sb ^ (((sb >> 9) & 1) << 5); R = (st >> 1) * 16 + swz / 64; C = (st & 1) * 32 + (swz % 64) / 2; }
__host__ __device__ __forceinline__ int perm32(int rho) { const int n = rho >> 4, i = rho & 15; return 8 * (i >> 2) + 4 * n + (i & 3); }

struct Unit { int pm, pn, e, n, rb; };

struct StaticOrder {
    int nM, nN, nwg, G, c;
    __device__ void init(int M, int N, int G_, int c_) { nM = M / BM; nN = N / BM; nwg = nM * nN; G = G_; c = c_; }
    __device__ bool next(int i, Unit& u) const {
        const long L = (long)i * G + c; if (L >= nwg) return false;
        int wgid = (int)L; { const int q = nwg / NXCD, r = nwg % NXCD, xcd = wgid % NXCD, off = wgid / NXCD; wgid = (xcd < r ? xcd * (q + 1) : r * (q + 1) + (xcd - r) * q) + off; }
        const int nig = WGM * nN, gid = wgid / nig, fm = gid * WGM, gsz = (nM - fm) < WGM ? (nM - fm) : WGM;
        u.pm = fm + ((wgid % nig) % gsz); u.pn = (wgid % nig) / gsz; u.e = 0; u.n = 0; u.rb = 0; return true;
    }
};
struct GroupedOrder {
    const LAS int* tpre; const LAS int* cnt; int nct, G, c;
    __device__ bool next(int i, Unit& u) const {
        const int L = i * G + c; const int rt = L / nct; if (rt >= tpre[NE]) return false;
        int e = 0;
#pragma unroll 1
        while (tpre[e + 1] <= rt) ++e;
        u.e = e; u.pm = rt - tpre[e]; u.pn = L - rt * nct; u.n = cnt[e]; u.rb = tpre[e] * BM; return true;
    }
};

template <int QM> struct DenseProbT {
    static constexpr bool GATHER = false; static constexpr int QMODE = QM, EB = QM ? 1 : 2;
    const void* A; const void* Bt; int K, lda, ldb;
    __device__ __forceinline__ const char* a_base(const Unit& u) const { return (const char*)A + (size_t)u.pm * BM * lda * EB; }
    __device__ __forceinline__ const char* b_base(const Unit& u) const { return (const char*)Bt + (size_t)u.pn * BM * ldb * EB; }
    __device__ __forceinline__ void a_off(const Unit&, const int (&R)[2], const int (&C)[2], unsigned (&vo)[2][2]) const {
#pragma unroll
        for (int h = 0; h < 2; ++h)
#pragma unroll
            for (int i = 0; i < 2; ++i) vo[h][i] = (unsigned)((h * HALF + R[i]) * lda) * (unsigned)EB + (unsigned)C[i] * 2u;
    }
};
typedef DenseProbT<0> DenseProb;
template <int QM> struct MoeUpProbT {
    static constexpr bool GATHER = true; static constexpr int QMODE = QM, EB = QM ? 1 : 2;
    const void* A; const void* Bt; const int* tok; int K, lda, ldb;
    __device__ __forceinline__ const char* a_base(const Unit&) const { return (const char*)A; }
    __device__ __forceinline__ const char* b_base(const Unit& u) const { return (const char*)Bt + ((size_t)u.e * 1024 + (size_t)u.pn * BM) * ldb * EB; }
    __device__ __forceinline__ void a_off(const Unit& u, const int (&R)[2], const int (&C)[2], unsigned (&vo)[2][2]) const {
#pragma unroll
        for (int h = 0; h < 2; ++h)
#pragma unroll
            for (int i = 0; i < 2; ++i) { const int s = u.pm * BM + h * HALF + R[i]; const int tl = tok[(size_t)u.e * T + s]; const int t = (s < u.n) ? tl : 0; vo[h][i] = (unsigned)(t * lda) * (unsigned)EB + (unsigned)C[i] * 2u; }
    }
};
template <int QM> struct MoeDownProbT {
    static constexpr bool GATHER = false; static constexpr int QMODE = QM, EB = QM ? 1 : 2;
    const void* A; const void* Bt; int K, lda, ldb;
    __device__ __forceinline__ const char* a_base(const Unit& u) const { return (const char*)A + ((size_t)u.rb + (size_t)u.pm * BM) * lda * EB; }
    __device__ __forceinline__ const char* b_base(const Unit& u) const { return (const char*)Bt + ((size_t)u.e * 2048 + (size_t)u.pn * BM) * ldb * EB; }
    __device__ __forceinline__ void a_off(const Unit&, const int (&R)[2], const int (&C)[2], unsigned (&vo)[2][2]) const {
#pragma unroll
        for (int h = 0; h < 2; ++h)
#pragma unroll
            for (int i = 0; i < 2; ++i) vo[h][i] = (unsigned)((h * HALF + R[i]) * lda) * (unsigned)EB + (unsigned)C[i] * 2u;
    }
};

template <class Prob, class Epi, class Sched, bool ALIGN_EPI>
__device__ __forceinline__ void gemm_phase(LAS unsigned char* lds, const Prob& P, const Sched& S, const Epi& E) {
    const int tid = threadIdx.x, wid = __builtin_amdgcn_readfirstlane(tid >> 6), lane = tid & 63, wr = wid >> 2, wc = wid & 3, fr = lane & 15, fq = lane >> 4;
    constexpr bool FP8 = Prob::QMODE == 1, I8 = Prob::QMODE == 2; constexpr int EB = Prob::QMODE ? 1 : 2;
    const int K = P.K, nt = K / (Prob::QMODE ? 2 * BK : BK);
    const int sc1 = 0x7F7F7F7F;
    int Rr[2], Cc[2]; unsigned voffB[2];
#pragma unroll
    for (int i = 0; i < 2; ++i) { int R, C; stage_rc(tid * 16 + i * 8192, R, C); Rr[i] = R; Cc[i] = C; const int Rb = Epi::PERM ? ((R & ~31) + perm32(R & 31)) : R; voffB[i] = (unsigned)(Rb * P.ldb) * (unsigned)EB + (unsigned)C * 2u; }
    const size_t kstep = (size_t)(BK * 2);
    const size_t hstepB = (size_t)HALF * P.ldb * EB;
    const unsigned ldsw = (unsigned)wid * 1024u;
    const int aoff = lds_byte(wr * 64 + fr, fq * 8), boff = lds_byte(wc * 32 + fr, fq * 8);
#define PG8_SA(b, h) (((b) * 2 + (h)) * HTB)
#define PG8_SB(b, h) ((4 + (b) * 2 + (h)) * HTB)
#define PG8_STAGE(bufoff, gbase, voff) do { _Pragma("unroll") for (int _i = 0; _i < 2; ++_i) \
        __builtin_amdgcn_global_load_lds((const unsigned*)((const char*)(gbase) + (voff)[_i]), (LAS unsigned*)(lds + (bufoff) + ldsw + _i * 8192), 16, 0, 0); } while (0)
#define PG8_LDA(dst, b, h) do { _Pragma("unroll") for (int m = 0; m < 4; ++m) _Pragma("unroll") for (int k = 0; k < 2; ++k) dst[m][k] = *(const LAS bf16x8*)(lds + PG8_SA(b, h) + aoff + m * 2048 + k * 1024); } while (0)
#define PG8_LDB(dst, b, h) do { _Pragma("unroll") for (int n = 0; n < 2; ++n) _Pragma("unroll") for (int k = 0; k < 2; ++k) dst[n][k] = *(const LAS bf16x8*)(lds + PG8_SB(b, h) + boff + n * 2048 + k * 1024); } while (0)
#define PG8_MMA(ai, bj, At, Bt) do { __builtin_amdgcn_s_setprio(1); _Pragma("unroll") for (int m = 0; m < 4; ++m) _Pragma("unroll") for (int n = 0; n < 2; ++n) { \
        if constexpr (FP8) { const i32x8 fb = __builtin_shufflevector(__builtin_bit_cast(i32x4, Bt[n][0]), __builtin_bit_cast(i32x4, Bt[n][1]), 0, 1, 2, 3, 4, 5, 6, 7); \
            const i32x8 fa = __builtin_shufflevector(__builtin_bit_cast(i32x4, At[m][0]), __builtin_bit_cast(i32x4, At[m][1]), 0, 1, 2, 3, 4, 5, 6, 7); \
            asm volatile("s_nop 1\n\tv_mfma_scale_f32_16x16x128_f8f6f4 %0, %1, %2, %0, %3, %3 op_sel_hi:[0,0,0]" : "+v"(acc[ai][bj][m][n]) : "v"(fb), "v"(fa), "v"(sc1)); } \
        else if constexpr (I8) { _Pragma("unroll") for (int k = 0; k < 2; ++k) acc[ai][bj][m][n] = __builtin_bit_cast(f32x4, __builtin_amdgcn_mfma_i32_16x16x64_i8(__builtin_bit_cast(i32x4, Bt[n][k]), __builtin_bit_cast(i32x4, At[m][k]), __builtin_bit_cast(i32x4, acc[ai][bj][m][n]), 0, 0, 0)); } \
        else { _Pragma("unroll") for (int k = 0; k < 2; ++k) acc[ai][bj][m][n] = __builtin_amdgcn_mfma_f32_16x16x32_bf16(Bt[n][k], At[m][k], acc[ai][bj][m][n], 0, 0, 0); } } \
        __builtin_amdgcn_s_setprio(0); } while (0)
#define PG8_WAIT_V(n) asm volatile("s_waitcnt vmcnt(" #n ")" ::: "memory")
#define PG8_WAIT_L(n) asm volatile("s_waitcnt lgkmcnt(" #n ")" ::: "memory")
#define PG8_BAR __builtin_amdgcn_s_barrier()
#define PG8_SCHED __builtin_amdgcn_sched_barrier(0)
    Unit cur, nxt; int ui = 0;
    if (!S.next(0, cur)) return;
    f32x4 acc[2][2][4][2];
#pragma unroll
    for (int a = 0; a < 2; ++a)
#pragma unroll
        for (int b = 0; b < 2; ++b)
#pragma unroll
            for (int m = 0; m < 4; ++m)
#pragma unroll
                for (int n = 0; n < 2; ++n) acc[a][b][m][n] = (f32x4){0.f, 0.f, 0.f, 0.f};
    bf16x8 At[4][2], B0[2][2], B1[2][2];
    unsigned vA[2][2], vN[2][2];
    P.a_off(cur, Rr, Cc, vA);
#pragma unroll
    for (int h = 0; h < 2; ++h) { vN[h][0] = vA[h][0]; vN[h][1] = vA[h][1]; }
    const char* cA = P.a_base(cur); const char* cB = P.b_base(cur);
    PG8_STAGE(PG8_SB(0, 0), cB, voffB); PG8_STAGE(PG8_SB(0, 1), cB + hstepB, voffB); PG8_STAGE(PG8_SA(0, 0), cA, vA[0]); PG8_STAGE(PG8_SA(0, 1), cA, vA[1]);
    if (wr == 1) PG8_BAR;
    PG8_WAIT_V(2); PG8_BAR;
    PG8_STAGE(PG8_SB(1, 0), cB + kstep, voffB); PG8_STAGE(PG8_SA(1, 0), cA + kstep, vA[0]); PG8_STAGE(PG8_SB(1, 1), cB + hstepB + kstep, voffB);
    PG8_WAIT_V(6); PG8_BAR;
    for (;;) {
        const bool has_next = S.next(ui + 1, nxt);
        const char* nA = has_next ? P.a_base(nxt) : cA; const char* nB = has_next ? P.b_base(nxt) : cB;
        for (int t = 0; t < nt; t += 2) {
            const bool last = (t == nt - 2);
            const char* a1 = cA + (size_t)(t + 1) * kstep;
            const char* a2 = last ? nA : cA + (size_t)(t + 2) * kstep; const char* b2 = last ? nB : cB + (size_t)(t + 2) * kstep;
            const char* a3 = a2 + kstep; const char* b3 = b2 + kstep;
            if constexpr (Prob::GATHER) { if (last && has_next) P.a_off(nxt, Rr, Cc, vN); }
            unsigned vS[2][2];
#pragma unroll
            for (int h = 0; h < 2; ++h) { vS[h][0] = (Prob::GATHER && last) ? vN[h][0] : vA[h][0]; vS[h][1] = (Prob::GATHER && last) ? vN[h][1] : vA[h][1]; }
            PG8_LDB(B0, 0, 0); PG8_LDB(B1, 0, 1); PG8_SCHED; PG8_LDA(At, 0, 0); PG8_STAGE(PG8_SA(1, 1), a1, vA[1]);
            PG8_WAIT_V(8); PG8_WAIT_L(0); PG8_BAR; PG8_MMA(0, 0, At, B0); PG8_MMA(0, 1, At, B1); PG8_BAR; PG8_SCHED;
            PG8_LDA(At, 0, 1); PG8_STAGE(PG8_SB(0, 0), b2, voffB); PG8_STAGE(PG8_SB(0, 1), b2 + hstepB, voffB); PG8_STAGE(PG8_SA(0, 0), a2, vS[0]);
            PG8_WAIT_V(8); PG8_WAIT_L(0); PG8_BAR; PG8_MMA(1, 0, At, B0); PG8_MMA(1, 1, At, B1); PG8_BAR; PG8_SCHED;
            PG8_LDB(B0, 1, 0); PG8_LDB(B1, 1, 1); PG8_SCHED; PG8_LDA(At, 1, 0); PG8_STAGE(PG8_SA(0, 1), a2, vS[1]);
            PG8_WAIT_V(8); PG8_WAIT_L(0); PG8_BAR; PG8_MMA(0, 0, At, B0); PG8_MMA(0, 1, At, B1); PG8_BAR; PG8_SCHED;
            PG8_LDA(At, 1, 1); PG8_STAGE(PG8_SB(1, 0), b3, voffB); PG8_STAGE(PG8_SB(1, 1), b3 + hstepB, voffB); PG8_STAGE(PG8_SA(1, 0), a3, vS[0]);
            PG8_WAIT_V(8); PG8_WAIT_L(0); PG8_BAR; PG8_MMA(1, 0, At, B0); PG8_MMA(1, 1, At, B1); PG8_BAR; PG8_SCHED;
        }
        if constexpr (ALIGN_EPI) { if (wr == 0) PG8_BAR; }
        if constexpr (FP8) asm volatile("s_nop 15\n\ts_nop 15" ::: "memory");
        if constexpr (I8) {
#pragma unroll
            for (int a = 0; a < 2; ++a)
#pragma unroll
                for (int b = 0; b < 2; ++b)
#pragma unroll
                    for (int m = 0; m < 4; ++m)
#pragma unroll
                        for (int n = 0; n < 2; ++n) { const i32x4 iv = __builtin_bit_cast(i32x4, acc[a][b][m][n]); acc[a][b][m][n] = (f32x4){(float)iv[0], (float)iv[1], (float)iv[2], (float)iv[3]}; } }
        E(acc, cur, wr, wc, fr, fq);
        if constexpr (Epi::SIDE) E.side_work(ui, wid, lane);
        if (!has_next) break;
#pragma unroll
        for (int a = 0; a < 2; ++a)
#pragma unroll
            for (int b = 0; b < 2; ++b)
#pragma unroll
                for (int m = 0; m < 4; ++m)
#pragma unroll
                    for (int n = 0; n < 2; ++n) acc[a][b][m][n] = (f32x4){0.f, 0.f, 0.f, 0.f};
        cur = nxt; cA = nA; cB = nB; ++ui;
        if constexpr (Prob::GATHER) {
#pragma unroll
            for (int h = 0; h < 2; ++h) { vA[h][0] = vN[h][0]; vA[h][1] = vN[h][1]; }
        }
        if constexpr (ALIGN_EPI) { if (wr == 1) PG8_BAR; }
    }
    PG8_WAIT_V(0);
    if constexpr (!ALIGN_EPI) { if (wr == 0) PG8_BAR; }
    PG8_BAR;
#undef PG8_SA
#undef PG8_SB
#undef PG8_STAGE
#undef PG8_LDA
#undef PG8_LDB
#undef PG8_MMA
#undef PG8_WAIT_V
#undef PG8_WAIT_L
#undef PG8_BAR
#undef PG8_SCHED
}
}

#ifndef Q_MASK
#define Q_MASK 0xFFFFFFFFFull
#endif
#ifndef QM_IN
#define QM_IN 2
#endif
#ifndef QM_UP
#define QM_UP 2
#endif
#ifndef QM_DOWN
#define QM_DOWN 1
#endif
constexpr unsigned long long IN_F8 = Q_MASK & 0xFFFFFFFFFull, IN_BF = ~IN_F8 & 0xFFFFFFFFFull;
constexpr int IN_NF8 = __builtin_popcountll(IN_F8), IN_NBF = 36 - IN_NF8;
constexpr float FP8_SA = 32.f, FP8_SB = 1024.f;
constexpr float I8_SA = 32.f, I8_SB = 1448.f, I8_SH2 = 26.f;
__device__ __forceinline__ unsigned pk4_fp8(float a, float b, float c, float d) {
    a = fminf(fmaxf(a, -448.f), 448.f); b = fminf(fmaxf(b, -448.f), 448.f); c = fminf(fmaxf(c, -448.f), 448.f); d = fminf(fmaxf(d, -448.f), 448.f);
    int w = __builtin_amdgcn_cvt_pk_fp8_f32(a, b, 0, false); w = __builtin_amdgcn_cvt_pk_fp8_f32(c, d, w, true); return (unsigned)w;
}
__device__ __forceinline__ unsigned pk4_i8(float a, float b, float c, float d) {
    const int ia = (int)__builtin_rintf(fminf(fmaxf(a, -127.f), 127.f)), ib = (int)__builtin_rintf(fminf(fmaxf(b, -127.f), 127.f));
    const int ic = (int)__builtin_rintf(fminf(fmaxf(c, -127.f), 127.f)), id = (int)__builtin_rintf(fminf(fmaxf(d, -127.f), 127.f));
    return (unsigned)(ia & 0xff) | ((unsigned)(ib & 0xff) << 8) | ((unsigned)(ic & 0xff) << 16) | ((unsigned)(id & 0xff) << 24);
}
__device__ __forceinline__ unsigned pk4_u8(float a, float b, float c, float d) {
    const unsigned ia = (unsigned)__builtin_rintf(a), ib = (unsigned)__builtin_rintf(b), ic = (unsigned)__builtin_rintf(c), id = (unsigned)__builtin_rintf(d);
    return ia | (ib << 8) | (ic << 16) | (id << 24);
}
template <int QM> __device__ __forceinline__ unsigned pk4_q(float a, float b, float c, float d) { if (QM == 2) return pk4_i8(a, b, c, d); else return pk4_fp8(a, b, c, d); }
constexpr float I8_SP = 1024.f;
constexpr float Q_SA_IN = QM_IN == 2 ? I8_SA : FP8_SA, Q_SB_IN = QM_IN == 2 ? I8_SB : FP8_SB;
constexpr float Q_SA_UP = QM_UP == 2 ? I8_SH2 : FP8_SA, Q_SB_UP = QM_UP == 2 ? I8_SB : FP8_SB;
#define FP8_UP (QM_UP != 0)
#define FP8_DOWN (QM_DOWN != 0)
constexpr float FP8_SH = 16.f, FP8_SD = 512.f, FP8_SY = 64.f;
struct TrDesc { const float* W; unsigned char* WT; int ldw, k0, n0, ldt, drow0, dk0, qm; float sc; };
constexpr int TR_I_IN = 32 * 144, TR_I_PR = 16 * 32, TR_I_OUT = 32 * 32, TR_I_EXG = NE * 32 * 8, TR_I_EXD = NE * 8 * 32;
constexpr int TR_NITEMS = TR_I_IN + 2 * TR_I_PR + TR_I_OUT + 2 * TR_I_EXG + TR_I_EXD;
struct TrSrc { const float *w_in, *p_rec, *p_attn, *w_out, *w_gate, *w_up, *w_down; unsigned char* ws; };
__device__ __forceinline__ TrDesc tr_decode(const TrSrc& F, int r) {
    TrDesc d; d.dk0 = 0;
    if (r < TR_I_IN) { d.n0 = 64 * (r % 144); d.k0 = 64 * (r / 144); d.W = F.w_in; d.ldw = INW; d.ldt = 2048; d.qm = QM_IN; d.sc = Q_SB_IN; d.WT = F.ws + WS_WIN8; d.drow0 = d.n0; return d; } r -= TR_I_IN;
    if (r < 2 * TR_I_PR) { const int at = r >= TR_I_PR; if (at) r -= TR_I_PR; d.W = at ? F.p_attn : F.p_rec; d.ldw = 2048; d.k0 = 64 * (r / 32); d.n0 = 64 * (r % 32); d.WT = F.ws + WS_WP_T; d.ldt = 2048; d.drow0 = d.n0; d.dk0 = at ? 1024 : 0; d.qm = 2; d.sc = I8_SP; return d; } r -= 2 * TR_I_PR;
    if (r < TR_I_OUT) { d.W = F.w_out; d.ldw = 2048; d.k0 = 64 * (r / 32); d.n0 = 64 * (r % 32); d.WT = F.ws + WS_WOUT_T; d.ldt = 2048; d.drow0 = d.n0; d.qm = 2; d.sc = I8_SB; return d; } r -= TR_I_OUT;
    if (r < 2 * TR_I_EXG) { const int up = r >= TR_I_EXG; if (up) r -= TR_I_EXG; const int e = r / 256, rr = r % 256; d.n0 = 64 * (rr % 8); d.k0 = 64 * (rr / 8);
        d.W = (up ? F.w_up : F.w_gate) + (size_t)e * D * EH; d.ldw = EH; d.ldt = 2048; d.drow0 = (d.n0 >> 7) * 256 + (d.n0 & 127) + (up ? 128 : 0);
        d.qm = QM_UP; d.sc = Q_SB_UP; d.WT = F.ws + WS_WGU_T + (size_t)e * 1024 * 2048; return d; } r -= 2 * TR_I_EXG;
    { const int e = r / 256, rr = r % 256; d.W = F.w_down + (size_t)e * EH * D; d.ldw = D; d.k0 = 64 * (rr / 32); d.n0 = 64 * (rr % 32); d.ldt = 512; d.drow0 = d.n0;
      d.qm = QM_DOWN; d.sc = FP8_SD; d.WT = F.ws + WS_WD_T + (size_t)e * 2048 * 512; }
    return d;
}
__device__ __forceinline__ void tr_load(const TrDesc& d, f32x4 (&v)[16], int lane) {
    const float* p = d.W + (size_t)(d.k0 + 16 * (lane >> 4)) * d.ldw + d.n0 + 4 * (lane & 15);
#pragma unroll
    for (int i = 0; i < 16; ++i) v[i] = *(const f32x4*)(p + (size_t)i * d.ldw);
}
__device__ __forceinline__ void tr_store(const TrDesc& d, const f32x4 (&v)[16], int lane) {
    unsigned char* q = d.WT + (size_t)(d.drow0 + 4 * (lane & 15)) * d.ldt + d.dk0 + d.k0 + 16 * (lane >> 4); const float sc = d.sc;
#pragma unroll
    for (int c = 0; c < 4; ++c) { u32x4 o;
        if (d.qm == 2) { o.x = pk4_i8(v[0][c] * sc, v[1][c] * sc, v[2][c] * sc, v[3][c] * sc); o.y = pk4_i8(v[4][c] * sc, v[5][c] * sc, v[6][c] * sc, v[7][c] * sc); o.z = pk4_i8(v[8][c] * sc, v[9][c] * sc, v[10][c] * sc, v[11][c] * sc); o.w = pk4_i8(v[12][c] * sc, v[13][c] * sc, v[14][c] * sc, v[15][c] * sc); }
        else { o.x = pk4_fp8(v[0][c] * sc, v[1][c] * sc, v[2][c] * sc, v[3][c] * sc); o.y = pk4_fp8(v[4][c] * sc, v[5][c] * sc, v[6][c] * sc, v[7][c] * sc); o.z = pk4_fp8(v[8][c] * sc, v[9][c] * sc, v[10][c] * sc, v[11][c] * sc); o.w = pk4_fp8(v[12][c] * sc, v[13][c] * sc, v[14][c] * sc, v[15][c] * sc); }
        *(u32x4*)(q + (size_t)c * d.ldt) = o; }
}

namespace pg8 {
struct EpiIn {
    static constexpr bool PERM = true, SIDE = true;
    bf16_t *xrec, *grec, *q, *k, *v, *sgr, *sga; float osc; unsigned long long mask; TrSrc src; int side_c, side_stride;
    __device__ __forceinline__ void side_work(int ui, int wid, int lane) const {
        const int item = TR_I_IN + side_c + (ui * 8 + wid) * side_stride; if (item >= TR_NITEMS) return;
        const TrDesc d = tr_decode(src, item); f32x4 v[16]; tr_load(d, v, lane); tr_store(d, v, lane); }
    __device__ __forceinline__ void operator()(const f32x4 (&acc)[2][2][4][2], const Unit& u, int wr, int wc, int fr, int fq) const {
        int pn = 0; { int left = u.pn; unsigned long long mm = mask; for (;;) { const int b = __builtin_ctzll(mm); if (left == 0) { pn = b; break; } mm &= mm - 1; --left; } }
        bf16_t* base; int ldc, ct, act;
        if (pn < 4) { base = xrec; ldc = 1024; ct = pn; act = 0; }
        else if (pn < 8) { base = grec; ldc = 1024; ct = pn - 4; act = 1; }
        else if (pn < 12) { base = q; ldc = 1024; ct = pn - 8; act = 0; }
        else if (pn < 16) { base = k; ldc = 1024; ct = pn - 12; act = 0; }
        else if (pn < 20) { base = v; ldc = 1024; ct = pn - 16; act = 0; }
        else if (pn < 28) { base = sgr; ldc = 2048; ct = pn - 20; act = 2; }
        else { base = sga; ldc = 2048; ct = pn - 28; act = 2; }
        const int row0 = u.pm * BM + wr * 64 + fr, col0 = ct * BM + wc * 32 + 8 * fq;
#pragma unroll
        for (int ai = 0; ai < 2; ++ai)
#pragma unroll
            for (int m = 0; m < 4; ++m) { bf16_t* rowp = base + (size_t)(row0 + ai * HALF + m * 16) * ldc + col0;
#pragma unroll
                for (int bj = 0; bj < 2; ++bj) { f32x4 v0 = acc[ai][bj][m][0] * osc, v1 = acc[ai][bj][m][1] * osc;
                    if (act == 1) {
#pragma unroll
                        for (int j = 0; j < 4; ++j) { v0[j] = gelu_tanh(v0[j]); v1[j] = gelu_tanh(v1[j]); } }
                    if (act == 2) {
#pragma unroll
                        for (int j = 0; j < 4; ++j) { v0[j] = 255.f * fsigmoid(v0[j]); v1[j] = 255.f * fsigmoid(v1[j]); }
                        u32x2 w; w.x = pk4_u8(v0[0], v0[1], v0[2], v0[3]); w.y = pk4_u8(v1[0], v1[1], v1[2], v1[3]);
                        *(u32x2*)((unsigned char*)base + (size_t)(row0 + ai * HALF + m * 16) * 2048 + col0 + bj * HALF) = w; }
                    else { u32x4 w; w.x = cvt_pk_bf16(v0[0], v0[1]); w.y = cvt_pk_bf16(v0[2], v0[3]); w.z = cvt_pk_bf16(v1[0], v1[1]); w.w = cvt_pk_bf16(v1[2], v1[3]);
                        *(u32x4*)(rowp + bj * HALF) = w; } } }
    }
};
template <bool ADD> struct EpiGate {
    static constexpr bool PERM = true, SIDE = false;
    const unsigned char* gate; bf16_t* out; const float* rs; int rss; float osc;
    __device__ __forceinline__ void operator()(const f32x4 (&acc)[2][2][4][2], const Unit& u, int wr, int wc, int fr, int fq) const {
        const int row0 = u.pm * BM + wr * 64 + fr, col0 = u.pn * BM + wc * 32 + 8 * fq;
#pragma unroll
        for (int ai = 0; ai < 2; ++ai) {
            u32x2 gv[4][2]; u32x4 pv[4]; float scv[4];
#pragma unroll
            for (int m = 0; m < 4; ++m) { scv[m] = rs[(size_t)(row0 + ai * HALF + m * 16) * rss];
#pragma unroll
                for (int bj = 0; bj < 2; ++bj) gv[m][bj] = *(const u32x2*)(gate + ((unsigned)(row0 + ai * HALF + m * 16) * 2048u + (unsigned)(col0 + bj * HALF))); }
#pragma unroll
            for (int bj = 0; bj < 2; ++bj) {
                if (ADD) {
#pragma unroll
                    for (int m = 0; m < 4; ++m) pv[m] = *(const u32x4*)(out + ((unsigned)(row0 + ai * HALF + m * 16) * 2048u + (unsigned)(col0 + bj * HALF))); }
                __builtin_amdgcn_sched_barrier(0);
#pragma unroll
                for (int m = 0; m < 4; ++m) { const unsigned off = (unsigned)(row0 + ai * HALF + m * 16) * 2048u + (unsigned)(col0 + bj * HALF); const float sc = scv[m] * osc;
                    const f32x4 a0 = acc[ai][bj][m][0] * sc, a1 = acc[ai][bj][m][1] * sc;
                    const u32x2 g = gv[m][bj];
                    float r[8];
                    r[0] = (float)(g.x & 0xffu) * a0[0]; r[1] = (float)((g.x >> 8) & 0xffu) * a0[1]; r[2] = (float)((g.x >> 16) & 0xffu) * a0[2]; r[3] = (float)(g.x >> 24) * a0[3];
                    r[4] = (float)(g.y & 0xffu) * a1[0]; r[5] = (float)((g.y >> 8) & 0xffu) * a1[1]; r[6] = (float)((g.y >> 16) & 0xffu) * a1[2]; r[7] = (float)(g.y >> 24) * a1[3];
                    if (ADD) { const u32x4 p = pv[m];
                        r[0] += bf_lo(p.x); r[1] += bf_hi(p.x); r[2] += bf_lo(p.y); r[3] += bf_hi(p.y); r[4] += bf_lo(p.z); r[5] += bf_hi(p.z); r[6] += bf_lo(p.w); r[7] += bf_hi(p.w); }
                    u32x4 w; w.x = cvt_pk_bf16(r[0], r[1]); w.y = cvt_pk_bf16(r[2], r[3]); w.z = cvt_pk_bf16(r[4], r[5]); w.w = cvt_pk_bf16(r[6], r[7]);
                    *(u32x4*)(out + off) = w; } } }
    }
};
struct EpiResid {
    static constexpr bool PERM = true, SIDE = false;
    bf16_t* out; const float* rs; float osc;
    __device__ __forceinline__ void operator()(const f32x4 (&acc)[2][2][4][2], const Unit& u, int wr, int wc, int fr, int fq) const {
        const int row0 = u.pm * BM + wr * 64 + fr, col0 = u.pn * BM + wc * 32 + 8 * fq;
        float scv[2][4];
#pragma unroll
        for (int ai = 0; ai < 2; ++ai)
#pragma unroll
            for (int m = 0; m < 4; ++m) scv[ai][m] = rs[row0 + ai * HALF + m * 16] * osc;
        __builtin_amdgcn_sched_barrier(0);
#pragma unroll
        for (int ai = 0; ai < 2; ++ai)
#pragma unroll
            for (int m = 0; m < 4; ++m) { const int row = row0 + ai * HALF + m * 16; const float sc = scv[ai][m]; bf16_t* rowp = out + (size_t)row * D + col0;
#pragma unroll
                for (int bj = 0; bj < 2; ++bj) { const f32x4 v0 = acc[ai][bj][m][0] * sc, v1 = acc[ai][bj][m][1] * sc;
                    u32x4 w; w.x = cvt_pk_bf16(v0[0], v0[1]); w.y = cvt_pk_bf16(v0[2], v0[3]); w.z = cvt_pk_bf16(v1[0], v1[1]); w.w = cvt_pk_bf16(v1[2], v1[3]);
                    *(u32x4*)(rowp + bj * HALF) = w; } }
    }
};
struct EpiHid {
    static constexpr bool PERM = true, SIDE = false;
    const float* rs; void* hid; float osc;
    __device__ __forceinline__ void operator()(const f32x4 (&acc)[2][2][4][2], const Unit& u, int wr, int wc, int fr, int fq) const {
        const int s0 = u.pm * BM + wr * 64 + fr, col0 = u.pn * HALF + wc * 32 + 8 * fq;
        float sclv[2][4];
#pragma unroll
        for (int ai = 0; ai < 2; ++ai)
#pragma unroll
            for (int m = 0; m < 4; ++m) sclv[ai][m] = rs[(size_t)u.e * T + s0 + ai * HALF + m * 16];
        __builtin_amdgcn_sched_barrier(0);
#pragma unroll
        for (int ai = 0; ai < 2; ++ai)
#pragma unroll
            for (int m = 0; m < 4; ++m) { const int s = s0 + ai * HALF + m * 16; const float scl = sclv[ai][m]; const float sc = (s < u.n) ? scl * osc : 0.f;
                float r[8];
#pragma unroll
                for (int n = 0; n < 2; ++n)
#pragma unroll
                    for (int j = 0; j < 4; ++j) { const float g = acc[ai][0][m][n][j] * sc, up = acc[ai][1][m][n][j] * sc; r[n * 4 + j] = g * fsigmoid(g) * up; }
#if FP8_DOWN
                u32x2 w; w.x = pk4_fp8(r[0] * FP8_SH, r[1] * FP8_SH, r[2] * FP8_SH, r[3] * FP8_SH); w.y = pk4_fp8(r[4] * FP8_SH, r[5] * FP8_SH, r[6] * FP8_SH, r[7] * FP8_SH);
                *(u32x2*)((unsigned char*)hid + (size_t)(u.rb + s) * EH + col0) = w;
#else
                u32x4 w; w.x = cvt_pk_bf16(r[0], r[1]); w.y = cvt_pk_bf16(r[2], r[3]); w.z = cvt_pk_bf16(r[4], r[5]); w.w = cvt_pk_bf16(r[6], r[7]);
                *(u32x4*)((bf16_t*)hid + (size_t)(u.rb + s) * EH + col0) = w;
#endif
            }
    }
};
struct EpiDown {
    static constexpr bool PERM = true, SIDE = false;
    const int* dst; const float* w; unsigned char* y; float osc;
    __device__ __forceinline__ void operator()(const f32x4 (&acc)[2][2][4][2], const Unit& u, int wr, int wc, int fr, int fq) const {
        const int s0 = u.pm * BM + wr * 64 + fr, col0 = u.pn * BM + wc * 32 + 8 * fq;
        int dlv[2][4]; float scv[2][4];
#pragma unroll
        for (int ai = 0; ai < 2; ++ai)
#pragma unroll
            for (int m = 0; m < 4; ++m) { const int s = s0 + ai * HALF + m * 16; dlv[ai][m] = dst[(size_t)u.e * T + s]; scv[ai][m] = w[(size_t)u.e * T + s] * osc * FP8_SY; }
        __builtin_amdgcn_sched_barrier(0);
#pragma unroll
        for (int ai = 0; ai < 2; ++ai)
#pragma unroll
            for (int m = 0; m < 4; ++m) asm volatile("" : "+v"(dlv[ai][m]), "+v"(scv[ai][m]));
#pragma unroll
        for (int ai = 0; ai < 2; ++ai)
#pragma unroll
            for (int m = 0; m < 4; ++m) { const int s = s0 + ai * HALF + m * 16;
                const int dl = dlv[ai][m]; const float sc = scv[ai][m];
                if (s < u.n) { unsigned char* rowp = y + (size_t)dl * D + col0;
#pragma unroll
                    for (int bj = 0; bj < 2; ++bj) { const f32x4 v0 = acc[ai][bj][m][0] * sc, v1 = acc[ai][bj][m][1] * sc;
                        u32x2 o; o.x = pk4_fp8(v0[0], v0[1], v0[2], v0[3]); o.y = pk4_fp8(v1[0], v1[1], v1[2], v1[3]);
                        *(u32x2*)(rowp + bj * HALF) = o; } } }
    }
};
}

struct Frame {
    LAS unsigned char* lds; volatile LAS unsigned* MISC; unsigned* ctl;
    int tid, lane, wave, vcu, G;
    const float* in[22]; float* out; unsigned char* ws;
};

__device__ __forceinline__ void tr_item(const float* W, int ldw, int k0, int n0, bf16_t* WT, int ldt, int drow0, int dk0, LAS float* scr, int lane) {
#pragma unroll 8
    for (int i = 0; i < 32; ++i) { const int kk = 2 * i + (lane >> 5); scr[kk * 33 + (lane & 31)] = W[(size_t)(k0 + kk) * ldw + n0 + (lane & 31)]; }
    LDS_WAIT(); asm volatile("" ::: "memory");
    const int c = lane & 7;
#pragma unroll
    for (int j = 0; j < 4; ++j) { const int n = (lane >> 3) + 8 * j; const LAS float* s = scr + (8 * c) * 33 + n;
        u32x4 o; o.x = cvt_pk_bf16(s[0 * 33], s[1 * 33]); o.y = cvt_pk_bf16(s[2 * 33], s[3 * 33]); o.z = cvt_pk_bf16(s[4 * 33], s[5 * 33]); o.w = cvt_pk_bf16(s[6 * 33], s[7 * 33]);
        *(u32x4*)(WT + (size_t)(drow0 + n) * ldt + dk0 + k0 + 8 * c) = o; }
    LDS_WAIT(); asm volatile("" ::: "memory");
}

__device__ __forceinline__ void tr_item8(const float* W, int ldw, int k0, int n0, unsigned char* WT, int ldt, int drow0, int dk0, float sc, LAS float* scr, int lane) {
#pragma unroll 8
    for (int i = 0; i < 32; ++i) { const int kk = 2 * i + (lane >> 5); scr[kk * 33 + (lane & 31)] = W[(size_t)(k0 + kk) * ldw + n0 + (lane & 31)] * sc; }
    LDS_WAIT(); asm volatile("" ::: "memory");
    const int c = lane & 3;
#pragma unroll
    for (int j = 0; j < 2; ++j) { const int n = (lane >> 2) + 16 * j; const LAS float* s = scr + (16 * c) * 33 + n;
        u32x4 o; o.x = pk4_fp8(s[0 * 33], s[1 * 33], s[2 * 33], s[3 * 33]); o.y = pk4_fp8(s[4 * 33], s[5 * 33], s[6 * 33], s[7 * 33]);
        o.z = pk4_fp8(s[8 * 33], s[9 * 33], s[10 * 33], s[11 * 33]); o.w = pk4_fp8(s[12 * 33], s[13 * 33], s[14 * 33], s[15 * 33]);
        *(u32x4*)(WT + (size_t)(drow0 + n) * ldt + dk0 + k0 + 16 * c) = o; }
    LDS_WAIT(); asm volatile("" ::: "memory");
}

__device__ __forceinline__ void p0_prologue(Frame& F) {
    LAS float* scr = (LAS float*)(F.lds + F.wave * 16384);
    const int gw = F.vcu * NWAVES + F.wave, NGW = F.G * NWAVES, lane = F.lane;
    bf16_t* WIN_T = (bf16_t*)(F.ws + WS_WIN_T); bf16_t* WP_T = (bf16_t*)(F.ws + WS_WP_T); bf16_t* WOUT_T = (bf16_t*)(F.ws + WS_WOUT_T);
    bf16_t* WGU_T = (bf16_t*)(F.ws + WS_WGU_T); bf16_t* WD_T = (bf16_t*)(F.ws + WS_WD_T); bf16_t* WA_T = (bf16_t*)(F.ws + WS_WA_T); bf16_t* WX_T = (bf16_t*)(F.ws + WS_WX_T);
    constexpr int I_IN = 32 * 288, I_PR = 16 * 64, I_OUT = 32 * 64, I_EX = 512 * NE, I_LRU = 128;
    constexpr int NITEMS = I_IN + 2 * I_PR + I_OUT + 3 * I_EX + I_LRU;
    const TrSrc src{F.in[2], F.in[10], F.in[11], F.in[12], F.in[18], F.in[19], F.in[20], F.ws};
    for (int it = gw; it < TR_I_IN; it += 2 * NGW) {
        const int it2 = it + NGW; const bool two = it2 < TR_I_IN;
        TrDesc d0 = tr_decode(src, it), d1 = d0; f32x4 v0[16], v1[16];
        tr_load(d0, v0, lane);
        if (two) { d1 = tr_decode(src, it2); tr_load(d1, v1, lane); }
        tr_store(d0, v0, lane);
        if (two) tr_store(d1, v1, lane);
    }
    for (int r = gw; r < 128; r += NGW) { const int which = r / 64, rr = r % 64, nb = rr / 8, r8 = rr % 8;
        tr_item(F.in[which ? 7 : 5] + (size_t)nb * LBD * LBD, LBD, 64 * (r8 / 4), 32 * (r8 % 4), (which ? WX_T : WA_T) + (size_t)nb * LBD * LBD, LBD, 32 * (r8 % 4), 0, scr, lane); }
    { float* WR_T = (float*)(F.ws + WS_WR_T); const float* gf = F.in[13]; const float* wg = F.in[14]; const float* we = F.in[16];
      for (int i = (F.vcu * NTHR + F.tid); i < 64 * D; i += F.G * NTHR) { const int col = i / D, k = i % D;
          float v = 0.f; if (col < 32) v = we[(size_t)k * NE + col] * gf[k]; else if (col < 36) v = wg[(size_t)k * NG + (col - 32)] * gf[k];
          WR_T[i] = v; } }
    { const float* x = F.in[0]; const float* g = F.in[1]; bf16_t* XN = (bf16_t*)(F.ws + WS_XN);
      f32x4 gv[8];
#pragma unroll
      for (int j = 0; j < 8; ++j) gv[j] = ((const f32x4*)g)[lane + 64 * j];
      for (int m0 = gw; m0 < T; m0 += 2 * NGW) {
          f32x4 va[8], vb[8];
          { const f32x4* xa = (const f32x4*)(x + (size_t)m0 * D) + lane; const f32x4* xb = (const f32x4*)(x + (size_t)(m0 + NGW) * D) + lane;
#pragma unroll
            for (int j = 0; j < 8; ++j) va[j] = xa[64 * j];
#pragma unroll
            for (int j = 0; j < 8; ++j) vb[j] = xb[64 * j]; }
#pragma unroll
          for (int half = 0; half < 2; ++half) { const int m = m0 + half * NGW; f32x4 (&v)[8] = half ? vb : va; float s = 0.f;
#pragma unroll
              for (int j = 0; j < 8; ++j) s += (v[j].x * v[j].x + v[j].y * v[j].y) + (v[j].z * v[j].z + v[j].w * v[j].w);
              const float r = rsqrtf(wave_sum(s) * (1.f / D) + RMS_EPS);
              if (IN_NF8 > 0) { unsigned* o = (unsigned*)((unsigned char*)F.out + (size_t)m * D) + lane; const float r8 = r * Q_SA_IN;
#pragma unroll
                  for (int j = 0; j < 8; ++j) o[64 * j] = pk4_q<QM_IN>(v[j].x * r8 * gv[j].x, v[j].y * r8 * gv[j].y, v[j].z * r8 * gv[j].z, v[j].w * r8 * gv[j].w); }
              if (IN_NBF > 0) { u32x2* o = (u32x2*)(XN + (size_t)m * D) + lane;
#pragma unroll
                  for (int j = 0; j < 8; ++j) { u32x2 w; w.x = cvt_pk_bf16(v[j].x * r * gv[j].x, v[j].y * r * gv[j].y); w.y = cvt_pk_bf16(v[j].z * r * gv[j].z, v[j].w * r * gv[j].w); o[64 * j] = w; } }
          }
      } }
}


template <bool SPLIT> __device__ __forceinline__ void quant_row(Frame& F, const bf16_t* src, unsigned char* dst, float* rs, int t) {
    const int lane = F.lane; const u32x4* p = (const u32x4*)(src + (size_t)t * 2048) + lane; u32x4 v[4];
#pragma unroll
    for (int j = 0; j < 4; ++j) v[j] = p[64 * j];
    float mx[2] = {0.f, 0.f};
#pragma unroll
    for (int j = 0; j < 4; ++j) { const unsigned w[4] = {v[j].x, v[j].y, v[j].z, v[j].w}; float m = 0.f;
#pragma unroll
        for (int e = 0; e < 4; ++e) m = fmaxf(m, fmaxf(fabsf(bf_lo(w[e])), fabsf(bf_hi(w[e]))));
        mx[j >> 1] = fmaxf(mx[j >> 1], m); }
#pragma unroll
    for (int o = 1; o < 64; o <<= 1) { mx[0] = fmaxf(mx[0], __shfl_xor(mx[0], o)); mx[1] = fmaxf(mx[1], __shfl_xor(mx[1], o)); }
    if (!SPLIT) { mx[0] = fmaxf(mx[0], mx[1]); mx[1] = mx[0]; }
    const float q0 = 127.f / fmaxf(mx[0], 1e-30f), q1 = 127.f / fmaxf(mx[1], 1e-30f);
    if (lane == 0) { if (SPLIT) { rs[2 * (size_t)t] = mx[0] * (1.f / 127.f); rs[2 * (size_t)t + 1] = mx[1] * (1.f / 127.f); } else rs[t] = mx[0] * (1.f / 127.f); }
    u32x2* o = (u32x2*)(dst + (size_t)t * 2048) + lane;
#pragma unroll
    for (int j = 0; j < 4; ++j) { const float q = (j >> 1) ? q1 : q0; u32x2 w;
        w.x = pk4_i8(bf_lo(v[j].x) * q, bf_hi(v[j].x) * q, bf_lo(v[j].y) * q, bf_hi(v[j].y) * q); w.y = pk4_i8(bf_lo(v[j].z) * q, bf_hi(v[j].z) * q, bf_lo(v[j].w) * q, bf_hi(v[j].w) * q);
        o[64 * j] = w; }
}

__device__ __forceinline__ void final_norm(Frame& F) {
    const int gw = F.vcu * NWAVES + F.wave, NGW = F.G * NWAVES, lane = F.lane;
    const float* g = F.in[21]; const bf16_t* Y = (const bf16_t*)(F.ws + WS_Y);
    f32x4 gv[8];
#pragma unroll
    for (int j = 0; j < 8; ++j) gv[j] = ((const f32x4*)g)[lane + 64 * j];
    for (int m = gw; m < T; m += NGW) {
        f32x4* xr = (f32x4*)(F.out + (size_t)m * D) + lane; f32x4 v[8]; float s = 0.f;
        { const u32x2* dl = (const u32x2*)((const bf16_t*)(F.ws + WS_DELTA) + (size_t)m * D) + lane;
#pragma unroll
          for (int j = 0; j < 8; ++j) { const u32x2 dd = dl[64 * j]; v[j].x = bf_lo(dd.x); v[j].y = bf_hi(dd.x); v[j].z = bf_lo(dd.y); v[j].w = bf_hi(dd.y); } }
#if EN_MOE
        const unsigned* y0 = (const unsigned*)((const unsigned char*)Y + (size_t)m * D) + lane; const unsigned* y1 = (const unsigned*)((const unsigned char*)Y + (size_t)(T + m) * D) + lane;
#pragma unroll
        for (int j = 0; j < 8; ++j) { const int a = (int)y0[64 * j], b = (int)y1[64 * j];
            const f32x2 al = __builtin_amdgcn_cvt_pk_f32_fp8(a, false), ah = __builtin_amdgcn_cvt_pk_f32_fp8(a, true), bl = __builtin_amdgcn_cvt_pk_f32_fp8(b, false), bh = __builtin_amdgcn_cvt_pk_f32_fp8(b, true);
            v[j].x += (al.x + bl.x) * (1.f / FP8_SY); v[j].y += (al.y + bl.y) * (1.f / FP8_SY); v[j].z += (ah.x + bh.x) * (1.f / FP8_SY); v[j].w += (ah.y + bh.y) * (1.f / FP8_SY); }
#endif
#pragma unroll
        for (int j = 0; j < 8; ++j) s += (v[j].x * v[j].x + v[j].y * v[j].y) + (v[j].z * v[j].z + v[j].w * v[j].w);
        const float r = rsqrtf(wave_sum(s) * (1.f / D) + RMS_EPS);
#pragma unroll
        for (int j = 0; j < 8; ++j) { f32x4 o; o.x = v[j].x * r * gv[j].x; o.y = v[j].y * r * gv[j].y; o.z = v[j].z * r * gv[j].z; o.w = v[j].w * r * gv[j].w; xr[64 * j] = o; }
    }
}
__device__ __forceinline__ int xc_addr(int bl, int row, int c16) { return bl * 65536 + row * 256 + ((c16 ^ (row & 15)) << 4); }
template <bool FINAL>
__device__ __forceinline__ void scan_unit(Frame& F, int b, int chunk, int cq) {
    const int tid = F.tid, lane = F.lane, wave = F.wave;
    const bf16_t* XREC = (const bf16_t*)(F.ws + WS_XREC);
    const size_t t0 = (size_t)b * S + (size_t)chunk * 256; const int ch0 = cq * 256;
    {
        const int cg = tid & 31, tg = tid >> 5, ch = ch0 + 8 * cg, r0 = 16 * tg;
        const float* cw = F.in[3]; const float* cb = F.in[4];
        float w[4][8], bias[8];
#pragma unroll
        for (int k = 0; k < 4; ++k) { const f32x4 a = *(const f32x4*)(cw + k * LW + ch), c = *(const f32x4*)(cw + k * LW + ch + 4);
            w[k][0] = a.x; w[k][1] = a.y; w[k][2] = a.z; w[k][3] = a.w; w[k][4] = c.x; w[k][5] = c.y; w[k][6] = c.z; w[k][7] = c.w; }
        { const f32x4 a = *(const f32x4*)(cb + ch), c = *(const f32x4*)(cb + ch + 4); bias[0] = a.x; bias[1] = a.y; bias[2] = a.z; bias[3] = a.w; bias[4] = c.x; bias[5] = c.y; bias[6] = c.z; bias[7] = c.w; }
        float xm[3][8];
#pragma unroll
        for (int i = 0; i < 3; ++i) { const int rr = r0 - 3 + i; u32x4 v = (u32x4){0u, 0u, 0u, 0u};
            if (chunk > 0 || rr >= 0) v = *(const u32x4*)(XREC + (size_t)((long)t0 + rr) * LW + ch);
            xm[i][0] = bf_lo(v.x); xm[i][1] = bf_hi(v.x); xm[i][2] = bf_lo(v.y); xm[i][3] = bf_hi(v.y); xm[i][4] = bf_lo(v.z); xm[i][5] = bf_hi(v.z); xm[i][6] = bf_lo(v.w); xm[i][7] = bf_hi(v.w); }
        const int bl = cg >> 4, c16 = cg & 15;
        u32x4 xv[16];
#pragma unroll
        for (int r = 0; r < 16; ++r) xv[r] = *(const u32x4*)(XREC + (t0 + r0 + r) * LW + ch);
#pragma unroll
        for (int r = 0; r < 16; ++r) {
            const u32x4 v = xv[r];
            float x0[8]; x0[0] = bf_lo(v.x); x0[1] = bf_hi(v.x); x0[2] = bf_lo(v.y); x0[3] = bf_hi(v.y); x0[4] = bf_lo(v.z); x0[5] = bf_hi(v.z); x0[6] = bf_lo(v.w); x0[7] = bf_hi(v.w);
            float y[8];
#pragma unroll
            for (int c = 0; c < 8; ++c) { y[c] = bias[c] + w[0][c] * xm[0][c] + w[1][c] * xm[1][c] + w[2][c] * xm[2][c] + w[3][c] * x0[c]; xm[0][c] = xm[1][c]; xm[1][c] = xm[2][c]; xm[2][c] = x0[c]; }
            u32x4 o; o.x = cvt_pk_bf16(y[0], y[1]); o.y = cvt_pk_bf16(y[2], y[3]); o.z = cvt_pk_bf16(y[4], y[5]); o.w = cvt_pk_bf16(y[6], y[7]);
            *(LAS u32x4*)(F.lds + xc_addr(bl, r0 + r, c16)) = o;
        }
    }
    __syncthreads();
    {
        const int r32 = lane & 31, hi = lane >> 5, bl = wave >> 2, nb = 2 * cq + bl, dl = 32 * (wave & 3) + r32, d = nb * LBD + dl;
        const bf16_t* WA_T = (const bf16_t*)(F.ws + WS_WA_T); const bf16_t* WX_T = (const bf16_t*)(F.ws + WS_WX_T);
        bf16x8 wa[8], wx[8];
#pragma unroll
        for (int ks = 0; ks < 8; ++ks) { wa[ks] = *(const bf16x8*)(WA_T + ((size_t)nb * LBD + dl) * LBD + 16 * ks + 8 * hi); wx[ks] = *(const bf16x8*)(WX_T + ((size_t)nb * LBD + dl) * LBD + 16 * ks + 8 * hi); }
        const float ba = F.in[6][d], bx = F.in[8][d], lam = F.in[9][d];
        const float cl = -8.0f * log1pf(expf(-lam));
        float hc = 0.f, Atot = 1.f;
        float* SSUM = (float*)(F.ws + WS_SSUM);
        if (FINAL) {
#pragma unroll 1
            for (int j0 = 0; j0 < chunk; j0 += 8) { f32x2 sv[8];
#pragma unroll
                for (int j = 0; j < 8; ++j) sv[j] = *(const f32x2*)(SSUM + (((size_t)b * NBLK + j0 + j) * LW + d) * 2);
#pragma unroll
                for (int j = 0; j < 8; ++j) { const bool ok = (j0 + j) < chunk; hc = ok ? (sv[j].x * hc + sv[j].y) : hc; } } }
        const bf16_t* GREC = (const bf16_t*)(F.ws + WS_GREC); bf16_t* YCAT = (bf16_t*)(F.ws + WS_YCAT);
#pragma unroll 1
        for (int tt = 0; tt < 8; ++tt) {
            f32x16 ar = {}, ai = {};
            bf16x8 am[8]; bf16_t xcr[16];
#pragma unroll
            for (int ks = 0; ks < 8; ++ks) am[ks] = *(const LAS bf16x8*)(F.lds + xc_addr(bl, 32 * tt + r32, 2 * ks + hi));
#pragma unroll
            for (int r = 0; r < 16; ++r) { const int row = 32 * tt + (r & 3) + 8 * (r >> 2) + 4 * hi; xcr[r] = *(const LAS bf16_t*)(F.lds + xc_addr(bl, row, dl >> 3) + (dl & 7) * 2); }
            __builtin_amdgcn_sched_barrier(0);
#pragma unroll
            for (int ks = 0; ks < 8; ++ks) { ar = __builtin_amdgcn_mfma_f32_32x32x16_bf16(am[ks], wa[ks], ar, 0, 0, 0); ai = __builtin_amdgcn_mfma_f32_32x32x16_bf16(am[ks], wx[ks], ai, 0, 0, 0); }
            float av[16], bv[16], lav[16];
#pragma unroll
            for (int r = 0; r < 16; ++r) {
                const float xc = bf2f(xcr[r]);
                const float rg = fsigmoid(ar[r] + ba), ig = fsigmoid(ai[r] + bx);
                const float la = cl * rg; av[r] = __builtin_amdgcn_exp2f(la * 1.4426950408889634f); lav[r] = la; const float x2 = 2.0f * la;
                const float em = -x2 * (1.0f + x2 * (0.5f + x2 * (0.16666667f + x2 * (0.041666668f + x2 * 0.0083333338f))));
                bv[r] = __builtin_amdgcn_sqrtf(em) * ig * xc; }
            if (!FINAL) {
                int ttv = tt; asm volatile("" : "+v"(ttv));
                const unsigned rl = 32u * (unsigned)ttv + 4u * (unsigned)hi; unsigned* AB = (unsigned*)F.out + (size_t)F.vcu * 65536 + (unsigned)(d & 255);
#pragma unroll
                for (int r = 0; r < 16; ++r) AB[(rl + (unsigned)((r & 3) + 8 * (r >> 2))) * 256u] = cvt_pk_bf16(lav[r], bv[r]);
            }
            float Ag[4], Hg[4], hl[16], Ac[16];
#pragma unroll
            for (int g = 0; g < 4; ++g) { float A = 1.f, H = 0.f;
#pragma unroll
                for (int j = 0; j < 4; ++j) { const int r = 4 * g + j; H = av[r] * H + bv[r]; A *= av[r]; hl[r] = H; Ac[r] = A; }
                Ag[g] = A; Hg[g] = H; }
            float hin[4];
#pragma unroll
            for (int g = 0; g < 4; ++g) { const float Ao = __shfl_xor(Ag[g], 32), Ho = __shfl_xor(Hg[g], 32);
                const float A0 = hi ? Ao : Ag[g], H0 = hi ? Ho : Hg[g], A1 = hi ? Ag[g] : Ao, H1 = hi ? Hg[g] : Ho;
                const float h0 = hc; hc = A0 * hc + H0; const float h1 = hc; hc = A1 * hc + H1; hin[g] = hi ? h1 : h0; Atot *= A0 * A1; }
            if (FINAL) {
                int ttv = tt; asm volatile("" : "+v"(ttv));
                const unsigned rb = (unsigned)t0 + 32u * (unsigned)ttv + 4u * (unsigned)hi;
#pragma unroll
                for (int r = 0; r < 16; ++r) { const unsigned t = rb + (unsigned)((r & 3) + 8 * (r >> 2)); const float hf = hl[r] + Ac[r] * hin[r >> 2];
                    const float gr = bf2f(GREC[t * (unsigned)LW + (unsigned)d]);
                    YCAT[t * 2048u + (unsigned)d] = (bf16_t)(cvt_pk_bf16(hf * gr, 0.f) & 0xffffu);
                    if ((r & 3) == 3) asm volatile("" ::: "memory"); }
            }
        }
        if (!FINAL && hi == 0) {
            const unsigned long long sv = ((unsigned long long)__float_as_uint(hc) << 32) | (unsigned long long)__float_as_uint(Atot);
            __hip_atomic_store((unsigned long long*)(SSUM + (((size_t)b * NBLK + chunk) * LW + d) * 2), sv, __ATOMIC_RELAXED, __HIP_MEMORY_SCOPE_AGENT); }
    }
    __syncthreads();
}


__device__ __forceinline__ void scan_fix(Frame& F, int task) {
    const int lane = F.lane, r32 = lane & 31, hi = lane >> 5;
    const int cg = task & 31, chunk = (task >> 5) & 31, b = task >> 10, d = cg * 32 + r32;
    const size_t t0 = (size_t)b * S + (size_t)chunk * 256;
    const float* SSUM = (const float*)(F.ws + WS_SSUM); const unsigned* AB = (const unsigned*)F.out + (size_t)F.vcu * 65536 + (unsigned)(d & 255);
    const bf16_t* GREC = (const bf16_t*)(F.ws + WS_GREC); bf16_t* YCAT = (bf16_t*)(F.ws + WS_YCAT);
    float hc = 0.f;
    unsigned abA[16]; bf16_t grA[16];
    { const unsigned rb = (unsigned)t0 + 4u * (unsigned)hi;
#pragma unroll
      for (int r = 0; r < 16; ++r) { const unsigned ro = (unsigned)((r & 3) + 8 * (r >> 2)); const unsigned t = rb + ro; abA[r] = AB[(4u * (unsigned)hi + ro) * 256u]; grA[r] = GREC[t * (unsigned)LW + (unsigned)d]; } }
#pragma unroll 1
    for (int j0 = 0; j0 < chunk; j0 += 8) { f32x2 sv[8];
#pragma unroll
        for (int j = 0; j < 8; ++j) { const unsigned long long q = __hip_atomic_load((const unsigned long long*)(SSUM + (((size_t)b * NBLK + j0 + j) * LW + d) * 2), __ATOMIC_RELAXED, __HIP_MEMORY_SCOPE_AGENT);
            sv[j].x = __uint_as_float((unsigned)q); sv[j].y = __uint_as_float((unsigned)(q >> 32)); }
#pragma unroll
        for (int j = 0; j < 8; ++j) { const bool ok = (j0 + j) < chunk; hc = ok ? (sv[j].x * hc + sv[j].y) : hc; } }
#define SF_LOAD(TT, ABV, GRV) do { int ttv = (TT); asm volatile("" : "+v"(ttv)); const unsigned rb = (unsigned)t0 + 32u * (unsigned)ttv + 4u * (unsigned)hi; \
        _Pragma("unroll") for (int r = 0; r < 16; ++r) { const unsigned ro = (unsigned)((r & 3) + 8 * (r >> 2)); const unsigned t = rb + ro; ABV[r] = AB[(32u * (unsigned)ttv + 4u * (unsigned)hi + ro) * 256u]; GRV[r] = GREC[t * (unsigned)LW + (unsigned)d]; } } while (0)
#define SF_STEP(TT, ABV, GRV) do { int ttv = (TT); asm volatile("" : "+v"(ttv)); const unsigned rb = (unsigned)t0 + 32u * (unsigned)ttv + 4u * (unsigned)hi; \
        float av[16], bv[16]; \
        _Pragma("unroll") for (int r = 0; r < 16; ++r) { av[r] = __builtin_amdgcn_exp2f(bf_lo(ABV[r]) * 1.4426950408889634f); bv[r] = bf_hi(ABV[r]); } \
        float Ag[4], Hg[4], hl[16], Ac[16]; \
        _Pragma("unroll") for (int g = 0; g < 4; ++g) { float A = 1.f, H = 0.f; \
            _Pragma("unroll") for (int j = 0; j < 4; ++j) { const int r = 4 * g + j; H = av[r] * H + bv[r]; A *= av[r]; hl[r] = H; Ac[r] = A; } \
            Ag[g] = A; Hg[g] = H; } \
        float hin[4]; \
        _Pragma("unroll") for (int g = 0; g < 4; ++g) { const float Ao = __shfl_xor(Ag[g], 32), Ho = __shfl_xor(Hg[g], 32); \
            const float A0 = hi ? Ao : Ag[g], H0 = hi ? Ho : Hg[g], A1 = hi ? Ag[g] : Ao, H1 = hi ? Hg[g] : Ho; \
            const float h0 = hc; hc = A0 * hc + H0; const float h1 = hc; hc = A1 * hc + H1; hin[g] = hi ? h1 : h0; } \
        _Pragma("unroll") for (int r = 0; r < 16; ++r) { const unsigned t = rb + (unsigned)((r & 3) + 8 * (r >> 2)); const float hf = hl[r] + Ac[r] * hin[r >> 2]; \
            YCAT[t * 2048u + (unsigned)d] = (bf16_t)(cvt_pk_bf16(hf * bf2f(GRV[r]), 0.f) & 0xffffu); } } while (0)
    unsigned abB[16]; bf16_t grB[16];
#pragma unroll 1
    for (int tt = 0; tt < 8; tt += 2) {
        SF_LOAD(tt + 1, abB, grB);
        SF_STEP(tt, abA, grA);
        if (tt + 2 < 8) SF_LOAD(tt + 2, abA, grA);
        SF_STEP(tt + 1, abB, grB);
    }
#undef SF_LOAD
#undef SF_STEP
}

__device__ __forceinline__ void kmean_unit(Frame& F, int u) {
    const int tid = F.tid; const int bh = u >> 5, n = u & 31, b = bh >> 3, h = bh & 7;
    const bf16_t* Kp = (const bf16_t*)(F.ws + WS_K) + ((size_t)b * S + (size_t)n * 256) * AW + h * HD;
    const int rg = tid >> 4, cc = tid & 15; float s[8] = {0.f, 0.f, 0.f, 0.f, 0.f, 0.f, 0.f, 0.f}; float sq[8][8];
#pragma unroll
    for (int i = 0; i < 8; ++i) { const u32x4 v = *(const u32x4*)(Kp + (size_t)(rg + 32 * i) * AW + 8 * cc);
        const float e[8] = {bf_lo(v.x), bf_hi(v.x), bf_lo(v.y), bf_hi(v.y), bf_lo(v.z), bf_hi(v.z), bf_lo(v.w), bf_hi(v.w)};
#pragma unroll
        for (int c = 0; c < 8; ++c) { s[c] += e[c]; sq[i][c] = e[c] * e[c]; } }
    LAS float* part = (LAS float*)F.lds; LAS float* nmx = part + 32 * 128;
#pragma unroll
    for (int c = 0; c < 8; ++c) part[rg * 128 + 8 * cc + c] = s[c];
    { float mx = 0.f;
#pragma unroll
      for (int i = 0; i < 8; ++i) { float q = 0.f;
#pragma unroll
          for (int c = 0; c < 8; ++c) q += sq[i][c];
          q += __shfl_xor(q, 1); q += __shfl_xor(q, 2); q += __shfl_xor(q, 4); q += __shfl_xor(q, 8); mx = fmaxf(mx, q); }
      if (cc == 0) nmx[rg] = mx; }
    __syncthreads();
    if (tid == 0) { float m = 0.f; for (int r = 0; r < 32; ++r) m = fmaxf(m, nmx[r]); ((float*)(F.ws + WS_KNORM))[u] = m; }
    if (tid < 128) { float a = 0.f;
#pragma unroll 8
        for (int r = 0; r < 32; ++r) a += part[r * 128 + tid];
        const float mean = a * (1.f / 256.f); ((float*)(F.ws + WS_KMEAN))[(size_t)u * 128 + tid] = mean;
        const unsigned hb = cvt_pk_bf16(mean, 0.f) & 0xffffu; const float lo = mean - __uint_as_float(hb << 16);
        ((bf16_t*)(F.ws + WS_KMH))[(size_t)u * 128 + tid] = (bf16_t)hb; ((bf16_t*)(F.ws + WS_KML))[(size_t)u * 128 + tid] = (bf16_t)(cvt_pk_bf16(lo, 0.f) & 0xffffu); }
    __syncthreads();
}

__device__ __forceinline__ void route_phase(Frame& F) {
    const int tid = F.tid, lane = F.lane, wave = F.wave, r32 = lane & 31, hi = lane >> 5;
    constexpr int NU = NB * NH * 16;
    LAS int* lcnt = (LAS int*)(F.lds + 16384); LAS int* lbase = lcnt + 32; LAS float* knl = (LAS float*)(lbase + 32);
    constexpr int GPP = 35;
    LAS float* gp = (LAS float*)(F.lds + 32768);
    bf16x8 qa[2][8], ka[2][8], bhv[8], blv[8]; float knv = 0.f;
#define ROUTE_LOAD(U) do { const int _bh = (U) >> 4, _j0 = 1 + 2 * ((U) & 15), _b = _bh >> 3, _h = _bh & 7; \
        const bf16_t* mh = (const bf16_t*)(F.ws + WS_KMH) + ((size_t)_bh * 32 + r32) * 128 + 8 * hi; const bf16_t* ml = (const bf16_t*)(F.ws + WS_KML) + ((size_t)_bh * 32 + r32) * 128 + 8 * hi; \
        _Pragma("unroll") for (int hf = 0; hf < 2; ++hf) { const int _jj = (_j0 + hf <= 31) ? _j0 + hf : _j0; \
            const size_t trow = (size_t)_b * S + (size_t)_jj * 256 + wave * 32 + r32; \
            const bf16_t* qp = (const bf16_t*)(F.ws + WS_Q) + trow * AW + _h * HD + 8 * hi; const bf16_t* kp = (const bf16_t*)(F.ws + WS_K) + trow * AW + _h * HD + 8 * hi; \
            _Pragma("unroll") for (int ks = 0; ks < 8; ++ks) { qa[hf][ks] = *(const bf16x8*)(qp + 16 * ks); ka[hf][ks] = *(const bf16x8*)(kp + 16 * ks); } } \
        _Pragma("unroll") for (int ks = 0; ks < 8; ++ks) { bhv[ks] = *(const bf16x8*)(mh + 16 * ks); blv[ks] = *(const bf16x8*)(ml + 16 * ks); } \
        knv = ((const float*)(F.ws + WS_KNORM))[_bh * 32 + r32]; } while (0)
    int u = F.vcu; if (u >= NU) return;
    ROUTE_LOAD(u);
    for (;;) {
        const int un = u + F.G; const int bh = u >> 4, j0 = 1 + 2 * (u & 15), b = bh >> 3, h = bh & 7; const int jmax = (j0 + 1 <= 31) ? j0 + 1 : j0;
        if (tid < 32) { lcnt[tid] = 0; knl[tid] = knv; }
#pragma unroll
        for (int hf = 0; hf < 2; ++hf) {
            f32x16 acc = {};
#pragma unroll
            for (int ks = 0; ks < 8; ++ks) { acc = __builtin_amdgcn_mfma_f32_32x32x16_bf16(qa[hf][ks], bhv[ks], acc, 0, 0, 0); acc = __builtin_amdgcn_mfma_f32_32x32x16_bf16(qa[hf][ks], blv[ks], acc, 0, 0, 0); }
            float qq = 0.f, qk = 0.f;
#pragma unroll
            for (int ks = 0; ks < 8; ++ks)
#pragma unroll
                for (int e = 0; e < 8; ++e) { const float qv = bf2f((bf16_t)qa[hf][ks][e]), kv = bf2f((bf16_t)ka[hf][ks][e]); qq += qv * qv; qk += qv * kv; }
            qq += __shfl_xor(qq, 32); qk += __shfl_xor(qk, 32);
            const int qb = hf * 256 + wave * 32;
#pragma unroll
            for (int r = 0; r < 16; ++r) gp[(qb + (r & 3) + 8 * (r >> 2) + 4 * hi) * GPP + r32] = acc[r];
            if (hi == 0) { gp[(qb + r32) * GPP + 32] = qq; gp[(qb + r32) * GPP + 33] = qk; }
        }
        __syncthreads();
        if (un < NU) ROUTE_LOAD(un);
        int sel[3] = {-1, -1, -1}, slot[3] = {0, 0, 0};
        const int j = j0 + (tid >> 8), qi = tid & 255; const bool live = j <= 31;
        if (live) {
            float bv[3] = {-3.0e38f, -3.0e38f, -3.0e38f};
#pragma unroll 1
            for (int n = 0; n < j; ++n) {
                const float g = gp[tid * GPP + n];
                if (g > bv[0]) { bv[2] = bv[1]; sel[2] = sel[1]; bv[1] = bv[0]; sel[1] = sel[0]; bv[0] = g; sel[0] = n; }
                else if (g > bv[1]) { bv[2] = bv[1]; sel[2] = sel[1]; bv[1] = g; sel[1] = n; }
                else if (g > bv[2]) { bv[2] = g; sel[2] = n; }
            }
            { const float qn = sqrtf(gp[tid * GPP + 32]), sself = 0.088388347648318440f * gp[tid * GPP + 33];
              const float slope = exp2f(-(float)(h + 1)); float* LSE = (float*)(F.ws + WS_LSE);
#pragma unroll
              for (int k = 0; k < 3; ++k) if (sel[k] >= 0) { const int n = sel[k]; const float dmin = (float)((j - n - 1) * 256 + qi + 1);
                  const float ub = 0.088388347648318440f * qn * sqrtf(knl[n]) * 1.0001f - slope * dmin;
                  if (ub < sself - 110.f) { LSE[(((size_t)b * S + (size_t)j * 256 + qi) * NH + h) * 4 + k] = -3.0e38f; sel[k] = -1 - n; } } }
#pragma unroll
            for (int k = 0; k < 3; ++k) if (sel[k] >= 0) slot[k] = __hip_atomic_fetch_add(lcnt + sel[k], 1, __ATOMIC_RELAXED, __HIP_MEMORY_SCOPE_WORKGROUP);
        }
        __syncthreads();
        if (tid < jmax) lbase[tid] = (int)atomicAdd(F.ctl + CW_ACNT + bh * 32 + tid, (unsigned)lcnt[tid]);
        __syncthreads();
        if (live) { unsigned* AL = (unsigned*)(F.ws + WS_ALIST) + (size_t)bh * ALIST_PER_BH;
#pragma unroll
            for (int k = 0; k < 3; ++k) if (sel[k] >= 0) AL[alist_off(sel[k]) + lbase[sel[k]] + slot[k]] = ((unsigned)(j * 256 + qi) << 2) | (unsigned)k; }
        __syncthreads();
        if (un >= NU) break;
        u = un;
    }
#undef ROUTE_LOAD
}
namespace att {
constexpr int KVBLK = 64, LDK = AW;
constexpr float SCALE = 0.088388347648318440f;
constexpr float THR = 8.f;
constexpr size_t SHM_V = KVBLK * HD * 2, SHM_K = KVBLK * HD * 2;
#define KSWZ(row, colB) ((row) * 256 + ((colB) ^ (((row) & 7) << 4)))
#define SBAR() __builtin_amdgcn_sched_barrier(0)
__device__ __forceinline__ int crow(int r, int hi) { return (r & 3) + 8 * (r >> 2) + 4 * hi; }
__device__ __forceinline__ void partialSM(f32x16& p0, f32x16& p1, float& m_reg, float& mn, float& alpha) {
  constexpr float C = SCALE * 1.4426950408889634f;
  float pmax = p0[0];
#pragma unroll
  for (int r = 1; r < 16; ++r) pmax = fmaxf(pmax, p0[r]);
#pragma unroll
  for (int r = 0; r < 16; ++r) pmax = fmaxf(pmax, p1[r]);
  { auto rr = __builtin_amdgcn_permlane32_swap(__float_as_uint(pmax), __float_as_uint(pmax), false, false);
    pmax = fmaxf(__uint_as_float(rr[0]), __uint_as_float(rr[1])); }
  if (__builtin_expect(__all(pmax - m_reg <= THR / SCALE), 1)) { mn = m_reg; alpha = 1.f; }
  else { mn = fmaxf(m_reg, pmax); alpha = __builtin_amdgcn_exp2f((m_reg - mn) * C); m_reg = mn; }
  const float mnC = -mn * C;
#pragma unroll
  for (int r = 0; r < 16; ++r) p0[r] = fmaf(p0[r], C, mnC);
#pragma unroll
  for (int r = 0; r < 16; ++r) p1[r] = fmaf(p1[r], C, mnC);
#pragma unroll
  for (int r = 0; r < 16; ++r) p0[r] = __builtin_amdgcn_exp2f(p0[r]);
}
__device__ __forceinline__ void finishSM(f32x16& p0, f32x16& p1, float alpha, float& l_reg, bf16x8& pa0, bf16x8& pa1, bf16x8& pa2, bf16x8& pa3) {
#pragma unroll
  for (int r = 0; r < 16; ++r) p1[r] = __builtin_amdgcn_exp2f(p1[r]);
  float ps = 0;
#pragma unroll
  for (int r = 0; r < 16; ++r) ps += p0[r];
#pragma unroll
  for (int r = 0; r < 16; ++r) ps += p1[r];
  { auto rr = __builtin_amdgcn_permlane32_swap(__float_as_uint(ps), __float_as_uint(ps), false, false);
    ps = __uint_as_float(rr[0]) + __uint_as_float(rr[1]); }
  l_reg = l_reg * alpha + ps;
#define PK4(P, BASE, OUT) do { unsigned a0 = cvt_pk_bf16(P[BASE + 0], P[BASE + 1]), a1 = cvt_pk_bf16(P[BASE + 2], P[BASE + 3]);   \
    unsigned b0 = cvt_pk_bf16(P[BASE + 4], P[BASE + 5]), b1 = cvt_pk_bf16(P[BASE + 6], P[BASE + 7]);                              \
    auto r0 = __builtin_amdgcn_permlane32_swap(a0, b0, false, false); auto r1 = __builtin_amdgcn_permlane32_swap(a1, b1, false, false); \
    u32x4 w = {r0[0], r1[0], r0[1], r1[1]}; OUT = *reinterpret_cast<bf16x8*>(&w); } while (0)
  PK4(p0, 0, pa0); PK4(p0, 8, pa1); PK4(p1, 0, pa2); PK4(p1, 8, pa3);
#undef PK4
}
__device__ __forceinline__ void qkt_init(f32x16& p0, f32x16& p1, float bq, float slr) {
#pragma unroll
  for (int r = 0; r < 16; ++r) { const int c0 = (r & 3) + 8 * (r >> 2); p0[r] = fmaf(slr, (float)c0, bq); p1[r] = fmaf(slr, (float)(c0 + 32), bq); }
}
__device__ __forceinline__ void qkt_mask(f32x16& p0, f32x16& p1, int lim) {
#pragma unroll
  for (int r = 0; r < 16; ++r) { const int c0 = (r & 3) + 8 * (r >> 2); if (c0 > lim) p0[r] = -1e30f; if (c0 + 32 > lim) p1[r] = -1e30f; }
}
__device__ __forceinline__ void qkt_mma(f32x16& p0, f32x16& p1, const char* Ks, const bf16x8* qr, int r32, int hi) {
#pragma unroll
  for (int d0 = 0; d0 < 8; ++d0) { const int cb = (d0 * 16 + hi * 8) * 2;
    const bf16x8 b0 = *reinterpret_cast<const bf16x8*>(Ks + KSWZ(r32, cb));
    const bf16x8 b1 = *reinterpret_cast<const bf16x8*>(Ks + KSWZ(32 + r32, cb));
    p0 = __builtin_amdgcn_mfma_f32_32x32x16_bf16(b0, qr[d0], p0, 0, 0, 0);
    p1 = __builtin_amdgcn_mfma_f32_32x32x16_bf16(b1, qr[d0], p1, 0, 0, 0); }
}
template <bool OWN>
__device__ __forceinline__ void qkt(f32x16& p0, f32x16& p1, const char* Ks, const bf16x8* qr, int r32, int hi, float bq, float slr, int lim) {
  qkt_init(p0, p1, bq, slr); if (OWN) qkt_mask(p0, p1, lim); qkt_mma(p0, p1, Ks, qr, r32, hi);
}
__device__ __forceinline__ int v_st(int k, int c) { const int kk = (k & ~0xC) | ((k & 4) << 1) | ((k & 8) >> 1); return ((kk >> 3) * 4 + (c >> 5)) * 512 + ((kk & 7) * 32 + (c & 31)) * 2; }
__device__ __forceinline__ int v_rd_base(int lane) { return ((lane & 3) << 3) | (((lane >> 2) & 3) << 6) | (((lane >> 4) & 1) << 5) | (((lane >> 5) & 1) << 8); }
constexpr int v_rd_off(int d0, int ks, int half) { return d0 * 512 + ks * 4096 + half * 2048; }
template <int OFF> __device__ __forceinline__ s16x4 tr_read(int vb) {
  s16x4 r; asm volatile("ds_read_b64_tr_b16 %0, %1 offset:%2" : "=&v"(r) : "v"(vb), "i"(OFF) : "memory"); return r;
}
template <int D0> __device__ __forceinline__ void pv_one(f32x16& od, int vb, bf16x8 pa0, bf16x8 pa1, bf16x8 pa2, bf16x8 pa3) {
  const s16x4 l0 = tr_read<v_rd_off(D0, 0, 0)>(vb), h0 = tr_read<v_rd_off(D0, 0, 1)>(vb), l1 = tr_read<v_rd_off(D0, 1, 0)>(vb), h1 = tr_read<v_rd_off(D0, 1, 1)>(vb);
  const s16x4 l2 = tr_read<v_rd_off(D0, 2, 0)>(vb), h2 = tr_read<v_rd_off(D0, 2, 1)>(vb), l3 = tr_read<v_rd_off(D0, 3, 0)>(vb), h3 = tr_read<v_rd_off(D0, 3, 1)>(vb);
  asm volatile("s_waitcnt lgkmcnt(0)" ::: "memory"); SBAR();
#define PK(L, H) (bf16x8){L[0], L[1], L[2], L[3], H[0], H[1], H[2], H[3]}
  od = __builtin_amdgcn_mfma_f32_32x32x16_bf16(pa0, PK(l0, h0), od, 0, 0, 0);
  od = __builtin_amdgcn_mfma_f32_32x32x16_bf16(pa1, PK(l1, h1), od, 0, 0, 0);
  od = __builtin_amdgcn_mfma_f32_32x32x16_bf16(pa2, PK(l2, h2), od, 0, 0, 0);
  od = __builtin_amdgcn_mfma_f32_32x32x16_bf16(pa3, PK(l3, h3), od, 0, 0, 0);
#undef PK
}
__device__ __forceinline__ void pv_d0(f32x16* o, int vb, bf16x8 pa0, bf16x8 pa1, bf16x8 pa2, bf16x8 pa3) {
  pv_one<0>(o[0], vb, pa0, pa1, pa2, pa3); pv_one<1>(o[1], vb, pa0, pa1, pa2, pa3); pv_one<2>(o[2], vb, pa0, pa1, pa2, pa3); pv_one<3>(o[3], vb, pa0, pa1, pa2, pa3);
}

}
namespace att {
struct Desc { int b, h, n, chunk, cnt, own; };
__device__ __forceinline__ Desc decode(int i, const LAS int* ipre, int nsel, const unsigned* ac) {
  Desc d; int bhn;
  if (i < nsel) { int lo = 0, hi = 1024; while (hi - lo > 1) { const int mid = (lo + hi) >> 1; if (ipre[mid] <= i) lo = mid; else hi = mid; } bhn = lo; d.chunk = i - ipre[lo]; d.cnt = (int)ac[bhn]; d.own = 0; }
  else { bhn = i - nsel; d.chunk = 0; d.cnt = 256; d.own = 1; }
  d.b = bhn >> 8; d.h = (bhn >> 5) & 7; d.n = bhn & 31; return d;
}
__device__ __forceinline__ void phase(Frame& F, const LAS int* ipre, int nsel, const unsigned* ac) {
  char* lds = (char*)(unsigned char*)F.lds;
  const int tid = F.tid, wid = F.wave, lane = F.lane, r32 = lane & 31, hi = lane >> 5;
  const int ntot = nsel + NB * NH * NBLK;
  int it = F.vcu; if (it >= ntot) return;
  const bf16_t* Qg = (const bf16_t*)(F.ws + WS_Q); const bf16_t* Kg = (const bf16_t*)(F.ws + WS_K); const bf16_t* Vg = (const bf16_t*)(F.ws + WS_V);
  const unsigned* AL = (const unsigned*)(F.ws + WS_ALIST);
  bf16_t* PART = (bf16_t*)((unsigned char*)F.out); float* LSE = (float*)(F.ws + WS_LSE);
  bf16_t* V_lds = (bf16_t*)lds; bf16_t* K_lds = (bf16_t*)(lds + 2 * SHM_V);
  float* wsf = (float*)(lds + 2 * SHM_V + 2 * SHM_K) + wid * 64; float* li_l = wsf; float* al_l = wsf + 32;
  const int sr = tid >> 4, sc = (tid & 15) * 8, vst0 = v_st(sr, sc), vst1 = v_st(32 + sr, sc);
  const int vb0 = (int)(uintptr_t)V_lds + v_rd_base(lane);
  struct { bf16x8 vs0, vs1, ks0, ks1; } sr_[2];
  constexpr float C = SCALE * 1.4426950408889634f;
#define SLOADX(i, d, j) do { const size_t _o = ((size_t)(d).b * S + (size_t)(d).n * 256 + 64 * (j) + sr) * AW + (d).h * HD + sc; \
    sr_[i].vs0 = *(const bf16x8*)(Vg + _o); sr_[i].vs1 = *(const bf16x8*)(Vg + _o + (size_t)32 * AW); sr_[i].ks0 = *(const bf16x8*)(Kg + _o); sr_[i].ks1 = *(const bf16x8*)(Kg + _o + (size_t)32 * AW); } while (0)
#define SWRITE(bb, i) do { *(bf16x8*)((char*)V_lds + (bb) * SHM_V + vst0) = sr_[i].vs0;          \
    *(bf16x8*)((char*)V_lds + (bb) * SHM_V + vst1) = sr_[i].vs1; const int kc = sc * 2;               \
    *(bf16x8*)((char*)K_lds + (bb) * SHM_K + KSWZ(sr, kc)) = sr_[i].ks0;                       \
    *(bf16x8*)((char*)K_lds + (bb) * SHM_K + KSWZ(32 + sr, kc)) = sr_[i].ks1; } while (0)
#define RESC(a) do { if (__any((a) < 1.f)) { if (hi == 0) al_l[r32] = (a); asm volatile("s_waitcnt lgkmcnt(0)" ::: "memory"); \
    _Pragma("unroll") for (int d = 0; d < 4; ++d) _Pragma("unroll") for (int r = 0; r < 16; ++r) o[d][r] *= al_l[crow(r, hi)]; } } while (0)
#define LANEQ(d, tq, prow) do { int _ks = 3; bool _v = true; \
    if ((d).own) tq = (d).n * 256 + wid * 32 + r32; \
    else { const int _idx = (d).chunk * 256 + wid * 32 + r32; _v = _idx < (d).cnt; \
      const unsigned _e = AL[(size_t)((d).b * NH + (d).h) * ALIST_PER_BH + alist_off((d).n) + (_v ? _idx : (d).chunk * 256)]; tq = (int)(_e >> 2); _ks = (int)(_e & 3u); } \
    prow = _v ? (int)((((size_t)(d).b * S + tq) * NH + (d).h) * 4 + _ks) : -1; } while (0)
#define QLOAD(d, tq) do { const bf16_t* _q = Qg + ((size_t)(d).b * S + (size_t)(tq)) * AW + (d).h * HD + hi * 8; \
    _Pragma("unroll") for (int d0 = 0; d0 < 8; ++d0) qr[d0] = *(const bf16x8*)(_q + d0 * 16); } while (0)
#define SLR(d) (exp2f(-(float)((d).h + 1)) / SCALE)
#define TJ(d, j) ((d).own ? (j) : 3 - (j))
#define BQ(j) (slr * (float)(dc.n * 256 + 64 * TJ(dc, j) + 4 * hi - tq_c))
#define LIM(j) (wid * 32 + r32 - 64 * (j) - 4 * hi)
#define QKT(p0, p1, buf, j) do { qkt_init(p0, p1, BQ(j), slr); if (dc.own) { int _lim = LIM(j); asm volatile("" : "+v"(_lim)); qkt_mask(p0, p1, _lim); } qkt_mma(p0, p1, buf, qr, r32, hi); } while (0)
#define EPILOGUE() do { const float _lse = m_reg * C + __builtin_amdgcn_logf(l_reg); int* dst_l = (int*)al_l; \
    if (hi == 0) { li_l[r32] = l_reg; dst_l[r32] = prow_p; if (prow_p >= 0) LSE[prow_p] = _lse; } \
    asm volatile("s_waitcnt lgkmcnt(0)" ::: "memory"); \
    _Pragma("unroll") for (int r0 = 0; r0 < 16; r0 += 8) { float _lv[8]; int _pv[8];     \
      _Pragma("unroll") for (int q = 0; q < 8; ++q) { const int rr = crow(r0 + q, hi); _lv[q] = li_l[rr]; _pv[q] = dst_l[rr]; } \
      _Pragma("unroll") for (int q = 0; q < 8; ++q) asm volatile("" : "+v"(_lv[q]), "+v"(_pv[q])); \
      _Pragma("unroll") for (int q = 0; q < 8; ++q) { const int r = r0 + q; const float rl = __builtin_amdgcn_rcpf(_lv[q]); const int pr = _pv[q]; \
        if (pr >= 0) { _Pragma("unroll") for (int d0 = 0; d0 < 4; ++d0) PART[(size_t)pr * HD + d0 * 32 + r32] = (bf16_t)cvt_pk_bf16(o[d0][r] * rl, 0.f); } } } \
    asm volatile("s_waitcnt lgkmcnt(0)" ::: "memory"); \
    m_reg = -1e30f; l_reg = 0.f; _Pragma("unroll") for (int d = 0; d < 4; ++d) _Pragma("unroll") for (int r = 0; r < 16; ++r) o[d][r] = 0.f; } while (0)

  Desc dc = decode(it, ipre, nsel, ac), dn = dc;
  int tq_c, prow_c, tq_n = 0, prow_n = -1, prow_p = -1;
  LANEQ(dc, tq_c, prow_c);
  float m_reg = -1e30f, l_reg = 0.f; f32x16 o[4] = {}; bf16x8 qr[8];
  QLOAD(dc, tq_c);
  float slr = SLR(dc);
  f32x16 pA0, pA1, pB0, pB1; float mnA, mnB, alA = 1.f, alB = 1.f; bf16x8 pa0, pa1, pa2, pa3;
  constexpr int SE = 0, SO = 1;
  SLOADX(SE, dc, TJ(dc, 0)); SLOADX(SO, dc, TJ(dc, 1));
  SWRITE(0, SE); __syncthreads();
  bool first = true;
  for (;;) {
    const bool has_next = (it + F.G) < ntot;
    SBAR(); QKT(pA0, pA1, (const char*)K_lds, 0);
    if (!first) finishSM(pB0, pB1, alB, l_reg, pa0, pa1, pa2, pa3);
    SBAR(); SLOADX(SE, dc, TJ(dc, 2)); SBAR();
    if (!first) { pv_d0(o, vb0 + (int)SHM_V, pa0, pa1, pa2, pa3); EPILOGUE(); }
    partialSM(pA0, pA1, m_reg, mnA, alA);
    __syncthreads(); SWRITE(1, SO);
    __syncthreads();
    SBAR(); QKT(pB0, pB1, (const char*)K_lds + SHM_K, 1);
    finishSM(pA0, pA1, alA, l_reg, pa0, pa1, pa2, pa3);
    SBAR(); SLOADX(SO, dc, TJ(dc, 3));
    if (has_next) { dn = decode(it + F.G, ipre, nsel, ac); LANEQ(dn, tq_n, prow_n); }
    SBAR();
    pv_d0(o, vb0, pa0, pa1, pa2, pa3); partialSM(pB0, pB1, m_reg, mnB, alB);
    __syncthreads(); SWRITE(0, SE);
    RESC(alB); __syncthreads();
    SBAR(); QKT(pA0, pA1, (const char*)K_lds, 2);
    finishSM(pB0, pB1, alB, l_reg, pa0, pa1, pa2, pa3);
    SBAR(); if (has_next) SLOADX(SE, dn, TJ(dn, 0)); SBAR();
    pv_d0(o, vb0 + (int)SHM_V, pa0, pa1, pa2, pa3); partialSM(pA0, pA1, m_reg, mnA, alA);
    __syncthreads(); SWRITE(1, SO);
    RESC(alA); __syncthreads();
    SBAR(); QKT(pB0, pB1, (const char*)K_lds + SHM_K, 3);
    finishSM(pA0, pA1, alA, l_reg, pa0, pa1, pa2, pa3);
    SBAR(); if (has_next) { SLOADX(SO, dn, TJ(dn, 1)); QLOAD(dn, tq_n); } SBAR();
    pv_d0(o, vb0, pa0, pa1, pa2, pa3); partialSM(pB0, pB1, m_reg, mnB, alB);
    __syncthreads(); if (has_next) SWRITE(0, SE);
    RESC(alB); __syncthreads();
    prow_p = prow_c;
    if (!has_next) break;
    dc = dn; tq_c = tq_n; prow_c = prow_n; slr = SLR(dc); first = false; it += F.G;
  }
  finishSM(pB0, pB1, alB, l_reg, pa0, pa1, pa2, pa3); SBAR();
  pv_d0(o, vb0 + (int)SHM_V, pa0, pa1, pa2, pa3);
  EPILOGUE();
  __syncthreads();
#undef SLOADX
#undef SWRITE
#undef RESC
#undef LANEQ
#undef QLOAD
#undef SLR
#undef BQ
#undef LIM
#undef TJ
#undef QKT
#undef EPILOGUE
}

__device__ __forceinline__ void combine_token(Frame& F, int t, const f32x4 ls, const float* lse_next, f32x4& lsn) {
  const int lane = F.lane, h = lane >> 3, c8 = lane & 7;
  const bf16_t* PART = (const bf16_t*)((unsigned char*)F.out) + ((size_t)t * NH + h) * 4 * HD + 16 * c8;
  const int j = (t & (S - 1)) >> 8;
  float l[4]; bool ok[4]; float M = -3.0e38f;
#pragma unroll
  for (int k = 0; k < 4; ++k) { ok[k] = ((k == 3) || (k < j)) && ls[k] > -1.0e37f; l[k] = ok[k] ? ls[k] : -3.0e38f; M = fmaxf(M, l[k]); }
  u32x4 v[4][2];
#pragma unroll
  for (int k = 0; k < 4; ++k) { v[k][0] = (u32x4){0u, 0u, 0u, 0u}; v[k][1] = (u32x4){0u, 0u, 0u, 0u}; if (ok[k]) { v[k][0] = *(const u32x4*)(PART + (size_t)k * HD); v[k][1] = *(const u32x4*)(PART + (size_t)k * HD + 8); } }
  const u32x4* yr = (const u32x4*)((const bf16_t*)(F.ws + WS_YCAT) + (size_t)t * 2048) + lane; const u32x4 r0 = yr[0], r1 = yr[64];
  lsn = *(const f32x4*)lse_next;
  float acc[16]; float den = 0.f;
#pragma unroll
  for (int e = 0; e < 16; ++e) acc[e] = 0.f;
#pragma unroll
  for (int k = 0; k < 4; ++k) { const float w = ok[k] ? __builtin_amdgcn_exp2f(l[k] - M) : 0.f; den += w;
    const u32x4 a = v[k][0], b = v[k][1];
    acc[0] += w * bf_lo(a.x); acc[1] += w * bf_hi(a.x); acc[2] += w * bf_lo(a.y); acc[3] += w * bf_hi(a.y); acc[4] += w * bf_lo(a.z); acc[5] += w * bf_hi(a.z); acc[6] += w * bf_lo(a.w); acc[7] += w * bf_hi(a.w);
    acc[8] += w * bf_lo(b.x); acc[9] += w * bf_hi(b.x); acc[10] += w * bf_lo(b.y); acc[11] += w * bf_hi(b.y); acc[12] += w * bf_lo(b.z); acc[13] += w * bf_hi(b.z); acc[14] += w * bf_lo(b.w); acc[15] += w * bf_hi(b.w); }
  const float rd = __builtin_amdgcn_rcpf(den); float mxa = 0.f;
#pragma unroll
  for (int e = 0; e < 16; ++e) { acc[e] *= rd; mxa = fmaxf(mxa, fabsf(acc[e])); }
  float mxr = 0.f;
  { const unsigned w[8] = {r0.x, r0.y, r0.z, r0.w, r1.x, r1.y, r1.z, r1.w};
#pragma unroll
    for (int e = 0; e < 8; ++e) mxr = fmaxf(mxr, fmaxf(fabsf(bf_lo(w[e])), fabsf(bf_hi(w[e])))); }
#pragma unroll
  for (int o = 1; o < 64; o <<= 1) { mxa = fmaxf(mxa, __shfl_xor(mxa, o)); mxr = fmaxf(mxr, __shfl_xor(mxr, o)); }
  const float qa = 127.f / fmaxf(mxa, 1e-30f), qr = 127.f / fmaxf(mxr, 1e-30f);
  unsigned char* yc = F.ws + WS_YC8 + (size_t)t * 2048; float* rs = (float*)(F.ws + WS_RS1) + 2 * (size_t)t;
  if (lane == 0) { rs[0] = mxr * (1.f / 127.f); rs[1] = mxa * (1.f / 127.f); }
  { u32x2 w; w.x = pk4_i8(bf_lo(r0.x) * qr, bf_hi(r0.x) * qr, bf_lo(r0.y) * qr, bf_hi(r0.y) * qr); w.y = pk4_i8(bf_lo(r0.z) * qr, bf_hi(r0.z) * qr, bf_lo(r0.w) * qr, bf_hi(r0.w) * qr); *((u32x2*)yc + lane) = w;
    w.x = pk4_i8(bf_lo(r1.x) * qr, bf_hi(r1.x) * qr, bf_lo(r1.y) * qr, bf_hi(r1.y) * qr); w.y = pk4_i8(bf_lo(r1.z) * qr, bf_hi(r1.z) * qr, bf_lo(r1.w) * qr, bf_hi(r1.w) * qr); *((u32x2*)yc + 64 + lane) = w; }
  { u32x4 w; w.x = pk4_i8(acc[0] * qa, acc[1] * qa, acc[2] * qa, acc[3] * qa); w.y = pk4_i8(acc[4] * qa, acc[5] * qa, acc[6] * qa, acc[7] * qa);
    w.z = pk4_i8(acc[8] * qa, acc[9] * qa, acc[10] * qa, acc[11] * qa); w.w = pk4_i8(acc[12] * qa, acc[13] * qa, acc[14] * qa, acc[15] * qa);
    *(u32x4*)(yc + 1024 + h * HD + 16 * c8) = w; }
}
}
__device__ __forceinline__ void router_iter(Frame& F, int it) {
    const int lane = F.lane, wave = F.wave, r16 = lane & 15, q4 = lane >> 4;
    const int tok0 = it * 128 + wave * 16, tok = tok0 + r16;
    const float* WR = (const float*)(F.ws + WS_WR_T); const float* gf = F.in[13];
    LAS float* stg = (LAS float*)(F.lds + wave * 8192);
    constexpr int WRB_OFF = 65536, WRB_BYTES = 48 * 512;
    f32x4 c0 = {0.f, 0.f, 0.f, 0.f}, c1 = c0, c2 = c0; float ss = 0.f;
    const int hrow = lane >> 5, u32i = lane & 31;
    f32x4 xv[8]; u32x2 dv[8]; f32x4 gq;
#define RT_ROWS(C) do { _Pragma("unroll") for (int j = 0; j < 8; ++j) { const size_t off = (size_t)(tok0 + 2 * j + hrow) * D + 128 * (C) + 4 * u32i; \
        xv[j] = *(const f32x4*)(F.in[0] + off); dv[j] = *(const u32x2*)((const bf16_t*)(F.ws + WS_DELTA) + off); } gq = *(const f32x4*)(gf + 128 * (C) + 4 * u32i); } while (0)
#define RT_WDMA(C, BUF) do { _Pragma("unroll") for (int i = 0; i < 3; ++i) { const int q = wave * 3 + i, p = 64 * q + lane, row = p >> 5, c16 = p & 31; \
        __builtin_amdgcn_global_load_lds((const unsigned*)(WR + (size_t)row * D + 128 * (C) + 4 * (c16 ^ (row & 15))), (LAS unsigned*)(F.lds + WRB_OFF + (BUF) * WRB_BYTES + q * 1024), 16, 0, 0); } } while (0)
    RT_ROWS(0); RT_WDMA(0, 0);
#pragma unroll 1
    for (int c = 0; c < 16; ++c) {
        asm volatile("s_waitcnt vmcnt(0)" ::: "memory");
        __syncthreads();
        const f32x4 g = gq;
#pragma unroll
        for (int j = 0; j < 8; ++j) { const int r = 2 * j + hrow; const size_t off = (size_t)(tok0 + r) * D + 128 * c + 4 * u32i;
            f32x4 a = xv[j]; a.x += bf_lo(dv[j].x); a.y += bf_hi(dv[j].x); a.z += bf_lo(dv[j].y); a.w += bf_hi(dv[j].y);
            u32x2 xw; xw.x = cvt_pk_bf16(a.x, a.y); xw.y = cvt_pk_bf16(a.z, a.w);
            *(u32x2*)((bf16_t*)(F.ws + WS_DELTA) + off) = xw;
            *(unsigned*)((unsigned char*)(F.ws + WS_H2) + off) = pk4_q<QM_UP>(a.x * g.x * Q_SA_UP, a.y * g.y * Q_SA_UP, a.z * g.z * Q_SA_UP, a.w * g.w * Q_SA_UP);
            *(LAS f32x4*)(stg + r * 128 + 4 * (u32i ^ (r & 15))) = a; }
        { const int cn = (c < 15) ? c + 1 : 15; RT_ROWS(cn); RT_WDMA(cn, (c + 1) & 1); }
        __builtin_amdgcn_sched_barrier(0);
        const LAS float* wb = (const LAS float*)(F.lds + WRB_OFF + (c & 1) * WRB_BYTES);
#pragma unroll
        for (int s4 = 0; s4 < 4; ++s4) { const int u = 8 * s4 + 2 * q4, ua = 4 * (u ^ r16), ub = 4 * ((u + 1) ^ r16);
            const f32x4 a0 = *(const LAS f32x4*)(stg + r16 * 128 + ua), a1 = *(const LAS f32x4*)(stg + r16 * 128 + ub);
            ss += (a0.x * a0.x + a0.y * a0.y) + (a0.z * a0.z + a0.w * a0.w) + (a1.x * a1.x + a1.y * a1.y) + (a1.z * a1.z + a1.w * a1.w);
            const f32x4 w00 = *(const LAS f32x4*)(wb + r16 * 128 + ua), w01 = *(const LAS f32x4*)(wb + r16 * 128 + ub);
            const f32x4 w10 = *(const LAS f32x4*)(wb + (16 + r16) * 128 + ua), w11 = *(const LAS f32x4*)(wb + (16 + r16) * 128 + ub);
            const f32x4 w20 = *(const LAS f32x4*)(wb + (32 + r16) * 128 + ua), w21 = *(const LAS f32x4*)(wb + (32 + r16) * 128 + ub);
#pragma unroll
            for (int e = 0; e < 4; ++e) { c0 = __builtin_amdgcn_mfma_f32_16x16x4f32(a0[e], w00[e], c0, 0, 0, 0); c1 = __builtin_amdgcn_mfma_f32_16x16x4f32(a0[e], w10[e], c1, 0, 0, 0); c2 = __builtin_amdgcn_mfma_f32_16x16x4f32(a0[e], w20[e], c2, 0, 0, 0); }
#pragma unroll
            for (int e = 0; e < 4; ++e) { c0 = __builtin_amdgcn_mfma_f32_16x16x4f32(a1[e], w01[e], c0, 0, 0, 0); c1 = __builtin_amdgcn_mfma_f32_16x16x4f32(a1[e], w11[e], c1, 0, 0, 0); c2 = __builtin_amdgcn_mfma_f32_16x16x4f32(a1[e], w21[e], c2, 0, 0, 0); } }
    }
    asm volatile("s_waitcnt vmcnt(0)" ::: "memory");
    __syncthreads();
#undef RT_ROWS
#undef RT_WDMA
    ss += __shfl_xor(ss, 16); ss += __shfl_xor(ss, 32);
    const float rinv = rsqrtf(ss * (1.f / D) + RMS_EPS);
    LAS float* lg = stg; LAS int* hist = (LAS int*)(F.lds + TAB_OFF); LAS int* gbase = hist + 32;
    if (F.tid < 32) hist[F.tid] = 0;
#pragma unroll
    for (int r = 0; r < 4; ++r) { const int trow = 4 * q4 + r; lg[trow * 40 + r16] = c0[r]; lg[trow * 40 + 16 + r16] = c1[r]; if (r16 < 4) lg[trow * 40 + 32 + r16] = c2[r]; }
    __syncthreads();
    int ex[2] = {0, 0}, sl[2] = {0, 0}; float wt[2] = {0.f, 0.f};
    if (lane < 16) {
        const float* bg = F.in[15]; const float* be = F.in[17];
        float gl[4]; int gi = 0;
#pragma unroll
        for (int g = 0; g < 4; ++g) gl[g] = rinv * lg[lane * 40 + 32 + g] + bg[g];
        float gm = gl[0];
#pragma unroll
        for (int g = 1; g < 4; ++g) if (gl[g] > gm) { gm = gl[g]; gi = g; }
        float gs = 0.f;
#pragma unroll
        for (int g = 0; g < 4; ++g) gs += __expf(gl[g] - gm);
        const float gw = 1.0f / gs;
        float el[8];
#pragma unroll
        for (int e = 0; e < 8; ++e) el[e] = rinv * lg[lane * 40 + gi * 8 + e] + be[gi * 8 + e];
        int i1 = 0; float m1 = el[0];
#pragma unroll
        for (int e = 1; e < 8; ++e) if (el[e] > m1) { m1 = el[e]; i1 = e; }
        int i2 = -1; float m2 = -3.0e38f;
#pragma unroll
        for (int e = 0; e < 8; ++e) if (e != i1 && el[e] > m2) { m2 = el[e]; i2 = e; }
        const float e2 = __expf(m2 - m1), w1 = 1.0f / (1.0f + e2), w2 = e2 * w1;
        ex[0] = gi * 8 + i1; ex[1] = gi * 8 + i2; wt[0] = gw * w1; wt[1] = gw * w2;
        sl[0] = __hip_atomic_fetch_add(hist + ex[0], 1, __ATOMIC_RELAXED, __HIP_MEMORY_SCOPE_WORKGROUP);
        sl[1] = __hip_atomic_fetch_add(hist + ex[1], 1, __ATOMIC_RELAXED, __HIP_MEMORY_SCOPE_WORKGROUP);
    }
    __syncthreads();
    if (F.tid < 32) gbase[F.tid] = (int)atomicAdd(F.ctl + CW_ECNT + F.tid, (unsigned)hist[F.tid]);
    __syncthreads();
    if (lane < 16) {
        int* MTOK = (int*)(F.ws + WS_MTOK); int* MDST = (int*)(F.ws + WS_MDST); float* MW = (float*)(F.ws + WS_MW); float* MRS = (float*)(F.ws + WS_MRS);
#pragma unroll
        for (int k = 0; k < 2; ++k) { const size_t p = (size_t)ex[k] * T + gbase[ex[k]] + sl[k]; MTOK[p] = tok; MDST[p] = k * T + tok; MW[p] = wt[k]; MRS[p] = rinv; }
    }
    __syncthreads();
}
constexpr int N_PHASES = 14;
struct Args { const float* in[22]; float* out; unsigned char* ws; int ph_lo, ph_hi, use_bar, pad; };
__global__ void __launch_bounds__(NTHR, 2) fwd(Args args) {
    extern __shared__ __attribute__((aligned(16))) unsigned char lds[];
    Frame F;
    F.lds = (LAS unsigned char*)lds; F.MISC = (volatile LAS unsigned*)(F.lds + MISC_OFF);
    F.tid = threadIdx.x; F.lane = F.tid & 63; F.wave = __builtin_amdgcn_readfirstlane(F.tid >> 6);
    F.G = gridDim.x; { const int bx = blockIdx.x; F.vcu = (F.G % 8 == 0) ? (bx % 8) * (F.G / 8) + bx / 8 : bx; }
    F.ws = args.ws; F.out = args.out; F.ctl = (unsigned*)(args.ws + WS_CTL);
#pragma unroll
    for (int i = 0; i < 22; ++i) F.in[i] = args.in[i];
    if (F.tid < 64) F.MISC[F.tid] = 0u;
    __syncthreads();
    XcdBarrier bar; bar.bar = F.ctl + CW_BAR; bar.x = 0; bar.st = nullptr;
    if (args.use_bar) bar = xcd_barrier_post(F.ctl + CW_BAR, F.MISC + 8);
    const int lo = args.ph_lo, hi = args.ph_hi;
#define IN(k) (lo <= (k) && (k) < hi)
#define SEAM(k) do { if (IN(k) && IN((k) + 1)) xcd_barrier(bar); } while (0)

    if (IN(0)) { p0_prologue(F); __syncthreads(); }
    SEAM(0);
    if (IN(1)) {
        const pg8::EpiIn E0{(bf16_t*)(F.ws + WS_XREC), (bf16_t*)(F.ws + WS_GREC), (bf16_t*)(F.ws + WS_Q), (bf16_t*)(F.ws + WS_K), (bf16_t*)(F.ws + WS_V), (bf16_t*)(F.ws + WS_SGR), (bf16_t*)(F.ws + WS_SGA), 1.0f, IN_BF,
            TrSrc{F.in[2], F.in[10], F.in[11], F.in[12], F.in[18], F.in[19], F.in[20], F.ws}, F.vcu, F.G};
        if (IN_NBF > 0) {
            pg8::DenseProbT<0> P{(const void*)(F.ws + WS_XN), (const void*)(F.ws + WS_WIN_T), D, D, D};
            pg8::StaticOrder So; So.init(T, IN_NBF * 256, F.G, (int)blockIdx.x);
            pg8::gemm_phase<pg8::DenseProbT<0>, pg8::EpiIn, pg8::StaticOrder, true>(F.lds, P, So, E0);
        }
        if (IN_NF8 > 0) {
            pg8::DenseProbT<QM_IN> P{(const void*)F.out, (const void*)(F.ws + WS_WIN8), D, D, D};
            pg8::StaticOrder So; So.init(T, IN_NF8 * 256, F.G, (int)blockIdx.x);
            pg8::EpiIn E = E0; E.osc = 1.0f / (Q_SA_IN * Q_SB_IN); E.mask = IN_F8;
            pg8::gemm_phase<pg8::DenseProbT<QM_IN>, pg8::EpiIn, pg8::StaticOrder, true>(F.lds, P, So, E);
        }
    }
    SEAM(1);
    if (IN(2)) {
#if EN_ATTN
        for (int u = F.vcu; u < NB * NH * NBLK; u += F.G) kmean_unit(F, u);
#endif
        for (int u = F.vcu; u < NB * NBLK * 4; u += F.G) { const int b = u >> 7, chunk = (u >> 2) & 31, cq = u & 3;
            scan_unit<false>(F, b, chunk, cq);
            asm volatile("s_waitcnt vmcnt(0)" ::: "memory");
            __syncthreads();
            unsigned* fl = F.ctl + CW_SFLAG + (b * NBLK) * 4 + cq;
            if (F.tid == 0) (void)xb_add(fl + chunk * 4, 1u);
            if (F.lane < chunk) { unsigned sp = 0u; while (xb_ld(fl + F.lane * 4) == 0u) { __builtin_amdgcn_s_sleep(1); if (++sp > (1u << 22)) break; } }
            asm volatile("s_waitcnt vmcnt(0)" ::: "memory");
            scan_fix(F, (((b * NBLK) + chunk) << 5) | (cq * 8 + F.wave));
            asm volatile("s_waitcnt vmcnt(0)" ::: "memory"); __syncthreads();
        }
    }
    SEAM(2);
    if (IN(3)) {
#if EN_ATTN
        route_phase(F);
#endif
        __syncthreads();
    }
    SEAM(3);
    if (IN(4)) {
#if EN_ATTN
        LAS int* ipre = (LAS int*)(F.lds + TAB_OFF); LAS int* tmp = ipre + 1040; LAS int* lb = tmp + 512;
        const int t = F.tid; const unsigned* ac = F.ctl + CW_ACNT;
        const int v0 = ((int)ac[2 * t] + 255) >> 8, v1 = ((int)ac[2 * t + 1] + 255) >> 8;
        tmp[t] = v0 + v1;
        __syncthreads();
        if (t < 64) { int w = 0;
#pragma unroll
            for (int i = 0; i < 8; ++i) w += tmp[t * 8 + i];
            int inc = w;
#pragma unroll
            for (int o = 1; o < 64; o <<= 1) { const int y = __shfl_up(inc, o); if (t >= o) inc += y; }
            lb[t] = inc - w; }
        __syncthreads();
        { int base = lb[t >> 3]; for (int u2 = (t & ~7); u2 < t; ++u2) base += tmp[u2];
          ipre[2 * t] = base; ipre[2 * t + 1] = base + v0; if (t == NTHR - 1) ipre[1024] = base + v0 + v1; }
        __syncthreads();
        const int nitems = ipre[1024];
        att::phase(F, ipre, nitems, ac);
#endif
    }
    SEAM(4);
    if (IN(5)) {
#if EN_ATTN
        { const float* LSE = (const float*)(F.ws + WS_LSE) + (size_t)(F.lane >> 3) * 4; int t = F.vcu * NWAVES + F.wave;
          f32x4 ls = *(const f32x4*)(LSE + (size_t)t * NH * 4); asm volatile("" : "+v"(ls));
          for (; t < T; t += F.G * NWAVES) { const int tn = (t + F.G * NWAVES < T) ? t + F.G * NWAVES : t; f32x4 lsn; att::combine_token(F, t, ls, LSE + (size_t)tn * NH * 4, lsn); ls = lsn; } }
#endif
    }
    SEAM(5);
    if (IN(7)) {
        pg8::StaticOrder So; So.init(T, D, F.G, (int)blockIdx.x);
        { pg8::DenseProbT<2> P{(const void*)(F.ws + WS_YC8), (const void*)(F.ws + WS_WP_T), 1024, 2048, 2048};
          pg8::EpiGate<false> E{(const unsigned char*)(F.ws + WS_SGR), (bf16_t*)(F.ws + WS_MERGED), (const float*)(F.ws + WS_RS1), 2, 1.0f / (I8_SP * 255.f)};
          pg8::gemm_phase<pg8::DenseProbT<2>, pg8::EpiGate<false>, pg8::StaticOrder, true>(F.lds, P, So, E); }
#if EN_ATTN
        { pg8::DenseProbT<2> P{(const void*)(F.ws + WS_YC8 + 1024), (const void*)(F.ws + WS_WP_T + 1024), 1024, 2048, 2048};
          pg8::EpiGate<true> E{(const unsigned char*)(F.ws + WS_SGA), (bf16_t*)(F.ws + WS_MERGED), (const float*)(F.ws + WS_RS1) + 1, 2, 1.0f / (I8_SP * 255.f)};
          pg8::gemm_phase<pg8::DenseProbT<2>, pg8::EpiGate<true>, pg8::StaticOrder, true>(F.lds, P, So, E); }
#endif
    }
    SEAM(7);
    if (IN(8)) {
        for (int t = F.vcu * NWAVES + F.wave; t < T; t += F.G * NWAVES) quant_row<false>(F, (const bf16_t*)(F.ws + WS_MERGED), F.ws + WS_MG8, (float*)(F.ws + WS_RS2), t);
    }
    SEAM(8);
    if (IN(9)) {
        pg8::DenseProbT<2> P{(const void*)(F.ws + WS_MG8), (const void*)(F.ws + WS_WOUT_T), D, D, D};
        pg8::StaticOrder So; So.init(T, D, F.G, (int)blockIdx.x);
        pg8::EpiResid E{(bf16_t*)(F.ws + WS_DELTA), (const float*)(F.ws + WS_RS2), 1.0f / I8_SB};
        pg8::gemm_phase<pg8::DenseProbT<2>, pg8::EpiResid, pg8::StaticOrder, true>(F.lds, P, So, E);
    }
    SEAM(9);
    if (IN(10)) {
#if EN_MOE
        for (int it = F.vcu; it < T / 128; it += F.G) router_iter(F, it);
#endif
    }
    SEAM(10);
#if EN_MOE
    LAS int* tpre = (LAS int*)(F.lds + TAB_OFF); LAS int* ecnt = tpre + 40;
    if (IN(11) || IN(12)) {
        if (F.tid == 0) { int a = 0; for (int e = 0; e < NE; ++e) { const int c = (int)F.ctl[CW_ECNT + e]; ecnt[e] = c; tpre[e] = a; a += (c + 255) >> 8; } tpre[NE] = a; }
        __syncthreads();
    }
#endif
    if (IN(11)) {
#if EN_MOE
        pg8::MoeUpProbT<QM_UP> P{(const void*)(F.ws + WS_H2), (const void*)(F.ws + WS_WGU_T), (const int*)(F.ws + WS_MTOK), D, D, D};
        pg8::GroupedOrder So{tpre, ecnt, 4, F.G, F.vcu};
        pg8::EpiHid E{(const float*)(F.ws + WS_MRS), (void*)(F.ws + WS_HID), QM_UP ? 1.0f / (Q_SA_UP * Q_SB_UP) : 1.0f};
        pg8::gemm_phase<pg8::MoeUpProbT<QM_UP>, pg8::EpiHid, pg8::GroupedOrder, true>(F.lds, P, So, E);
#endif
    }
    SEAM(11);
    if (IN(12)) {
#if EN_MOE
        pg8::MoeDownProbT<QM_DOWN> P{(const void*)(F.ws + WS_HID), (const void*)(F.ws + WS_WD_T), EH, EH, EH};
        pg8::GroupedOrder So{tpre, ecnt, 8, F.G, F.vcu};
        pg8::EpiDown E{(const int*)(F.ws + WS_MDST), (const float*)(F.ws + WS_MW), (unsigned char*)(F.ws + WS_Y), FP8_DOWN ? 1.0f / (FP8_SH * FP8_SD) : 1.0f};
        pg8::gemm_phase<pg8::MoeDownProbT<QM_DOWN>, pg8::EpiDown, pg8::GroupedOrder, true>(F.lds, P, So, E);
#endif
    }
    SEAM(12);
    if (IN(13)) final_norm(F);
#undef IN
#undef SEAM
}

extern "C" void kernel_launch(void* const* d_in, const int* in_sizes, int n_in, void* d_out, int out_size, void* d_ws, size_t ws_size, hipStream_t stream) {
    static int grid = 0;
    if (grid == 0) {
        if (n_in != 22 || in_sizes[0] != T * D || out_size != T * D || ws_size < WS_END) { fprintf(stderr, "kernel_launch: shape / workspace mismatch (n_in %d, ws %zu)\n", n_in, ws_size); grid = -1; return; }
        int dev = 0, cus = 0, per_cu = 0;
        if (hipGetDevice(&dev) != hipSuccess || hipDeviceGetAttribute(&cus, hipDeviceAttributeMultiprocessorCount, dev) != hipSuccess) { grid = -1; return; }
        if (hipFuncSetAttribute((const void*)fwd, hipFuncAttributeMaxDynamicSharedMemorySize, LDS_BYTES) != hipSuccess) { fprintf(stderr, "kernel_launch: hipFuncSetAttribute failed\n"); grid = -1; return; }
        if (hipOccupancyMaxActiveBlocksPerMultiprocessor(&per_cu, (const void*)fwd, NTHR, LDS_BYTES) != hipSuccess || per_cu < 1) { fprintf(stderr, "kernel_launch: occupancy query says %d blocks per CU\n", per_cu); }
        (void)hipGetLastError();
        grid = cus;
    }
    if (grid < 0) return;
    (void)hipMemsetAsync((char*)d_ws + WS_CTL, 0, CTL_ZERO_BYTES, stream);
    Args a{};
    for (int i = 0; i < 22; ++i) a.in[i] = (const float*)d_in[i];
    a.out = (float*)d_out; a.ws = (unsigned char*)d_ws; a.pad = 0;
#if MK_N_LAUNCHES == 1
    a.ph_lo = 0; a.ph_hi = N_PHASES; a.use_bar = 1;
    hipLaunchKernelGGL(fwd, dim3(grid), dim3(NTHR), LDS_BYTES, stream, a);
#else
    for (int p = 0; p < N_PHASES; ++p) { a.ph_lo = p; a.ph_hi = p + 1; a.use_bar = 0; hipLaunchKernelGGL(fwd, dim3(grid), dim3(NTHR), LDS_BYTES, stream, a); }
#endif
}
```

```cpp
#include <hip/hip_runtime.h>
#include <stdint.h>
#include <cstdio>

#ifndef MK_N_LAUNCHES
#define MK_N_LAUNCHES 1
#endif
#ifndef EN_ATTN
#define EN_ATTN 1
#endif
#ifndef EN_MOE
#define EN_MOE 1
#endif

#define LAS __attribute__((address_space(3)))
#define GAS __attribute__((address_space(1)))
typedef unsigned short bf16_t;
typedef short bf16x8 __attribute__((ext_vector_type(8)));
typedef short s16x4 __attribute__((ext_vector_type(4)));
typedef float f32x2 __attribute__((ext_vector_type(2)));
typedef float f32x4 __attribute__((ext_vector_type(4)));
typedef float f32x16 __attribute__((ext_vector_type(16)));
typedef unsigned u32x2 __attribute__((ext_vector_type(2)));
typedef unsigned u32x4 __attribute__((ext_vector_type(4)));
typedef int i32x4 __attribute__((ext_vector_type(4)));
typedef int i32x8 __attribute__((ext_vector_type(8)));

constexpr int NB = 4, S = 8192, T = NB * S, D = 2048;
constexpr int LW = 1024, NLB = 8, LBD = 128;
constexpr int NH = 8, HD = 128, AW = NH * HD, MBLK = 256, NBLK = S / MBLK;
constexpr int NE = 32, NG = 4, EPG = 8, EH = 512;
constexpr int INW = 2 * LW + 3 * AW + 2 * D;
constexpr float RMS_EPS = 1e-6f;
constexpr int NWAVES = 8, NTHR = 512;

constexpr size_t MiB = (size_t)1 << 20;
constexpr size_t WS_CTL = 0, CTL_ZERO_BYTES = 128 * 1024;
constexpr size_t WS_WA_T = 1 * MiB;
constexpr size_t WS_WX_T = WS_WA_T + 256 * 1024;
constexpr size_t WS_WR_T = WS_WX_T + 256 * 1024;
constexpr size_t WS_KMEAN = 2 * MiB;
constexpr size_t WS_SSUM = WS_KMEAN + 512 * 1024;
constexpr size_t WS_KNORM = WS_SSUM + 1024 * 1024;
constexpr size_t WS_KMH = WS_KNORM + 64 * 1024, WS_KML = WS_KMH + 256 * 1024;
constexpr size_t WS_WIN_T = 8 * MiB;
constexpr size_t WS_WP_T = 44 * MiB;
constexpr size_t WS_WOUT_T = 52 * MiB;
constexpr size_t WS_WGU_T = 60 * MiB;
constexpr size_t WS_WD_T = 188 * MiB;
constexpr size_t WS_ALIST = 252 * MiB;
constexpr size_t WS_MTOK = 268 * MiB, WS_MDST = 272 * MiB, WS_MW = 276 * MiB, WS_MRS = 280 * MiB;
constexpr size_t WS_XN = 284 * MiB;
constexpr size_t WS_YCAT = WS_XN, WS_H2 = WS_XN;
constexpr size_t WS_XREC = 412 * MiB, WS_GREC = 476 * MiB;
constexpr size_t WS_MERGED = WS_XREC;
constexpr size_t WS_LSE = 988 * MiB;
constexpr size_t WS_Q = 540 * MiB, WS_K = 604 * MiB, WS_V = 668 * MiB;
constexpr size_t WS_HID = WS_Q;
constexpr size_t WS_YC8 = WS_Q;
constexpr size_t WS_RS1 = WS_K, WS_RS2 = WS_K + 1 * MiB;
constexpr size_t WS_MG8 = WS_V;
constexpr size_t WS_SGR = 732 * MiB, WS_SGA = 860 * MiB;
constexpr size_t WS_Y = WS_SGR;
constexpr size_t WS_DELTA = WS_SGA;
constexpr size_t WS_WIN8 = 988 * MiB;
constexpr size_t WS_END = 1008 * MiB;
constexpr size_t OUT_PART = 0, OUT_LSE = 192 * MiB;
constexpr int ALIST_PER_BH = 256 * 496;
__host__ __device__ constexpr int alist_off(int n) { return 256 * (31 * n - (n * (n - 1)) / 2); }

constexpr int CW_TMO = 0;
constexpr int CW_BAR = 4096;
constexpr int CW_ACNT = 16384;
constexpr int CW_ECNT = 20480;
constexpr int CW_SFLAG = 24576;

constexpr int RING_BYTES = 131072;
constexpr int MISC_OFF = 139264;
constexpr int TAB_OFF = MISC_OFF + 256;
constexpr int LDS_BYTES = 163840;

__device__ __forceinline__ unsigned cvt_pk_bf16(float lo, float hi) { unsigned r; asm volatile("v_cvt_pk_bf16_f32 %0, %1, %2" : "=v"(r) : "v"(lo), "v"(hi)); return r; }
__device__ __forceinline__ float bf_lo(unsigned w) { return __uint_as_float(w << 16); }
__device__ __forceinline__ float bf_hi(unsigned w) { return __uint_as_float(w & 0xffff0000u); }
__device__ __forceinline__ float bf2f(bf16_t v) { return __uint_as_float(((unsigned)v) << 16); }
__device__ __forceinline__ float fsigmoid(float z) { return __builtin_amdgcn_rcpf(1.0f + __builtin_amdgcn_exp2f(-1.4426950408889634f * z)); }
__device__ __forceinline__ float gelu_tanh(float x) { const float u = 1.5957691216057308f * (x + 0.044715f * x * x * x); return x * fsigmoid(u); }
__device__ __forceinline__ float wave_sum(float v) {
#pragma unroll
    for (int o = 1; o < 64; o <<= 1) v += __shfl_xor(v, o);
    return v;
}
#define LDS_WAIT() asm volatile("s_waitcnt lgkmcnt(0)" ::: "memory")
#define VM_WAIT() asm volatile("s_waitcnt vmcnt(0)" ::: "memory")

#define XB_TMO      128
#define XB_XCNT(j)  (256  + 64 * (j))
#define XB_XSUB(j)  (1280 + 64 * (j))
#define XB_XGEN(j)  (2304 + 64 * (j))
#define XB_TOP      3328
#define XB_TOPGEN   3392
#define XCD_BAR_WORDS 3456
#define XB_SPIN_CAP (1u << 18)
__device__ __forceinline__ unsigned xb_ld(unsigned* p)              { return __hip_atomic_load(p, __ATOMIC_RELAXED, __HIP_MEMORY_SCOPE_AGENT); }
__device__ __forceinline__ unsigned xb_add(unsigned* p, unsigned v) { return __hip_atomic_fetch_add(p, v, __ATOMIC_RELAXED, __HIP_MEMORY_SCOPE_AGENT); }
__device__ __forceinline__ unsigned xb_xcc_id() { return (unsigned)__builtin_amdgcn_s_getreg((3 << 11) | 20) & 0xFu; }
#define XB_SPIN(cond, bar) do { unsigned _sp = 0; while (cond) { __builtin_amdgcn_s_sleep(1); \
    if ((++_sp & 255u) == 0u) { if (xb_ld(&(bar)[XB_TMO])) break; if (_sp > XB_SPIN_CAP) { atomicAdd(&(bar)[XB_TMO], 1u); break; } } } } while (0)
struct XcdBarrier { unsigned* bar; unsigned x; volatile LAS unsigned* st; };
__device__ __forceinline__ XcdBarrier xcd_barrier_post(unsigned* bar, volatile LAS unsigned* st) {
    XcdBarrier b; b.bar = bar; b.x = xb_xcc_id(); b.st = st;
    if (threadIdx.x == 0) (void)xb_add(&bar[XB_XCNT(b.x)], 1u);
    return b;
}
__device__ __forceinline__ void xcd_barrier_complete(unsigned* bar, unsigned x, unsigned& nloc, unsigned& nx) {
    const unsigned G = gridDim.x * gridDim.y * gridDim.z;
    unsigned sum, cnt, mine, sp = 0u;
    for (;;) {
        sum = 0u; cnt = 0u; mine = 0u;
#pragma unroll
        for (unsigned j = 0; j < 16; ++j) { const unsigned c = xb_ld(&bar[XB_XCNT(j)]); sum += c; cnt += (c > 0u) ? 1u : 0u; mine = (j == x) ? c : mine; }
        if (sum == G) break;
        __builtin_amdgcn_s_sleep(1);
        if ((++sp & 255u) == 0u) { if (xb_ld(&bar[XB_TMO])) break; if (sp > XB_SPIN_CAP) { atomicAdd(&bar[XB_TMO], 1u); break; } }
    }
    nloc = mine > 0u ? mine : 1u; nx = cnt > 0u ? cnt : 1u;
}
__device__ __forceinline__ void xcd_barrier(const XcdBarrier& b) {
    asm volatile("s_waitcnt vmcnt(0)" ::: "memory");
    __syncthreads();
    if (threadIdx.x == 0) {
        unsigned* bar = b.bar;
        __builtin_amdgcn_s_waitcnt(0);
        unsigned nloc = b.st[0], nx = b.st[1];
        if (nloc == 0u) { xcd_barrier_complete(bar, b.x, nloc, nx); b.st[0] = nloc; b.st[1] = nx; }
        const unsigned old = xb_add(&bar[XB_XSUB(b.x)], 1u);
        const unsigned gen = old / nloc;
        if (old + 1u == (gen + 1u) * nloc) {
            __builtin_amdgcn_fence(__ATOMIC_RELEASE, "agent");
            asm volatile("s_waitcnt vmcnt(0)" ::: "memory");
            const unsigned og = xb_add(&bar[XB_TOP], 1u);
            const unsigned tg = og / nx;
            if (og + 1u == (tg + 1u) * nx) xb_add(&bar[XB_TOPGEN], 1u);
            else XB_SPIN(xb_ld(&bar[XB_TOPGEN]) == tg, bar);
            __builtin_amdgcn_fence(__ATOMIC_ACQUIRE, "agent");
            xb_add(&bar[XB_XGEN(b.x)], 1u);
            asm volatile("s_waitcnt vmcnt(0)" ::: "memory");
        } else {
            XB_SPIN(xb_ld(&bar[XB_XGEN(b.x)]) == gen, bar);
            __builtin_amdgcn_fence(__ATOMIC_ACQUIRE, "agent");
            asm volatile("s_waitcnt vmcnt(0)" ::: "memory");
        }
    }
    __syncthreads();
}

namespace pg8 {
constexpr int BM = 256, BK = 64, HALF = 128, HTB = HALF * BK * 2, STAGE_BYTES = 8 * HTB, NXCD = 8, WGM = 4;
__host__ __device__ __forceinline__ int lds_byte(int r, int c) { const int st = (r >> 4) * 2 + (c >> 5), rr = r & 15, cc = c & 31, ob = rr * 64 + cc * 2; return st * 1024 + (ob ^ (((ob >> 9) & 1) << 5)); }
__host__ __device__ __forceinline__ void stage_rc(int b, int& R, int& C) { const int st = b / 1024, sb = b % 1024, swz = sb ^ (((sb >> 9) & 1) << 5); R = (st >> 1) * 16 + swz / 64; C = (st & 1) * 32 + (swz % 64) / 2; }
__host__ __device__ __forceinline__ int perm32(int rho) { const int n = rho >> 4, i = rho & 15; return 8 * (i >> 2) + 4 * n + (i & 3); }

struct Unit { int pm, pn, e, n, rb; };

struct StaticOrder {
    int nM, nN, nwg, G, c;
    __device__ void init(int M, int N, int G_, int c_) { nM = M / BM; nN = N / BM; nwg = nM * nN; G = G_; c = c_; }
    __device__ bool next(int i, Unit& u) const {
        const long L = (long)i * G + c; if (L >= nwg) return false;
        int wgid = (int)L; { const int q = nwg / NXCD, r = nwg % NXCD, xcd = wgid % NXCD, off = wgid / NXCD; wgid = (xcd < r ? xcd * (q + 1) : r * (q + 1) + (xcd - r) * q) + off; }
        const int nig = WGM * nN, gid = wgid / nig, fm = gid * WGM, gsz = (nM - fm) < WGM ? (nM - fm) : WGM;
        u.pm = fm + ((wgid % nig) % gsz); u.pn = (wgid % nig) / gsz; u.e = 0; u.n = 0; u.rb = 0; return true;
    }
};
struct GroupedOrder {
    const LAS int* tpre; const LAS int* cnt; int nct, G, c;
    __device__ bool next(int i, Unit& u) const {
        const int L = i * G + c; const int rt = L / nct; if (rt >= tpre[NE]) return false;
        int e = 0;
#pragma unroll 1
        while (tpre[e + 1] <= rt) ++e;
        u.e = e; u.pm = rt - tpre[e]; u.pn = L - rt * nct; u.n = cnt[e]; u.rb = tpre[e] * BM; return true;
    }
};

template <int QM> struct DenseProbT {
    static constexpr bool GATHER = false; static constexpr int QMODE = QM, EB = QM ? 1 : 2;
    const void* A; const void* Bt; int K, lda, ldb;
    __device__ __forceinline__ const char* a_base(const Unit& u) const { return (const char*)A + (size_t)u.pm * BM * lda * EB; }
    __device__ __forceinline__ const char* b_base(const Unit& u) const { return (const char*)Bt + (size_t)u.pn * BM * ldb * EB; }
    __device__ __forceinline__ void a_off(const Unit&, const int (&R)[2], const int (&C)[2], unsigned (&vo)[2][2]) const {
#pragma unroll
        for (int h = 0; h < 2; ++h)
#pragma unroll
            for (int i = 0; i < 2; ++i) vo[h][i] = (unsigned)((h * HALF + R[i]) * lda) * (unsigned)EB + (unsigned)C[i] * 2u;
    }
};
typedef DenseProbT<0> DenseProb;
template <int QM> struct MoeUpProbT {
    static constexpr bool GATHER = true; static constexpr int QMODE = QM, EB = QM ? 1 : 2;
    const void* A; const void* Bt; const int* tok; int K, lda, ldb;
    __device__ __forceinline__ const char* a_base(const Unit&) const { return (const char*)A; }
    __device__ __forceinline__ const char* b_base(const Unit& u) const { return (const char*)Bt + ((size_t)u.e * 1024 + (size_t)u.pn * BM) * ldb * EB; }
    __device__ __forceinline__ void a_off(const Unit& u, const int (&R)[2], const int (&C)[2], unsigned (&vo)[2][2]) const {
#pragma unroll
        for (int h = 0; h < 2; ++h)
#pragma unroll
            for (int i = 0; i < 2; ++i) { const int s = u.pm * BM + h * HALF + R[i]; const int tl = tok[(size_t)u.e * T + s]; const int t = (s < u.n) ? tl : 0; vo[h][i] = (unsigned)(t * lda) * (unsigned)EB + (unsigned)C[i] * 2u; }
    }
};
template <int QM> struct MoeDownProbT {
    static constexpr bool GATHER = false; static constexpr int QMODE = QM, EB = QM ? 1 : 2;
    const void* A; const void* Bt; int K, lda, ldb;
    __device__ __forceinline__ const char* a_base(const Unit& u) const { return (const char*)A + ((size_t)u.rb + (size_t)u.pm * BM) * lda * EB; }
    __device__ __forceinline__ const char* b_base(const Unit& u) const { return (const char*)Bt + ((size_t)u.e * 2048 + (size_t)u.pn * BM) * ldb * EB; }
    __device__ __forceinline__ void a_off(const Unit&, const int (&R)[2], const int (&C)[2], unsigned (&vo)[2][2]) const {
#pragma unroll
        for (int h = 0; h < 2; ++h)
#pragma unroll
            for (int i = 0; i < 2; ++i) vo[h][i] = (unsigned)((h * HALF + R[i]) * lda) * (unsigned)EB + (unsigned)C[i] * 2u;
    }
};

template <class Prob, class Epi, class Sched, bool ALIGN_EPI>
__device__ __forceinline__ void gemm_phase(LAS unsigned char* lds, const Prob& P, const Sched& S, const Epi& E) {
    const int tid = threadIdx.x, wid = __builtin_amdgcn_readfirstlane(tid >> 6), lane = tid & 63, wr = wid >> 2, wc = wid & 3, fr = lane & 15, fq = lane >> 4;
    constexpr bool FP8 = Prob::QMODE == 1, I8 = Prob::QMODE == 2; constexpr int EB = Prob::QMODE ? 1 : 2;
    const int K = P.K, nt = K / (Prob::QMODE ? 2 * BK : BK);
    const int sc1 = 0x7F7F7F7F;
    int Rr[2], Cc[2]; unsigned voffB[2];
#pragma unroll
    for (int i = 0; i < 2; ++i) { int R, C; stage_rc(tid * 16 + i * 8192, R, C); Rr[i] = R; Cc[i] = C; const int Rb = Epi::PERM ? ((R & ~31) + perm32(R & 31)) : R; voffB[i] = (unsigned)(Rb * P.ldb) * (unsigned)EB + (unsigned)C * 2u; }
    const size_t kstep = (size_t)(BK * 2);
    const size_t hstepB = (size_t)HALF * P.ldb * EB;
    const unsigned ldsw = (unsigned)wid * 1024u;
    const int aoff = lds_byte(wr * 64 + fr, fq * 8), boff = lds_byte(wc * 32 + fr, fq * 8);
#define PG8_SA(b, h) (((b) * 2 + (h)) * HTB)
#define PG8_SB(b, h) ((4 + (b) * 2 + (h)) * HTB)
#define PG8_STAGE(bufoff, gbase, voff) do { _Pragma("unroll") for (int _i = 0; _i < 2; ++_i) \
        __builtin_amdgcn_global_load_lds((const unsigned*)((const char*)(gbase) + (voff)[_i]), (LAS unsigned*)(lds + (bufoff) + ldsw + _i * 8192), 16, 0, 0); } while (0)
#define PG8_LDA(dst, b, h) do { _Pragma("unroll") for (int m = 0; m < 4; ++m) _Pragma("unroll") for (int k = 0; k < 2; ++k) dst[m][k] = *(const LAS bf16x8*)(lds + PG8_SA(b, h) + aoff + m * 2048 + k * 1024); } while (0)
#define PG8_LDB(dst, b, h) do { _Pragma("unroll") for (int n = 0; n < 2; ++n) _Pragma("unroll") for (int k = 0; k < 2; ++k) dst[n][k] = *(const LAS bf16x8*)(lds + PG8_SB(b, h) + boff + n * 2048 + k * 1024); } while (0)
#define PG8_MMA(ai, bj, At, Bt) do { __builtin_amdgcn_s_setprio(1); _Pragma("unroll") for (int m = 0; m < 4; ++m) _Pragma("unroll") for (int n = 0; n < 2; ++n) { \
        if constexpr (FP8) { const i32x8 fb = __builtin_shufflevector(__builtin_bit_cast(i32x4, Bt[n][0]), __builtin_bit_cast(i32x4, Bt[n][1]), 0, 1, 2, 3, 4, 5, 6, 7); \
            const i32x8 fa = __builtin_shufflevector(__builtin_bit_cast(i32x4, At[m][0]), __builtin_bit_cast(i32x4, At[m][1]), 0, 1, 2, 3, 4, 5, 6, 7); \
            asm volatile("s_nop 1\n\tv_mfma_scale_f32_16x16x128_f8f6f4 %0, %1, %2, %0, %3, %3 op_sel_hi:[0,0,0]" : "+v"(acc[ai][bj][m][n]) : "v"(fb), "v"(fa), "v"(sc1)); } \
        else if constexpr (I8) { _Pragma("unroll") for (int k = 0; k < 2; ++k) acc[ai][bj][m][n] = __builtin_bit_cast(f32x4, __builtin_amdgcn_mfma_i32_16x16x64_i8(__builtin_bit_cast(i32x4, Bt[n][k]), __builtin_bit_cast(i32x4, At[m][k]), __builtin_bit_cast(i32x4, acc[ai][bj][m][n]), 0, 0, 0)); } \
        else { _Pragma("unroll") for (int k = 0; k < 2; ++k) acc[ai][bj][m][n] = __builtin_amdgcn_mfma_f32_16x16x32_bf16(Bt[n][k], At[m][k], acc[ai][bj][m][n], 0, 0, 0); } } \
        __builtin_amdgcn_s_setprio(0); } while (0)
#define PG8_WAIT_V(n) asm volatile("s_waitcnt vmcnt(" #n ")" ::: "memory")
#define PG8_WAIT_L(n) asm volatile("s_waitcnt lgkmcnt(" #n ")" ::: "memory")
#define PG8_BAR __builtin_amdgcn_s_barrier()
#define PG8_SCHED __builtin_amdgcn_sched_barrier(0)
    Unit cur, nxt; int ui = 0;
    if (!S.next(0, cur)) return;
    f32x4 acc[2][2][4][2];
#pragma unroll
    for (int a = 0; a < 2; ++a)
#pragma unroll
        for (int b = 0; b < 2; ++b)
#pragma unroll
            for (int m = 0; m < 4; ++m)
#pragma unroll
                for (int n = 0; n < 2; ++n) acc[a][b][m][n] = (f32x4){0.f, 0.f, 0.f, 0.f};
    bf16x8 At[4][2], B0[2][2], B1[2][2];
    unsigned vA[2][2], vN[2][2];
    P.a_off(cur, Rr, Cc, vA);
#pragma unroll
    for (int h = 0; h < 2; ++h) { vN[h][0] = vA[h][0]; vN[h][1] = vA[h][1]; }
    const char* cA = P.a_base(cur); const char* cB = P.b_base(cur);
    PG8_STAGE(PG8_SB(0, 0), cB, voffB); PG8_STAGE(PG8_SB(0, 1), cB + hstepB, voffB); PG8_STAGE(PG8_SA(0, 0), cA, vA[0]); PG8_STAGE(PG8_SA(0, 1), cA, vA[1]);
    if (wr == 1) PG8_BAR;
    PG8_WAIT_V(2); PG8_BAR;
    PG8_STAGE(PG8_SB(1, 0), cB + kstep, voffB); PG8_STAGE(PG8_SA(1, 0), cA + kstep, vA[0]); PG8_STAGE(PG8_SB(1, 1), cB + hstepB + kstep, voffB);
    PG8_WAIT_V(6); PG8_BAR;
    for (;;) {
        const bool has_next = S.next(ui + 1, nxt);
        const char* nA = has_next ? P.a_base(nxt) : cA; const char* nB = has_next ? P.b_base(nxt) : cB;
        for (int t = 0; t < nt; t += 2) {
            const bool last = (t == nt - 2);
            const char* a1 = cA + (size_t)(t + 1) * kstep;
            const char* a2 = last ? nA : cA + (size_t)(t + 2) * kstep; const char* b2 = last ? nB : cB + (size_t)(t + 2) * kstep;
            const char* a3 = a2 + kstep; const char* b3 = b2 + kstep;
            if constexpr (Prob::GATHER) { if (last && has_next) P.a_off(nxt, Rr, Cc, vN); }
            unsigned vS[2][2];
#pragma unroll
            for (int h = 0; h < 2; ++h) { vS[h][0] = (Prob::GATHER && last) ? vN[h][0] : vA[h][0]; vS[h][1] = (Prob::GATHER && last) ? vN[h][1] : vA[h][1]; }
            PG8_LDB(B0, 0, 0); PG8_LDB(B1, 0, 1); PG8_SCHED; PG8_LDA(At, 0, 0); PG8_STAGE(PG8_SA(1, 1), a1, vA[1]);
            PG8_WAIT_V(8); PG8_WAIT_L(0); PG8_BAR; PG8_MMA(0, 0, At, B0); PG8_MMA(0, 1, At, B1); PG8_BAR; PG8_SCHED;
            PG8_LDA(At, 0, 1); PG8_STAGE(PG8_SB(0, 0), b2, voffB); PG8_STAGE(PG8_SB(0, 1), b2 + hstepB, voffB); PG8_STAGE(PG8_SA(0, 0), a2, vS[0]);
            PG8_WAIT_V(8); PG8_WAIT_L(0); PG8_BAR; PG8_MMA(1, 0, At, B0); PG8_MMA(1, 1, At, B1); PG8_BAR; PG8_SCHED;
            PG8_LDB(B0, 1, 0); PG8_LDB(B1, 1, 1); PG8_SCHED; PG8_LDA(At, 1, 0); PG8_STAGE(PG8_SA(0, 1), a2, vS[1]);
            PG8_WAIT_V(8); PG8_WAIT_L(0); PG8_BAR; PG8_MMA(0, 0, At, B0); PG8_MMA(0, 1, At, B1); PG8_BAR; PG8_SCHED;
            PG8_LDA(At, 1, 1); PG8_STAGE(PG8_SB(1, 0), b3, voffB); PG8_STAGE(PG8_SB(1, 1), b3 + hstepB, voffB); PG8_STAGE(PG8_SA(1, 0), a3, vS[0]);
            PG8_WAIT_V(8); PG8_WAIT_L(0); PG8_BAR; PG8_MMA(1, 0, At, B0); PG8_MMA(1, 1, At, B1); PG8_BAR; PG8_SCHED;
        }
        if constexpr (ALIGN_EPI) { if (wr == 0) PG8_BAR; }
        if constexpr (FP8) asm volatile("s_nop 15\n\ts_nop 15" ::: "memory");
        if constexpr (I8) {
#pragma unroll
            for (int a = 0; a < 2; ++a)
#pragma unroll
                for (int b = 0; b < 2; ++b)
#pragma unroll
                    for (int m = 0; m < 4; ++m)
#pragma unroll
                        for (int n = 0; n < 2; ++n) { const i32x4 iv = __builtin_bit_cast(i32x4, acc[a][b][m][n]); acc[a][b][m][n] = (f32x4){(float)iv[0], (float)iv[1], (float)iv[2], (float)iv[3]}; } }
        E(acc, cur, wr, wc, fr, fq);
        if constexpr (Epi::SIDE) E.side_work(ui, wid, lane);
        if (!has_next) break;
#pragma unroll
        for (int a = 0; a < 2; ++a)
#pragma unroll
            for (int b = 0; b < 2; ++b)
#pragma unroll
                for (int m = 0; m < 4; ++m)
#pragma unroll
                    for (int n = 0; n < 2; ++n) acc[a][b][m][n] = (f32x4){0.f, 0.f, 0.f, 0.f};
        cur = nxt; cA = nA; cB = nB; ++ui;
        if constexpr (Prob::GATHER) {
#pragma unroll
            for (int h = 0; h < 2; ++h) { vA[h][0] = vN[h][0]; vA[h][1] = vN[h][1]; }
        }
        if constexpr (ALIGN_EPI) { if (wr == 1) PG8_BAR; }
    }
    PG8_WAIT_V(0);
    if constexpr (!ALIGN_EPI) { if (wr == 0) PG8_BAR; }
    PG8_BAR;
#undef PG8_SA
#undef PG8_SB
#undef PG8_STAGE
#undef PG8_LDA
#undef PG8_LDB
#undef PG8_MMA
#undef PG8_WAIT_V
#undef PG8_WAIT_L
#undef PG8_BAR
#undef PG8_SCHED
}
}

#ifndef Q_MASK
#define Q_MASK 0xFFFFFFFFFull
#endif
#ifndef QM_IN
#define QM_IN 2
#endif
#ifndef QM_UP
#define QM_UP 2
#endif
#ifndef QM_DOWN
#define QM_DOWN 1
#endif
constexpr unsigned long long IN_F8 = Q_MASK & 0xFFFFFFFFFull, IN_BF = ~IN_F8 & 0xFFFFFFFFFull;
constexpr int IN_NF8 = __builtin_popcountll(IN_F8), IN_NBF = 36 - IN_NF8;
constexpr float FP8_SA = 32.f, FP8_SB = 1024.f;
constexpr float I8_SA = 32.f, I8_SB = 1448.f, I8_SH2 = 26.f;
__device__ __forceinline__ unsigned pk4_fp8(float a, float b, float c, float d) {
    a = fminf(fmaxf(a, -448.f), 448.f); b = fminf(fmaxf(b, -448.f), 448.f); c = fminf(fmaxf(c, -448.f), 448.f); d = fminf(fmaxf(d, -448.f), 448.f);
    int w = __builtin_amdgcn_cvt_pk_fp8_f32(a, b, 0, false); w = __builtin_amdgcn_cvt_pk_fp8_f32(c, d, w, true); return (unsigned)w;
}
__device__ __forceinline__ unsigned pk4_i8(float a, float b, float c, float d) {
    const int ia = (int)__builtin_rintf(fminf(fmaxf(a, -127.f), 127.f)), ib = (int)__builtin_rintf(fminf(fmaxf(b, -127.f), 127.f));
    const int ic = (int)__builtin_rintf(fminf(fmaxf(c, -127.f), 127.f)), id = (int)__builtin_rintf(fminf(fmaxf(d, -127.f), 127.f));
    return (unsigned)(ia & 0xff) | ((unsigned)(ib & 0xff) << 8) | ((unsigned)(ic & 0xff) << 16) | ((unsigned)(id & 0xff) << 24);
}
__device__ __forceinline__ unsigned pk4_u8(float a, float b, float c, float d) {
    const unsigned ia = (unsigned)__builtin_rintf(a), ib = (unsigned)__builtin_rintf(b), ic = (unsigned)__builtin_rintf(c), id = (unsigned)__builtin_rintf(d);
    return ia | (ib << 8) | (ic << 16) | (id << 24);
}
template <int QM> __device__ __forceinline__ unsigned pk4_q(float a, float b, float c, float d) { if (QM == 2) return pk4_i8(a, b, c, d); else return pk4_fp8(a, b, c, d); }
constexpr float I8_SP = 1024.f;
constexpr float Q_SA_IN = QM_IN == 2 ? I8_SA : FP8_SA, Q_SB_IN = QM_IN == 2 ? I8_SB : FP8_SB;
constexpr float Q_SA_UP = QM_UP == 2 ? I8_SH2 : FP8_SA, Q_SB_UP = QM_UP == 2 ? I8_SB : FP8_SB;
#define FP8_UP (QM_UP != 0)
#define FP8_DOWN (QM_DOWN != 0)
constexpr float FP8_SH = 16.f, FP8_SD = 512.f, FP8_SY = 64.f;
struct TrDesc { const float* W; unsigned char* WT; int ldw, k0, n0, ldt, drow0, dk0, qm; float sc; };
constexpr int TR_I_IN = 32 * 144, TR_I_PR = 16 * 32, TR_I_OUT = 32 * 32, TR_I_EXG = NE * 32 * 8, TR_I_EXD = NE * 8 * 32;
constexpr int TR_NITEMS = TR_I_IN + 2 * TR_I_PR + TR_I_OUT + 2 * TR_I_EXG + TR_I_EXD;
struct TrSrc { const float *w_in, *p_rec, *p_attn, *w_out, *w_gate, *w_up, *w_down; unsigned char* ws; };
__device__ __forceinline__ TrDesc tr_decode(const TrSrc& F, int r) {
    TrDesc d; d.dk0 = 0;
    if (r < TR_I_IN) { d.n0 = 64 * (r % 144); d.k0 = 64 * (r / 144); d.W = F.w_in; d.ldw = INW; d.ldt = 2048; d.qm = QM_IN; d.sc = Q_SB_IN; d.WT = F.ws + WS_WIN8; d.drow0 = d.n0; return d; } r -= TR_I_IN;
    if (r < 2 * TR_I_PR) { const int at = r >= TR_I_PR; if (at) r -= TR_I_PR; d.W = at ? F.p_attn : F.p_rec; d.ldw = 2048; d.k0 = 64 * (r / 32); d.n0 = 64 * (r % 32); d.WT = F.ws + WS_WP_T; d.ldt = 2048; d.drow0 = d.n0; d.dk0 = at ? 1024 : 0; d.qm = 2; d.sc = I8_SP; return d; } r -= 2 * TR_I_PR;
    if (r < TR_I_OUT) { d.W = F.w_out; d.ldw = 2048; d.k0 = 64 * (r / 32); d.n0 = 64 * (r % 32); d.WT = F.ws + WS_WOUT_T; d.ldt = 2048; d.drow0 = d.n0; d.qm = 2; d.sc = I8_SB; return d; } r -= TR_I_OUT;
    if (r < 2 * TR_I_EXG) { const int up = r >= TR_I_EXG; if (up) r -= TR_I_EXG; const int e = r / 256, rr = r % 256; d.n0 = 64 * (rr % 8); d.k0 = 64 * (rr / 8);
        d.W = (up ? F.w_up : F.w_gate) + (size_t)e * D * EH; d.ldw = EH; d.ldt = 2048; d.drow0 = (d.n0 >> 7) * 256 + (d.n0 & 127) + (up ? 128 : 0);
        d.qm = QM_UP; d.sc = Q_SB_UP; d.WT = F.ws + WS_WGU_T + (size_t)e * 1024 * 2048; return d; } r -= 2 * TR_I_EXG;
    { const int e = r / 256, rr = r % 256; d.W = F.w_down + (size_t)e * EH * D; d.ldw = D; d.k0 = 64 * (rr / 32); d.n0 = 64 * (rr % 32); d.ldt = 512; d.drow0 = d.n0;
      d.qm = QM_DOWN; d.sc = FP8_SD; d.WT = F.ws + WS_WD_T + (size_t)e * 2048 * 512; }
    return d;
}
__device__ __forceinline__ void tr_load(const TrDesc& d, f32x4 (&v)[16], int lane) {
    const float* p = d.W + (size_t)(d.k0 + 16 * (lane >> 4)) * d.ldw + d.n0 + 4 * (lane & 15);
#pragma unroll
    for (int i = 0; i < 16; ++i) v[i] = *(const f32x4*)(p + (size_t)i * d.ldw);
}
__device__ __forceinline__ void tr_store(const TrDesc& d, const f32x4 (&v)[16], int lane) {
    unsigned char* q = d.WT + (size_t)(d.drow0 + 4 * (lane & 15)) * d.ldt + d.dk0 + d.k0 + 16 * (lane >> 4); const float sc = d.sc;
#pragma unroll
    for (int c = 0; c < 4; ++c) { u32x4 o;
        if (d.qm == 2) { o.x = pk4_i8(v[0][c] * sc, v[1][c] * sc, v[2][c] * sc, v[3][c] * sc); o.y = pk4_i8(v[4][c] * sc, v[5][c] * sc, v[6][c] * sc, v[7][c] * sc); o.z = pk4_i8(v[8][c] * sc, v[9][c] * sc, v[10][c] * sc, v[11][c] * sc); o.w = pk4_i8(v[12][c] * sc, v[13][c] * sc, v[14][c] * sc, v[15][c] * sc); }
        else { o.x = pk4_fp8(v[0][c] * sc, v[1][c] * sc, v[2][c] * sc, v[3][c] * sc); o.y = pk4_fp8(v[4][c] * sc, v[5][c] * sc, v[6][c] * sc, v[7][c] * sc); o.z = pk4_fp8(v[8][c] * sc, v[9][c] * sc, v[10][c] * sc, v[11][c] * sc); o.w = pk4_fp8(v[12][c] * sc, v[13][c] * sc, v[14][c] * sc, v[15][c] * sc); }
        *(u32x4*)(q + (size_t)c * d.ldt) = o; }
}

namespace pg8 {
struct EpiIn {
    static constexpr bool PERM = true, SIDE = true;
    bf16_t *xrec, *grec, *q, *k, *v, *sgr, *sga; float osc; unsigned long long mask; TrSrc src; int side_c, side_stride;
    __device__ __forceinline__ void side_work(int ui, int wid, int lane) const {
        const int item = TR_I_IN + side_c + (ui * 8 + wid) * side_stride; if (item >= TR_NITEMS) return;
        const TrDesc d = tr_decode(src, item); f32x4 v[16]; tr_load(d, v, lane); tr_store(d, v, lane); }
    __device__ __forceinline__ void operator()(const f32x4 (&acc)[2][2][4][2], const Unit& u, int wr, int wc, int fr, int fq) const {
        int pn = 0; { int left = u.pn; unsigned long long mm = mask; for (;;) { const int b = __builtin_ctzll(mm); if (left == 0) { pn = b; break; } mm &= mm - 1; --left; } }
        bf16_t* base; int ldc, ct, act;
        if (pn < 4) { base = xrec; ldc = 1024; ct = pn; act = 0; }
        else if (pn < 8) { base = grec; ldc = 1024; ct = pn - 4; act = 1; }
        else if (pn < 12) { base = q; ldc = 1024; ct = pn - 8; act = 0; }
        else if (pn < 16) { base = k; ldc = 1024; ct = pn - 12; act = 0; }
        else if (pn < 20) { base = v; ldc = 1024; ct = pn - 16; act = 0; }
        else if (pn < 28) { base = sgr; ldc = 2048; ct = pn - 20; act = 2; }
        else { base = sga; ldc = 2048; ct = pn - 28; act = 2; }
        const int row0 = u.pm * BM + wr * 64 + fr, col0 = ct * BM + wc * 32 + 8 * fq;
#pragma unroll
        for (int ai = 0; ai < 2; ++ai)
#pragma unroll
            for (int m = 0; m < 4; ++m) { bf16_t* rowp = base + (size_t)(row0 + ai * HALF + m * 16) * ldc + col0;
#pragma unroll
                for (int bj = 0; bj < 2; ++bj) { f32x4 v0 = acc[ai][bj][m][0] * osc, v1 = acc[ai][bj][m][1] * osc;
                    if (act == 1) {
#pragma unroll
                        for (int j = 0; j < 4; ++j) { v0[j] = gelu_tanh(v0[j]); v1[j] = gelu_tanh(v1[j]); } }
                    if (act == 2) {
#pragma unroll
                        for (int j = 0; j < 4; ++j) { v0[j] = 255.f * fsigmoid(v0[j]); v1[j] = 255.f * fsigmoid(v1[j]); }
                        u32x2 w; w.x = pk4_u8(v0[0], v0[1], v0[2], v0[3]); w.y = pk4_u8(v1[0], v1[1], v1[2], v1[3]);
                        *(u32x2*)((unsigned char*)base + (size_t)(row0 + ai * HALF + m * 16) * 2048 + col0 + bj * HALF) = w; }
                    else { u32x4 w; w.x = cvt_pk_bf16(v0[0], v0[1]); w.y = cvt_pk_bf16(v0[2], v0[3]); w.z = cvt_pk_bf16(v1[0], v1[1]); w.w = cvt_pk_bf16(v1[2], v1[3]);
                        *(u32x4*)(rowp + bj * HALF) = w; } } }
    }
};
template <bool ADD> struct EpiGate {
    static constexpr bool PERM = true, SIDE = false;
    const unsigned char* gate; bf16_t* out; const float* rs; int rss; float osc;
    __device__ __forceinline__ void operator()(const f32x4 (&acc)[2][2][4][2], const Unit& u, int wr, int wc, int fr, int fq) const {
        const int row0 = u.pm * BM + wr * 64 + fr, col0 = u.pn * BM + wc * 32 + 8 * fq;
#pragma unroll
        for (int ai = 0; ai < 2; ++ai) {
            u32x2 gv[4][2]; u32x4 pv[4]; float scv[4];
#pragma unroll
            for (int m = 0; m < 4; ++m) { scv[m] = rs[(size_t)(row0 + ai * HALF + m * 16) * rss];
#pragma unroll
                for (int bj = 0; bj < 2; ++bj) gv[m][bj] = *(const u32x2*)(gate + ((unsigned)(row0 + ai * HALF + m * 16) * 2048u + (unsigned)(col0 + bj * HALF))); }
#pragma unroll
            for (int bj = 0; bj < 2; ++bj) {
                if (ADD) {
#pragma unroll
                    for (int m = 0; m < 4; ++m) pv[m] = *(const u32x4*)(out + ((unsigned)(row0 + ai * HALF + m * 16) * 2048u + (unsigned)(col0 + bj * HALF))); }
                __builtin_amdgcn_sched_barrier(0);
#pragma unroll
                for (int m = 0; m < 4; ++m) { const unsigned off = (unsigned)(row0 + ai * HALF + m * 16) * 2048u + (unsigned)(col0 + bj * HALF); const float sc = scv[m] * osc;
                    const f32x4 a0 = acc[ai][bj][m][0] * sc, a1 = acc[ai][bj][m][1] * sc;
                    const u32x2 g = gv[m][bj];
                    float r[8];
                    r[0] = (float)(g.x & 0xffu) * a0[0]; r[1] = (float)((g.x >> 8) & 0xffu) * a0[1]; r[2] = (float)((g.x >> 16) & 0xffu) * a0[2]; r[3] = (float)(g.x >> 24) * a0[3];
                    r[4] = (float)(g.y & 0xffu) * a1[0]; r[5] = (float)((g.y >> 8) & 0xffu) * a1[1]; r[6] = (float)((g.y >> 16) & 0xffu) * a1[2]; r[7] = (float)(g.y >> 24) * a1[3];
                    if (ADD) { const u32x4 p = pv[m];
                        r[0] += bf_lo(p.x); r[1] += bf_hi(p.x); r[2] += bf_lo(p.y); r[3] += bf_hi(p.y); r[4] += bf_lo(p.z); r[5] += bf_hi(p.z); r[6] += bf_lo(p.w); r[7] += bf_hi(p.w); }
                    u32x4 w; w.x = cvt_pk_bf16(r[0], r[1]); w.y = cvt_pk_bf16(r[2], r[3]); w.z = cvt_pk_bf16(r[4], r[5]); w.w = cvt_pk_bf16(r[6], r[7]);
                    *(u32x4*)(out + off) = w; } } }
    }
};
struct EpiResid {
    static constexpr bool PERM = true, SIDE = false;
    bf16_t* out; const float* rs; float osc;
    __device__ __forceinline__ void operator()(const f32x4 (&acc)[2][2][4][2], const Unit& u, int wr, int wc, int fr, int fq) const {
        const int row0 = u.pm * BM + wr * 64 + fr, col0 = u.pn * BM + wc * 32 + 8 * fq;
        float scv[2][4];
#pragma unroll
        for (int ai = 0; ai < 2; ++ai)
#pragma unroll
            for (int m = 0; m < 4; ++m) scv[ai][m] = rs[row0 + ai * HALF + m * 16] * osc;
        __builtin_amdgcn_sched_barrier(0);
#pragma unroll
        for (int ai = 0; ai < 2; ++ai)
#pragma unroll
            for (int m = 0; m < 4; ++m) { const int row = row0 + ai * HALF + m * 16; const float sc = scv[ai][m]; bf16_t* rowp = out + (size_t)row * D + col0;
#pragma unroll
                for (int bj = 0; bj < 2; ++bj) { const f32x4 v0 = acc[ai][bj][m][0] * sc, v1 = acc[ai][bj][m][1] * sc;
                    u32x4 w; w.x = cvt_pk_bf16(v0[0], v0[1]); w.y = cvt_pk_bf16(v0[2], v0[3]); w.z = cvt_pk_bf16(v1[0], v1[1]); w.w = cvt_pk_bf16(v1[2], v1[3]);
                    *(u32x4*)(rowp + bj * HALF) = w; } }
    }
};
struct EpiHid {
    static constexpr bool PERM = true, SIDE = false;
    const float* rs; void* hid; float osc;
    __device__ __forceinline__ void operator()(const f32x4 (&acc)[2][2][4][2], const Unit& u, int wr, int wc, int fr, int fq) const {
        const int s0 = u.pm * BM + wr * 64 + fr, col0 = u.pn * HALF + wc * 32 + 8 * fq;
        float sclv[2][4];
#pragma unroll
        for (int ai = 0; ai < 2; ++ai)
#pragma unroll
            for (int m = 0; m < 4; ++m) sclv[ai][m] = rs[(size_t)u.e * T + s0 + ai * HALF + m * 16];
        __builtin_amdgcn_sched_barrier(0);
#pragma unroll
        for (int ai = 0; ai < 2; ++ai)
#pragma unroll
            for (int m = 0; m < 4; ++m) { const int s = s0 + ai * HALF + m * 16; const float scl = sclv[ai][m]; const float sc = (s < u.n) ? scl * osc : 0.f;
                float r[8];
#pragma unroll
                for (int n = 0; n < 2; ++n)
#pragma unroll
                    for (int j = 0; j < 4; ++j) { const float g = acc[ai][0][m][n][j] * sc, up = acc[ai][1][m][n][j] * sc; r[n * 4 + j] = g * fsigmoid(g) * up; }
#if FP8_DOWN
                u32x2 w; w.x = pk4_fp8(r[0] * FP8_SH, r[1] * FP8_SH, r[2] * FP8_SH, r[3] * FP8_SH); w.y = pk4_fp8(r[4] * FP8_SH, r[5] * FP8_SH, r[6] * FP8_SH, r[7] * FP8_SH);
                *(u32x2*)((unsigned char*)hid + (size_t)(u.rb + s) * EH + col0) = w;
#else
                u32x4 w; w.x = cvt_pk_bf16(r[0], r[1]); w.y = cvt_pk_bf16(r[2], r[3]); w.z = cvt_pk_bf16(r[4], r[5]); w.w = cvt_pk_bf16(r[6], r[7]);
                *(u32x4*)((bf16_t*)hid + (size_t)(u.rb + s) * EH + col0) = w;
#endif
            }
    }
};
struct EpiDown {
    static constexpr bool PERM = true, SIDE = false;
    const int* dst; const float* w; unsigned char* y; float osc;
    __device__ __forceinline__ void operator()(const f32x4 (&acc)[2][2][4][2], const Unit& u, int wr, int wc, int fr, int fq) const {
        const int s0 = u.pm * BM + wr * 64 + fr, col0 = u.pn * BM + wc * 32 + 8 * fq;
        int dlv[2][4]; float scv[2][4];
#pragma unroll
        for (int ai = 0; ai < 2; ++ai)
#pragma unroll
            for (int m = 0; m < 4; ++m) { const int s = s0 + ai * HALF + m * 16; dlv[ai][m] = dst[(size_t)u.e * T + s]; scv[ai][m] = w[(size_t)u.e * T + s] * osc * FP8_SY; }
        __builtin_amdgcn_sched_barrier(0);
#pragma unroll
        for (int ai = 0; ai < 2; ++ai)
#pragma unroll
            for (int m = 0; m < 4; ++m) asm volatile("" : "+v"(dlv[ai][m]), "+v"(scv[ai][m]));
#pragma unroll
        for (int ai = 0; ai < 2; ++ai)
#pragma unroll
            for (int m = 0; m < 4; ++m) { const int s = s0 + ai * HALF + m * 16;
                const int dl = dlv[ai][m]; const float sc = scv[ai][m];
                if (s < u.n) { unsigned char* rowp = y + (size_t)dl * D + col0;
#pragma unroll
                    for (int bj = 0; bj < 2; ++bj) { const f32x4 v0 = acc[ai][bj][m][0] * sc, v1 = acc[ai][bj][m][1] * sc;
                        u32x2 o; o.x = pk4_fp8(v0[0], v0[1], v0[2], v0[3]); o.y = pk4_fp8(v1[0], v1[1], v1[2], v1[3]);
                        *(u32x2*)(rowp + bj * HALF) = o; } } }
    }
};
}

struct Frame {
    LAS unsigned char* lds; volatile LAS unsigned* MISC; unsigned* ctl;
    int tid, lane, wave, vcu, G;
    const float* in[22]; float* out; unsigned char* ws;
};

__device__ __forceinline__ void tr_item(const float* W, int ldw, int k0, int n0, bf16_t* WT, int ldt, int drow0, int dk0, LAS float* scr, int lane) {
#pragma unroll 8
    for (int i = 0; i < 32; ++i) { const int kk = 2 * i + (lane >> 5); scr[kk * 33 + (lane & 31)] = W[(size_t)(k0 + kk) * ldw + n0 + (lane & 31)]; }
    LDS_WAIT(); asm volatile("" ::: "memory");
    const int c = lane & 7;
#pragma unroll
    for (int j = 0; j < 4; ++j) { const int n = (lane >> 3) + 8 * j; const LAS float* s = scr + (8 * c) * 33 + n;
        u32x4 o; o.x = cvt_pk_bf16(s[0 * 33], s[1 * 33]); o.y = cvt_pk_bf16(s[2 * 33], s[3 * 33]); o.z = cvt_pk_bf16(s[4 * 33], s[5 * 33]); o.w = cvt_pk_bf16(s[6 * 33], s[7 * 33]);
        *(u32x4*)(WT + (size_t)(drow0 + n) * ldt + dk0 + k0 + 8 * c) = o; }
    LDS_WAIT(); asm volatile("" ::: "memory");
}

__device__ __forceinline__ void tr_item8(const float* W, int ldw, int k0, int n0, unsigned char* WT, int ldt, int drow0, int dk0, float sc, LAS float* scr, int lane) {
#pragma unroll 8
    for (int i = 0; i < 32; ++i) { const int kk = 2 * i + (lane >> 5); scr[kk * 33 + (lane & 31)] = W[(size_t)(k0 + kk) * ldw + n0 + (lane & 31)] * sc; }
    LDS_WAIT(); asm volatile("" ::: "memory");
    const int c = lane & 3;
#pragma unroll
    for (int j = 0; j < 2; ++j) { const int n = (lane >> 2) + 16 * j; const LAS float* s = scr + (16 * c) * 33 + n;
        u32x4 o; o.x = pk4_fp8(s[0 * 33], s[1 * 33], s[2 * 33], s[3 * 33]); o.y = pk4_fp8(s[4 * 33], s[5 * 33], s[6 * 33], s[7 * 33]);
        o.z = pk4_fp8(s[8 * 33], s[9 * 33], s[10 * 33], s[11 * 33]); o.w = pk4_fp8(s[12 * 33], s[13 * 33], s[14 * 33], s[15 * 33]);
        *(u32x4*)(WT + (size_t)(drow0 + n) * ldt + dk0 + k0 + 16 * c) = o; }
    LDS_WAIT(); asm volatile("" ::: "memory");
}

__device__ __forceinline__ void p0_prologue(Frame& F) {
    LAS float* scr = (LAS float*)(F.lds + F.wave * 16384);
    const int gw = F.vcu * NWAVES + F.wave, NGW = F.G * NWAVES, lane = F.lane;
    bf16_t* WIN_T = (bf16_t*)(F.ws + WS_WIN_T); bf16_t* WP_T = (bf16_t*)(F.ws + WS_WP_T); bf16_t* WOUT_T = (bf16_t*)(F.ws + WS_WOUT_T);
    bf16_t* WGU_T = (bf16_t*)(F.ws + WS_WGU_T); bf16_t* WD_T = (bf16_t*)(F.ws + WS_WD_T); bf16_t* WA_T = (bf16_t*)(F.ws + WS_WA_T); bf16_t* WX_T = (bf16_t*)(F.ws + WS_WX_T);
    constexpr int I_IN = 32 * 288, I_PR = 16 * 64, I_OUT = 32 * 64, I_EX = 512 * NE, I_LRU = 128;
    constexpr int NITEMS = I_IN + 2 * I_PR + I_OUT + 3 * I_EX + I_LRU;
    const TrSrc src{F.in[2], F.in[10], F.in[11], F.in[12], F.in[18], F.in[19], F.in[20], F.ws};
    for (int it = gw; it < TR_I_IN; it += 2 * NGW) {
        const int it2 = it + NGW; const bool two = it2 < TR_I_IN;
        TrDesc d0 = tr_decode(src, it), d1 = d0; f32x4 v0[16], v1[16];
        tr_load(d0, v0, lane);
        if (two) { d1 = tr_decode(src, it2); tr_load(d1, v1, lane); }
        tr_store(d0, v0, lane);
        if (two) tr_store(d1, v1, lane);
    }
    for (int r = gw; r < 128; r += NGW) { const int which = r / 64, rr = r % 64, nb = rr / 8, r8 = rr % 8;
        tr_item(F.in[which ? 7 : 5] + (size_t)nb * LBD * LBD, LBD, 64 * (r8 / 4), 32 * (r8 % 4), (which ? WX_T : WA_T) + (size_t)nb * LBD * LBD, LBD, 32 * (r8 % 4), 0, scr, lane); }
    { float* WR_T = (float*)(F.ws + WS_WR_T); const float* gf = F.in[13]; const float* wg = F.in[14]; const float* we = F.in[16];
      for (int i = (F.vcu * NTHR + F.tid); i < 64 * D; i += F.G * NTHR) { const int col = i / D, k = i % D;
          float v = 0.f; if (col < 32) v = we[(size_t)k * NE + col] * gf[k]; else if (col < 36) v = wg[(size_t)k * NG + (col - 32)] * gf[k];
          WR_T[i] = v; } }
    { const float* x = F.in[0]; const float* g = F.in[1]; bf16_t* XN = (bf16_t*)(F.ws + WS_XN);
      f32x4 gv[8];
#pragma unroll
      for (int j = 0; j < 8; ++j) gv[j] = ((const f32x4*)g)[lane + 64 * j];
      for (int m0 = gw; m0 < T; m0 += 2 * NGW) {
          f32x4 va[8], vb[8];
          { const f32x4* xa = (const f32x4*)(x + (size_t)m0 * D) + lane; const f32x4* xb = (const f32x4*)(x + (size_t)(m0 + NGW) * D) + lane;
#pragma unroll
            for (int j = 0; j < 8; ++j) va[j] = xa[64 * j];
#pragma unroll
            for (int j = 0; j < 8; ++j) vb[j] = xb[64 * j]; }
#pragma unroll
          for (int half = 0; half < 2; ++half) { const int m = m0 + half * NGW; f32x4 (&v)[8] = half ? vb : va; float s = 0.f;
#pragma unroll
              for (int j = 0; j < 8; ++j) s += (v[j].x * v[j].x + v[j].y * v[j].y) + (v[j].z * v[j].z + v[j].w * v[j].w);
              const float r = rsqrtf(wave_sum(s) * (1.f / D) + RMS_EPS);
              if (IN_NF8 > 0) { unsigned* o = (unsigned*)((unsigned char*)F.out + (size_t)m * D) + lane; const float r8 = r * Q_SA_IN;
#pragma unroll
                  for (int j = 0; j < 8; ++j) o[64 * j] = pk4_q<QM_IN>(v[j].x * r8 * gv[j].x, v[j].y * r8 * gv[j].y, v[j].z * r8 * gv[j].z, v[j].w * r8 * gv[j].w); }
              if (IN_NBF > 0) { u32x2* o = (u32x2*)(XN + (size_t)m * D) + lane;
#pragma unroll
                  for (int j = 0; j < 8; ++j) { u32x2 w; w.x = cvt_pk_bf16(v[j].x * r * gv[j].x, v[j].y * r * gv[j].y); w.y = cvt_pk_bf16(v[j].z * r * gv[j].z, v[j].w * r * gv[j].w); o[64 * j] = w; } }
          }
      } }
}


template <bool SPLIT> __device__ __forceinline__ void quant_row(Frame& F, const bf16_t* src, unsigned char* dst, float* rs, int t) {
    const int lane = F.lane; const u32x4* p = (const u32x4*)(src + (size_t)t * 2048) + lane; u32x4 v[4];
#pragma unroll
    for (int j = 0; j < 4; ++j) v[j] = p[64 * j];
    float mx[2] = {0.f, 0.f};
#pragma unroll
    for (int j = 0; j < 4; ++j) { const unsigned w[4] = {v[j].x, v[j].y, v[j].z, v[j].w}; float m = 0.f;
#pragma unroll
        for (int e = 0; e < 4; ++e) m = fmaxf(m, fmaxf(fabsf(bf_lo(w[e])), fabsf(bf_hi(w[e]))));
        mx[j >> 1] = fmaxf(mx[j >> 1], m); }
#pragma unroll
    for (int o = 1; o < 64; o <<= 1) { mx[0] = fmaxf(mx[0], __shfl_xor(mx[0], o)); mx[1] = fmaxf(mx[1], __shfl_xor(mx[1], o)); }
    if (!SPLIT) { mx[0] = fmaxf(mx[0], mx[1]); mx[1] = mx[0]; }
    const float q0 = 127.f / fmaxf(mx[0], 1e-30f), q1 = 127.f / fmaxf(mx[1], 1e-30f);
    if (lane == 0) { if (SPLIT) { rs[2 * (size_t)t] = mx[0] * (1.f / 127.f); rs[2 * (size_t)t + 1] = mx[1] * (1.f / 127.f); } else rs[t] = mx[0] * (1.f / 127.f); }
    u32x2* o = (u32x2*)(dst + (size_t)t * 2048) + lane;
#pragma unroll
    for (int j = 0; j < 4; ++j) { const float q = (j >> 1) ? q1 : q0; u32x2 w;
        w.x = pk4_i8(bf_lo(v[j].x) * q, bf_hi(v[j].x) * q, bf_lo(v[j].y) * q, bf_hi(v[j].y) * q); w.y = pk4_i8(bf_lo(v[j].z) * q, bf_hi(v[j].z) * q, bf_lo(v[j].w) * q, bf_hi(v[j].w) * q);
        o[64 * j] = w; }
}

__device__ __forceinline__ void final_norm(Frame& F) {
    const int gw = F.vcu * NWAVES + F.wave, NGW = F.G * NWAVES, lane = F.lane;
    const float* g = F.in[21]; const bf16_t* Y = (const bf16_t*)(F.ws + WS_Y);
    f32x4 gv[8];
#pragma unroll
    for (int j = 0; j < 8; ++j) gv[j] = ((const f32x4*)g)[lane + 64 * j];
    for (int m = gw; m < T; m += NGW) {
        f32x4* xr = (f32x4*)(F.out + (size_t)m * D) + lane; f32x4 v[8]; float s = 0.f;
        { const u32x2* dl = (const u32x2*)((const bf16_t*)(F.ws + WS_DELTA) + (size_t)m * D) + lane;
#pragma unroll
          for (int j = 0; j < 8; ++j) { const u32x2 dd = dl[64 * j]; v[j].x = bf_lo(dd.x); v[j].y = bf_hi(dd.x); v[j].z = bf_lo(dd.y); v[j].w = bf_hi(dd.y); } }
#if EN_MOE
        const unsigned* y0 = (const unsigned*)((const unsigned char*)Y + (size_t)m * D) + lane; const unsigned* y1 = (const unsigned*)((const unsigned char*)Y + (size_t)(T + m) * D) + lane;
#pragma unroll
        for (int j = 0; j < 8; ++j) { const int a = (int)y0[64 * j], b = (int)y1[64 * j];
            const f32x2 al = __builtin_amdgcn_cvt_pk_f32_fp8(a, false), ah = __builtin_amdgcn_cvt_pk_f32_fp8(a, true), bl = __builtin_amdgcn_cvt_pk_f32_fp8(b, false), bh = __builtin_amdgcn_cvt_pk_f32_fp8(b, true);
            v[j].x += (al.x + bl.x) * (1.f / FP8_SY); v[j].y += (al.y + bl.y) * (1.f / FP8_SY); v[j].z += (ah.x + bh.x) * (1.f / FP8_SY); v[j].w += (ah.y + bh.y) * (1.f / FP8_SY); }
#endif
#pragma unroll
        for (int j = 0; j < 8; ++j) s += (v[j].x * v[j].x + v[j].y * v[j].y) + (v[j].z * v[j].z + v[j].w * v[j].w);
        const float r = rsqrtf(wave_sum(s) * (1.f / D) + RMS_EPS);
#pragma unroll
        for (int j = 0; j < 8; ++j) { f32x4 o; o.x = v[j].x * r * gv[j].x; o.y = v[j].y * r * gv[j].y; o.z = v[j].z * r * gv[j].z; o.w = v[j].w * r * gv[j].w; xr[64 * j] = o; }
    }
}
__device__ __forceinline__ int xc_addr(int bl, int row, int c16) { return bl * 65536 + row * 256 + ((c16 ^ (row & 15)) << 4); }
template <bool FINAL>
__device__ __forceinline__ void scan_unit(Frame& F, int b, int chunk, int cq) {
    const int tid = F.tid, lane = F.lane, wave = F.wave;
    const bf16_t* XREC = (const bf16_t*)(F.ws + WS_XREC);
    const size_t t0 = (size_t)b * S + (size_t)chunk * 256; const int ch0 = cq * 256;
    {
        const int cg = tid & 31, tg = tid >> 5, ch = ch0 + 8 * cg, r0 = 16 * tg;
        const float* cw = F.in[3]; const float* cb = F.in[4];
        float w[4][8], bias[8];
#pragma unroll
        for (int k = 0; k < 4; ++k) { const f32x4 a = *(const f32x4*)(cw + k * LW + ch), c = *(const f32x4*)(cw + k * LW + ch + 4);
            w[k][0] = a.x; w[k][1] = a.y; w[k][2] = a.z; w[k][3] = a.w; w[k][4] = c.x; w[k][5] = c.y; w[k][6] = c.z; w[k][7] = c.w; }
        { const f32x4 a = *(const f32x4*)(cb + ch), c = *(const f32x4*)(cb + ch + 4); bias[0] = a.x; bias[1] = a.y; bias[2] = a.z; bias[3] = a.w; bias[4] = c.x; bias[5] = c.y; bias[6] = c.z; bias[7] = c.w; }
        float xm[3][8];
#pragma unroll
        for (int i = 0; i < 3; ++i) { const int rr = r0 - 3 + i; u32x4 v = (u32x4){0u, 0u, 0u, 0u};
            if (chunk > 0 || rr >= 0) v = *(const u32x4*)(XREC + (size_t)((long)t0 + rr) * LW + ch);
            xm[i][0] = bf_lo(v.x); xm[i][1] = bf_hi(v.x); xm[i][2] = bf_lo(v.y); xm[i][3] = bf_hi(v.y); xm[i][4] = bf_lo(v.z); xm[i][5] = bf_hi(v.z); xm[i][6] = bf_lo(v.w); xm[i][7] = bf_hi(v.w); }
        const int bl = cg >> 4, c16 = cg & 15;
        u32x4 xv[16];
#pragma unroll
        for (int r = 0; r < 16; ++r) xv[r] = *(const u32x4*)(XREC + (t0 + r0 + r) * LW + ch);
#pragma unroll
        for (int r = 0; r < 16; ++r) {
            const u32x4 v = xv[r];
            float x0[8]; x0[0] = bf_lo(v.x); x0[1] = bf_hi(v.x); x0[2] = bf_lo(v.y); x0[3] = bf_hi(v.y); x0[4] = bf_lo(v.z); x0[5] = bf_hi(v.z); x0[6] = bf_lo(v.w); x0[7] = bf_hi(v.w);
            float y[8];
#pragma unroll
            for (int c = 0; c < 8; ++c) { y[c] = bias[c] + w[0][c] * xm[0][c] + w[1][c] * xm[1][c] + w[2][c] * xm[2][c] + w[3][c] * x0[c]; xm[0][c] = xm[1][c]; xm[1][c] = xm[2][c]; xm[2][c] = x0[c]; }
            u32x4 o; o.x = cvt_pk_bf16(y[0], y[1]); o.y = cvt_pk_bf16(y[2], y[3]); o.z = cvt_pk_bf16(y[4], y[5]); o.w = cvt_pk_bf16(y[6], y[7]);
            *(LAS u32x4*)(F.lds + xc_addr(bl, r0 + r, c16)) = o;
        }
    }
    __syncthreads();
    {
        const int r32 = lane & 31, hi = lane >> 5, bl = wave >> 2, nb = 2 * cq + bl, dl = 32 * (wave & 3) + r32, d = nb * LBD + dl;
        const bf16_t* WA_T = (const bf16_t*)(F.ws + WS_WA_T); const bf16_t* WX_T = (const bf16_t*)(F.ws + WS_WX_T);
        bf16x8 wa[8], wx[8];
#pragma unroll
        for (int ks = 0; ks < 8; ++ks) { wa[ks] = *(const bf16x8*)(WA_T + ((size_t)nb * LBD + dl) * LBD + 16 * ks + 8 * hi); wx[ks] = *(const bf16x8*)(WX_T + ((size_t)nb * LBD + dl) * LBD + 16 * ks + 8 * hi); }
        const float ba = F.in[6][d], bx = F.in[8][d], lam = F.in[9][d];
        const float cl = -8.0f * log1pf(expf(-lam));
        float hc = 0.f, Atot = 1.f;
        float* SSUM = (float*)(F.ws + WS_SSUM);
        if (FINAL) {
#pragma unroll 1
            for (int j0 = 0; j0 < chunk; j0 += 8) { f32x2 sv[8];
#pragma unroll
                for (int j = 0; j < 8; ++j) sv[j] = *(const f32x2*)(SSUM + (((size_t)b * NBLK + j0 + j) * LW + d) * 2);
#pragma unroll
                for (int j = 0; j < 8; ++j) { const bool ok = (j0 + j) < chunk; hc = ok ? (sv[j].x * hc + sv[j].y) : hc; } } }
        const bf16_t* GREC = (const bf16_t*)(F.ws + WS_GREC); bf16_t* YCAT = (bf16_t*)(F.ws + WS_YCAT);
#pragma unroll 1
        for (int tt = 0; tt < 8; ++tt) {
            f32x16 ar = {}, ai = {};
            bf16x8 am[8]; bf16_t xcr[16];
#pragma unroll
            for (int ks = 0; ks < 8; ++ks) am[ks] = *(const LAS bf16x8*)(F.lds + xc_addr(bl, 32 * tt + r32, 2 * ks + hi));
#pragma unroll
            for (int r = 0; r < 16; ++r) { const int row = 32 * tt + (r & 3) + 8 * (r >> 2) + 4 * hi; xcr[r] = *(const LAS bf16_t*)(F.lds + xc_addr(bl, row, dl >> 3) + (dl & 7) * 2); }
            __builtin_amdgcn_sched_barrier(0);
#pragma unroll
            for (int ks = 0; ks < 8; ++ks) { ar = __builtin_amdgcn_mfma_f32_32x32x16_bf16(am[ks], wa[ks], ar, 0, 0, 0); ai = __builtin_amdgcn_mfma_f32_32x32x16_bf16(am[ks], wx[ks], ai, 0, 0, 0); }
            float av[16], bv[16], lav[16];
#pragma unroll
            for (int r = 0; r < 16; ++r) {
                const float xc = bf2f(xcr[r]);
                const float rg = fsigmoid(ar[r] + ba), ig = fsigmoid(ai[r] + bx);
                const float la = cl * rg; av[r] = __builtin_amdgcn_exp2f(la * 1.4426950408889634f); lav[r] = la; const float x2 = 2.0f * la;
                const float em = -x2 * (1.0f + x2 * (0.5f + x2 * (0.16666667f + x2 * (0.041666668f + x2 * 0.0083333338f))));
                bv[r] = __builtin_amdgcn_sqrtf(em) * ig * xc; }
            if (!FINAL) {
                int ttv = tt; asm volatile("" : "+v"(ttv));
                const unsigned rl = 32u * (unsigned)ttv + 4u * (unsigned)hi; unsigned* AB = (unsigned*)F.out + (size_t)F.vcu * 65536 + (unsigned)(d & 255);
#pragma unroll
                for (int r = 0; r < 16; ++r) AB[(rl + (unsigned)((r & 3) + 8 * (r >> 2))) * 256u] = cvt_pk_bf16(lav[r], bv[r]);
            }
            float Ag[4], Hg[4], hl[16], Ac[16];
#pragma unroll
            for (int g = 0; g < 4; ++g) { float A = 1.f, H = 0.f;
#pragma unroll
                for (int j = 0; j < 4; ++j) { const int r = 4 * g + j; H = av[r] * H + bv[r]; A *= av[r]; hl[r] = H; Ac[r] = A; }
                Ag[g] = A; Hg[g] = H; }
            float hin[4];
#pragma unroll
            for (int g = 0; g < 4; ++g) { const float Ao = __shfl_xor(Ag[g], 32), Ho = __shfl_xor(Hg[g], 32);
                const float A0 = hi ? Ao : Ag[g], H0 = hi ? Ho : Hg[g], A1 = hi ? Ag[g] : Ao, H1 = hi ? Hg[g] : Ho;
                const float h0 = hc; hc = A0 * hc + H0; const float h1 = hc; hc = A1 * hc + H1; hin[g] = hi ? h1 : h0; Atot *= A0 * A1; }
            if (FINAL) {
                int ttv = tt; asm volatile("" : "+v"(ttv));
                const unsigned rb = (unsigned)t0 + 32u * (unsigned)ttv + 4u * (unsigned)hi;
#pragma unroll
                for (int r = 0; r < 16; ++r) { const unsigned t = rb + (unsigned)((r & 3) + 8 * (r >> 2)); const float hf = hl[r] + Ac[r] * hin[r >> 2];
                    const float gr = bf2f(GREC[t * (unsigned)LW + (unsigned)d]);
                    YCAT[t * 2048u + (unsigned)d] = (bf16_t)(cvt_pk_bf16(hf * gr, 0.f) & 0xffffu);
                    if ((r & 3) == 3) asm volatile("" ::: "memory"); }
            }
        }
        if (!FINAL && hi == 0) {
            const unsigned long long sv = ((unsigned long long)__float_as_uint(hc) << 32) | (unsigned long long)__float_as_uint(Atot);
            __hip_atomic_store((unsigned long long*)(SSUM + (((size_t)b * NBLK + chunk) * LW + d) * 2), sv, __ATOMIC_RELAXED, __HIP_MEMORY_SCOPE_AGENT); }
    }
    __syncthreads();
}


__device__ __forceinline__ void scan_fix(Frame& F, int task) {
    const int lane = F.lane, r32 = lane & 31, hi = lane >> 5;
    const int cg = task & 31, chunk = (task >> 5) & 31, b = task >> 10, d = cg * 32 + r32;
    const size_t t0 = (size_t)b * S + (size_t)chunk * 256;
    const float* SSUM = (const float*)(F.ws + WS_SSUM); const unsigned* AB = (const unsigned*)F.out + (size_t)F.vcu * 65536 + (unsigned)(d & 255);
    const bf16_t* GREC = (const bf16_t*)(F.ws + WS_GREC); bf16_t* YCAT = (bf16_t*)(F.ws + WS_YCAT);
    float hc = 0.f;
    unsigned abA[16]; bf16_t grA[16];
    { const unsigned rb = (unsigned)t0 + 4u * (unsigned)hi;
#pragma unroll
      for (int r = 0; r < 16; ++r) { const unsigned ro = (unsigned)((r & 3) + 8 * (r >> 2)); const unsigned t = rb + ro; abA[r] = AB[(4u * (unsigned)hi + ro) * 256u]; grA[r] = GREC[t * (unsigned)LW + (unsigned)d]; } }
#pragma unroll 1
    for (int j0 = 0; j0 < chunk; j0 += 8) { f32x2 sv[8];
#pragma unroll
        for (int j = 0; j < 8; ++j) { const unsigned long long q = __hip_atomic_load((const unsigned long long*)(SSUM + (((size_t)b * NBLK + j0 + j) * LW + d) * 2), __ATOMIC_RELAXED, __HIP_MEMORY_SCOPE_AGENT);
            sv[j].x = __uint_as_float((unsigned)q); sv[j].y = __uint_as_float((unsigned)(q >> 32)); }
#pragma unroll
        for (int j = 0; j < 8; ++j) { const bool ok = (j0 + j) < chunk; hc = ok ? (sv[j].x * hc + sv[j].y) : hc; } }
#define SF_LOAD(TT, ABV, GRV) do { int ttv = (TT); asm volatile("" : "+v"(ttv)); const unsigned rb = (unsigned)t0 + 32u * (unsigned)ttv + 4u * (unsigned)hi; \
        _Pragma("unroll") for (int r = 0; r < 16; ++r) { const unsigned ro = (unsigned)((r & 3) + 8 * (r >> 2)); const unsigned t = rb + ro; ABV[r] = AB[(32u * (unsigned)ttv + 4u * (unsigned)hi + ro) * 256u]; GRV[r] = GREC[t * (unsigned)LW + (unsigned)d]; } } while (0)
#define SF_STEP(TT, ABV, GRV) do { int ttv = (TT); asm volatile("" : "+v"(ttv)); const unsigned rb = (unsigned)t0 + 32u * (unsigned)ttv + 4u * (unsigned)hi; \
        float av[16], bv[16]; \
        _Pragma("unroll") for (int r = 0; r < 16; ++r) { av[r] = __builtin_amdgcn_exp2f(bf_lo(ABV[r]) * 1.4426950408889634f); bv[r] = bf_hi(ABV[r]); } \
        float Ag[4], Hg[4], hl[16], Ac[16]; \
        _Pragma("unroll") for (int g = 0; g < 4; ++g) { float A = 1.f, H = 0.f; \
            _Pragma("unroll") for (int j = 0; j < 4; ++j) { const int r = 4 * g + j; H = av[r] * H + bv[r]; A *= av[r]; hl[r] = H; Ac[r] = A; } \
            Ag[g] = A; Hg[g] = H; } \
        float hin[4]; \
        _Pragma("unroll") for (int g = 0; g < 4; ++g) { const float Ao = __shfl_xor(Ag[g], 32), Ho = __shfl_xor(Hg[g], 32); \
            const float A0 = hi ? Ao : Ag[g], H0 = hi ? Ho : Hg[g], A1 = hi ? Ag[g] : Ao, H1 = hi ? Hg[g] : Ho; \
            const float h0 = hc; hc = A0 * hc + H0; const float h1 = hc; hc = A1 * hc + H1; hin[g] = hi ? h1 : h0; } \
        _Pragma("unroll") for (int r = 0; r < 16; ++r) { const unsigned t = rb + (unsigned)((r & 3) + 8 * (r >> 2)); const float hf = hl[r] + Ac[r] * hin[r >> 2]; \
            YCAT[t * 2048u + (unsigned)d] = (bf16_t)(cvt_pk_bf16(hf * bf2f(GRV[r]), 0.f) & 0xffffu); } } while (0)
    unsigned abB[16]; bf16_t grB[16];
#pragma unroll 1
    for (int tt = 0; tt < 8; tt += 2) {
        SF_LOAD(tt + 1, abB, grB);
        SF_STEP(tt, abA, grA);
        if (tt + 2 < 8) SF_LOAD(tt + 2, abA, grA);
        SF_STEP(tt + 1, abB, grB);
    }
#undef SF_LOAD
#undef SF_STEP
}

__device__ __forceinline__ void kmean_unit(Frame& F, int u) {
    const int tid = F.tid; const int bh = u >> 5, n = u & 31, b = bh >> 3, h = bh & 7;
    const bf16_t* Kp = (const bf16_t*)(F.ws + WS_K) + ((size_t)b * S + (size_t)n * 256) * AW + h * HD;
    const int rg = tid >> 4, cc = tid & 15; float s[8] = {0.f, 0.f, 0.f, 0.f, 0.f, 0.f, 0.f, 0.f}; float sq[8][8];
#pragma unroll
    for (int i = 0; i < 8; ++i) { const u32x4 v = *(const u32x4*)(Kp + (size_t)(rg + 32 * i) * AW + 8 * cc);
        const float e[8] = {bf_lo(v.x), bf_hi(v.x), bf_lo(v.y), bf_hi(v.y), bf_lo(v.z), bf_hi(v.z), bf_lo(v.w), bf_hi(v.w)};
#pragma unroll
        for (int c = 0; c < 8; ++c) { s[c] += e[c]; sq[i][c] = e[c] * e[c]; } }
    LAS float* part = (LAS float*)F.lds; LAS float* nmx = part + 32 * 128;
#pragma unroll
    for (int c = 0; c < 8; ++c) part[rg * 128 + 8 * cc + c] = s[c];
    { float mx = 0.f;
#pragma unroll
      for (int i = 0; i < 8; ++i) { float q = 0.f;
#pragma unroll
          for (int c = 0; c < 8; ++c) q += sq[i][c];
          q += __shfl_xor(q, 1); q += __shfl_xor(q, 2); q += __shfl_xor(q, 4); q += __shfl_xor(q, 8); mx = fmaxf(mx, q); }
      if (cc == 0) nmx[rg] = mx; }
    __syncthreads();
    if (tid == 0) { float m = 0.f; for (int r = 0; r < 32; ++r) m = fmaxf(m, nmx[r]); ((float*)(F.ws + WS_KNORM))[u] = m; }
    if (tid < 128) { float a = 0.f;
#pragma unroll 8
        for (int r = 0; r < 32; ++r) a += part[r * 128 + tid];
        const float mean = a * (1.f / 256.f); ((float*)(F.ws + WS_KMEAN))[(size_t)u * 128 + tid] = mean;
        const unsigned hb = cvt_pk_bf16(mean, 0.f) & 0xffffu; const float lo = mean - __uint_as_float(hb << 16);
        ((bf16_t*)(F.ws + WS_KMH))[(size_t)u * 128 + tid] = (bf16_t)hb; ((bf16_t*)(F.ws + WS_KML))[(size_t)u * 128 + tid] = (bf16_t)(cvt_pk_bf16(lo, 0.f) & 0xffffu); }
    __syncthreads();
}

__device__ __forceinline__ void route_phase(Frame& F) {
    const int tid = F.tid, lane = F.lane, wave = F.wave, r32 = lane & 31, hi = lane >> 5;
    constexpr int NU = NB * NH * 16;
    LAS int* lcnt = (LAS int*)(F.lds + 16384); LAS int* lbase = lcnt + 32; LAS float* knl = (LAS float*)(lbase + 32);
    constexpr int GPP = 35;
    LAS float* gp = (LAS float*)(F.lds + 32768);
    bf16x8 qa[2][8], ka[2][8], bhv[8], blv[8]; float knv = 0.f;
#define ROUTE_LOAD(U) do { const int _bh = (U) >> 4, _j0 = 1 + 2 * ((U) & 15), _b = _bh >> 3, _h = _bh & 7; \
        const bf16_t* mh = (const bf16_t*)(F.ws + WS_KMH) + ((size_t)_bh * 32 + r32) * 128 + 8 * hi; const bf16_t* ml = (const bf16_t*)(F.ws + WS_KML) + ((size_t)_bh * 32 + r32) * 128 + 8 * hi; \
        _Pragma("unroll") for (int hf = 0; hf < 2; ++hf) { const int _jj = (_j0 + hf <= 31) ? _j0 + hf : _j0; \
            const size_t trow = (size_t)_b * S + (size_t)_jj * 256 + wave * 32 + r32; \
            const bf16_t* qp = (const bf16_t*)(F.ws + WS_Q) + trow * AW + _h * HD + 8 * hi; const bf16_t* kp = (const bf16_t*)(F.ws + WS_K) + trow * AW + _h * HD + 8 * hi; \
            _Pragma("unroll") for (int ks = 0; ks < 8; ++ks) { qa[hf][ks] = *(const bf16x8*)(qp + 16 * ks); ka[hf][ks] = *(const bf16x8*)(kp + 16 * ks); } } \
        _Pragma("unroll") for (int ks = 0; ks < 8; ++ks) { bhv[ks] = *(const bf16x8*)(mh + 16 * ks); blv[ks] = *(const bf16x8*)(ml + 16 * ks); } \
        knv = ((const float*)(F.ws + WS_KNORM))[_bh * 32 + r32]; } while (0)
    int u = F.vcu; if (u >= NU) return;
    ROUTE_LOAD(u);
    for (;;) {
        const int un = u + F.G; const int bh = u >> 4, j0 = 1 + 2 * (u & 15), b = bh >> 3, h = bh & 7; const int jmax = (j0 + 1 <= 31) ? j0 + 1 : j0;
        if (tid < 32) { lcnt[tid] = 0; knl[tid] = knv; }
#pragma unroll
        for (int hf = 0; hf < 2; ++hf) {
            f32x16 acc = {};
#pragma unroll
            for (int ks = 0; ks < 8; ++ks) { acc = __builtin_amdgcn_mfma_f32_32x32x16_bf16(qa[hf][ks], bhv[ks], acc, 0, 0, 0); acc = __builtin_amdgcn_mfma_f32_32x32x16_bf16(qa[hf][ks], blv[ks], acc, 0, 0, 0); }
            float qq = 0.f, qk = 0.f;
#pragma unroll
            for (int ks = 0; ks < 8; ++ks)
#pragma unroll
                for (int e = 0; e < 8; ++e) { const float qv = bf2f((bf16_t)qa[hf][ks][e]), kv = bf2f((bf16_t)ka[hf][ks][e]); qq += qv * qv; qk += qv * kv; }
            qq += __shfl_xor(qq, 32); qk += __shfl_xor(qk, 32);
            const int qb = hf * 256 + wave * 32;
#pragma unroll
            for (int r = 0; r < 16; ++r) gp[(qb + (r & 3) + 8 * (r >> 2) + 4 * hi) * GPP + r32] = acc[r];
            if (hi == 0) { gp[(qb + r32) * GPP + 32] = qq; gp[(qb + r32) * GPP + 33] = qk; }
        }
        __syncthreads();
        if (un < NU) ROUTE_LOAD(un);
        int sel[3] = {-1, -1, -1}, slot[3] = {0, 0, 0};
        const int j = j0 + (tid >> 8), qi = tid & 255; const bool live = j <= 31;
        if (live) {
            float bv[3] = {-3.0e38f, -3.0e38f, -3.0e38f};
#pragma unroll 1
            for (int n = 0; n < j; ++n) {
                const float g = gp[tid * GPP + n];
                if (g > bv[0]) { bv[2] = bv[1]; sel[2] = sel[1]; bv[1] = bv[0]; sel[1] = sel[0]; bv[0] = g; sel[0] = n; }
                else if (g > bv[1]) { bv[2] = bv[1]; sel[2] = sel[1]; bv[1] = g; sel[1] = n; }
                else if (g > bv[2]) { bv[2] = g; sel[2] = n; }
            }
            { const float qn = sqrtf(gp[tid * GPP + 32]), sself = 0.088388347648318440f * gp[tid * GPP + 33];
              const float slope = exp2f(-(float)(h + 1)); float* LSE = (float*)(F.ws + WS_LSE);
#pragma unroll
              for (int k = 0; k < 3; ++k) if (sel[k] >= 0) { const int n = sel[k]; const float dmin = (float)((j - n - 1) * 256 + qi + 1);
                  const float ub = 0.088388347648318440f * qn * sqrtf(knl[n]) * 1.0001f - slope * dmin;
                  if (ub < sself - 110.f) { LSE[(((size_t)b * S + (size_t)j * 256 + qi) * NH + h) * 4 + k] = -3.0e38f; sel[k] = -1 - n; } } }
#pragma unroll
            for (int k = 0; k < 3; ++k) if (sel[k] >= 0) slot[k] = __hip_atomic_fetch_add(lcnt + sel[k], 1, __ATOMIC_RELAXED, __HIP_MEMORY_SCOPE_WORKGROUP);
        }
        __syncthreads();
        if (tid < jmax) lbase[tid] = (int)atomicAdd(F.ctl + CW_ACNT + bh * 32 + tid, (unsigned)lcnt[tid]);
        __syncthreads();
        if (live) { unsigned* AL = (unsigned*)(F.ws + WS_ALIST) + (size_t)bh * ALIST_PER_BH;
#pragma unroll
            for (int k = 0; k < 3; ++k) if (sel[k] >= 0) AL[alist_off(sel[k]) + lbase[sel[k]] + slot[k]] = ((unsigned)(j * 256 + qi) << 2) | (unsigned)k; }
        __syncthreads();
        if (un >= NU) break;
        u = un;
    }
#undef ROUTE_LOAD
}
namespace att {
constexpr int KVBLK = 64, LDK = AW;
constexpr float SCALE = 0.088388347648318440f;
constexpr float THR = 8.f;
constexpr size_t SHM_V = KVBLK * HD * 2, SHM_K = KVBLK * HD * 2;
#define KSWZ(row, colB) ((row) * 256 + ((colB) ^ (((row) & 7) << 4)))
#define SBAR() __builtin_amdgcn_sched_barrier(0)
__device__ __forceinline__ int crow(int r, int hi) { return (r & 3) + 8 * (r >> 2) + 4 * hi; }
__device__ __forceinline__ void partialSM(f32x16& p0, f32x16& p1, float& m_reg, float& mn, float& alpha) {
  constexpr float C = SCALE * 1.4426950408889634f;
  float pmax = p0[0];
#pragma unroll
  for (int r = 1; r < 16; ++r) pmax = fmaxf(pmax, p0[r]);
#pragma unroll
  for (int r = 0; r < 16; ++r) pmax = fmaxf(pmax, p1[r]);
  { auto rr = __builtin_amdgcn_permlane32_swap(__float_as_uint(pmax), __float_as_uint(pmax), false, false);
    pmax = fmaxf(__uint_as_float(rr[0]), __uint_as_float(rr[1])); }
  if (__builtin_expect(__all(pmax - m_reg <= THR / SCALE), 1)) { mn = m_reg; alpha = 1.f; }
  else { mn = fmaxf(m_reg, pmax); alpha = __builtin_amdgcn_exp2f((m_reg - mn) * C); m_reg = mn; }
  const float mnC = -mn * C;
#pragma unroll
  for (int r = 0; r < 16; ++r) p0[r] = fmaf(p0[r], C, mnC);
#pragma unroll
  for (int r = 0; r < 16; ++r) p1[r] = fmaf(p1[r], C, mnC);
#pragma unroll
  for (int r = 0; r < 16; ++r) p0[r] = __builtin_amdgcn_exp2f(p0[r]);
}
__device__ __forceinline__ void finishSM(f32x16& p0, f32x16& p1, float alpha, float& l_reg, bf16x8& pa0, bf16x8& pa1, bf16x8& pa2, bf16x8& pa3) {
#pragma unroll
  for (int r = 0; r < 16; ++r) p1[r] = __builtin_amdgcn_exp2f(p1[r]);
  float ps = 0;
#pragma unroll
  for (int r = 0; r < 16; ++r) ps += p0[r];
#pragma unroll
  for (int r = 0; r < 16; ++r) ps += p1[r];
  { auto rr = __builtin_amdgcn_permlane32_swap(__float_as_uint(ps), __float_as_uint(ps), false, false);
    ps = __uint_as_float(rr[0]) + __uint_as_float(rr[1]); }
  l_reg = l_reg * alpha + ps;
#define PK4(P, BASE, OUT) do { unsigned a0 = cvt_pk_bf16(P[BASE + 0], P[BASE + 1]), a1 = cvt_pk_bf16(P[BASE + 2], P[BASE + 3]);   \
    unsigned b0 = cvt_pk_bf16(P[BASE + 4], P[BASE + 5]), b1 = cvt_pk_bf16(P[BASE + 6], P[BASE + 7]);                              \
    auto r0 = __builtin_amdgcn_permlane32_swap(a0, b0, false, false); auto r1 = __builtin_amdgcn_permlane32_swap(a1, b1, false, false); \
    u32x4 w = {r0[0], r1[0], r0[1], r1[1]}; OUT = *reinterpret_cast<bf16x8*>(&w); } while (0)
  PK4(p0, 0, pa0); PK4(p0, 8, pa1); PK4(p1, 0, pa2); PK4(p1, 8, pa3);
#undef PK4
}
__device__ __forceinline__ void qkt_init(f32x16& p0, f32x16& p1, float bq, float slr) {
#pragma unroll
  for (int r = 0; r < 16; ++r) { const int c0 = (r & 3) + 8 * (r >> 2); p0[r] = fmaf(slr, (float)c0, bq); p1[r] = fmaf(slr, (float)(c0 + 32), bq); }
}
__device__ __forceinline__ void qkt_mask(f32x16& p0, f32x16& p1, int lim) {
#pragma unroll
  for (int r = 0; r < 16; ++r) { const int c0 = (r & 3) + 8 * (r >> 2); if (c0 > lim) p0[r] = -1e30f; if (c0 + 32 > lim) p1[r] = -1e30f; }
}
__device__ __forceinline__ void qkt_mma(f32x16& p0, f32x16& p1, const char* Ks, const bf16x8* qr, int r32, int hi) {
#pragma unroll
  for (int d0 = 0; d0 < 8; ++d0) { const int cb = (d0 * 16 + hi * 8) * 2;
    const bf16x8 b0 = *reinterpret_cast<const bf16x8*>(Ks + KSWZ(r32, cb));
    const bf16x8 b1 = *reinterpret_cast<const bf16x8*>(Ks + KSWZ(32 + r32, cb));
    p0 = __builtin_amdgcn_mfma_f32_32x32x16_bf16(b0, qr[d0], p0, 0, 0, 0);
    p1 = __builtin_amdgcn_mfma_f32_32x32x16_bf16(b1, qr[d0], p1, 0, 0, 0); }
}
template <bool OWN>
__device__ __forceinline__ void qkt(f32x16& p0, f32x16& p1, const char* Ks, const bf16x8* qr, int r32, int hi, float bq, float slr, int lim) {
  qkt_init(p0, p1, bq, slr); if (OWN) qkt_mask(p0, p1, lim); qkt_mma(p0, p1, Ks, qr, r32, hi);
}
__device__ __forceinline__ int v_st(int k, int c) { const int kk = (k & ~0xC) | ((k & 4) << 1) | ((k & 8) >> 1); return ((kk >> 3) * 4 + (c >> 5)) * 512 + ((kk & 7) * 32 + (c & 31)) * 2; }
__device__ __forceinline__ int v_rd_base(int lane) { return ((lane & 3) << 3) | (((lane >> 2) & 3) << 6) | (((lane >> 4) & 1) << 5) | (((lane >> 5) & 1) << 8); }
constexpr int v_rd_off(int d0, int ks, int half) { return d0 * 512 + ks * 4096 + half * 2048; }
template <int OFF> __device__ __forceinline__ s16x4 tr_read(int vb) {
  s16x4 r; asm volatile("ds_read_b64_tr_b16 %0, %1 offset:%2" : "=&v"(r) : "v"(vb), "i"(OFF) : "memory"); return r;
}
template <int D0> __device__ __forceinline__ void pv_one(f32x16& od, int vb, bf16x8 pa0, bf16x8 pa1, bf16x8 pa2, bf16x8 pa3) {
  const s16x4 l0 = tr_read<v_rd_off(D0, 0, 0)>(vb), h0 = tr_read<v_rd_off(D0, 0, 1)>(vb), l1 = tr_read<v_rd_off(D0, 1, 0)>(vb), h1 = tr_read<v_rd_off(D0, 1, 1)>(vb);
  const s16x4 l2 = tr_read<v_rd_off(D0, 2, 0)>(vb), h2 = tr_read<v_rd_off(D0, 2, 1)>(vb), l3 = tr_read<v_rd_off(D0, 3, 0)>(vb), h3 = tr_read<v_rd_off(D0, 3, 1)>(vb);
  asm volatile("s_waitcnt lgkmcnt(0)" ::: "memory"); SBAR();
#define PK(L, H) (bf16x8){L[0], L[1], L[2], L[3], H[0], H[1], H[2], H[3]}
  od = __builtin_amdgcn_mfma_f32_32x32x16_bf16(pa0, PK(l0, h0), od, 0, 0, 0);
  od = __builtin_amdgcn_mfma_f32_32x32x16_bf16(pa1, PK(l1, h1), od, 0, 0, 0);
  od = __builtin_amdgcn_mfma_f32_32x32x16_bf16(pa2, PK(l2, h2), od, 0, 0, 0);
  od = __builtin_amdgcn_mfma_f32_32x32x16_bf16(pa3, PK(l3, h3), od, 0, 0, 0);
#undef PK
}
__device__ __forceinline__ void pv_d0(f32x16* o, int vb, bf16x8 pa0, bf16x8 pa1, bf16x8 pa2, bf16x8 pa3) {
  pv_one<0>(o[0], vb, pa0, pa1, pa2, pa3); pv_one<1>(o[1], vb, pa0, pa1, pa2, pa3); pv_one<2>(o[2], vb, pa0, pa1, pa2, pa3); pv_one<3>(o[3], vb, pa0, pa1, pa2, pa3);
}

}
namespace att {
struct Desc { int b, h, n, chunk, cnt, own; };
__device__ __forceinline__ Desc decode(int i, const LAS int* ipre, int nsel, const unsigned* ac) {
  Desc d; int bhn;
  if (i < nsel) { int lo = 0, hi = 1024; while (hi - lo > 1) { const int mid = (lo + hi) >> 1; if (ipre[mid] <= i) lo = mid; else hi = mid; } bhn = lo; d.chunk = i - ipre[lo]; d.cnt = (int)ac[bhn]; d.own = 0; }
  else { bhn = i - nsel; d.chunk = 0; d.cnt = 256; d.own = 1; }
  d.b = bhn >> 8; d.h = (bhn >> 5) & 7; d.n = bhn & 31; return d;
}
__device__ __forceinline__ void phase(Frame& F, const LAS int* ipre, int nsel, const unsigned* ac) {
  char* lds = (char*)(unsigned char*)F.lds;
  const int tid = F.tid, wid = F.wave, lane = F.lane, r32 = lane & 31, hi = lane >> 5;
  const int ntot = nsel + NB * NH * NBLK;
  int it = F.vcu; if (it >= ntot) return;
  const bf16_t* Qg = (const bf16_t*)(F.ws + WS_Q); const bf16_t* Kg = (const bf16_t*)(F.ws + WS_K); const bf16_t* Vg = (const bf16_t*)(F.ws + WS_V);
  const unsigned* AL = (const unsigned*)(F.ws + WS_ALIST);
  bf16_t* PART = (bf16_t*)((unsigned char*)F.out); float* LSE = (float*)(F.ws + WS_LSE);
  bf16_t* V_lds = (bf16_t*)lds; bf16_t* K_lds = (bf16_t*)(lds + 2 * SHM_V);
  float* wsf = (float*)(lds + 2 * SHM_V + 2 * SHM_K) + wid * 64; float* li_l = wsf; float* al_l = wsf + 32;
  const int sr = tid >> 4, sc = (tid & 15) * 8, vst0 = v_st(sr, sc), vst1 = v_st(32 + sr, sc);
  const int vb0 = (int)(uintptr_t)V_lds + v_rd_base(lane);
  struct { bf16x8 vs0, vs1, ks0, ks1; } sr_[2];
  constexpr float C = SCALE * 1.4426950408889634f;
#define SLOADX(i, d, j) do { const size_t _o = ((size_t)(d).b * S + (size_t)(d).n * 256 + 64 * (j) + sr) * AW + (d).h * HD + sc; \
    sr_[i].vs0 = *(const bf16x8*)(Vg + _o); sr_[i].vs1 = *(const bf16x8*)(Vg + _o + (size_t)32 * AW); sr_[i].ks0 = *(const bf16x8*)(Kg + _o); sr_[i].ks1 = *(const bf16x8*)(Kg + _o + (size_t)32 * AW); } while (0)
#define SWRITE(bb, i) do { *(bf16x8*)((char*)V_lds + (bb) * SHM_V + vst0) = sr_[i].vs0;          \
    *(bf16x8*)((char*)V_lds + (bb) * SHM_V + vst1) = sr_[i].vs1; const int kc = sc * 2;               \
    *(bf16x8*)((char*)K_lds + (bb) * SHM_K + KSWZ(sr, kc)) = sr_[i].ks0;                       \
    *(bf16x8*)((char*)K_lds + (bb) * SHM_K + KSWZ(32 + sr, kc)) = sr_[i].ks1; } while (0)
#define RESC(a) do { if (__any((a) < 1.f)) { if (hi == 0) al_l[r32] = (a); asm volatile("s_waitcnt lgkmcnt(0)" ::: "memory"); \
    _Pragma("unroll") for (int d = 0; d < 4; ++d) _Pragma("unroll") for (int r = 0; r < 16; ++r) o[d][r] *= al_l[crow(r, hi)]; } } while (0)
#define LANEQ(d, tq, prow) do { int _ks = 3; bool _v = true; \
    if ((d).own) tq = (d).n * 256 + wid * 32 + r32; \
    else { const int _idx = (d).chunk * 256 + wid * 32 + r32; _v = _idx < (d).cnt; \
      const unsigned _e = AL[(size_t)((d).b * NH + (d).h) * ALIST_PER_BH + alist_off((d).n) + (_v ? _idx : (d).chunk * 256)]; tq = (int)(_e >> 2); _ks = (int)(_e & 3u); } \
    prow = _v ? (int)((((size_t)(d).b * S + tq) * NH + (d).h) * 4 + _ks) : -1; } while (0)
#define QLOAD(d, tq) do { const bf16_t* _q = Qg + ((size_t)(d).b * S + (size_t)(tq)) * AW + (d).h * HD + hi * 8; \
    _Pragma("unroll") for (int d0 = 0; d0 < 8; ++d0) qr[d0] = *(const bf16x8*)(_q + d0 * 16); } while (0)
#define SLR(d) (exp2f(-(float)((d).h + 1)) / SCALE)
#define TJ(d, j) ((d).own ? (j) : 3 - (j))
#define BQ(j) (slr * (float)(dc.n * 256 + 64 * TJ(dc, j) + 4 * hi - tq_c))
#define LIM(j) (wid * 32 + r32 - 64 * (j) - 4 * hi)
#define QKT(p0, p1, buf, j) do { qkt_init(p0, p1, BQ(j), slr); if (dc.own) { int _lim = LIM(j); asm volatile("" : "+v"(_lim)); qkt_mask(p0, p1, _lim); } qkt_mma(p0, p1, buf, qr, r32, hi); } while (0)
#define EPILOGUE() do { const float _lse = m_reg * C + __builtin_amdgcn_logf(l_reg); int* dst_l = (int*)al_l; \
    if (hi == 0) { li_l[r32] = l_reg; dst_l[r32] = prow_p; if (prow_p >= 0) LSE[prow_p] = _lse; } \
    asm volatile("s_waitcnt lgkmcnt(0)" ::: "memory"); \
    _Pragma("unroll") for (int r0 = 0; r0 < 16; r0 += 8) { float _lv[8]; int _pv[8];     \
      _Pragma("unroll") for (int q = 0; q < 8; ++q) { const int rr = crow(r0 + q, hi); _lv[q] = li_l[rr]; _pv[q] = dst_l[rr]; } \
      _Pragma("unroll") for (int q = 0; q < 8; ++q) asm volatile("" : "+v"(_lv[q]), "+v"(_pv[q])); \
      _Pragma("unroll") for (int q = 0; q < 8; ++q) { const int r = r0 + q; const float rl = __builtin_amdgcn_rcpf(_lv[q]); const int pr = _pv[q]; \
        if (pr >= 0) { _Pragma("unroll") for (int d0 = 0; d0 < 4; ++d0) PART[(size_t)pr * HD + d0 * 32 + r32] = (bf16_t)cvt_pk_bf16(o[d0][r] * rl, 0.f); } } } \
    asm volatile("s_waitcnt lgkmcnt(0)" ::: "memory"); \
    m_reg = -1e30f; l_reg = 0.f; _Pragma("unroll") for (int d = 0; d < 4; ++d) _Pragma("unroll") for (int r = 0; r < 16; ++r) o[d][r] = 0.f; } while (0)

  LAS int* dtab = (LAS int*)ipre + 1664;
  if (tid < 64) { const int i = F.vcu + tid * F.G; if (i < ntot) { const Desc d = decode(i, ipre, nsel, ac); *(LAS i32x4*)(dtab + 4 * tid) = (i32x4){(d.b << 8) | (d.h << 5) | d.n, d.chunk, d.cnt, d.own}; } }
  __syncthreads();
#define DESC_AT(K, D) do { const i32x4 _q = *(const LAS i32x4*)(dtab + 4 * (K)); (D).b = _q[0] >> 8; (D).h = (_q[0] >> 5) & 7; (D).n = _q[0] & 31; (D).chunk = _q[1]; (D).cnt = _q[2]; (D).own = _q[3]; } while (0)
  int kit = 0;
  Desc dc; DESC_AT(0, dc); Desc dn = dc;
  int tq_c, prow_c, tq_n = 0, prow_n = -1, prow_p = -1;
  LANEQ(dc, tq_c, prow_c);
  float m_reg = -1e30f, l_reg = 0.f; f32x16 o[4] = {}; bf16x8 qr[8];
  QLOAD(dc, tq_c);
  float slr = SLR(dc);
  f32x16 pA0, pA1, pB0, pB1; float mnA, mnB, alA = 1.f, alB = 1.f; bf16x8 pa0, pa1, pa2, pa3;
  constexpr int SE = 0, SO = 1;
  SLOADX(SE, dc, TJ(dc, 0)); SLOADX(SO, dc, TJ(dc, 1));
  SWRITE(0, SE); __syncthreads();
  bool first = true;
  for (;;) {
    const bool has_next = (it + F.G) < ntot;
    SBAR(); QKT(pA0, pA1, (const char*)K_lds, 0);
    if (!first) finishSM(pB0, pB1, alB, l_reg, pa0, pa1, pa2, pa3);
    SBAR(); SLOADX(SE, dc, TJ(dc, 2)); SBAR();
    if (!first) { pv_d0(o, vb0 + (int)SHM_V, pa0, pa1, pa2, pa3); EPILOGUE(); }
    partialSM(pA0, pA1, m_reg, mnA, alA);
    __syncthreads(); SWRITE(1, SO);
    __syncthreads();
    SBAR(); QKT(pB0, pB1, (const char*)K_lds + SHM_K, 1);
    finishSM(pA0, pA1, alA, l_reg, pa0, pa1, pa2, pa3);
    SBAR(); SLOADX(SO, dc, TJ(dc, 3));
    if (has_next) { DESC_AT(kit + 1, dn); LANEQ(dn, tq_n, prow_n); }
    SBAR();
    pv_d0(o, vb0, pa0, pa1, pa2, pa3); partialSM(pB0, pB1, m_reg, mnB, alB);
    __syncthreads(); SWRITE(0, SE);
    RESC(alB); __syncthreads();
    SBAR(); QKT(pA0, pA1, (const char*)K_lds, 2);
    finishSM(pB0, pB1, alB, l_reg, pa0, pa1, pa2, pa3);
    SBAR(); if (has_next) SLOADX(SE, dn, TJ(dn, 0)); SBAR();
    pv_d0(o, vb0 + (int)SHM_V, pa0, pa1, pa2, pa3); partialSM(pA0, pA1, m_reg, mnA, alA);
    __syncthreads(); SWRITE(1, SO);
    RESC(alA); __syncthreads();
    SBAR(); QKT(pB0, pB1, (const char*)K_lds + SHM_K, 3);
    finishSM(pA0, pA1, alA, l_reg, pa0, pa1, pa2, pa3);
    SBAR(); if (has_next) { SLOADX(SO, dn, TJ(dn, 1)); QLOAD(dn, tq_n); } SBAR();
    pv_d0(o, vb0, pa0, pa1, pa2, pa3); partialSM(pB0, pB1, m_reg, mnB, alB);
    __syncthreads(); if (has_next) SWRITE(0, SE);
    RESC(alB); __syncthreads();
    prow_p = prow_c;
    if (!has_next) break;
    dc = dn; tq_c = tq_n; prow_c = prow_n; slr = SLR(dc); first = false; it += F.G; ++kit;
  }
  finishSM(pB0, pB1, alB, l_reg, pa0, pa1, pa2, pa3); SBAR();
  pv_d0(o, vb0 + (int)SHM_V, pa0, pa1, pa2, pa3);
  EPILOGUE();
  __syncthreads();
#undef DESC_AT
#undef SLOADX
#undef SWRITE
#undef RESC
#undef LANEQ
#undef QLOAD
#undef SLR
#undef BQ
#undef LIM
#undef TJ
#undef QKT
#undef EPILOGUE
}

__device__ __forceinline__ void combine_token(Frame& F, int t, const f32x4 ls, const float* lse_next, f32x4& lsn) {
  const int lane = F.lane, h = lane >> 3, c8 = lane & 7;
  const bf16_t* PART = (const bf16_t*)((unsigned char*)F.out) + ((size_t)t * NH + h) * 4 * HD + 16 * c8;
  const int j = (t & (S - 1)) >> 8;
  float l[4]; bool ok[4]; float M = -3.0e38f;
#pragma unroll
  for (int k = 0; k < 4; ++k) { ok[k] = ((k == 3) || (k < j)) && ls[k] > -1.0e37f; l[k] = ok[k] ? ls[k] : -3.0e38f; M = fmaxf(M, l[k]); }
  u32x4 v[4][2];
#pragma unroll
  for (int k = 0; k < 4; ++k) { v[k][0] = (u32x4){0u, 0u, 0u, 0u}; v[k][1] = (u32x4){0u, 0u, 0u, 0u}; if (ok[k]) { v[k][0] = *(const u32x4*)(PART + (size_t)k * HD); v[k][1] = *(const u32x4*)(PART + (size_t)k * HD + 8); } }
  const u32x4* yr = (const u32x4*)((const bf16_t*)(F.ws + WS_YCAT) + (size_t)t * 2048) + lane; const u32x4 r0 = yr[0], r1 = yr[64];
  lsn = *(const f32x4*)lse_next;
  float acc[16]; float den = 0.f;
#pragma unroll
  for (int e = 0; e < 16; ++e) acc[e] = 0.f;
#pragma unroll
  for (int k = 0; k < 4; ++k) { const float w = ok[k] ? __builtin_amdgcn_exp2f(l[k] - M) : 0.f; den += w;
    const u32x4 a = v[k][0], b = v[k][1];
    acc[0] += w * bf_lo(a.x); acc[1] += w * bf_hi(a.x); acc[2] += w * bf_lo(a.y); acc[3] += w * bf_hi(a.y); acc[4] += w * bf_lo(a.z); acc[5] += w * bf_hi(a.z); acc[6] += w * bf_lo(a.w); acc[7] += w * bf_hi(a.w);
    acc[8] += w * bf_lo(b.x); acc[9] += w * bf_hi(b.x); acc[10] += w * bf_lo(b.y); acc[11] += w * bf_hi(b.y); acc[12] += w * bf_lo(b.z); acc[13] += w * bf_hi(b.z); acc[14] += w * bf_lo(b.w); acc[15] += w * bf_hi(b.w); }
  const float rd = __builtin_amdgcn_rcpf(den); float mxa = 0.f;
#pragma unroll
  for (int e = 0; e < 16; ++e) { acc[e] *= rd; mxa = fmaxf(mxa, fabsf(acc[e])); }
  float mxr = 0.f;
  { const unsigned w[8] = {r0.x, r0.y, r0.z, r0.w, r1.x, r1.y, r1.z, r1.w};
#pragma unroll
    for (int e = 0; e < 8; ++e) mxr = fmaxf(mxr, fmaxf(fabsf(bf_lo(w[e])), fabsf(bf_hi(w[e])))); }
#pragma unroll
  for (int o = 1; o < 64; o <<= 1) { mxa = fmaxf(mxa, __shfl_xor(mxa, o)); mxr = fmaxf(mxr, __shfl_xor(mxr, o)); }
  const float qa = 127.f / fmaxf(mxa, 1e-30f), qr = 127.f / fmaxf(mxr, 1e-30f);
  unsigned char* yc = F.ws + WS_YC8 + (size_t)t * 2048; float* rs = (float*)(F.ws + WS_RS1) + 2 * (size_t)t;
  if (lane == 0) { rs[0] = mxr * (1.f / 127.f); rs[1] = mxa * (1.f / 127.f); }
  { u32x2 w; w.x = pk4_i8(bf_lo(r0.x) * qr, bf_hi(r0.x) * qr, bf_lo(r0.y) * qr, bf_hi(r0.y) * qr); w.y = pk4_i8(bf_lo(r0.z) * qr, bf_hi(r0.z) * qr, bf_lo(r0.w) * qr, bf_hi(r0.w) * qr); *((u32x2*)yc + lane) = w;
    w.x = pk4_i8(bf_lo(r1.x) * qr, bf_hi(r1.x) * qr, bf_lo(r1.y) * qr, bf_hi(r1.y) * qr); w.y = pk4_i8(bf_lo(r1.z) * qr, bf_hi(r1.z) * qr, bf_lo(r1.w) * qr, bf_hi(r1.w) * qr); *((u32x2*)yc + 64 + lane) = w; }
  { u32x4 w; w.x = pk4_i8(acc[0] * qa, acc[1] * qa, acc[2] * qa, acc[3] * qa); w.y = pk4_i8(acc[4] * qa, acc[5] * qa, acc[6] * qa, acc[7] * qa);
    w.z = pk4_i8(acc[8] * qa, acc[9] * qa, acc[10] * qa, acc[11] * qa); w.w = pk4_i8(acc[12] * qa, acc[13] * qa, acc[14] * qa, acc[15] * qa);
    *(u32x4*)(yc + 1024 + h * HD + 16 * c8) = w; }
}
}
__device__ __forceinline__ void router_iter(Frame& F, int it) {
    const int lane = F.lane, wave = F.wave, r16 = lane & 15, q4 = lane >> 4;
    const int tok0 = it * 128 + wave * 16, tok = tok0 + r16;
    const float* WR = (const float*)(F.ws + WS_WR_T); const float* gf = F.in[13];
    LAS float* stg = (LAS float*)(F.lds + wave * 8192);
    constexpr int WRB_OFF = 65536, WRB_BYTES = 48 * 512;
    f32x4 c0 = {0.f, 0.f, 0.f, 0.f}, c1 = c0, c2 = c0; float ss = 0.f;
    const int hrow = lane >> 5, u32i = lane & 31;
    f32x4 xv[8]; u32x2 dv[8]; f32x4 gq;
#define RT_ROWS(C) do { _Pragma("unroll") for (int j = 0; j < 8; ++j) { const size_t off = (size_t)(tok0 + 2 * j + hrow) * D + 128 * (C) + 4 * u32i; \
        xv[j] = *(const f32x4*)(F.in[0] + off); dv[j] = *(const u32x2*)((const bf16_t*)(F.ws + WS_DELTA) + off); } gq = *(const f32x4*)(gf + 128 * (C) + 4 * u32i); } while (0)
#define RT_WDMA(C, BUF) do { _Pragma("unroll") for (int i = 0; i < 3; ++i) { const int q = wave * 3 + i, p = 64 * q + lane, row = p >> 5, c16 = p & 31; \
        __builtin_amdgcn_global_load_lds((const unsigned*)(WR + (size_t)row * D + 128 * (C) + 4 * (c16 ^ (row & 15))), (LAS unsigned*)(F.lds + WRB_OFF + (BUF) * WRB_BYTES + q * 1024), 16, 0, 0); } } while (0)
    RT_ROWS(0); RT_WDMA(0, 0);
#pragma unroll 1
    for (int c = 0; c < 16; ++c) {
        asm volatile("s_waitcnt vmcnt(0)" ::: "memory");
        __syncthreads();
        const f32x4 g = gq;
#pragma unroll
        for (int j = 0; j < 8; ++j) { const int r = 2 * j + hrow; const size_t off = (size_t)(tok0 + r) * D + 128 * c + 4 * u32i;
            f32x4 a = xv[j]; a.x += bf_lo(dv[j].x); a.y += bf_hi(dv[j].x); a.z += bf_lo(dv[j].y); a.w += bf_hi(dv[j].y);
            u32x2 xw; xw.x = cvt_pk_bf16(a.x, a.y); xw.y = cvt_pk_bf16(a.z, a.w);
            *(u32x2*)((bf16_t*)(F.ws + WS_DELTA) + off) = xw;
            *(unsigned*)((unsigned char*)(F.ws + WS_H2) + off) = pk4_q<QM_UP>(a.x * g.x * Q_SA_UP, a.y * g.y * Q_SA_UP, a.z * g.z * Q_SA_UP, a.w * g.w * Q_SA_UP);
            *(LAS f32x4*)(stg + r * 128 + 4 * (u32i ^ (r & 15))) = a; }
        { const int cn = (c < 15) ? c + 1 : 15; RT_ROWS(cn); RT_WDMA(cn, (c + 1) & 1); }
        __builtin_amdgcn_sched_barrier(0);
        const LAS float* wb = (const LAS float*)(F.lds + WRB_OFF + (c & 1) * WRB_BYTES);
#pragma unroll
        for (int s4 = 0; s4 < 4; ++s4) { const int u = 8 * s4 + 2 * q4, ua = 4 * (u ^ r16), ub = 4 * ((u + 1) ^ r16);
            const f32x4 a0 = *(const LAS f32x4*)(stg + r16 * 128 + ua), a1 = *(const LAS f32x4*)(stg + r16 * 128 + ub);
            ss += (a0.x * a0.x + a0.y * a0.y) + (a0.z * a0.z + a0.w * a0.w) + (a1.x * a1.x + a1.y * a1.y) + (a1.z * a1.z + a1.w * a1.w);
            const f32x4 w00 = *(const LAS f32x4*)(wb + r16 * 128 + ua), w01 = *(const LAS f32x4*)(wb + r16 * 128 + ub);
            const f32x4 w10 = *(const LAS f32x4*)(wb + (16 + r16) * 128 + ua), w11 = *(const LAS f32x4*)(wb + (16 + r16) * 128 + ub);
            const f32x4 w20 = *(const LAS f32x4*)(wb + (32 + r16) * 128 + ua), w21 = *(const LAS f32x4*)(wb + (32 + r16) * 128 + ub);
#pragma unroll
            for (int e = 0; e < 4; ++e) { c0 = __builtin_amdgcn_mfma_f32_16x16x4f32(a0[e], w00[e], c0, 0, 0, 0); c1 = __builtin_amdgcn_mfma_f32_16x16x4f32(a0[e], w10[e], c1, 0, 0, 0); c2 = __builtin_amdgcn_mfma_f32_16x16x4f32(a0[e], w20[e], c2, 0, 0, 0); }
#pragma unroll
            for (int e = 0; e < 4; ++e) { c0 = __builtin_amdgcn_mfma_f32_16x16x4f32(a1[e], w01[e], c0, 0, 0, 0); c1 = __builtin_amdgcn_mfma_f32_16x16x4f32(a1[e], w11[e], c1, 0, 0, 0); c2 = __builtin_amdgcn_mfma_f32_16x16x4f32(a1[e], w21[e], c2, 0, 0, 0); } }
    }
    asm volatile("s_waitcnt vmcnt(0)" ::: "memory");
    __syncthreads();
#undef RT_ROWS
#undef RT_WDMA
    ss += __shfl_xor(ss, 16); ss += __shfl_xor(ss, 32);
    const float rinv = rsqrtf(ss * (1.f / D) + RMS_EPS);
    LAS float* lg = stg; LAS int* hist = (LAS int*)(F.lds + TAB_OFF); LAS int* gbase = hist + 32;
    if (F.tid < 32) hist[F.tid] = 0;
#pragma unroll
    for (int r = 0; r < 4; ++r) { const int trow = 4 * q4 + r; lg[trow * 40 + r16] = c0[r]; lg[trow * 40 + 16 + r16] = c1[r]; if (r16 < 4) lg[trow * 40 + 32 + r16] = c2[r]; }
    __syncthreads();
    int ex[2] = {0, 0}, sl[2] = {0, 0}; float wt[2] = {0.f, 0.f};
    if (lane < 16) {
        const float* bg = F.in[15]; const float* be = F.in[17];
        float gl[4]; int gi = 0;
#pragma unroll
        for (int g = 0; g < 4; ++g) gl[g] = rinv * lg[lane * 40 + 32 + g] + bg[g];
        float gm = gl[0];
#pragma unroll
        for (int g = 1; g < 4; ++g) if (gl[g] > gm) { gm = gl[g]; gi = g; }
        float gs = 0.f;
#pragma unroll
        for (int g = 0; g < 4; ++g) gs += __expf(gl[g] - gm);
        const float gw = 1.0f / gs;
        float el[8];
#pragma unroll
        for (int e = 0; e < 8; ++e) el[e] = rinv * lg[lane * 40 + gi * 8 + e] + be[gi * 8 + e];
        int i1 = 0; float m1 = el[0];
#pragma unroll
        for (int e = 1; e < 8; ++e) if (el[e] > m1) { m1 = el[e]; i1 = e; }
        int i2 = -1; float m2 = -3.0e38f;
#pragma unroll
        for (int e = 0; e < 8; ++e) if (e != i1 && el[e] > m2) { m2 = el[e]; i2 = e; }
        const float e2 = __expf(m2 - m1), w1 = 1.0f / (1.0f + e2), w2 = e2 * w1;
        ex[0] = gi * 8 + i1; ex[1] = gi * 8 + i2; wt[0] = gw * w1; wt[1] = gw * w2;
        sl[0] = __hip_atomic_fetch_add(hist + ex[0], 1, __ATOMIC_RELAXED, __HIP_MEMORY_SCOPE_WORKGROUP);
        sl[1] = __hip_atomic_fetch_add(hist + ex[1], 1, __ATOMIC_RELAXED, __HIP_MEMORY_SCOPE_WORKGROUP);
    }
    __syncthreads();
    if (F.tid < 32) gbase[F.tid] = (int)atomicAdd(F.ctl + CW_ECNT + F.tid, (unsigned)hist[F.tid]);
    __syncthreads();
    if (lane < 16) {
        int* MTOK = (int*)(F.ws + WS_MTOK); int* MDST = (int*)(F.ws + WS_MDST); float* MW = (float*)(F.ws + WS_MW); float* MRS = (float*)(F.ws + WS_MRS);
#pragma unroll
        for (int k = 0; k < 2; ++k) { const size_t p = (size_t)ex[k] * T + gbase[ex[k]] + sl[k]; MTOK[p] = tok; MDST[p] = k * T + tok; MW[p] = wt[k]; MRS[p] = rinv; }
    }
    __syncthreads();
}
constexpr int N_PHASES = 14;
struct Args { const float* in[22]; float* out; unsigned char* ws; int ph_lo, ph_hi, use_bar, pad; };
__global__ void __launch_bounds__(NTHR, 2) fwd(Args args) {
    extern __shared__ __attribute__((aligned(16))) unsigned char lds[];
    Frame F;
    F.lds = (LAS unsigned char*)lds; F.MISC = (volatile LAS unsigned*)(F.lds + MISC_OFF);
    F.tid = threadIdx.x; F.lane = F.tid & 63; F.wave = __builtin_amdgcn_readfirstlane(F.tid >> 6);
    F.G = gridDim.x; { const int bx = blockIdx.x; F.vcu = (F.G % 8 == 0) ? (bx % 8) * (F.G / 8) + bx / 8 : bx; }
    F.ws = args.ws; F.out = args.out; F.ctl = (unsigned*)(args.ws + WS_CTL);
#pragma unroll
    for (int i = 0; i < 22; ++i) F.in[i] = args.in[i];
    if (F.tid < 64) F.MISC[F.tid] = 0u;
    __syncthreads();
    XcdBarrier bar; bar.bar = F.ctl + CW_BAR; bar.x = 0; bar.st = nullptr;
    if (args.use_bar) bar = xcd_barrier_post(F.ctl + CW_BAR, F.MISC + 8);
    const int lo = args.ph_lo, hi = args.ph_hi;
#define IN(k) (lo <= (k) && (k) < hi)
#define SEAM(k) do { if (IN(k) && IN((k) + 1)) xcd_barrier(bar); } while (0)

    if (IN(0)) { p0_prologue(F); __syncthreads(); }
    SEAM(0);
    if (IN(1)) {
        const pg8::EpiIn E0{(bf16_t*)(F.ws + WS_XREC), (bf16_t*)(F.ws + WS_GREC), (bf16_t*)(F.ws + WS_Q), (bf16_t*)(F.ws + WS_K), (bf16_t*)(F.ws + WS_V), (bf16_t*)(F.ws + WS_SGR), (bf16_t*)(F.ws + WS_SGA), 1.0f, IN_BF,
            TrSrc{F.in[2], F.in[10], F.in[11], F.in[12], F.in[18], F.in[19], F.in[20], F.ws}, F.vcu, F.G};
        if (IN_NBF > 0) {
            pg8::DenseProbT<0> P{(const void*)(F.ws + WS_XN), (const void*)(F.ws + WS_WIN_T), D, D, D};
            pg8::StaticOrder So; So.init(T, IN_NBF * 256, F.G, (int)blockIdx.x);
            pg8::gemm_phase<pg8::DenseProbT<0>, pg8::EpiIn, pg8::StaticOrder, true>(F.lds, P, So, E0);
        }
        if (IN_NF8 > 0) {
            pg8::DenseProbT<QM_IN> P{(const void*)F.out, (const void*)(F.ws + WS_WIN8), D, D, D};
            pg8::StaticOrder So; So.init(T, IN_NF8 * 256, F.G, (int)blockIdx.x);
            pg8::EpiIn E = E0; E.osc = 1.0f / (Q_SA_IN * Q_SB_IN); E.mask = IN_F8;
            pg8::gemm_phase<pg8::DenseProbT<QM_IN>, pg8::EpiIn, pg8::StaticOrder, true>(F.lds, P, So, E);
        }
    }
    SEAM(1);
    if (IN(2)) {
#if EN_ATTN
        for (int u = F.vcu; u < NB * NH * NBLK; u += F.G) kmean_unit(F, u);
#endif
        for (int u = F.vcu; u < NB * NBLK * 4; u += F.G) { const int b = u >> 7, chunk = (u >> 2) & 31, cq = u & 3;
            scan_unit<false>(F, b, chunk, cq);
            asm volatile("s_waitcnt vmcnt(0)" ::: "memory");
            __syncthreads();
            unsigned* fl = F.ctl + CW_SFLAG + (b * NBLK) * 4 + cq;
            if (F.tid == 0) (void)xb_add(fl + chunk * 4, 1u);
            if (F.lane < chunk) { unsigned sp = 0u; while (xb_ld(fl + F.lane * 4) == 0u) { __builtin_amdgcn_s_sleep(1); if (++sp > (1u << 22)) break; } }
            asm volatile("s_waitcnt vmcnt(0)" ::: "memory");
            scan_fix(F, (((b * NBLK) + chunk) << 5) | (cq * 8 + F.wave));
            asm volatile("s_waitcnt vmcnt(0)" ::: "memory"); __syncthreads();
        }
    }
    SEAM(2);
    if (IN(3)) {
#if EN_ATTN
        route_phase(F);
#endif
        __syncthreads();
    }
    SEAM(3);
    if (IN(4)) {
#if EN_ATTN
        LAS int* ipre = (LAS int*)(F.lds + TAB_OFF); LAS int* tmp = ipre + 1040; LAS int* lb = tmp + 512;
        const int t = F.tid; const unsigned* ac = F.ctl + CW_ACNT;
        const int v0 = ((int)ac[2 * t] + 255) >> 8, v1 = ((int)ac[2 * t + 1] + 255) >> 8;
        tmp[t] = v0 + v1;
        __syncthreads();
        if (t < 64) { int w = 0;
#pragma unroll
            for (int i = 0; i < 8; ++i) w += tmp[t * 8 + i];
            int inc = w;
#pragma unroll
            for (int o = 1; o < 64; o <<= 1) { const int y = __shfl_up(inc, o); if (t >= o) inc += y; }
            lb[t] = inc - w; }
        __syncthreads();
        { int base = lb[t >> 3]; for (int u2 = (t & ~7); u2 < t; ++u2) base += tmp[u2];
          ipre[2 * t] = base; ipre[2 * t + 1] = base + v0; if (t == NTHR - 1) ipre[1024] = base + v0 + v1; }
        __syncthreads();
        const int nitems = ipre[1024];
        att::phase(F, ipre, nitems, ac);
#endif
    }
    SEAM(4);
    if (IN(5)) {
#if EN_ATTN
        { const float* LSE = (const float*)(F.ws + WS_LSE) + (size_t)(F.lane >> 3) * 4; int t = F.vcu * NWAVES + F.wave;
          f32x4 ls = *(const f32x4*)(LSE + (size_t)t * NH * 4); asm volatile("" : "+v"(ls));
          for (; t < T; t += F.G * NWAVES) { const int tn = (t + F.G * NWAVES < T) ? t + F.G * NWAVES : t; f32x4 lsn; att::combine_token(F, t, ls, LSE + (size_t)tn * NH * 4, lsn); ls = lsn; } }
#endif
    }
    SEAM(5);
    if (IN(7)) {
        pg8::StaticOrder So; So.init(T, D, F.G, (int)blockIdx.x);
        { pg8::DenseProbT<2> P{(const void*)(F.ws + WS_YC8), (const void*)(F.ws + WS_WP_T), 1024, 2048, 2048};
          pg8::EpiGate<false> E{(const unsigned char*)(F.ws + WS_SGR), (bf16_t*)(F.ws + WS_MERGED), (const float*)(F.ws + WS_RS1), 2, 1.0f / (I8_SP * 255.f)};
          pg8::gemm_phase<pg8::DenseProbT<2>, pg8::EpiGate<false>, pg8::StaticOrder, true>(F.lds, P, So, E); }
#if EN_ATTN
        { pg8::DenseProbT<2> P{(const void*)(F.ws + WS_YC8 + 1024), (const void*)(F.ws + WS_WP_T + 1024), 1024, 2048, 2048};
          pg8::EpiGate<true> E{(const unsigned char*)(F.ws + WS_SGA), (bf16_t*)(F.ws + WS_MERGED), (const float*)(F.ws + WS_RS1) + 1, 2, 1.0f / (I8_SP * 255.f)};
          pg8::gemm_phase<pg8::DenseProbT<2>, pg8::EpiGate<true>, pg8::StaticOrder, true>(F.lds, P, So, E); }
#endif
    }
    SEAM(7);
    if (IN(8)) {
        for (int t = F.vcu * NWAVES + F.wave; t < T; t += F.G * NWAVES) quant_row<false>(F, (const bf16_t*)(F.ws + WS_MERGED), F.ws + WS_MG8, (float*)(F.ws + WS_RS2), t);
    }
    SEAM(8);
    if (IN(9)) {
        pg8::DenseProbT<2> P{(const void*)(F.ws + WS_MG8), (const void*)(F.ws + WS_WOUT_T), D, D, D};
        pg8::StaticOrder So; So.init(T, D, F.G, (int)blockIdx.x);
        pg8::EpiResid E{(bf16_t*)(F.ws + WS_DELTA), (const float*)(F.ws + WS_RS2), 1.0f / I8_SB};
        pg8::gemm_phase<pg8::DenseProbT<2>, pg8::EpiResid, pg8::StaticOrder, true>(F.lds, P, So, E);
    }
    SEAM(9);
    if (IN(10)) {
#if EN_MOE
        for (int it = F.vcu; it < T / 128; it += F.G) router_iter(F, it);
#endif
    }
    SEAM(10);
#if EN_MOE
    LAS int* tpre = (LAS int*)(F.lds + TAB_OFF); LAS int* ecnt = tpre + 40;
    if (IN(11) || IN(12)) {
        if (F.tid == 0) { int a = 0; for (int e = 0; e < NE; ++e) { const int c = (int)F.ctl[CW_ECNT + e]; ecnt[e] = c; tpre[e] = a; a += (c + 255) >> 8; } tpre[NE] = a; }
        __syncthreads();
    }
#endif
    if (IN(11)) {
#if EN_MOE
        pg8::MoeUpProbT<QM_UP> P{(const void*)(F.ws + WS_H2), (const void*)(F.ws + WS_WGU_T), (const int*)(F.ws + WS_MTOK), D, D, D};
        pg8::GroupedOrder So{tpre, ecnt, 4, F.G, F.vcu};
        pg8::EpiHid E{(const float*)(F.ws + WS_MRS), (void*)(F.ws + WS_HID), QM_UP ? 1.0f / (Q_SA_UP * Q_SB_UP) : 1.0f};
        pg8::gemm_phase<pg8::MoeUpProbT<QM_UP>, pg8::EpiHid, pg8::GroupedOrder, true>(F.lds, P, So, E);
#endif
    }
    SEAM(11);
    if (IN(12)) {
#if EN_MOE
        pg8::MoeDownProbT<QM_DOWN> P{(const void*)(F.ws + WS_HID), (const void*)(F.ws + WS_WD_T), EH, EH, EH};
        pg8::GroupedOrder So{tpre, ecnt, 8, F.G, F.vcu};
        pg8::EpiDown E{(const int*)(F.ws + WS_MDST), (const float*)(F.ws + WS_MW), (unsigned char*)(F.ws + WS_Y), FP8_DOWN ? 1.0f / (FP8_SH * FP8_SD) : 1.0f};
        pg8::gemm_phase<pg8::MoeDownProbT<QM_DOWN>, pg8::EpiDown, pg8::GroupedOrder, true>(F.lds, P, So, E);
#endif
    }
    SEAM(12);
    if (IN(13)) final_norm(F);
#undef IN
#undef SEAM
}

extern "C" void kernel_launch(void* const* d_in, const int* in_sizes, int n_in, void* d_out, int out_size, void* d_ws, size_t ws_size, hipStream_t stream) {
    static int grid = 0;
    if (grid == 0) {
        if (n_in != 22 || in_sizes[0] != T * D || out_size != T * D || ws_size < WS_END) { fprintf(stderr, "kernel_launch: shape / workspace mismatch (n_in %d, ws %zu)\n", n_in, ws_size); grid = -1; return; }
        int dev = 0, cus = 0, per_cu = 0;
        if (hipGetDevice(&dev) != hipSuccess || hipDeviceGetAttribute(&cus, hipDeviceAttributeMultiprocessorCount, dev) != hipSuccess) { grid = -1; return; }
        if (hipFuncSetAttribute((const void*)fwd, hipFuncAttributeMaxDynamicSharedMemorySize, LDS_BYTES) != hipSuccess) { fprintf(stderr, "kernel_launch: hipFuncSetAttribute failed\n"); grid = -1; return; }
        if (hipOccupancyMaxActiveBlocksPerMultiprocessor(&per_cu, (const void*)fwd, NTHR, LDS_BYTES) != hipSuccess || per_cu < 1) { fprintf(stderr, "kernel_launch: occupancy query says %d blocks per CU\n", per_cu); }
        (void)hipGetLastError();
        grid = cus;
    }
    if (grid < 0) return;
    (void)hipMemsetAsync((char*)d_ws + WS_CTL, 0, CTL_ZERO_BYTES, stream);
    Args a{};
    for (int i = 0; i < 22; ++i) a.in[i] = (const float*)d_in[i];
    a.out = (float*)d_out; a.ws = (unsigned char*)d_ws; a.pad = 0;
#if MK_N_LAUNCHES == 1
    a.ph_lo = 0; a.ph_hi = N_PHASES; a.use_bar = 1;
    hipLaunchKernelGGL(fwd, dim3(grid), dim3(NTHR), LDS_BYTES, stream, a);
#else
    for (int p = 0; p < N_PHASES; ++p) { a.ph_lo = p; a.ph_hi = p + 1; a.use_bar = 0; hipLaunchKernelGGL(fwd, dim3(grid), dim3(NTHR), LDS_BYTES, stream, a); }
#endif
}
```

```cpp
#include <hip/hip_runtime.h>
#include <stdint.h>
#include <cstdio>

#ifndef MK_N_LAUNCHES
#define MK_N_LAUNCHES 1
#endif
#ifndef EN_ATTN
#define EN_ATTN 1
#endif
#ifndef EN_MOE
#define EN_MOE 1
#endif

#define LAS __attribute__((address_space(3)))
#define GAS __attribute__((address_space(1)))
typedef unsigned short bf16_t;
typedef short bf16x8 __attribute__((ext_vector_type(8)));
typedef short s16x4 __attribute__((ext_vector_type(4)));
typedef float f32x2 __attribute__((ext_vector_type(2)));
typedef float f32x4 __attribute__((ext_vector_type(4)));
typedef float f32x16 __attribute__((ext_vector_type(16)));
typedef unsigned u32x2 __attribute__((ext_vector_type(2)));
typedef unsigned u32x4 __attribute__((ext_vector_type(4)));
typedef int i32x4 __attribute__((ext_vector_type(4)));
typedef int i32x8 __attribute__((ext_vector_type(8)));

constexpr int NB = 4, S = 8192, T = NB * S, D = 2048;
constexpr int LW = 1024, NLB = 8, LBD = 128;
constexpr int NH = 8, HD = 128, AW = NH * HD, MBLK = 256, NBLK = S / MBLK;
constexpr int NE = 32, NG = 4, EPG = 8, EH = 512;
constexpr int INW = 2 * LW + 3 * AW + 2 * D;
constexpr float RMS_EPS = 1e-6f;
constexpr int NWAVES = 8, NTHR = 512;

constexpr size_t MiB = (size_t)1 << 20;
constexpr size_t WS_CTL = 0, CTL_ZERO_BYTES = 128 * 1024;
constexpr size_t WS_WA_T = 1 * MiB;
constexpr size_t WS_WX_T = WS_WA_T + 256 * 1024;
constexpr size_t WS_WR_T = WS_WX_T + 256 * 1024;
constexpr size_t WS_KMEAN = 2 * MiB;
constexpr size_t WS_SSUM = WS_KMEAN + 512 * 1024;
constexpr size_t WS_KNORM = WS_SSUM + 1024 * 1024;
constexpr size_t WS_KMH = WS_KNORM + 64 * 1024, WS_KML = WS_KMH + 256 * 1024;
constexpr size_t WS_WIN_T = 8 * MiB;
constexpr size_t WS_WP_T = 44 * MiB;
constexpr size_t WS_WOUT_T = 52 * MiB;
constexpr size_t WS_WGU_T = 60 * MiB;
constexpr size_t WS_WD_T = 188 * MiB;
constexpr size_t WS_ALIST = 252 * MiB;
constexpr size_t WS_MTOK = 268 * MiB, WS_MDST = 272 * MiB, WS_MW = 276 * MiB, WS_MRS = 280 * MiB;
constexpr size_t WS_XN = 284 * MiB;
constexpr size_t WS_YCAT = WS_XN, WS_H2 = WS_XN;
constexpr size_t WS_XREC = 412 * MiB, WS_GREC = 476 * MiB;
constexpr size_t WS_MERGED = WS_XREC;
constexpr size_t WS_LSE = 988 * MiB;
constexpr size_t WS_Q = 540 * MiB, WS_K = 604 * MiB, WS_V = 668 * MiB;
constexpr size_t WS_HID = WS_Q;
constexpr size_t WS_YC8 = WS_Q;
constexpr size_t WS_RS1 = WS_K, WS_RS2 = WS_K + 1 * MiB;
constexpr size_t WS_MG8 = WS_V;
constexpr size_t WS_SGR = 732 * MiB, WS_SGA = 860 * MiB;
constexpr size_t WS_Y = WS_SGR;
constexpr size_t WS_DELTA = WS_SGA;
constexpr size_t WS_WIN8 = 988 * MiB;
constexpr size_t WS_END = 1008 * MiB;
constexpr size_t OUT_PART = 0, OUT_LSE = 192 * MiB;
constexpr int ALIST_PER_BH = 256 * 496;
__host__ __device__ constexpr int alist_off(int n) { return 256 * (31 * n - (n * (n - 1)) / 2); }

constexpr int CW_TMO = 0;
constexpr int CW_BAR = 4096;
constexpr int CW_ACNT = 16384;
constexpr int CW_ECNT = 20480;
constexpr int CW_SFLAG = 24576;

constexpr int RING_BYTES = 131072;
constexpr int MISC_OFF = 139264;
constexpr int TAB_OFF = MISC_OFF + 256;
constexpr int LDS_BYTES = 163840;

__device__ __forceinline__ unsigned cvt_pk_bf16(float lo, float hi) { unsigned r; asm volatile("v_cvt_pk_bf16_f32 %0, %1, %2" : "=v"(r) : "v"(lo), "v"(hi)); return r; }
__device__ __forceinline__ float bf_lo(unsigned w) { return __uint_as_float(w << 16); }
__device__ __forceinline__ float bf_hi(unsigned w) { return __uint_as_float(w & 0xffff0000u); }
__device__ __forceinline__ float bf2f(bf16_t v) { return __uint_as_float(((unsigned)v) << 16); }
__device__ __forceinline__ float fsigmoid(float z) { return __builtin_amdgcn_rcpf(1.0f + __builtin_amdgcn_exp2f(-1.4426950408889634f * z)); }
__device__ __forceinline__ float gelu_tanh(float x) { const float u = 1.5957691216057308f * (x + 0.044715f * x * x * x); return x * fsigmoid(u); }
__device__ __forceinline__ float wave_sum(float v) {
#pragma unroll
    for (int o = 1; o < 64; o <<= 1) v += __shfl_xor(v, o);
    return v;
}
#define LDS_WAIT() asm volatile("s_waitcnt lgkmcnt(0)" ::: "memory")
#define VM_WAIT() asm volatile("s_waitcnt vmcnt(0)" ::: "memory")

#define XB_TMO      128
#define XB_XCNT(j)  (256  + 64 * (j))
#define XB_XSUB(j)  (1280 + 64 * (j))
#define XB_XGEN(j)  (2304 + 64 * (j))
#define XB_TOP      3328
#define XB_TOPGEN   3392
#define XCD_BAR_WORDS 3456
#define XB_SPIN_CAP (1u << 18)
__device__ __forceinline__ unsigned xb_ld(unsigned* p)              { return __hip_atomic_load(p, __ATOMIC_RELAXED, __HIP_MEMORY_SCOPE_AGENT); }
__device__ __forceinline__ unsigned xb_add(unsigned* p, unsigned v) { return __hip_atomic_fetch_add(p, v, __ATOMIC_RELAXED, __HIP_MEMORY_SCOPE_AGENT); }
__device__ __forceinline__ unsigned xb_xcc_id() { return (unsigned)__builtin_amdgcn_s_getreg((3 << 11) | 20) & 0xFu; }
#define XB_SPIN(cond, bar) do { unsigned _sp = 0; while (cond) { __builtin_amdgcn_s_sleep(1); \
    if ((++_sp & 255u) == 0u) { if (xb_ld(&(bar)[XB_TMO])) break; if (_sp > XB_SPIN_CAP) { atomicAdd(&(bar)[XB_TMO], 1u); break; } } } } while (0)
struct XcdBarrier { unsigned* bar; unsigned x; volatile LAS unsigned* st; };
__device__ __forceinline__ XcdBarrier xcd_barrier_post(unsigned* bar, volatile LAS unsigned* st) {
    XcdBarrier b; b.bar = bar; b.x = xb_xcc_id(); b.st = st;
    if (threadIdx.x == 0) (void)xb_add(&bar[XB_XCNT(b.x)], 1u);
    return b;
}
__device__ __forceinline__ void xcd_barrier_complete(unsigned* bar, unsigned x, unsigned& nloc, unsigned& nx) {
    const unsigned G = gridDim.x * gridDim.y * gridDim.z;
    unsigned sum, cnt, mine, sp = 0u;
    for (;;) {
        sum = 0u; cnt = 0u; mine = 0u;
#pragma unroll
        for (unsigned j = 0; j < 16; ++j) { const unsigned c = xb_ld(&bar[XB_XCNT(j)]); sum += c; cnt += (c > 0u) ? 1u : 0u; mine = (j == x) ? c : mine; }
        if (sum == G) break;
        __builtin_amdgcn_s_sleep(1);
        if ((++sp & 255u) == 0u) { if (xb_ld(&bar[XB_TMO])) break; if (sp > XB_SPIN_CAP) { atomicAdd(&bar[XB_TMO], 1u); break; } }
    }
    nloc = mine > 0u ? mine : 1u; nx = cnt > 0u ? cnt : 1u;
}
__device__ __forceinline__ void xcd_barrier(const XcdBarrier& b) {
    asm volatile("s_waitcnt vmcnt(0)" ::: "memory");
    __syncthreads();
    if (threadIdx.x == 0) {
        unsigned* bar = b.bar;
        __builtin_amdgcn_s_waitcnt(0);
        unsigned nloc = b.st[0], nx = b.st[1];
        if (nloc == 0u) { xcd_barrier_complete(bar, b.x, nloc, nx); b.st[0] = nloc; b.st[1] = nx; }
        const unsigned old = xb_add(&bar[XB_XSUB(b.x)], 1u);
        const unsigned gen = old / nloc;
        if (old + 1u == (gen + 1u) * nloc) {
            __builtin_amdgcn_fence(__ATOMIC_RELEASE, "agent");
            asm volatile("s_waitcnt vmcnt(0)" ::: "memory");
            const unsigned og = xb_add(&bar[XB_TOP], 1u);
            const unsigned tg = og / nx;
            if (og + 1u == (tg + 1u) * nx) xb_add(&bar[XB_TOPGEN], 1u);
            else XB_SPIN(xb_ld(&bar[XB_TOPGEN]) == tg, bar);
            __builtin_amdgcn_fence(__ATOMIC_ACQUIRE, "agent");
            xb_add(&bar[XB_XGEN(b.x)], 1u);
            asm volatile("s_waitcnt vmcnt(0)" ::: "memory");
        } else {
            XB_SPIN(xb_ld(&bar[XB_XGEN(b.x)]) == gen, bar);
            __builtin_amdgcn_fence(__ATOMIC_ACQUIRE, "agent");
            asm volatile("s_waitcnt vmcnt(0)" ::: "memory");
        }
    }
    __syncthreads();
}

namespace pg8 {
constexpr int BM = 256, BK = 64, HALF = 128, HTB = HALF * BK * 2, STAGE_BYTES = 8 * HTB, NXCD = 8, WGM = 4;
__host__ __device__ __forceinline__ int lds_byte(int r, int c) { const int st = (r >> 4) * 2 + (c >> 5), rr = r & 15, cc = c & 31, ob = rr * 64 + cc * 2; return st * 1024 + (ob ^ (((ob >> 9) & 1) << 5)); }
__host__ __device__ __forceinline__ void stage_rc(int b, int& R, int& C) { const int st = b / 1024, sb = b % 1024, swz = sb ^ (((sb >> 9) & 1) << 5); R = (st >> 1) * 16 + swz / 64; C = (st & 1) * 32 + (swz % 64) / 2; }
__host__ __device__ __forceinline__ int perm32(int rho) { const int n = rho >> 4, i = rho & 15; return 8 * (i >> 2) + 4 * n + (i & 3); }

struct Unit { int pm, pn, e, n, rb; };

struct StaticOrder {
    int nM, nN, nwg, G, c;
    __device__ void init(int M, int N, int G_, int c_) { nM = M / BM; nN = N / BM; nwg = nM * nN; G = G_; c = c_; }
    __device__ bool next(int i, Unit& u) const {
        const long L = (long)i * G + c; if (L >= nwg) return false;
        int wgid = (int)L; { const int q = nwg / NXCD, r = nwg % NXCD, xcd = wgid % NXCD, off = wgid / NXCD; wgid = (xcd < r ? xcd * (q + 1) : r * (q + 1) + (xcd - r) * q) + off; }
        const int nig = WGM * nN, gid = wgid / nig, fm = gid * WGM, gsz = (nM - fm) < WGM ? (nM - fm) : WGM;
        u.pm = fm + ((wgid % nig) % gsz); u.pn = (wgid % nig) / gsz; u.e = 0; u.n = 0; u.rb = 0; return true;
    }
};
struct GroupedOrder {
    const LAS int* tpre; const LAS int* cnt; int nct, G, c;
    __device__ bool next(int i, Unit& u) const {
        const int L = i * G + c; const int rt = L / nct; if (rt >= tpre[NE]) return false;
        const int ln = (int)(threadIdx.x & 63u); const int pv = tpre[1 + (ln & 31)];
        const int e = __builtin_popcountll(__ballot(ln < NE && pv <= rt));
        u.e = e; u.pm = rt - tpre[e]; u.pn = L - rt * nct; u.n = cnt[e]; u.rb = tpre[e] * BM; return true;
    }
};

template <int QM> struct DenseProbT {
    static constexpr bool GATHER = false; static constexpr int QMODE = QM, EB = QM ? 1 : 2;
    const void* A; const void* Bt; int K, lda, ldb;
    __device__ __forceinline__ const char* a_base(const Unit& u) const { return (const char*)A + (size_t)u.pm * BM * lda * EB; }
    __device__ __forceinline__ const char* b_base(const Unit& u) const { return (const char*)Bt + (size_t)u.pn * BM * ldb * EB; }
    __device__ __forceinline__ void a_off(const Unit&, const int (&R)[2], const int (&C)[2], unsigned (&vo)[2][2]) const {
#pragma unroll
        for (int h = 0; h < 2; ++h)
#pragma unroll
            for (int i = 0; i < 2; ++i) vo[h][i] = (unsigned)((h * HALF + R[i]) * lda) * (unsigned)EB + (unsigned)C[i] * 2u;
    }
};
typedef DenseProbT<0> DenseProb;
template <int QM> struct MoeUpProbT {
    static constexpr bool GATHER = true; static constexpr int QMODE = QM, EB = QM ? 1 : 2;
    const void* A; const void* Bt; const int* tok; int K, lda, ldb;
    __device__ __forceinline__ const char* a_base(const Unit&) const { return (const char*)A; }
    __device__ __forceinline__ const char* b_base(const Unit& u) const { return (const char*)Bt + ((size_t)u.e * 1024 + (size_t)u.pn * BM) * ldb * EB; }
    __device__ __forceinline__ void a_off(const Unit& u, const int (&R)[2], const int (&C)[2], unsigned (&vo)[2][2]) const {
#pragma unroll
        for (int h = 0; h < 2; ++h)
#pragma unroll
            for (int i = 0; i < 2; ++i) { const int s = u.pm * BM + h * HALF + R[i]; const int tl = tok[(size_t)u.e * T + s]; const int t = (s < u.n) ? tl : 0; vo[h][i] = (unsigned)(t * lda) * (unsigned)EB + (unsigned)C[i] * 2u; }
    }
};
template <int QM> struct MoeDownProbT {
    static constexpr bool GATHER = false; static constexpr int QMODE = QM, EB = QM ? 1 : 2;
    const void* A; const void* Bt; int K, lda, ldb;
    __device__ __forceinline__ const char* a_base(const Unit& u) const { return (const char*)A + ((size_t)u.rb + (size_t)u.pm * BM) * lda * EB; }
    __device__ __forceinline__ const char* b_base(const Unit& u) const { return (const char*)Bt + ((size_t)u.e * 2048 + (size_t)u.pn * BM) * ldb * EB; }
    __device__ __forceinline__ void a_off(const Unit&, const int (&R)[2], const int (&C)[2], unsigned (&vo)[2][2]) const {
#pragma unroll
        for (int h = 0; h < 2; ++h)
#pragma unroll
            for (int i = 0; i < 2; ++i) vo[h][i] = (unsigned)((h * HALF + R[i]) * lda) * (unsigned)EB + (unsigned)C[i] * 2u;
    }
};

template <class Prob, class Epi, class Sched, bool ALIGN_EPI>
__device__ __forceinline__ void gemm_phase(LAS unsigned char* lds, const Prob& P, const Sched& S, const Epi& E) {
    const int tid = threadIdx.x, wid = __builtin_amdgcn_readfirstlane(tid >> 6), lane = tid & 63, wr = wid >> 2, wc = wid & 3, fr = lane & 15, fq = lane >> 4;
    constexpr bool FP8 = Prob::QMODE == 1, I8 = Prob::QMODE == 2; constexpr int EB = Prob::QMODE ? 1 : 2;
    const int K = P.K, nt = K / (Prob::QMODE ? 2 * BK : BK);
    const int sc1 = 0x7F7F7F7F;
    int Rr[2], Cc[2]; unsigned voffB[2];
#pragma unroll
    for (int i = 0; i < 2; ++i) { int R, C; stage_rc(tid * 16 + i * 8192, R, C); Rr[i] = R; Cc[i] = C; const int Rb = Epi::PERM ? ((R & ~31) + perm32(R & 31)) : R; voffB[i] = (unsigned)(Rb * P.ldb) * (unsigned)EB + (unsigned)C * 2u; }
    const size_t kstep = (size_t)(BK * 2);
    const size_t hstepB = (size_t)HALF * P.ldb * EB;
    const unsigned ldsw = (unsigned)wid * 1024u;
    const int aoff = lds_byte(wr * 64 + fr, fq * 8), boff = lds_byte(wc * 32 + fr, fq * 8);
#define PG8_SA(b, h) (((b) * 2 + (h)) * HTB)
#define PG8_SB(b, h) ((4 + (b) * 2 + (h)) * HTB)
#define PG8_STAGE(bufoff, gbase, voff) do { _Pragma("unroll") for (int _i = 0; _i < 2; ++_i) \
        __builtin_amdgcn_global_load_lds((const unsigned*)((const char*)(gbase) + (voff)[_i]), (LAS unsigned*)(lds + (bufoff) + ldsw + _i * 8192), 16, 0, 0); } while (0)
#define PG8_LDA(dst, b, h) do { _Pragma("unroll") for (int m = 0; m < 4; ++m) _Pragma("unroll") for (int k = 0; k < 2; ++k) dst[m][k] = *(const LAS bf16x8*)(lds + PG8_SA(b, h) + aoff + m * 2048 + k * 1024); } while (0)
#define PG8_LDB(dst, b, h) do { _Pragma("unroll") for (int n = 0; n < 2; ++n) _Pragma("unroll") for (int k = 0; k < 2; ++k) dst[n][k] = *(const LAS bf16x8*)(lds + PG8_SB(b, h) + boff + n * 2048 + k * 1024); } while (0)
#define PG8_MMA(ai, bj, At, Bt) do { __builtin_amdgcn_s_setprio(1); _Pragma("unroll") for (int m = 0; m < 4; ++m) _Pragma("unroll") for (int n = 0; n < 2; ++n) { \
        if constexpr (FP8) { const i32x8 fb = __builtin_shufflevector(__builtin_bit_cast(i32x4, Bt[n][0]), __builtin_bit_cast(i32x4, Bt[n][1]), 0, 1, 2, 3, 4, 5, 6, 7); \
            const i32x8 fa = __builtin_shufflevector(__builtin_bit_cast(i32x4, At[m][0]), __builtin_bit_cast(i32x4, At[m][1]), 0, 1, 2, 3, 4, 5, 6, 7); \
            asm volatile("s_nop 1\n\tv_mfma_scale_f32_16x16x128_f8f6f4 %0, %1, %2, %0, %3, %3 op_sel_hi:[0,0,0]" : "+v"(acc[ai][bj][m][n]) : "v"(fb), "v"(fa), "v"(sc1)); } \
        else if constexpr (I8) { _Pragma("unroll") for (int k = 0; k < 2; ++k) acc[ai][bj][m][n] = __builtin_bit_cast(f32x4, __builtin_amdgcn_mfma_i32_16x16x64_i8(__builtin_bit_cast(i32x4, Bt[n][k]), __builtin_bit_cast(i32x4, At[m][k]), __builtin_bit_cast(i32x4, acc[ai][bj][m][n]), 0, 0, 0)); } \
        else { _Pragma("unroll") for (int k = 0; k < 2; ++k) acc[ai][bj][m][n] = __builtin_amdgcn_mfma_f32_16x16x32_bf16(Bt[n][k], At[m][k], acc[ai][bj][m][n], 0, 0, 0); } } \
        __builtin_amdgcn_s_setprio(0); } while (0)
#define PG8_WAIT_V(n) asm volatile("s_waitcnt vmcnt(" #n ")" ::: "memory")
#define PG8_WAIT_L(n) asm volatile("s_waitcnt lgkmcnt(" #n ")" ::: "memory")
#define PG8_BAR __builtin_amdgcn_s_barrier()
#define PG8_SCHED __builtin_amdgcn_sched_barrier(0)
    Unit cur, nxt; int ui = 0;
    if (!S.next(0, cur)) return;
    f32x4 acc[2][2][4][2];
#pragma unroll
    for (int a = 0; a < 2; ++a)
#pragma unroll
        for (int b = 0; b < 2; ++b)
#pragma unroll
            for (int m = 0; m < 4; ++m)
#pragma unroll
                for (int n = 0; n < 2; ++n) acc[a][b][m][n] = (f32x4){0.f, 0.f, 0.f, 0.f};
    bf16x8 At[4][2], B0[2][2], B1[2][2];
    unsigned vA[2][2], vN[2][2];
    P.a_off(cur, Rr, Cc, vA);
#pragma unroll
    for (int h = 0; h < 2; ++h) { vN[h][0] = vA[h][0]; vN[h][1] = vA[h][1]; }
    const char* cA = P.a_base(cur); const char* cB = P.b_base(cur);
    PG8_STAGE(PG8_SB(0, 0), cB, voffB); PG8_STAGE(PG8_SB(0, 1), cB + hstepB, voffB); PG8_STAGE(PG8_SA(0, 0), cA, vA[0]); PG8_STAGE(PG8_SA(0, 1), cA, vA[1]);
    if (wr == 1) PG8_BAR;
    PG8_WAIT_V(2); PG8_BAR;
    PG8_STAGE(PG8_SB(1, 0), cB + kstep, voffB); PG8_STAGE(PG8_SA(1, 0), cA + kstep, vA[0]); PG8_STAGE(PG8_SB(1, 1), cB + hstepB + kstep, voffB);
    PG8_WAIT_V(6); PG8_BAR;
    for (;;) {
        const bool has_next = S.next(ui + 1, nxt);
        const char* nA = has_next ? P.a_base(nxt) : cA; const char* nB = has_next ? P.b_base(nxt) : cB;
        for (int t = 0; t < nt; t += 2) {
            const bool last = (t == nt - 2);
            const char* a1 = cA + (size_t)(t + 1) * kstep;
            const char* a2 = last ? nA : cA + (size_t)(t + 2) * kstep; const char* b2 = last ? nB : cB + (size_t)(t + 2) * kstep;
            const char* a3 = a2 + kstep; const char* b3 = b2 + kstep;
            if constexpr (Prob::GATHER) { if (last && has_next) P.a_off(nxt, Rr, Cc, vN); }
            unsigned vS[2][2];
#pragma unroll
            for (int h = 0; h < 2; ++h) { vS[h][0] = (Prob::GATHER && last) ? vN[h][0] : vA[h][0]; vS[h][1] = (Prob::GATHER && last) ? vN[h][1] : vA[h][1]; }
            PG8_LDB(B0, 0, 0); PG8_LDB(B1, 0, 1); PG8_SCHED; PG8_LDA(At, 0, 0); PG8_STAGE(PG8_SA(1, 1), a1, vA[1]);
            PG8_WAIT_V(8); PG8_WAIT_L(0); PG8_BAR; PG8_MMA(0, 0, At, B0); PG8_MMA(0, 1, At, B1); PG8_BAR; PG8_SCHED;
            PG8_LDA(At, 0, 1); PG8_STAGE(PG8_SB(0, 0), b2, voffB); PG8_STAGE(PG8_SB(0, 1), b2 + hstepB, voffB); PG8_STAGE(PG8_SA(0, 0), a2, vS[0]);
            PG8_WAIT_V(8); PG8_WAIT_L(0); PG8_BAR; PG8_MMA(1, 0, At, B0); PG8_MMA(1, 1, At, B1); PG8_BAR; PG8_SCHED;
            PG8_LDB(B0, 1, 0); PG8_LDB(B1, 1, 1); PG8_SCHED; PG8_LDA(At, 1, 0); PG8_STAGE(PG8_SA(0, 1), a2, vS[1]);
            PG8_WAIT_V(8); PG8_WAIT_L(0); PG8_BAR; PG8_MMA(0, 0, At, B0); PG8_MMA(0, 1, At, B1); PG8_BAR; PG8_SCHED;
            PG8_LDA(At, 1, 1); PG8_STAGE(PG8_SB(1, 0), b3, voffB); PG8_STAGE(PG8_SB(1, 1), b3 + hstepB, voffB); PG8_STAGE(PG8_SA(1, 0), a3, vS[0]);
            PG8_WAIT_V(8); PG8_WAIT_L(0); PG8_BAR; PG8_MMA(1, 0, At, B0); PG8_MMA(1, 1, At, B1); PG8_BAR; PG8_SCHED;
        }
        if constexpr (ALIGN_EPI) { if (wr == 0) PG8_BAR; }
        if constexpr (FP8) asm volatile("s_nop 15\n\ts_nop 15" ::: "memory");
        if constexpr (I8) {
#pragma unroll
            for (int a = 0; a < 2; ++a)
#pragma unroll
                for (int b = 0; b < 2; ++b)
#pragma unroll
                    for (int m = 0; m < 4; ++m)
#pragma unroll
                        for (int n = 0; n < 2; ++n) { const i32x4 iv = __builtin_bit_cast(i32x4, acc[a][b][m][n]); acc[a][b][m][n] = (f32x4){(float)iv[0], (float)iv[1], (float)iv[2], (float)iv[3]}; } }
        E(acc, cur, wr, wc, fr, fq);
        if constexpr (Epi::SIDE) E.side_work(ui, wid, lane);
        if (!has_next) break;
#pragma unroll
        for (int a = 0; a < 2; ++a)
#pragma unroll
            for (int b = 0; b < 2; ++b)
#pragma unroll
                for (int m = 0; m < 4; ++m)
#pragma unroll
                    for (int n = 0; n < 2; ++n) acc[a][b][m][n] = (f32x4){0.f, 0.f, 0.f, 0.f};
        cur = nxt; cA = nA; cB = nB; ++ui;
        if constexpr (Prob::GATHER) {
#pragma unroll
            for (int h = 0; h < 2; ++h) { vA[h][0] = vN[h][0]; vA[h][1] = vN[h][1]; }
        }
        if constexpr (ALIGN_EPI) { if (wr == 1) PG8_BAR; }
    }
    PG8_WAIT_V(0);
    if constexpr (!ALIGN_EPI) { if (wr == 0) PG8_BAR; }
    PG8_BAR;
#undef PG8_SA
#undef PG8_SB
#undef PG8_STAGE
#undef PG8_LDA
#undef PG8_LDB
#undef PG8_MMA
#undef PG8_WAIT_V
#undef PG8_WAIT_L
#undef PG8_BAR
#undef PG8_SCHED
}
}

#ifndef Q_MASK
#define Q_MASK 0xFFFFFFFFFull
#endif
#ifndef QM_IN
#define QM_IN 2
#endif
#ifndef QM_UP
#define QM_UP 2
#endif
#ifndef QM_DOWN
#define QM_DOWN 1
#endif
constexpr unsigned long long IN_F8 = Q_MASK & 0xFFFFFFFFFull, IN_BF = ~IN_F8 & 0xFFFFFFFFFull;
constexpr int IN_NF8 = __builtin_popcountll(IN_F8), IN_NBF = 36 - IN_NF8;
constexpr float FP8_SA = 32.f, FP8_SB = 1024.f;
constexpr float I8_SA = 32.f, I8_SB = 1448.f, I8_SH2 = 26.f;
__device__ __forceinline__ unsigned pk4_fp8(float a, float b, float c, float d) {
    a = fminf(fmaxf(a, -448.f), 448.f); b = fminf(fmaxf(b, -448.f), 448.f); c = fminf(fmaxf(c, -448.f), 448.f); d = fminf(fmaxf(d, -448.f), 448.f);
    int w = __builtin_amdgcn_cvt_pk_fp8_f32(a, b, 0, false); w = __builtin_amdgcn_cvt_pk_fp8_f32(c, d, w, true); return (unsigned)w;
}
__device__ __forceinline__ unsigned pk4_i8(float a, float b, float c, float d) {
    const int ia = (int)__builtin_rintf(fminf(fmaxf(a, -127.f), 127.f)), ib = (int)__builtin_rintf(fminf(fmaxf(b, -127.f), 127.f));
    const int ic = (int)__builtin_rintf(fminf(fmaxf(c, -127.f), 127.f)), id = (int)__builtin_rintf(fminf(fmaxf(d, -127.f), 127.f));
    return (unsigned)(ia & 0xff) | ((unsigned)(ib & 0xff) << 8) | ((unsigned)(ic & 0xff) << 16) | ((unsigned)(id & 0xff) << 24);
}
__device__ __forceinline__ unsigned pk4_u8(float a, float b, float c, float d) {
    const unsigned ia = (unsigned)__builtin_rintf(a), ib = (unsigned)__builtin_rintf(b), ic = (unsigned)__builtin_rintf(c), id = (unsigned)__builtin_rintf(d);
    return ia | (ib << 8) | (ic << 16) | (id << 24);
}
template <int QM> __device__ __forceinline__ unsigned pk4_q(float a, float b, float c, float d) { if (QM == 2) return pk4_i8(a, b, c, d); else return pk4_fp8(a, b, c, d); }
constexpr float I8_SP = 1024.f;
constexpr float Q_SA_IN = QM_IN == 2 ? I8_SA : FP8_SA, Q_SB_IN = QM_IN == 2 ? I8_SB : FP8_SB;
constexpr float Q_SA_UP = QM_UP == 2 ? I8_SH2 : FP8_SA, Q_SB_UP = QM_UP == 2 ? I8_SB : FP8_SB;
#define FP8_UP (QM_UP != 0)
#define FP8_DOWN (QM_DOWN != 0)
constexpr float FP8_SH = 16.f, FP8_SD = 512.f, FP8_SY = 64.f;
struct TrDesc { const float* W; unsigned char* WT; int ldw, k0, n0, ldt, drow0, dk0, qm; float sc; };
constexpr int TR_I_IN = 32 * 144, TR_I_PR = 16 * 32, TR_I_OUT = 32 * 32, TR_I_EXG = NE * 32 * 8, TR_I_EXD = NE * 8 * 32;
constexpr int TR_NITEMS = TR_I_IN + 2 * TR_I_PR + TR_I_OUT + 2 * TR_I_EXG + TR_I_EXD;
struct TrSrc { const float *w_in, *p_rec, *p_attn, *w_out, *w_gate, *w_up, *w_down; unsigned char* ws; };
__device__ __forceinline__ TrDesc tr_decode(const TrSrc& F, int r) {
    TrDesc d; d.dk0 = 0;
    if (r < TR_I_IN) { d.n0 = 64 * (r % 144); d.k0 = 64 * (r / 144); d.W = F.w_in; d.ldw = INW; d.ldt = 2048; d.qm = QM_IN; d.sc = Q_SB_IN; d.WT = F.ws + WS_WIN8; d.drow0 = d.n0; return d; } r -= TR_I_IN;
    if (r < 2 * TR_I_PR) { const int at = r >= TR_I_PR; if (at) r -= TR_I_PR; d.W = at ? F.p_attn : F.p_rec; d.ldw = 2048; d.k0 = 64 * (r / 32); d.n0 = 64 * (r % 32); d.WT = F.ws + WS_WP_T; d.ldt = 2048; d.drow0 = d.n0; d.dk0 = at ? 1024 : 0; d.qm = 2; d.sc = I8_SP; return d; } r -= 2 * TR_I_PR;
    if (r < TR_I_OUT) { d.W = F.w_out; d.ldw = 2048; d.k0 = 64 * (r / 32); d.n0 = 64 * (r % 32); d.WT = F.ws + WS_WOUT_T; d.ldt = 2048; d.drow0 = d.n0; d.qm = 2; d.sc = I8_SB; return d; } r -= TR_I_OUT;
    if (r < 2 * TR_I_EXG) { const int up = r >= TR_I_EXG; if (up) r -= TR_I_EXG; const int e = r / 256, rr = r % 256; d.n0 = 64 * (rr % 8); d.k0 = 64 * (rr / 8);
        d.W = (up ? F.w_up : F.w_gate) + (size_t)e * D * EH; d.ldw = EH; d.ldt = 2048; d.drow0 = (d.n0 >> 7) * 256 + (d.n0 & 127) + (up ? 128 : 0);
        d.qm = QM_UP; d.sc = Q_SB_UP; d.WT = F.ws + WS_WGU_T + (size_t)e * 1024 * 2048; return d; } r -= 2 * TR_I_EXG;
    { const int e = r / 256, rr = r % 256; d.W = F.w_down + (size_t)e * EH * D; d.ldw = D; d.k0 = 64 * (rr / 32); d.n0 = 64 * (rr % 32); d.ldt = 512; d.drow0 = d.n0;
      d.qm = QM_DOWN; d.sc = FP8_SD; d.WT = F.ws + WS_WD_T + (size_t)e * 2048 * 512; }
    return d;
}
__device__ __forceinline__ void tr_load(const TrDesc& d, f32x4 (&v)[16], int lane) {
    const float* p = d.W + (size_t)(d.k0 + 16 * (lane >> 4)) * d.ldw + d.n0 + 4 * (lane & 15);
#pragma unroll
    for (int i = 0; i < 16; ++i) v[i] = *(const f32x4*)(p + (size_t)i * d.ldw);
}
__device__ __forceinline__ void tr_store(const TrDesc& d, const f32x4 (&v)[16], int lane) {
    unsigned char* q = d.WT + (size_t)(d.drow0 + 4 * (lane & 15)) * d.ldt + d.dk0 + d.k0 + 16 * (lane >> 4); const float sc = d.sc;
#pragma unroll
    for (int c = 0; c < 4; ++c) { u32x4 o;
        if (d.qm == 2) { o.x = pk4_i8(v[0][c] * sc, v[1][c] * sc, v[2][c] * sc, v[3][c] * sc); o.y = pk4_i8(v[4][c] * sc, v[5][c] * sc, v[6][c] * sc, v[7][c] * sc); o.z = pk4_i8(v[8][c] * sc, v[9][c] * sc, v[10][c] * sc, v[11][c] * sc); o.w = pk4_i8(v[12][c] * sc, v[13][c] * sc, v[14][c] * sc, v[15][c] * sc); }
        else { o.x = pk4_fp8(v[0][c] * sc, v[1][c] * sc, v[2][c] * sc, v[3][c] * sc); o.y = pk4_fp8(v[4][c] * sc, v[5][c] * sc, v[6][c] * sc, v[7][c] * sc); o.z = pk4_fp8(v[8][c] * sc, v[9][c] * sc, v[10][c] * sc, v[11][c] * sc); o.w = pk4_fp8(v[12][c] * sc, v[13][c] * sc, v[14][c] * sc, v[15][c] * sc); }
        *(u32x4*)(q + (size_t)c * d.ldt) = o; }
}

namespace pg8 {
struct EpiIn {
    static constexpr bool PERM = true, SIDE = true;
    bf16_t *xrec, *grec, *q, *k, *v, *sgr, *sga; float osc; unsigned long long mask; TrSrc src; int side_c, side_stride;
    __device__ __forceinline__ void side_work(int ui, int wid, int lane) const {
        const int item = TR_I_IN + side_c + (ui * 8 + wid) * side_stride; if (item >= TR_NITEMS) return;
        const TrDesc d = tr_decode(src, item); f32x4 v[16]; tr_load(d, v, lane); tr_store(d, v, lane); }
    __device__ __forceinline__ void operator()(const f32x4 (&acc)[2][2][4][2], const Unit& u, int wr, int wc, int fr, int fq) const {
        int pn = 0; { int left = u.pn; unsigned long long mm = mask; for (;;) { const int b = __builtin_ctzll(mm); if (left == 0) { pn = b; break; } mm &= mm - 1; --left; } }
        bf16_t* base; int ldc, ct, act;
        if (pn < 4) { base = xrec; ldc = 1024; ct = pn; act = 0; }
        else if (pn < 8) { base = grec; ldc = 1024; ct = pn - 4; act = 1; }
        else if (pn < 12) { base = q; ldc = 1024; ct = pn - 8; act = 0; }
        else if (pn < 16) { base = k; ldc = 1024; ct = pn - 12; act = 0; }
        else if (pn < 20) { base = v; ldc = 1024; ct = pn - 16; act = 0; }
        else if (pn < 28) { base = sgr; ldc = 2048; ct = pn - 20; act = 2; }
        else { base = sga; ldc = 2048; ct = pn - 28; act = 2; }
        const int row0 = u.pm * BM + wr * 64 + fr, col0 = ct * BM + wc * 32 + 8 * fq;
#pragma unroll
        for (int ai = 0; ai < 2; ++ai)
#pragma unroll
            for (int m = 0; m < 4; ++m) { bf16_t* rowp = base + (size_t)(row0 + ai * HALF + m * 16) * ldc + col0;
#pragma unroll
                for (int bj = 0; bj < 2; ++bj) { f32x4 v0 = acc[ai][bj][m][0] * osc, v1 = acc[ai][bj][m][1] * osc;
                    if (act == 1) {
#pragma unroll
                        for (int j = 0; j < 4; ++j) { v0[j] = gelu_tanh(v0[j]); v1[j] = gelu_tanh(v1[j]); } }
                    if (act == 2) {
#pragma unroll
                        for (int j = 0; j < 4; ++j) { v0[j] = 255.f * fsigmoid(v0[j]); v1[j] = 255.f * fsigmoid(v1[j]); }
                        u32x2 w; w.x = pk4_u8(v0[0], v0[1], v0[2], v0[3]); w.y = pk4_u8(v1[0], v1[1], v1[2], v1[3]);
                        *(u32x2*)((unsigned char*)base + (size_t)(row0 + ai * HALF + m * 16) * 2048 + col0 + bj * HALF) = w; }
                    else { u32x4 w; w.x = cvt_pk_bf16(v0[0], v0[1]); w.y = cvt_pk_bf16(v0[2], v0[3]); w.z = cvt_pk_bf16(v1[0], v1[1]); w.w = cvt_pk_bf16(v1[2], v1[3]);
                        *(u32x4*)(rowp + bj * HALF) = w; } } }
    }
};
template <bool ADD> struct EpiGate {
    static constexpr bool PERM = true, SIDE = false;
    const unsigned char* gate; bf16_t* out; const float* rs; int rss; float osc;
    __device__ __forceinline__ void operator()(const f32x4 (&acc)[2][2][4][2], const Unit& u, int wr, int wc, int fr, int fq) const {
        const int row0 = u.pm * BM + wr * 64 + fr, col0 = u.pn * BM + wc * 32 + 8 * fq;
#pragma unroll
        for (int ai = 0; ai < 2; ++ai) {
            u32x2 gv[4][2]; u32x4 pv[4]; float scv[4];
#pragma unroll
            for (int m = 0; m < 4; ++m) { scv[m] = rs[(size_t)(row0 + ai * HALF + m * 16) * rss];
#pragma unroll
                for (int bj = 0; bj < 2; ++bj) gv[m][bj] = *(const u32x2*)(gate + ((unsigned)(row0 + ai * HALF + m * 16) * 2048u + (unsigned)(col0 + bj * HALF))); }
#pragma unroll
            for (int bj = 0; bj < 2; ++bj) {
                if (ADD) {
#pragma unroll
                    for (int m = 0; m < 4; ++m) pv[m] = *(const u32x4*)(out + ((unsigned)(row0 + ai * HALF + m * 16) * 2048u + (unsigned)(col0 + bj * HALF))); }
                __builtin_amdgcn_sched_barrier(0);
#pragma unroll
                for (int m = 0; m < 4; ++m) { const unsigned off = (unsigned)(row0 + ai * HALF + m * 16) * 2048u + (unsigned)(col0 + bj * HALF); const float sc = scv[m] * osc;
                    const f32x4 a0 = acc[ai][bj][m][0] * sc, a1 = acc[ai][bj][m][1] * sc;
                    const u32x2 g = gv[m][bj];
                    float r[8];
                    r[0] = (float)(g.x & 0xffu) * a0[0]; r[1] = (float)((g.x >> 8) & 0xffu) * a0[1]; r[2] = (float)((g.x >> 16) & 0xffu) * a0[2]; r[3] = (float)(g.x >> 24) * a0[3];
                    r[4] = (float)(g.y & 0xffu) * a1[0]; r[5] = (float)((g.y >> 8) & 0xffu) * a1[1]; r[6] = (float)((g.y >> 16) & 0xffu) * a1[2]; r[7] = (float)(g.y >> 24) * a1[3];
                    if (ADD) { const u32x4 p = pv[m];
                        r[0] += bf_lo(p.x); r[1] += bf_hi(p.x); r[2] += bf_lo(p.y); r[3] += bf_hi(p.y); r[4] += bf_lo(p.z); r[5] += bf_hi(p.z); r[6] += bf_lo(p.w); r[7] += bf_hi(p.w); }
                    u32x4 w; w.x = cvt_pk_bf16(r[0], r[1]); w.y = cvt_pk_bf16(r[2], r[3]); w.z = cvt_pk_bf16(r[4], r[5]); w.w = cvt_pk_bf16(r[6], r[7]);
                    *(u32x4*)(out + off) = w; } } }
    }
};
struct EpiResid {
    static constexpr bool PERM = true, SIDE = false;
    bf16_t* out; const float* rs; float osc;
    __device__ __forceinline__ void operator()(const f32x4 (&acc)[2][2][4][2], const Unit& u, int wr, int wc, int fr, int fq) const {
        const int row0 = u.pm * BM + wr * 64 + fr, col0 = u.pn * BM + wc * 32 + 8 * fq;
        float scv[2][4];
#pragma unroll
        for (int ai = 0; ai < 2; ++ai)
#pragma unroll
            for (int m = 0; m < 4; ++m) scv[ai][m] = rs[row0 + ai * HALF + m * 16] * osc;
        __builtin_amdgcn_sched_barrier(0);
#pragma unroll
        for (int ai = 0; ai < 2; ++ai)
#pragma unroll
            for (int m = 0; m < 4; ++m) { const int row = row0 + ai * HALF + m * 16; const float sc = scv[ai][m]; bf16_t* rowp = out + (size_t)row * D + col0;
#pragma unroll
                for (int bj = 0; bj < 2; ++bj) { const f32x4 v0 = acc[ai][bj][m][0] * sc, v1 = acc[ai][bj][m][1] * sc;
                    u32x4 w; w.x = cvt_pk_bf16(v0[0], v0[1]); w.y = cvt_pk_bf16(v0[2], v0[3]); w.z = cvt_pk_bf16(v1[0], v1[1]); w.w = cvt_pk_bf16(v1[2], v1[3]);
                    *(u32x4*)(rowp + bj * HALF) = w; } }
    }
};
struct EpiHid {
    static constexpr bool PERM = true, SIDE = false;
    const float* rs; void* hid; float osc;
    __device__ __forceinline__ void operator()(const f32x4 (&acc)[2][2][4][2], const Unit& u, int wr, int wc, int fr, int fq) const {
        const int s0 = u.pm * BM + wr * 64 + fr, col0 = u.pn * HALF + wc * 32 + 8 * fq;
        float sclv[2][4];
#pragma unroll
        for (int ai = 0; ai < 2; ++ai)
#pragma unroll
            for (int m = 0; m < 4; ++m) sclv[ai][m] = rs[(size_t)u.e * T + s0 + ai * HALF + m * 16];
        __builtin_amdgcn_sched_barrier(0);
#pragma unroll
        for (int ai = 0; ai < 2; ++ai)
#pragma unroll
            for (int m = 0; m < 4; ++m) { const int s = s0 + ai * HALF + m * 16; const float scl = sclv[ai][m]; const float sc = (s < u.n) ? scl * osc : 0.f;
                float r[8];
#pragma unroll
                for (int n = 0; n < 2; ++n)
#pragma unroll
                    for (int j = 0; j < 4; ++j) { const float g = acc[ai][0][m][n][j] * sc, up = acc[ai][1][m][n][j] * sc; r[n * 4 + j] = g * fsigmoid(g) * up; }
#if FP8_DOWN
                u32x2 w; w.x = pk4_fp8(r[0] * FP8_SH, r[1] * FP8_SH, r[2] * FP8_SH, r[3] * FP8_SH); w.y = pk4_fp8(r[4] * FP8_SH, r[5] * FP8_SH, r[6] * FP8_SH, r[7] * FP8_SH);
                *(u32x2*)((unsigned char*)hid + (size_t)(u.rb + s) * EH + col0) = w;
#else
                u32x4 w; w.x = cvt_pk_bf16(r[0], r[1]); w.y = cvt_pk_bf16(r[2], r[3]); w.z = cvt_pk_bf16(r[4], r[5]); w.w = cvt_pk_bf16(r[6], r[7]);
                *(u32x4*)((bf16_t*)hid + (size_t)(u.rb + s) * EH + col0) = w;
#endif
            }
    }
};
struct EpiDown {
    static constexpr bool PERM = true, SIDE = false;
    const int* dst; const float* w; unsigned char* y; float osc;
    __device__ __forceinline__ void operator()(const f32x4 (&acc)[2][2][4][2], const Unit& u, int wr, int wc, int fr, int fq) const {
        const int s0 = u.pm * BM + wr * 64 + fr, col0 = u.pn * BM + wc * 32 + 8 * fq;
        int dlv[2][4]; float scv[2][4];
#pragma unroll
        for (int ai = 0; ai < 2; ++ai)
#pragma unroll
            for (int m = 0; m < 4; ++m) { const int s = s0 + ai * HALF + m * 16; dlv[ai][m] = dst[(size_t)u.e * T + s]; scv[ai][m] = w[(size_t)u.e * T + s] * osc * FP8_SY; }
        __builtin_amdgcn_sched_barrier(0);
#pragma unroll
        for (int ai = 0; ai < 2; ++ai)
#pragma unroll
            for (int m = 0; m < 4; ++m) asm volatile("" : "+v"(dlv[ai][m]), "+v"(scv[ai][m]));
#pragma unroll
        for (int ai = 0; ai < 2; ++ai)
#pragma unroll
            for (int m = 0; m < 4; ++m) { const int s = s0 + ai * HALF + m * 16;
                const int dl = dlv[ai][m]; const float sc = scv[ai][m];
                if (s < u.n) { unsigned char* rowp = y + (size_t)dl * D + col0;
#pragma unroll
                    for (int bj = 0; bj < 2; ++bj) { const f32x4 v0 = acc[ai][bj][m][0] * sc, v1 = acc[ai][bj][m][1] * sc;
                        u32x2 o; o.x = pk4_fp8(v0[0], v0[1], v0[2], v0[3]); o.y = pk4_fp8(v1[0], v1[1], v1[2], v1[3]);
                        *(u32x2*)(rowp + bj * HALF) = o; } } }
    }
};
}

struct Frame {
    LAS unsigned char* lds; volatile LAS unsigned* MISC; unsigned* ctl;
    int tid, lane, wave, vcu, G;
    const float* in[22]; float* out; unsigned char* ws;
};

__device__ __forceinline__ void tr_item(const float* W, int ldw, int k0, int n0, bf16_t* WT, int ldt, int drow0, int dk0, LAS float* scr, int lane) {
#pragma unroll 8
    for (int i = 0; i < 32; ++i) { const int kk = 2 * i + (lane >> 5); scr[kk * 33 + (lane & 31)] = W[(size_t)(k0 + kk) * ldw + n0 + (lane & 31)]; }
    LDS_WAIT(); asm volatile("" ::: "memory");
    const int c = lane & 7;
#pragma unroll
    for (int j = 0; j < 4; ++j) { const int n = (lane >> 3) + 8 * j; const LAS float* s = scr + (8 * c) * 33 + n;
        u32x4 o; o.x = cvt_pk_bf16(s[0 * 33], s[1 * 33]); o.y = cvt_pk_bf16(s[2 * 33], s[3 * 33]); o.z = cvt_pk_bf16(s[4 * 33], s[5 * 33]); o.w = cvt_pk_bf16(s[6 * 33], s[7 * 33]);
        *(u32x4*)(WT + (size_t)(drow0 + n) * ldt + dk0 + k0 + 8 * c) = o; }
    LDS_WAIT(); asm volatile("" ::: "memory");
}

__device__ __forceinline__ void tr_item8(const float* W, int ldw, int k0, int n0, unsigned char* WT, int ldt, int drow0, int dk0, float sc, LAS float* scr, int lane) {
#pragma unroll 8
    for (int i = 0; i < 32; ++i) { const int kk = 2 * i + (lane >> 5); scr[kk * 33 + (lane & 31)] = W[(size_t)(k0 + kk) * ldw + n0 + (lane & 31)] * sc; }
    LDS_WAIT(); asm volatile("" ::: "memory");
    const int c = lane & 3;
#pragma unroll
    for (int j = 0; j < 2; ++j) { const int n = (lane >> 2) + 16 * j; const LAS float* s = scr + (16 * c) * 33 + n;
        u32x4 o; o.x = pk4_fp8(s[0 * 33], s[1 * 33], s[2 * 33], s[3 * 33]); o.y = pk4_fp8(s[4 * 33], s[5 * 33], s[6 * 33], s[7 * 33]);
        o.z = pk4_fp8(s[8 * 33], s[9 * 33], s[10 * 33], s[11 * 33]); o.w = pk4_fp8(s[12 * 33], s[13 * 33], s[14 * 33], s[15 * 33]);
        *(u32x4*)(WT + (size_t)(drow0 + n) * ldt + dk0 + k0 + 16 * c) = o; }
    LDS_WAIT(); asm volatile("" ::: "memory");
}

__device__ __forceinline__ void p0_prologue(Frame& F) {
    LAS float* scr = (LAS float*)(F.lds + F.wave * 16384);
    const int gw = F.vcu * NWAVES + F.wave, NGW = F.G * NWAVES, lane = F.lane;
    bf16_t* WIN_T = (bf16_t*)(F.ws + WS_WIN_T); bf16_t* WP_T = (bf16_t*)(F.ws + WS_WP_T); bf16_t* WOUT_T = (bf16_t*)(F.ws + WS_WOUT_T);
    bf16_t* WGU_T = (bf16_t*)(F.ws + WS_WGU_T); bf16_t* WD_T = (bf16_t*)(F.ws + WS_WD_T); bf16_t* WA_T = (bf16_t*)(F.ws + WS_WA_T); bf16_t* WX_T = (bf16_t*)(F.ws + WS_WX_T);
    constexpr int I_IN = 32 * 288, I_PR = 16 * 64, I_OUT = 32 * 64, I_EX = 512 * NE, I_LRU = 128;
    constexpr int NITEMS = I_IN + 2 * I_PR + I_OUT + 3 * I_EX + I_LRU;
    const TrSrc src{F.in[2], F.in[10], F.in[11], F.in[12], F.in[18], F.in[19], F.in[20], F.ws};
    for (int it = gw; it < TR_I_IN; it += 2 * NGW) {
        const int it2 = it + NGW; const bool two = it2 < TR_I_IN;
        TrDesc d0 = tr_decode(src, it), d1 = d0; f32x4 v0[16], v1[16];
        tr_load(d0, v0, lane);
        if (two) { d1 = tr_decode(src, it2); tr_load(d1, v1, lane); }
        tr_store(d0, v0, lane);
        if (two) tr_store(d1, v1, lane);
    }
    for (int r = gw; r < 128; r += NGW) { const int which = r / 64, rr = r % 64, nb = rr / 8, r8 = rr % 8;
        tr_item(F.in[which ? 7 : 5] + (size_t)nb * LBD * LBD, LBD, 64 * (r8 / 4), 32 * (r8 % 4), (which ? WX_T : WA_T) + (size_t)nb * LBD * LBD, LBD, 32 * (r8 % 4), 0, scr, lane); }
    { float* WR_T = (float*)(F.ws + WS_WR_T); const float* gf = F.in[13]; const float* wg = F.in[14]; const float* we = F.in[16];
      for (int i = (F.vcu * NTHR + F.tid); i < 64 * D; i += F.G * NTHR) { const int col = i / D, k = i % D;
          float v = 0.f; if (col < 32) v = we[(size_t)k * NE + col] * gf[k]; else if (col < 36) v = wg[(size_t)k * NG + (col - 32)] * gf[k];
          WR_T[i] = v; } }
    { const float* x = F.in[0]; const float* g = F.in[1]; bf16_t* XN = (bf16_t*)(F.ws + WS_XN);
      f32x4 gv[8];
#pragma unroll
      for (int j = 0; j < 8; ++j) gv[j] = ((const f32x4*)g)[lane + 64 * j];
      for (int m0 = gw; m0 < T; m0 += 2 * NGW) {
          f32x4 va[8], vb[8];
          { const f32x4* xa = (const f32x4*)(x + (size_t)m0 * D) + lane; const f32x4* xb = (const f32x4*)(x + (size_t)(m0 + NGW) * D) + lane;
#pragma unroll
            for (int j = 0; j < 8; ++j) va[j] = xa[64 * j];
#pragma unroll
            for (int j = 0; j < 8; ++j) vb[j] = xb[64 * j]; }
#pragma unroll
          for (int half = 0; half < 2; ++half) { const int m = m0 + half * NGW; f32x4 (&v)[8] = half ? vb : va; float s = 0.f;
#pragma unroll
              for (int j = 0; j < 8; ++j) s += (v[j].x * v[j].x + v[j].y * v[j].y) + (v[j].z * v[j].z + v[j].w * v[j].w);
              const float r = rsqrtf(wave_sum(s) * (1.f / D) + RMS_EPS);
              if (IN_NF8 > 0) { unsigned* o = (unsigned*)((unsigned char*)F.out + (size_t)m * D) + lane; const float r8 = r * Q_SA_IN;
#pragma unroll
                  for (int j = 0; j < 8; ++j) o[64 * j] = pk4_q<QM_IN>(v[j].x * r8 * gv[j].x, v[j].y * r8 * gv[j].y, v[j].z * r8 * gv[j].z, v[j].w * r8 * gv[j].w); }
              if (IN_NBF > 0) { u32x2* o = (u32x2*)(XN + (size_t)m * D) + lane;
#pragma unroll
                  for (int j = 0; j < 8; ++j) { u32x2 w; w.x = cvt_pk_bf16(v[j].x * r * gv[j].x, v[j].y * r * gv[j].y); w.y = cvt_pk_bf16(v[j].z * r * gv[j].z, v[j].w * r * gv[j].w); o[64 * j] = w; } }
          }
      } }
}


template <bool SPLIT> __device__ __forceinline__ void quant_row(Frame& F, const bf16_t* src, unsigned char* dst, float* rs, int t) {
    const int lane = F.lane; const u32x4* p = (const u32x4*)(src + (size_t)t * 2048) + lane; u32x4 v[4];
#pragma unroll
    for (int j = 0; j < 4; ++j) v[j] = p[64 * j];
    float mx[2] = {0.f, 0.f};
#pragma unroll
    for (int j = 0; j < 4; ++j) { const unsigned w[4] = {v[j].x, v[j].y, v[j].z, v[j].w}; float m = 0.f;
#pragma unroll
        for (int e = 0; e < 4; ++e) m = fmaxf(m, fmaxf(fabsf(bf_lo(w[e])), fabsf(bf_hi(w[e]))));
        mx[j >> 1] = fmaxf(mx[j >> 1], m); }
#pragma unroll
    for (int o = 1; o < 64; o <<= 1) { mx[0] = fmaxf(mx[0], __shfl_xor(mx[0], o)); mx[1] = fmaxf(mx[1], __shfl_xor(mx[1], o)); }
    if (!SPLIT) { mx[0] = fmaxf(mx[0], mx[1]); mx[1] = mx[0]; }
    const float q0 = 127.f / fmaxf(mx[0], 1e-30f), q1 = 127.f / fmaxf(mx[1], 1e-30f);
    if (lane == 0) { if (SPLIT) { rs[2 * (size_t)t] = mx[0] * (1.f / 127.f); rs[2 * (size_t)t + 1] = mx[1] * (1.f / 127.f); } else rs[t] = mx[0] * (1.f / 127.f); }
    u32x2* o = (u32x2*)(dst + (size_t)t * 2048) + lane;
#pragma unroll
    for (int j = 0; j < 4; ++j) { const float q = (j >> 1) ? q1 : q0; u32x2 w;
        w.x = pk4_i8(bf_lo(v[j].x) * q, bf_hi(v[j].x) * q, bf_lo(v[j].y) * q, bf_hi(v[j].y) * q); w.y = pk4_i8(bf_lo(v[j].z) * q, bf_hi(v[j].z) * q, bf_lo(v[j].w) * q, bf_hi(v[j].w) * q);
        o[64 * j] = w; }
}

__device__ __forceinline__ void final_norm(Frame& F) {
    const int gw = F.vcu * NWAVES + F.wave, NGW = F.G * NWAVES, lane = F.lane;
    const float* g = F.in[21]; const bf16_t* Y = (const bf16_t*)(F.ws + WS_Y);
    f32x4 gv[8];
#pragma unroll
    for (int j = 0; j < 8; ++j) gv[j] = ((const f32x4*)g)[lane + 64 * j];
    for (int m = gw; m < T; m += NGW) {
        f32x4* xr = (f32x4*)(F.out + (size_t)m * D) + lane; f32x4 v[8]; float s = 0.f;
        { const u32x2* dl = (const u32x2*)((const bf16_t*)(F.ws + WS_DELTA) + (size_t)m * D) + lane;
#pragma unroll
          for (int j = 0; j < 8; ++j) { const u32x2 dd = dl[64 * j]; v[j].x = bf_lo(dd.x); v[j].y = bf_hi(dd.x); v[j].z = bf_lo(dd.y); v[j].w = bf_hi(dd.y); } }
#if EN_MOE
        const unsigned* y0 = (const unsigned*)((const unsigned char*)Y + (size_t)m * D) + lane; const unsigned* y1 = (const unsigned*)((const unsigned char*)Y + (size_t)(T + m) * D) + lane;
#pragma unroll
        for (int j = 0; j < 8; ++j) { const int a = (int)y0[64 * j], b = (int)y1[64 * j];
            const f32x2 al = __builtin_amdgcn_cvt_pk_f32_fp8(a, false), ah = __builtin_amdgcn_cvt_pk_f32_fp8(a, true), bl = __builtin_amdgcn_cvt_pk_f32_fp8(b, false), bh = __builtin_amdgcn_cvt_pk_f32_fp8(b, true);
            v[j].x += (al.x + bl.x) * (1.f / FP8_SY); v[j].y += (al.y + bl.y) * (1.f / FP8_SY); v[j].z += (ah.x + bh.x) * (1.f / FP8_SY); v[j].w += (ah.y + bh.y) * (1.f / FP8_SY); }
#endif
#pragma unroll
        for (int j = 0; j < 8; ++j) s += (v[j].x * v[j].x + v[j].y * v[j].y) + (v[j].z * v[j].z + v[j].w * v[j].w);
        const float r = rsqrtf(wave_sum(s) * (1.f / D) + RMS_EPS);
#pragma unroll
        for (int j = 0; j < 8; ++j) { f32x4 o; o.x = v[j].x * r * gv[j].x; o.y = v[j].y * r * gv[j].y; o.z = v[j].z * r * gv[j].z; o.w = v[j].w * r * gv[j].w; xr[64 * j] = o; }
    }
}
__device__ __forceinline__ int xc_addr(int bl, int row, int c16) { return bl * 65536 + row * 256 + ((c16 ^ (row & 15)) << 4); }
template <bool FINAL>
__device__ __forceinline__ void scan_unit(Frame& F, int b, int chunk, int cq) {
    const int tid = F.tid, lane = F.lane, wave = F.wave;
    const bf16_t* XREC = (const bf16_t*)(F.ws + WS_XREC);
    const size_t t0 = (size_t)b * S + (size_t)chunk * 256; const int ch0 = cq * 256;
    {
        const int cg = tid & 31, tg = tid >> 5, ch = ch0 + 8 * cg, r0 = 16 * tg;
        const float* cw = F.in[3]; const float* cb = F.in[4];
        float w[4][8], bias[8];
#pragma unroll
        for (int k = 0; k < 4; ++k) { const f32x4 a = *(const f32x4*)(cw + k * LW + ch), c = *(const f32x4*)(cw + k * LW + ch + 4);
            w[k][0] = a.x; w[k][1] = a.y; w[k][2] = a.z; w[k][3] = a.w; w[k][4] = c.x; w[k][5] = c.y; w[k][6] = c.z; w[k][7] = c.w; }
        { const f32x4 a = *(const f32x4*)(cb + ch), c = *(const f32x4*)(cb + ch + 4); bias[0] = a.x; bias[1] = a.y; bias[2] = a.z; bias[3] = a.w; bias[4] = c.x; bias[5] = c.y; bias[6] = c.z; bias[7] = c.w; }
        float xm[3][8];
#pragma unroll
        for (int i = 0; i < 3; ++i) { const int rr = r0 - 3 + i; u32x4 v = (u32x4){0u, 0u, 0u, 0u};
            if (chunk > 0 || rr >= 0) v = *(const u32x4*)(XREC + (size_t)((long)t0 + rr) * LW + ch);
            xm[i][0] = bf_lo(v.x); xm[i][1] = bf_hi(v.x); xm[i][2] = bf_lo(v.y); xm[i][3] = bf_hi(v.y); xm[i][4] = bf_lo(v.z); xm[i][5] = bf_hi(v.z); xm[i][6] = bf_lo(v.w); xm[i][7] = bf_hi(v.w); }
        const int bl = cg >> 4, c16 = cg & 15;
        u32x4 xv[16];
#pragma unroll
        for (int r = 0; r < 16; ++r) xv[r] = *(const u32x4*)(XREC + (t0 + r0 + r) * LW + ch);
#pragma unroll
        for (int r = 0; r < 16; ++r) {
            const u32x4 v = xv[r];
            float x0[8]; x0[0] = bf_lo(v.x); x0[1] = bf_hi(v.x); x0[2] = bf_lo(v.y); x0[3] = bf_hi(v.y); x0[4] = bf_lo(v.z); x0[5] = bf_hi(v.z); x0[6] = bf_lo(v.w); x0[7] = bf_hi(v.w);
            float y[8];
#pragma unroll
            for (int c = 0; c < 8; ++c) { y[c] = bias[c] + w[0][c] * xm[0][c] + w[1][c] * xm[1][c] + w[2][c] * xm[2][c] + w[3][c] * x0[c]; xm[0][c] = xm[1][c]; xm[1][c] = xm[2][c]; xm[2][c] = x0[c]; }
            u32x4 o; o.x = cvt_pk_bf16(y[0], y[1]); o.y = cvt_pk_bf16(y[2], y[3]); o.z = cvt_pk_bf16(y[4], y[5]); o.w = cvt_pk_bf16(y[6], y[7]);
            *(LAS u32x4*)(F.lds + xc_addr(bl, r0 + r, c16)) = o;
        }
    }
    __syncthreads();
    {
        const int r32 = lane & 31, hi = lane >> 5, bl = wave >> 2, nb = 2 * cq + bl, dl = 32 * (wave & 3) + r32, d = nb * LBD + dl;
        const bf16_t* WA_T = (const bf16_t*)(F.ws + WS_WA_T); const bf16_t* WX_T = (const bf16_t*)(F.ws + WS_WX_T);
        bf16x8 wa[8], wx[8];
#pragma unroll
        for (int ks = 0; ks < 8; ++ks) { wa[ks] = *(const bf16x8*)(WA_T + ((size_t)nb * LBD + dl) * LBD + 16 * ks + 8 * hi); wx[ks] = *(const bf16x8*)(WX_T + ((size_t)nb * LBD + dl) * LBD + 16 * ks + 8 * hi); }
        const float ba = F.in[6][d], bx = F.in[8][d], lam = F.in[9][d];
        const float cl = -8.0f * log1pf(expf(-lam));
        float hc = 0.f, Atot = 1.f;
        float* SSUM = (float*)(F.ws + WS_SSUM);
        if (FINAL) {
#pragma unroll 1
            for (int j0 = 0; j0 < chunk; j0 += 8) { f32x2 sv[8];
#pragma unroll
                for (int j = 0; j < 8; ++j) sv[j] = *(const f32x2*)(SSUM + (((size_t)b * NBLK + j0 + j) * LW + d) * 2);
#pragma unroll
                for (int j = 0; j < 8; ++j) { const bool ok = (j0 + j) < chunk; hc = ok ? (sv[j].x * hc + sv[j].y) : hc; } } }
        const bf16_t* GREC = (const bf16_t*)(F.ws + WS_GREC); bf16_t* YCAT = (bf16_t*)(F.ws + WS_YCAT);
#pragma unroll 1
        for (int tt = 0; tt < 8; ++tt) {
            f32x16 ar = {}, ai = {};
            bf16x8 am[8]; bf16_t xcr[16];
#pragma unroll
            for (int ks = 0; ks < 8; ++ks) am[ks] = *(const LAS bf16x8*)(F.lds + xc_addr(bl, 32 * tt + r32, 2 * ks + hi));
#pragma unroll
            for (int r = 0; r < 16; ++r) { const int row = 32 * tt + (r & 3) + 8 * (r >> 2) + 4 * hi; xcr[r] = *(const LAS bf16_t*)(F.lds + xc_addr(bl, row, dl >> 3) + (dl & 7) * 2); }
            __builtin_amdgcn_sched_barrier(0);
#pragma unroll
            for (int ks = 0; ks < 8; ++ks) { ar = __builtin_amdgcn_mfma_f32_32x32x16_bf16(am[ks], wa[ks], ar, 0, 0, 0); ai = __builtin_amdgcn_mfma_f32_32x32x16_bf16(am[ks], wx[ks], ai, 0, 0, 0); }
            float av[16], bv[16], lav[16];
#pragma unroll
            for (int r = 0; r < 16; ++r) {
                const float xc = bf2f(xcr[r]);
                const float rg = fsigmoid(ar[r] + ba), ig = fsigmoid(ai[r] + bx);
                const float la = cl * rg; av[r] = __builtin_amdgcn_exp2f(la * 1.4426950408889634f); lav[r] = la; const float x2 = 2.0f * la;
                const float em = -x2 * (1.0f + x2 * (0.5f + x2 * (0.16666667f + x2 * (0.041666668f + x2 * 0.0083333338f))));
                bv[r] = __builtin_amdgcn_sqrtf(em) * ig * xc; }
            if (!FINAL) {
                int ttv = tt; asm volatile("" : "+v"(ttv));
                const unsigned rl = 32u * (unsigned)ttv + 4u * (unsigned)hi; unsigned* AB = (unsigned*)F.out + (size_t)F.vcu * 65536 + (unsigned)(d & 255);
#pragma unroll
                for (int r = 0; r < 16; ++r) AB[(rl + (unsigned)((r & 3) + 8 * (r >> 2))) * 256u] = cvt_pk_bf16(lav[r], bv[r]);
            }
            float Ag[4], Hg[4], hl[16], Ac[16];
#pragma unroll
            for (int g = 0; g < 4; ++g) { float A = 1.f, H = 0.f;
#pragma unroll
                for (int j = 0; j < 4; ++j) { const int r = 4 * g + j; H = av[r] * H + bv[r]; A *= av[r]; hl[r] = H; Ac[r] = A; }
                Ag[g] = A; Hg[g] = H; }
            float hin[4];
#pragma unroll
            for (int g = 0; g < 4; ++g) { const float Ao = __shfl_xor(Ag[g], 32), Ho = __shfl_xor(Hg[g], 32);
                const float A0 = hi ? Ao : Ag[g], H0 = hi ? Ho : Hg[g], A1 = hi ? Ag[g] : Ao, H1 = hi ? Hg[g] : Ho;
                const float h0 = hc; hc = A0 * hc + H0; const float h1 = hc; hc = A1 * hc + H1; hin[g] = hi ? h1 : h0; Atot *= A0 * A1; }
            if (FINAL) {
                int ttv = tt; asm volatile("" : "+v"(ttv));
                const unsigned rb = (unsigned)t0 + 32u * (unsigned)ttv + 4u * (unsigned)hi;
#pragma unroll
                for (int r = 0; r < 16; ++r) { const unsigned t = rb + (unsigned)((r & 3) + 8 * (r >> 2)); const float hf = hl[r] + Ac[r] * hin[r >> 2];
                    const float gr = bf2f(GREC[t * (unsigned)LW + (unsigned)d]);
                    YCAT[t * 2048u + (unsigned)d] = (bf16_t)(cvt_pk_bf16(hf * gr, 0.f) & 0xffffu);
                    if ((r & 3) == 3) asm volatile("" ::: "memory"); }
            }
        }
        if (!FINAL && hi == 0) {
            const unsigned long long sv = ((unsigned long long)__float_as_uint(hc) << 32) | (unsigned long long)__float_as_uint(Atot);
            __hip_atomic_store((unsigned long long*)(SSUM + (((size_t)b * NBLK + chunk) * LW + d) * 2), sv, __ATOMIC_RELAXED, __HIP_MEMORY_SCOPE_AGENT); }
    }
    __syncthreads();
}


__device__ __forceinline__ void scan_fix(Frame& F, int task) {
    const int lane = F.lane, r32 = lane & 31, hi = lane >> 5;
    const int cg = task & 31, chunk = (task >> 5) & 31, b = task >> 10, d = cg * 32 + r32;
    const size_t t0 = (size_t)b * S + (size_t)chunk * 256;
    const float* SSUM = (const float*)(F.ws + WS_SSUM); const unsigned* AB = (const unsigned*)F.out + (size_t)F.vcu * 65536 + (unsigned)(d & 255);
    const bf16_t* GREC = (const bf16_t*)(F.ws + WS_GREC); bf16_t* YCAT = (bf16_t*)(F.ws + WS_YCAT);
    float hc = 0.f;
    unsigned abA[16]; bf16_t grA[16];
    { const unsigned rb = (unsigned)t0 + 4u * (unsigned)hi;
#pragma unroll
      for (int r = 0; r < 16; ++r) { const unsigned ro = (unsigned)((r & 3) + 8 * (r >> 2)); const unsigned t = rb + ro; abA[r] = AB[(4u * (unsigned)hi + ro) * 256u]; grA[r] = GREC[t * (unsigned)LW + (unsigned)d]; } }
#pragma unroll 1
    for (int j0 = 0; j0 < chunk; j0 += 8) { f32x2 sv[8];
#pragma unroll
        for (int j = 0; j < 8; ++j) { const unsigned long long q = __hip_atomic_load((const unsigned long long*)(SSUM + (((size_t)b * NBLK + j0 + j) * LW + d) * 2), __ATOMIC_RELAXED, __HIP_MEMORY_SCOPE_AGENT);
            sv[j].x = __uint_as_float((unsigned)q); sv[j].y = __uint_as_float((unsigned)(q >> 32)); }
#pragma unroll
        for (int j = 0; j < 8; ++j) { const bool ok = (j0 + j) < chunk; hc = ok ? (sv[j].x * hc + sv[j].y) : hc; } }
#define SF_LOAD(TT, ABV, GRV) do { int ttv = (TT); asm volatile("" : "+v"(ttv)); const unsigned rb = (unsigned)t0 + 32u * (unsigned)ttv + 4u * (unsigned)hi; \
        _Pragma("unroll") for (int r = 0; r < 16; ++r) { const unsigned ro = (unsigned)((r & 3) + 8 * (r >> 2)); const unsigned t = rb + ro; ABV[r] = AB[(32u * (unsigned)ttv + 4u * (unsigned)hi + ro) * 256u]; GRV[r] = GREC[t * (unsigned)LW + (unsigned)d]; } } while (0)
#define SF_STEP(TT, ABV, GRV) do { int ttv = (TT); asm volatile("" : "+v"(ttv)); const unsigned rb = (unsigned)t0 + 32u * (unsigned)ttv + 4u * (unsigned)hi; \
        float av[16], bv[16]; \
        _Pragma("unroll") for (int r = 0; r < 16; ++r) { av[r] = __builtin_amdgcn_exp2f(bf_lo(ABV[r]) * 1.4426950408889634f); bv[r] = bf_hi(ABV[r]); } \
        float Ag[4], Hg[4], hl[16], Ac[16]; \
        _Pragma("unroll") for (int g = 0; g < 4; ++g) { float A = 1.f, H = 0.f; \
            _Pragma("unroll") for (int j = 0; j < 4; ++j) { const int r = 4 * g + j; H = av[r] * H + bv[r]; A *= av[r]; hl[r] = H; Ac[r] = A; } \
            Ag[g] = A; Hg[g] = H; } \
        float hin[4]; \
        _Pragma("unroll") for (int g = 0; g < 4; ++g) { const float Ao = __shfl_xor(Ag[g], 32), Ho = __shfl_xor(Hg[g], 32); \
            const float A0 = hi ? Ao : Ag[g], H0 = hi ? Ho : Hg[g], A1 = hi ? Ag[g] : Ao, H1 = hi ? Hg[g] : Ho; \
            const float h0 = hc; hc = A0 * hc + H0; const float h1 = hc; hc = A1 * hc + H1; hin[g] = hi ? h1 : h0; } \
        _Pragma("unroll") for (int r = 0; r < 16; ++r) { const unsigned t = rb + (unsigned)((r & 3) + 8 * (r >> 2)); const float hf = hl[r] + Ac[r] * hin[r >> 2]; \
            YCAT[t * 2048u + (unsigned)d] = (bf16_t)(cvt_pk_bf16(hf * bf2f(GRV[r]), 0.f) & 0xffffu); } } while (0)
    unsigned abB[16]; bf16_t grB[16];
#pragma unroll 1
    for (int tt = 0; tt < 8; tt += 2) {
        SF_LOAD(tt + 1, abB, grB);
        SF_STEP(tt, abA, grA);
        if (tt + 2 < 8) SF_LOAD(tt + 2, abA, grA);
        SF_STEP(tt + 1, abB, grB);
    }
#undef SF_LOAD
#undef SF_STEP
}

__device__ __forceinline__ void kmean_unit(Frame& F, int u) {
    const int tid = F.tid; const int bh = u >> 5, n = u & 31, b = bh >> 3, h = bh & 7;
    const bf16_t* Kp = (const bf16_t*)(F.ws + WS_K) + ((size_t)b * S + (size_t)n * 256) * AW + h * HD;
    const int rg = tid >> 4, cc = tid & 15; float s[8] = {0.f, 0.f, 0.f, 0.f, 0.f, 0.f, 0.f, 0.f}; float sq[8][8];
#pragma unroll
    for (int i = 0; i < 8; ++i) { const u32x4 v = *(const u32x4*)(Kp + (size_t)(rg + 32 * i) * AW + 8 * cc);
        const float e[8] = {bf_lo(v.x), bf_hi(v.x), bf_lo(v.y), bf_hi(v.y), bf_lo(v.z), bf_hi(v.z), bf_lo(v.w), bf_hi(v.w)};
#pragma unroll
        for (int c = 0; c < 8; ++c) { s[c] += e[c]; sq[i][c] = e[c] * e[c]; } }
    LAS float* part = (LAS float*)F.lds; LAS float* nmx = part + 32 * 128;
#pragma unroll
    for (int c = 0; c < 8; ++c) part[rg * 128 + 8 * cc + c] = s[c];
    { float mx = 0.f;
#pragma unroll
      for (int i = 0; i < 8; ++i) { float q = 0.f;
#pragma unroll
          for (int c = 0; c < 8; ++c) q += sq[i][c];
          q += __shfl_xor(q, 1); q += __shfl_xor(q, 2); q += __shfl_xor(q, 4); q += __shfl_xor(q, 8); mx = fmaxf(mx, q); }
      if (cc == 0) nmx[rg] = mx; }
    __syncthreads();
    if (tid == 0) { float m = 0.f; for (int r = 0; r < 32; ++r) m = fmaxf(m, nmx[r]); ((float*)(F.ws + WS_KNORM))[u] = m; }
    if (tid < 128) { float a = 0.f;
#pragma unroll 8
        for (int r = 0; r < 32; ++r) a += part[r * 128 + tid];
        const float mean = a * (1.f / 256.f); ((float*)(F.ws + WS_KMEAN))[(size_t)u * 128 + tid] = mean;
        const unsigned hb = cvt_pk_bf16(mean, 0.f) & 0xffffu; const float lo = mean - __uint_as_float(hb << 16);
        ((bf16_t*)(F.ws + WS_KMH))[(size_t)u * 128 + tid] = (bf16_t)hb; ((bf16_t*)(F.ws + WS_KML))[(size_t)u * 128 + tid] = (bf16_t)(cvt_pk_bf16(lo, 0.f) & 0xffffu); }
    __syncthreads();
}

__device__ __forceinline__ void route_phase(Frame& F) {
    const int tid = F.tid, lane = F.lane, wave = F.wave, r32 = lane & 31, hi = lane >> 5;
    constexpr int NU = NB * NH * 16;
    LAS int* lcnt = (LAS int*)(F.lds + 16384); LAS int* lbase = lcnt + 32; LAS float* knl = (LAS float*)(lbase + 32);
    constexpr int GPP = 35;
    LAS float* gp = (LAS float*)(F.lds + 32768);
    bf16x8 qa[2][8], ka[2][8], bhv[8], blv[8]; float knv = 0.f;
#define ROUTE_LOAD(U) do { const int _bh = (U) >> 4, _j0 = 1 + 2 * ((U) & 15), _b = _bh >> 3, _h = _bh & 7; \
        const bf16_t* mh = (const bf16_t*)(F.ws + WS_KMH) + ((size_t)_bh * 32 + r32) * 128 + 8 * hi; const bf16_t* ml = (const bf16_t*)(F.ws + WS_KML) + ((size_t)_bh * 32 + r32) * 128 + 8 * hi; \
        _Pragma("unroll") for (int hf = 0; hf < 2; ++hf) { const int _jj = (_j0 + hf <= 31) ? _j0 + hf : _j0; \
            const size_t trow = (size_t)_b * S + (size_t)_jj * 256 + wave * 32 + r32; \
            const bf16_t* qp = (const bf16_t*)(F.ws + WS_Q) + trow * AW + _h * HD + 8 * hi; const bf16_t* kp = (const bf16_t*)(F.ws + WS_K) + trow * AW + _h * HD + 8 * hi; \
            _Pragma("unroll") for (int ks = 0; ks < 8; ++ks) { qa[hf][ks] = *(const bf16x8*)(qp + 16 * ks); ka[hf][ks] = *(const bf16x8*)(kp + 16 * ks); } } \
        _Pragma("unroll") for (int ks = 0; ks < 8; ++ks) { bhv[ks] = *(const bf16x8*)(mh + 16 * ks); blv[ks] = *(const bf16x8*)(ml + 16 * ks); } \
        knv = ((const float*)(F.ws + WS_KNORM))[_bh * 32 + r32]; } while (0)
    int u = F.vcu; if (u >= NU) return;
    ROUTE_LOAD(u);
    for (;;) {
        const int un = u + F.G; const int bh = u >> 4, j0 = 1 + 2 * (u & 15), b = bh >> 3, h = bh & 7; const int jmax = (j0 + 1 <= 31) ? j0 + 1 : j0;
        if (tid < 32) { lcnt[tid] = 0; knl[tid] = knv; }
#pragma unroll
        for (int hf = 0; hf < 2; ++hf) {
            f32x16 acc = {};
#pragma unroll
            for (int ks = 0; ks < 8; ++ks) { acc = __builtin_amdgcn_mfma_f32_32x32x16_bf16(qa[hf][ks], bhv[ks], acc, 0, 0, 0); acc = __builtin_amdgcn_mfma_f32_32x32x16_bf16(qa[hf][ks], blv[ks], acc, 0, 0, 0); }
            float qq = 0.f, qk = 0.f;
#pragma unroll
            for (int ks = 0; ks < 8; ++ks)
#pragma unroll
                for (int e = 0; e < 8; ++e) { const float qv = bf2f((bf16_t)qa[hf][ks][e]), kv = bf2f((bf16_t)ka[hf][ks][e]); qq += qv * qv; qk += qv * kv; }
            qq += __shfl_xor(qq, 32); qk += __shfl_xor(qk, 32);
            const int qb = hf * 256 + wave * 32;
#pragma unroll
            for (int r = 0; r < 16; ++r) gp[(qb + (r & 3) + 8 * (r >> 2) + 4 * hi) * GPP + r32] = acc[r];
            if (hi == 0) { gp[(qb + r32) * GPP + 32] = qq; gp[(qb + r32) * GPP + 33] = qk; }
        }
        __syncthreads();
        if (un < NU) ROUTE_LOAD(un);
        int sel[3] = {-1, -1, -1}, slot[3] = {0, 0, 0};
        const int j = j0 + (tid >> 8), qi = tid & 255; const bool live = j <= 31;
        if (live) {
            float bv[3] = {-3.0e38f, -3.0e38f, -3.0e38f};
#pragma unroll 1
            for (int n = 0; n < j; ++n) {
                const float g = gp[tid * GPP + n];
                if (g > bv[0]) { bv[2] = bv[1]; sel[2] = sel[1]; bv[1] = bv[0]; sel[1] = sel[0]; bv[0] = g; sel[0] = n; }
                else if (g > bv[1]) { bv[2] = bv[1]; sel[2] = sel[1]; bv[1] = g; sel[1] = n; }
                else if (g > bv[2]) { bv[2] = g; sel[2] = n; }
            }
            { const float qn = sqrtf(gp[tid * GPP + 32]), sself = 0.088388347648318440f * gp[tid * GPP + 33];
              const float slope = exp2f(-(float)(h + 1)); float* LSE = (float*)(F.ws + WS_LSE);
#pragma unroll
              for (int k = 0; k < 3; ++k) if (sel[k] >= 0) { const int n = sel[k]; const float dmin = (float)((j - n - 1) * 256 + qi + 1);
                  const float ub = 0.088388347648318440f * qn * sqrtf(knl[n]) * 1.0001f - slope * dmin;
                  if (ub < sself - 110.f) { LSE[(((size_t)b * S + (size_t)j * 256 + qi) * NH + h) * 4 + k] = -3.0e38f; sel[k] = -1 - n; } } }
#pragma unroll
            for (int k = 0; k < 3; ++k) if (sel[k] >= 0) slot[k] = __hip_atomic_fetch_add(lcnt + sel[k], 1, __ATOMIC_RELAXED, __HIP_MEMORY_SCOPE_WORKGROUP);
        }
        __syncthreads();
        if (tid < jmax) lbase[tid] = (int)atomicAdd(F.ctl + CW_ACNT + bh * 32 + tid, (unsigned)lcnt[tid]);
        __syncthreads();
        if (live) { unsigned* AL = (unsigned*)(F.ws + WS_ALIST) + (size_t)bh * ALIST_PER_BH;
#pragma unroll
            for (int k = 0; k < 3; ++k) if (sel[k] >= 0) AL[alist_off(sel[k]) + lbase[sel[k]] + slot[k]] = ((unsigned)(j * 256 + qi) << 2) | (unsigned)k; }
        __syncthreads();
        if (un >= NU) break;
        u = un;
    }
#undef ROUTE_LOAD
}
namespace att {
constexpr int KVBLK = 64, LDK = AW;
constexpr float SCALE = 0.088388347648318440f;
constexpr float THR = 8.f;
constexpr size_t SHM_V = KVBLK * HD * 2, SHM_K = KVBLK * HD * 2;
#define KSWZ(row, colB) ((row) * 256 + ((colB) ^ (((row) & 7) << 4)))
#define SBAR() __builtin_amdgcn_sched_barrier(0)
__device__ __forceinline__ int crow(int r, int hi) { return (r & 3) + 8 * (r >> 2) + 4 * hi; }
__device__ __forceinline__ void partialSM(f32x16& p0, f32x16& p1, float& m_reg, float& mn, float& alpha) {
  constexpr float C = SCALE * 1.4426950408889634f;
  float pmax = p0[0];
#pragma unroll
  for (int r = 1; r < 16; ++r) pmax = fmaxf(pmax, p0[r]);
#pragma unroll
  for (int r = 0; r < 16; ++r) pmax = fmaxf(pmax, p1[r]);
  { auto rr = __builtin_amdgcn_permlane32_swap(__float_as_uint(pmax), __float_as_uint(pmax), false, false);
    pmax = fmaxf(__uint_as_float(rr[0]), __uint_as_float(rr[1])); }
  if (__builtin_expect(__all(pmax - m_reg <= THR / SCALE), 1)) { mn = m_reg; alpha = 1.f; }
  else { mn = fmaxf(m_reg, pmax); alpha = __builtin_amdgcn_exp2f((m_reg - mn) * C); m_reg = mn; }
  const float mnC = -mn * C;
#pragma unroll
  for (int r = 0; r < 16; ++r) p0[r] = fmaf(p0[r], C, mnC);
#pragma unroll
  for (int r = 0; r < 16; ++r) p1[r] = fmaf(p1[r], C, mnC);
#pragma unroll
  for (int r = 0; r < 16; ++r) p0[r] = __builtin_amdgcn_exp2f(p0[r]);
}
__device__ __forceinline__ void finishSM(f32x16& p0, f32x16& p1, float alpha, float& l_reg, bf16x8& pa0, bf16x8& pa1, bf16x8& pa2, bf16x8& pa3) {
#pragma unroll
  for (int r = 0; r < 16; ++r) p1[r] = __builtin_amdgcn_exp2f(p1[r]);
  float ps = 0;
#pragma unroll
  for (int r = 0; r < 16; ++r) ps += p0[r];
#pragma unroll
  for (int r = 0; r < 16; ++r) ps += p1[r];
  { auto rr = __builtin_amdgcn_permlane32_swap(__float_as_uint(ps), __float_as_uint(ps), false, false);
    ps = __uint_as_float(rr[0]) + __uint_as_float(rr[1]); }
  l_reg = l_reg * alpha + ps;
#define PK4(P, BASE, OUT) do { unsigned a0 = cvt_pk_bf16(P[BASE + 0], P[BASE + 1]), a1 = cvt_pk_bf16(P[BASE + 2], P[BASE + 3]);   \
    unsigned b0 = cvt_pk_bf16(P[BASE + 4], P[BASE + 5]), b1 = cvt_pk_bf16(P[BASE + 6], P[BASE + 7]);                              \
    auto r0 = __builtin_amdgcn_permlane32_swap(a0, b0, false, false); auto r1 = __builtin_amdgcn_permlane32_swap(a1, b1, false, false); \
    u32x4 w = {r0[0], r1[0], r0[1], r1[1]}; OUT = *reinterpret_cast<bf16x8*>(&w); } while (0)
  PK4(p0, 0, pa0); PK4(p0, 8, pa1); PK4(p1, 0, pa2); PK4(p1, 8, pa3);
#undef PK4
}
__device__ __forceinline__ void qkt_init(f32x16& p0, f32x16& p1, float bq, float slr) {
#pragma unroll
  for (int r = 0; r < 16; ++r) { const int c0 = (r & 3) + 8 * (r >> 2); p0[r] = fmaf(slr, (float)c0, bq); p1[r] = fmaf(slr, (float)(c0 + 32), bq); }
}
__device__ __forceinline__ void qkt_mask(f32x16& p0, f32x16& p1, int lim) {
#pragma unroll
  for (int r = 0; r < 16; ++r) { const int c0 = (r & 3) + 8 * (r >> 2); if (c0 > lim) p0[r] = -1e30f; if (c0 + 32 > lim) p1[r] = -1e30f; }
}
__device__ __forceinline__ void qkt_mma(f32x16& p0, f32x16& p1, const char* Ks, const bf16x8* qr, int r32, int hi) {
#pragma unroll
  for (int d0 = 0; d0 < 8; ++d0) { const int cb = (d0 * 16 + hi * 8) * 2;
    const bf16x8 b0 = *reinterpret_cast<const bf16x8*>(Ks + KSWZ(r32, cb));
    const bf16x8 b1 = *reinterpret_cast<const bf16x8*>(Ks + KSWZ(32 + r32, cb));
    p0 = __builtin_amdgcn_mfma_f32_32x32x16_bf16(b0, qr[d0], p0, 0, 0, 0);
    p1 = __builtin_amdgcn_mfma_f32_32x32x16_bf16(b1, qr[d0], p1, 0, 0, 0); }
}
template <bool OWN>
__device__ __forceinline__ void qkt(f32x16& p0, f32x16& p1, const char* Ks, const bf16x8* qr, int r32, int hi, float bq, float slr, int lim) {
  qkt_init(p0, p1, bq, slr); if (OWN) qkt_mask(p0, p1, lim); qkt_mma(p0, p1, Ks, qr, r32, hi);
}
__device__ __forceinline__ int v_st(int k, int c) { const int kk = (k & ~0xC) | ((k & 4) << 1) | ((k & 8) >> 1); return ((kk >> 3) * 4 + (c >> 5)) * 512 + ((kk & 7) * 32 + (c & 31)) * 2; }
__device__ __forceinline__ int v_rd_base(int lane) { return ((lane & 3) << 3) | (((lane >> 2) & 3) << 6) | (((lane >> 4) & 1) << 5) | (((lane >> 5) & 1) << 8); }
constexpr int v_rd_off(int d0, int ks, int half) { return d0 * 512 + ks * 4096 + half * 2048; }
template <int OFF> __device__ __forceinline__ s16x4 tr_read(int vb) {
  s16x4 r; asm volatile("ds_read_b64_tr_b16 %0, %1 offset:%2" : "=&v"(r) : "v"(vb), "i"(OFF) : "memory"); return r;
}
template <int D0> __device__ __forceinline__ void pv_one(f32x16& od, int vb, bf16x8 pa0, bf16x8 pa1, bf16x8 pa2, bf16x8 pa3) {
  const s16x4 l0 = tr_read<v_rd_off(D0, 0, 0)>(vb), h0 = tr_read<v_rd_off(D0, 0, 1)>(vb), l1 = tr_read<v_rd_off(D0, 1, 0)>(vb), h1 = tr_read<v_rd_off(D0, 1, 1)>(vb);
  const s16x4 l2 = tr_read<v_rd_off(D0, 2, 0)>(vb), h2 = tr_read<v_rd_off(D0, 2, 1)>(vb), l3 = tr_read<v_rd_off(D0, 3, 0)>(vb), h3 = tr_read<v_rd_off(D0, 3, 1)>(vb);
  asm volatile("s_waitcnt lgkmcnt(0)" ::: "memory"); SBAR();
#define PK(L, H) (bf16x8){L[0], L[1], L[2], L[3], H[0], H[1], H[2], H[3]}
  od = __builtin_amdgcn_mfma_f32_32x32x16_bf16(pa0, PK(l0, h0), od, 0, 0, 0);
  od = __builtin_amdgcn_mfma_f32_32x32x16_bf16(pa1, PK(l1, h1), od, 0, 0, 0);
  od = __builtin_amdgcn_mfma_f32_32x32x16_bf16(pa2, PK(l2, h2), od, 0, 0, 0);
  od = __builtin_amdgcn_mfma_f32_32x32x16_bf16(pa3, PK(l3, h3), od, 0, 0, 0);
#undef PK
}
__device__ __forceinline__ void pv_d0(f32x16* o, int vb, bf16x8 pa0, bf16x8 pa1, bf16x8 pa2, bf16x8 pa3) {
  pv_one<0>(o[0], vb, pa0, pa1, pa2, pa3); pv_one<1>(o[1], vb, pa0, pa1, pa2, pa3); pv_one<2>(o[2], vb, pa0, pa1, pa2, pa3); pv_one<3>(o[3], vb, pa0, pa1, pa2, pa3);
}

}
namespace att {
struct Desc { int b, h, n, chunk, cnt, own; };
__device__ __forceinline__ Desc decode(int i, const LAS int* ipre, int nsel, const unsigned* ac) {
  Desc d; int bhn;
  if (i < nsel) { int lo = 0, hi = 1024; while (hi - lo > 1) { const int mid = (lo + hi) >> 1; if (ipre[mid] <= i) lo = mid; else hi = mid; } bhn = lo; d.chunk = i - ipre[lo]; d.cnt = (int)ac[bhn]; d.own = 0; }
  else { bhn = i - nsel; d.chunk = 0; d.cnt = 256; d.own = 1; }
  d.b = bhn >> 8; d.h = (bhn >> 5) & 7; d.n = bhn & 31; return d;
}
__device__ __forceinline__ void phase(Frame& F, const LAS int* ipre, int nsel, const unsigned* ac) {
  char* lds = (char*)(unsigned char*)F.lds;
  const int tid = F.tid, wid = F.wave, lane = F.lane, r32 = lane & 31, hi = lane >> 5;
  const int ntot = nsel + NB * NH * NBLK;
  int it = F.vcu; if (it >= ntot) return;
  const bf16_t* Qg = (const bf16_t*)(F.ws + WS_Q); const bf16_t* Kg = (const bf16_t*)(F.ws + WS_K); const bf16_t* Vg = (const bf16_t*)(F.ws + WS_V);
  const unsigned* AL = (const unsigned*)(F.ws + WS_ALIST);
  bf16_t* PART = (bf16_t*)((unsigned char*)F.out); float* LSE = (float*)(F.ws + WS_LSE);
  bf16_t* V_lds = (bf16_t*)lds; bf16_t* K_lds = (bf16_t*)(lds + 2 * SHM_V);
  float* wsf = (float*)(lds + 2 * SHM_V + 2 * SHM_K) + wid * 64; float* li_l = wsf; float* al_l = wsf + 32;
  const int sr = tid >> 4, sc = (tid & 15) * 8, vst0 = v_st(sr, sc), vst1 = v_st(32 + sr, sc);
  const int vb0 = (int)(uintptr_t)V_lds + v_rd_base(lane);
  struct { bf16x8 vs0, vs1, ks0, ks1; } sr_[2];
  constexpr float C = SCALE * 1.4426950408889634f;
#define SLOADX(i, d, j) do { const size_t _o = ((size_t)(d).b * S + (size_t)(d).n * 256 + 64 * (j) + sr) * AW + (d).h * HD + sc; \
    sr_[i].vs0 = *(const bf16x8*)(Vg + _o); sr_[i].vs1 = *(const bf16x8*)(Vg + _o + (size_t)32 * AW); sr_[i].ks0 = *(const bf16x8*)(Kg + _o); sr_[i].ks1 = *(const bf16x8*)(Kg + _o + (size_t)32 * AW); } while (0)
#define SWRITE(bb, i) do { *(bf16x8*)((char*)V_lds + (bb) * SHM_V + vst0) = sr_[i].vs0;          \
    *(bf16x8*)((char*)V_lds + (bb) * SHM_V + vst1) = sr_[i].vs1; const int kc = sc * 2;               \
    *(bf16x8*)((char*)K_lds + (bb) * SHM_K + KSWZ(sr, kc)) = sr_[i].ks0;                       \
    *(bf16x8*)((char*)K_lds + (bb) * SHM_K + KSWZ(32 + sr, kc)) = sr_[i].ks1; } while (0)
#define RESC(a) do { if (__any((a) < 1.f)) { if (hi == 0) al_l[r32] = (a); asm volatile("s_waitcnt lgkmcnt(0)" ::: "memory"); \
    _Pragma("unroll") for (int d = 0; d < 4; ++d) _Pragma("unroll") for (int r = 0; r < 16; ++r) o[d][r] *= al_l[crow(r, hi)]; } } while (0)
#define LANEQ(d, tq, prow) do { int _ks = 3; bool _v = true; \
    if ((d).own) tq = (d).n * 256 + wid * 32 + r32; \
    else { const int _idx = (d).chunk * 256 + wid * 32 + r32; _v = _idx < (d).cnt; \
      const unsigned _e = AL[(size_t)((d).b * NH + (d).h) * ALIST_PER_BH + alist_off((d).n) + (_v ? _idx : (d).chunk * 256)]; tq = (int)(_e >> 2); _ks = (int)(_e & 3u); } \
    prow = _v ? (int)((((size_t)(d).b * S + tq) * NH + (d).h) * 4 + _ks) : -1; } while (0)
#define QLOAD(d, tq) do { const bf16_t* _q = Qg + ((size_t)(d).b * S + (size_t)(tq)) * AW + (d).h * HD + hi * 8; \
    _Pragma("unroll") for (int d0 = 0; d0 < 8; ++d0) qr[d0] = *(const bf16x8*)(_q + d0 * 16); } while (0)
#define SLR(d) (exp2f(-(float)((d).h + 1)) / SCALE)
#define TJ(d, j) ((d).own ? (j) : 3 - (j))
#define BQ(j) (slr * (float)(dc.n * 256 + 64 * TJ(dc, j) + 4 * hi - tq_c))
#define LIM(j) (wid * 32 + r32 - 64 * (j) - 4 * hi)
#define QKT(p0, p1, buf, j) do { qkt_init(p0, p1, BQ(j), slr); if (dc.own) { int _lim = LIM(j); asm volatile("" : "+v"(_lim)); qkt_mask(p0, p1, _lim); } qkt_mma(p0, p1, buf, qr, r32, hi); } while (0)
#define EPILOGUE() do { const float _lse = m_reg * C + __builtin_amdgcn_logf(l_reg); int* dst_l = (int*)al_l; \
    if (hi == 0) { li_l[r32] = l_reg; dst_l[r32] = prow_p; if (prow_p >= 0) LSE[prow_p] = _lse; } \
    asm volatile("s_waitcnt lgkmcnt(0)" ::: "memory"); \
    _Pragma("unroll") for (int r0 = 0; r0 < 16; r0 += 8) { float _lv[8]; int _pv[8];     \
      _Pragma("unroll") for (int q = 0; q < 8; ++q) { const int rr = crow(r0 + q, hi); _lv[q] = li_l[rr]; _pv[q] = dst_l[rr]; } \
      _Pragma("unroll") for (int q = 0; q < 8; ++q) asm volatile("" : "+v"(_lv[q]), "+v"(_pv[q])); \
      _Pragma("unroll") for (int q = 0; q < 8; ++q) { const int r = r0 + q; const float rl = __builtin_amdgcn_rcpf(_lv[q]); const int pr = _pv[q]; \
        if (pr >= 0) { _Pragma("unroll") for (int d0 = 0; d0 < 4; ++d0) PART[(size_t)pr * HD + d0 * 32 + r32] = (bf16_t)cvt_pk_bf16(o[d0][r] * rl, 0.f); } } } \
    asm volatile("s_waitcnt lgkmcnt(0)" ::: "memory"); \
    m_reg = -1e30f; l_reg = 0.f; _Pragma("unroll") for (int d = 0; d < 4; ++d) _Pragma("unroll") for (int r = 0; r < 16; ++r) o[d][r] = 0.f; } while (0)

  LAS int* dtab = (LAS int*)ipre + 1664;
  if (tid < 64) { const int i = F.vcu + tid * F.G; if (i < ntot) { const Desc d = decode(i, ipre, nsel, ac); *(LAS i32x4*)(dtab + 4 * tid) = (i32x4){(d.b << 8) | (d.h << 5) | d.n, d.chunk, d.cnt, d.own}; } }
  __syncthreads();
#define DESC_AT(K, D) do { const i32x4 _q = *(const LAS i32x4*)(dtab + 4 * (K)); (D).b = _q[0] >> 8; (D).h = (_q[0] >> 5) & 7; (D).n = _q[0] & 31; (D).chunk = _q[1]; (D).cnt = _q[2]; (D).own = _q[3]; } while (0)
  int kit = 0;
  Desc dc; DESC_AT(0, dc); Desc dn = dc;
  int tq_c, prow_c, tq_n = 0, prow_n = -1, prow_p = -1;
  LANEQ(dc, tq_c, prow_c);
  float m_reg = -1e30f, l_reg = 0.f; f32x16 o[4] = {}; bf16x8 qr[8];
  QLOAD(dc, tq_c);
  float slr = SLR(dc);
  f32x16 pA0, pA1, pB0, pB1; float mnA, mnB, alA = 1.f, alB = 1.f; bf16x8 pa0, pa1, pa2, pa3;
  constexpr int SE = 0, SO = 1;
  SLOADX(SE, dc, TJ(dc, 0)); SLOADX(SO, dc, TJ(dc, 1));
  SWRITE(0, SE); __syncthreads();
  bool first = true;
  for (;;) {
    const bool has_next = (it + F.G) < ntot;
    SBAR(); QKT(pA0, pA1, (const char*)K_lds, 0);
    if (!first) finishSM(pB0, pB1, alB, l_reg, pa0, pa1, pa2, pa3);
    SBAR(); SLOADX(SE, dc, TJ(dc, 2)); SBAR();
    if (!first) { pv_d0(o, vb0 + (int)SHM_V, pa0, pa1, pa2, pa3); EPILOGUE(); }
    partialSM(pA0, pA1, m_reg, mnA, alA);
    __syncthreads(); SWRITE(1, SO);
    __syncthreads();
    SBAR(); QKT(pB0, pB1, (const char*)K_lds + SHM_K, 1);
    finishSM(pA0, pA1, alA, l_reg, pa0, pa1, pa2, pa3);
    SBAR(); SLOADX(SO, dc, TJ(dc, 3));
    if (has_next) { DESC_AT(kit + 1, dn); LANEQ(dn, tq_n, prow_n); }
    SBAR();
    pv_d0(o, vb0, pa0, pa1, pa2, pa3); partialSM(pB0, pB1, m_reg, mnB, alB);
    __syncthreads(); SWRITE(0, SE);
    RESC(alB); __syncthreads();
    SBAR(); QKT(pA0, pA1, (const char*)K_lds, 2);
    finishSM(pB0, pB1, alB, l_reg, pa0, pa1, pa2, pa3);
    SBAR(); if (has_next) SLOADX(SE, dn, TJ(dn, 0)); SBAR();
    pv_d0(o, vb0 + (int)SHM_V, pa0, pa1, pa2, pa3); partialSM(pA0, pA1, m_reg, mnA, alA);
    __syncthreads(); SWRITE(1, SO);
    RESC(alA); __syncthreads();
    SBAR(); QKT(pB0, pB1, (const char*)K_lds + SHM_K, 3);
    finishSM(pA0, pA1, alA, l_reg, pa0, pa1, pa2, pa3);
    SBAR(); if (has_next) { SLOADX(SO, dn, TJ(dn, 1)); QLOAD(dn, tq_n); } SBAR();
    pv_d0(o, vb0, pa0, pa1, pa2, pa3); partialSM(pB0, pB1, m_reg, mnB, alB);
    __syncthreads(); if (has_next) SWRITE(0, SE);
    RESC(alB); __syncthreads();
    prow_p = prow_c;
    if (!has_next) break;
    dc = dn; tq_c = tq_n; prow_c = prow_n; slr = SLR(dc); first = false; it += F.G; ++kit;
  }
  finishSM(pB0, pB1, alB, l_reg, pa0, pa1, pa2, pa3); SBAR();
  pv_d0(o, vb0 + (int)SHM_V, pa0, pa1, pa2, pa3);
  EPILOGUE();
  __syncthreads();
#undef DESC_AT
#undef SLOADX
#undef SWRITE
#undef RESC
#undef LANEQ
#undef QLOAD
#undef SLR
#undef BQ
#undef LIM
#undef TJ
#undef QKT
#undef EPILOGUE
}

__device__ __forceinline__ void combine_token(Frame& F, int t, const f32x4 ls, const float* lse_next, f32x4& lsn) {
  const int lane = F.lane, h = lane >> 3, c8 = lane & 7;
  const bf16_t* PART = (const bf16_t*)((unsigned char*)F.out) + ((size_t)t * NH + h) * 4 * HD + 16 * c8;
  const int j = (t & (S - 1)) >> 8;
  float l[4]; bool ok[4]; float M = -3.0e38f;
#pragma unroll
  for (int k = 0; k < 4; ++k) { ok[k] = ((k == 3) || (k < j)) && ls[k] > -1.0e37f; l[k] = ok[k] ? ls[k] : -3.0e38f; M = fmaxf(M, l[k]); }
  u32x4 v[4][2];
#pragma unroll
  for (int k = 0; k < 4; ++k) { v[k][0] = (u32x4){0u, 0u, 0u, 0u}; v[k][1] = (u32x4){0u, 0u, 0u, 0u}; if (ok[k]) { v[k][0] = *(const u32x4*)(PART + (size_t)k * HD); v[k][1] = *(const u32x4*)(PART + (size_t)k * HD + 8); } }
  const u32x4* yr = (const u32x4*)((const bf16_t*)(F.ws + WS_YCAT) + (size_t)t * 2048) + lane; const u32x4 r0 = yr[0], r1 = yr[64];
  lsn = *(const f32x4*)lse_next;
  float acc[16]; float den = 0.f;
#pragma unroll
  for (int e = 0; e < 16; ++e) acc[e] = 0.f;
#pragma unroll
  for (int k = 0; k < 4; ++k) { const float w = ok[k] ? __builtin_amdgcn_exp2f(l[k] - M) : 0.f; den += w;
    const u32x4 a = v[k][0], b = v[k][1];
    acc[0] += w * bf_lo(a.x); acc[1] += w * bf_hi(a.x); acc[2] += w * bf_lo(a.y); acc[3] += w * bf_hi(a.y); acc[4] += w * bf_lo(a.z); acc[5] += w * bf_hi(a.z); acc[6] += w * bf_lo(a.w); acc[7] += w * bf_hi(a.w);
    acc[8] += w * bf_lo(b.x); acc[9] += w * bf_hi(b.x); acc[10] += w * bf_lo(b.y); acc[11] += w * bf_hi(b.y); acc[12] += w * bf_lo(b.z); acc[13] += w * bf_hi(b.z); acc[14] += w * bf_lo(b.w); acc[15] += w * bf_hi(b.w); }
  const float rd = __builtin_amdgcn_rcpf(den); float mxa = 0.f;
#pragma unroll
  for (int e = 0; e < 16; ++e) { acc[e] *= rd; mxa = fmaxf(mxa, fabsf(acc[e])); }
  float mxr = 0.f;
  { const unsigned w[8] = {r0.x, r0.y, r0.z, r0.w, r1.x, r1.y, r1.z, r1.w};
#pragma unroll
    for (int e = 0; e < 8; ++e) mxr = fmaxf(mxr, fmaxf(fabsf(bf_lo(w[e])), fabsf(bf_hi(w[e])))); }
#pragma unroll
  for (int o = 1; o < 64; o <<= 1) { mxa = fmaxf(mxa, __shfl_xor(mxa, o)); mxr = fmaxf(mxr, __shfl_xor(mxr, o)); }
  const float qa = 127.f / fmaxf(mxa, 1e-30f), qr = 127.f / fmaxf(mxr, 1e-30f);
  unsigned char* yc = F.ws + WS_YC8 + (size_t)t * 2048; float* rs = (float*)(F.ws + WS_RS1) + 2 * (size_t)t;
  if (lane == 0) { rs[0] = mxr * (1.f / 127.f); rs[1] = mxa * (1.f / 127.f); }
  { u32x2 w; w.x = pk4_i8(bf_lo(r0.x) * qr, bf_hi(r0.x) * qr, bf_lo(r0.y) * qr, bf_hi(r0.y) * qr); w.y = pk4_i8(bf_lo(r0.z) * qr, bf_hi(r0.z) * qr, bf_lo(r0.w) * qr, bf_hi(r0.w) * qr); *((u32x2*)yc + lane) = w;
    w.x = pk4_i8(bf_lo(r1.x) * qr, bf_hi(r1.x) * qr, bf_lo(r1.y) * qr, bf_hi(r1.y) * qr); w.y = pk4_i8(bf_lo(r1.z) * qr, bf_hi(r1.z) * qr, bf_lo(r1.w) * qr, bf_hi(r1.w) * qr); *((u32x2*)yc + 64 + lane) = w; }
  { u32x4 w; w.x = pk4_i8(acc[0] * qa, acc[1] * qa, acc[2] * qa, acc[3] * qa); w.y = pk4_i8(acc[4] * qa, acc[5] * qa, acc[6] * qa, acc[7] * qa);
    w.z = pk4_i8(acc[8] * qa, acc[9] * qa, acc[10] * qa, acc[11] * qa); w.w = pk4_i8(acc[12] * qa, acc[13] * qa, acc[14] * qa, acc[15] * qa);
    *(u32x4*)(yc + 1024 + h * HD + 16 * c8) = w; }
}
}
__device__ __forceinline__ void router_iter(Frame& F, int it) {
    const int lane = F.lane, wave = F.wave, r16 = lane & 15, q4 = lane >> 4;
    const int tok0 = it * 128 + wave * 16, tok = tok0 + r16;
    const float* WR = (const float*)(F.ws + WS_WR_T); const float* gf = F.in[13];
    LAS float* stg = (LAS float*)(F.lds + wave * 8192);
    constexpr int WRB_OFF = 65536, WRB_BYTES = 48 * 512;
    f32x4 c0 = {0.f, 0.f, 0.f, 0.f}, c1 = c0, c2 = c0; float ss = 0.f;
    const int hrow = lane >> 5, u32i = lane & 31;
    f32x4 xv[8]; u32x2 dv[8]; f32x4 gq;
#define RT_ROWS(C) do { _Pragma("unroll") for (int j = 0; j < 8; ++j) { const size_t off = (size_t)(tok0 + 2 * j + hrow) * D + 128 * (C) + 4 * u32i; \
        xv[j] = *(const f32x4*)(F.in[0] + off); dv[j] = *(const u32x2*)((const bf16_t*)(F.ws + WS_DELTA) + off); } gq = *(const f32x4*)(gf + 128 * (C) + 4 * u32i); } while (0)
#define RT_WDMA(C, BUF) do { _Pragma("unroll") for (int i = 0; i < 3; ++i) { const int q = wave * 3 + i, p = 64 * q + lane, row = p >> 5, c16 = p & 31; \
        __builtin_amdgcn_global_load_lds((const unsigned*)(WR + (size_t)row * D + 128 * (C) + 4 * (c16 ^ (row & 15))), (LAS unsigned*)(F.lds + WRB_OFF + (BUF) * WRB_BYTES + q * 1024), 16, 0, 0); } } while (0)
    RT_ROWS(0); RT_WDMA(0, 0);
#pragma unroll 1
    for (int c = 0; c < 16; ++c) {
        asm volatile("s_waitcnt vmcnt(0)" ::: "memory");
        __syncthreads();
        const f32x4 g = gq;
#pragma unroll
        for (int j = 0; j < 8; ++j) { const int r = 2 * j + hrow; const size_t off = (size_t)(tok0 + r) * D + 128 * c + 4 * u32i;
            f32x4 a = xv[j]; a.x += bf_lo(dv[j].x); a.y += bf_hi(dv[j].x); a.z += bf_lo(dv[j].y); a.w += bf_hi(dv[j].y);
            u32x2 xw; xw.x = cvt_pk_bf16(a.x, a.y); xw.y = cvt_pk_bf16(a.z, a.w);
            *(u32x2*)((bf16_t*)(F.ws + WS_DELTA) + off) = xw;
            *(unsigned*)((unsigned char*)(F.ws + WS_H2) + off) = pk4_q<QM_UP>(a.x * g.x * Q_SA_UP, a.y * g.y * Q_SA_UP, a.z * g.z * Q_SA_UP, a.w * g.w * Q_SA_UP);
            *(LAS f32x4*)(stg + r * 128 + 4 * (u32i ^ (r & 15))) = a; }
        { const int cn = (c < 15) ? c + 1 : 15; RT_ROWS(cn); RT_WDMA(cn, (c + 1) & 1); }
        __builtin_amdgcn_sched_barrier(0);
        const LAS float* wb = (const LAS float*)(F.lds + WRB_OFF + (c & 1) * WRB_BYTES);
#pragma unroll
        for (int s4 = 0; s4 < 4; ++s4) { const int u = 8 * s4 + 2 * q4, ua = 4 * (u ^ r16), ub = 4 * ((u + 1) ^ r16);
            const f32x4 a0 = *(const LAS f32x4*)(stg + r16 * 128 + ua), a1 = *(const LAS f32x4*)(stg + r16 * 128 + ub);
            ss += (a0.x * a0.x + a0.y * a0.y) + (a0.z * a0.z + a0.w * a0.w) + (a1.x * a1.x + a1.y * a1.y) + (a1.z * a1.z + a1.w * a1.w);
            const f32x4 w00 = *(const LAS f32x4*)(wb + r16 * 128 + ua), w01 = *(const LAS f32x4*)(wb + r16 * 128 + ub);
            const f32x4 w10 = *(const LAS f32x4*)(wb + (16 + r16) * 128 + ua), w11 = *(const LAS f32x4*)(wb + (16 + r16) * 128 + ub);
            const f32x4 w20 = *(const LAS f32x4*)(wb + (32 + r16) * 128 + ua), w21 = *(const LAS f32x4*)(wb + (32 + r16) * 128 + ub);
#pragma unroll
            for (int e = 0; e < 4; ++e) { c0 = __builtin_amdgcn_mfma_f32_16x16x4f32(a0[e], w00[e], c0, 0, 0, 0); c1 = __builtin_amdgcn_mfma_f32_16x16x4f32(a0[e], w10[e], c1, 0, 0, 0); c2 = __builtin_amdgcn_mfma_f32_16x16x4f32(a0[e], w20[e], c2, 0, 0, 0); }
#pragma unroll
            for (int e = 0; e < 4; ++e) { c0 = __builtin_amdgcn_mfma_f32_16x16x4f32(a1[e], w01[e], c0, 0, 0, 0); c1 = __builtin_amdgcn_mfma_f32_16x16x4f32(a1[e], w11[e], c1, 0, 0, 0); c2 = __builtin_amdgcn_mfma_f32_16x16x4f32(a1[e], w21[e], c2, 0, 0, 0); } }
    }
    asm volatile("s_waitcnt vmcnt(0)" ::: "memory");
    __syncthreads();
#undef RT_ROWS
#undef RT_WDMA
    ss += __shfl_xor(ss, 16); ss += __shfl_xor(ss, 32);
    const float rinv = rsqrtf(ss * (1.f / D) + RMS_EPS);
    LAS float* lg = stg; LAS int* hist = (LAS int*)(F.lds + TAB_OFF); LAS int* gbase = hist + 32;
    if (F.tid < 32) hist[F.tid] = 0;
#pragma unroll
    for (int r = 0; r < 4; ++r) { const int trow = 4 * q4 + r; lg[trow * 40 + r16] = c0[r]; lg[trow * 40 + 16 + r16] = c1[r]; if (r16 < 4) lg[trow * 40 + 32 + r16] = c2[r]; }
    __syncthreads();
    int ex[2] = {0, 0}, sl[2] = {0, 0}; float wt[2] = {0.f, 0.f};
    if (lane < 16) {
        const float* bg = F.in[15]; const float* be = F.in[17];
        float gl[4]; int gi = 0;
#pragma unroll
        for (int g = 0; g < 4; ++g) gl[g] = rinv * lg[lane * 40 + 32 + g] + bg[g];
        float gm = gl[0];
#pragma unroll
        for (int g = 1; g < 4; ++g) if (gl[g] > gm) { gm = gl[g]; gi = g; }
        float gs = 0.f;
#pragma unroll
        for (int g = 0; g < 4; ++g) gs += __expf(gl[g] - gm);
        const float gw = 1.0f / gs;
        float el[8];
#pragma unroll
        for (int e = 0; e < 8; ++e) el[e] = rinv * lg[lane * 40 + gi * 8 + e] + be[gi * 8 + e];
        int i1 = 0; float m1 = el[0];
#pragma unroll
        for (int e = 1; e < 8; ++e) if (el[e] > m1) { m1 = el[e]; i1 = e; }
        int i2 = -1; float m2 = -3.0e38f;
#pragma unroll
        for (int e = 0; e < 8; ++e) if (e != i1 && el[e] > m2) { m2 = el[e]; i2 = e; }
        const float e2 = __expf(m2 - m1), w1 = 1.0f / (1.0f + e2), w2 = e2 * w1;
        ex[0] = gi * 8 + i1; ex[1] = gi * 8 + i2; wt[0] = gw * w1; wt[1] = gw * w2;
        sl[0] = __hip_atomic_fetch_add(hist + ex[0], 1, __ATOMIC_RELAXED, __HIP_MEMORY_SCOPE_WORKGROUP);
        sl[1] = __hip_atomic_fetch_add(hist + ex[1], 1, __ATOMIC_RELAXED, __HIP_MEMORY_SCOPE_WORKGROUP);
    }
    __syncthreads();
    if (F.tid < 32) gbase[F.tid] = (int)atomicAdd(F.ctl + CW_ECNT + F.tid, (unsigned)hist[F.tid]);
    __syncthreads();
    if (lane < 16) {
        int* MTOK = (int*)(F.ws + WS_MTOK); int* MDST = (int*)(F.ws + WS_MDST); float* MW = (float*)(F.ws + WS_MW); float* MRS = (float*)(F.ws + WS_MRS);
#pragma unroll
        for (int k = 0; k < 2; ++k) { const size_t p = (size_t)ex[k] * T + gbase[ex[k]] + sl[k]; MTOK[p] = tok; MDST[p] = k * T + tok; MW[p] = wt[k]; MRS[p] = rinv; }
    }
    __syncthreads();
}
constexpr int N_PHASES = 14;
struct Args { const float* in[22]; float* out; unsigned char* ws; int ph_lo, ph_hi, use_bar, pad; };
__global__ void __launch_bounds__(NTHR, 2) fwd(Args args) {
    extern __shared__ __attribute__((aligned(16))) unsigned char lds[];
    Frame F;
    F.lds = (LAS unsigned char*)lds; F.MISC = (volatile LAS unsigned*)(F.lds + MISC_OFF);
    F.tid = threadIdx.x; F.lane = F.tid & 63; F.wave = __builtin_amdgcn_readfirstlane(F.tid >> 6);
    F.G = gridDim.x; { const int bx = blockIdx.x; F.vcu = (F.G % 8 == 0) ? (bx % 8) * (F.G / 8) + bx / 8 : bx; }
    F.ws = args.ws; F.out = args.out; F.ctl = (unsigned*)(args.ws + WS_CTL);
#pragma unroll
    for (int i = 0; i < 22; ++i) F.in[i] = args.in[i];
    if (F.tid < 64) F.MISC[F.tid] = 0u;
    __syncthreads();
    XcdBarrier bar; bar.bar = F.ctl + CW_BAR; bar.x = 0; bar.st = nullptr;
    if (args.use_bar) bar = xcd_barrier_post(F.ctl + CW_BAR, F.MISC + 8);
    const int lo = args.ph_lo, hi = args.ph_hi;
#define IN(k) (lo <= (k) && (k) < hi)
#define SEAM(k) do { if (IN(k) && IN((k) + 1)) xcd_barrier(bar); } while (0)

    if (IN(0)) { p0_prologue(F); __syncthreads(); }
    SEAM(0);
    if (IN(1)) {
        const pg8::EpiIn E0{(bf16_t*)(F.ws + WS_XREC), (bf16_t*)(F.ws + WS_GREC), (bf16_t*)(F.ws + WS_Q), (bf16_t*)(F.ws + WS_K), (bf16_t*)(F.ws + WS_V), (bf16_t*)(F.ws + WS_SGR), (bf16_t*)(F.ws + WS_SGA), 1.0f, IN_BF,
            TrSrc{F.in[2], F.in[10], F.in[11], F.in[12], F.in[18], F.in[19], F.in[20], F.ws}, F.vcu, F.G};
        if (IN_NBF > 0) {
            pg8::DenseProbT<0> P{(const void*)(F.ws + WS_XN), (const void*)(F.ws + WS_WIN_T), D, D, D};
            pg8::StaticOrder So; So.init(T, IN_NBF * 256, F.G, (int)blockIdx.x);
            pg8::gemm_phase<pg8::DenseProbT<0>, pg8::EpiIn, pg8::StaticOrder, true>(F.lds, P, So, E0);
        }
        if (IN_NF8 > 0) {
            pg8::DenseProbT<QM_IN> P{(const void*)F.out, (const void*)(F.ws + WS_WIN8), D, D, D};
            pg8::StaticOrder So; So.init(T, IN_NF8 * 256, F.G, (int)blockIdx.x);
            pg8::EpiIn E = E0; E.osc = 1.0f / (Q_SA_IN * Q_SB_IN); E.mask = IN_F8;
            pg8::gemm_phase<pg8::DenseProbT<QM_IN>, pg8::EpiIn, pg8::StaticOrder, true>(F.lds, P, So, E);
        }
    }
    SEAM(1);
    if (IN(2)) {
#if EN_ATTN
        for (int u = F.vcu; u < NB * NH * NBLK; u += F.G) kmean_unit(F, u);
#endif
        for (int u = F.vcu; u < NB * NBLK * 4; u += F.G) { const int b = u >> 7, chunk = (u >> 2) & 31, cq = u & 3;
            scan_unit<false>(F, b, chunk, cq);
            asm volatile("s_waitcnt vmcnt(0)" ::: "memory");
            __syncthreads();
            unsigned* fl = F.ctl + CW_SFLAG + (b * NBLK) * 4 + cq;
            if (F.tid == 0) (void)xb_add(fl + chunk * 4, 1u);
            if (F.lane < chunk) { unsigned sp = 0u; while (xb_ld(fl + F.lane * 4) == 0u) { __builtin_amdgcn_s_sleep(1); if (++sp > (1u << 22)) break; } }
            asm volatile("s_waitcnt vmcnt(0)" ::: "memory");
            scan_fix(F, (((b * NBLK) + chunk) << 5) | (cq * 8 + F.wave));
            asm volatile("s_waitcnt vmcnt(0)" ::: "memory"); __syncthreads();
        }
    }
    SEAM(2);
    if (IN(3)) {
#if EN_ATTN
        route_phase(F);
#endif
        __syncthreads();
    }
    SEAM(3);
    if (IN(4)) {
#if EN_ATTN
        LAS int* ipre = (LAS int*)(F.lds + TAB_OFF); LAS int* tmp = ipre + 1040; LAS int* lb = tmp + 512;
        const int t = F.tid; const unsigned* ac = F.ctl + CW_ACNT;
        const int v0 = ((int)ac[2 * t] + 255) >> 8, v1 = ((int)ac[2 * t + 1] + 255) >> 8;
        tmp[t] = v0 + v1;
        __syncthreads();
        if (t < 64) { int w = 0;
#pragma unroll
            for (int i = 0; i < 8; ++i) w += tmp[t * 8 + i];
            int inc = w;
#pragma unroll
            for (int o = 1; o < 64; o <<= 1) { const int y = __shfl_up(inc, o); if (t >= o) inc += y; }
            lb[t] = inc - w; }
        __syncthreads();
        { int base = lb[t >> 3]; for (int u2 = (t & ~7); u2 < t; ++u2) base += tmp[u2];
          ipre[2 * t] = base; ipre[2 * t + 1] = base + v0; if (t == NTHR - 1) ipre[1024] = base + v0 + v1; }
        __syncthreads();
        const int nitems = ipre[1024];
        att::phase(F, ipre, nitems, ac);
#endif
    }
    SEAM(4);
    if (IN(5)) {
#if EN_ATTN
        { const float* LSE = (const float*)(F.ws + WS_LSE) + (size_t)(F.lane >> 3) * 4; int t = F.vcu * NWAVES + F.wave;
          f32x4 ls = *(const f32x4*)(LSE + (size_t)t * NH * 4); asm volatile("" : "+v"(ls));
          for (; t < T; t += F.G * NWAVES) { const int tn = (t + F.G * NWAVES < T) ? t + F.G * NWAVES : t; f32x4 lsn; att::combine_token(F, t, ls, LSE + (size_t)tn * NH * 4, lsn); ls = lsn; } }
#endif
    }
    SEAM(5);
    if (IN(7)) {
        pg8::StaticOrder So; So.init(T, D, F.G, (int)blockIdx.x);
        { pg8::DenseProbT<2> P{(const void*)(F.ws + WS_YC8), (const void*)(F.ws + WS_WP_T), 1024, 2048, 2048};
          pg8::EpiGate<false> E{(const unsigned char*)(F.ws + WS_SGR), (bf16_t*)(F.ws + WS_MERGED), (const float*)(F.ws + WS_RS1), 2, 1.0f / (I8_SP * 255.f)};
          pg8::gemm_phase<pg8::DenseProbT<2>, pg8::EpiGate<false>, pg8::StaticOrder, true>(F.lds, P, So, E); }
#if EN_ATTN
        { pg8::DenseProbT<2> P{(const void*)(F.ws + WS_YC8 + 1024), (const void*)(F.ws + WS_WP_T + 1024), 1024, 2048, 2048};
          pg8::EpiGate<true> E{(const unsigned char*)(F.ws + WS_SGA), (bf16_t*)(F.ws + WS_MERGED), (const float*)(F.ws + WS_RS1) + 1, 2, 1.0f / (I8_SP * 255.f)};
          pg8::gemm_phase<pg8::DenseProbT<2>, pg8::EpiGate<true>, pg8::StaticOrder, true>(F.lds, P, So, E); }
#endif
    }
    SEAM(7);
    if (IN(8)) {
        for (int t = F.vcu * NWAVES + F.wave; t < T; t += F.G * NWAVES) quant_row<false>(F, (const bf16_t*)(F.ws + WS_MERGED), F.ws + WS_MG8, (float*)(F.ws + WS_RS2), t);
    }
    SEAM(8);
    if (IN(9)) {
        pg8::DenseProbT<2> P{(const void*)(F.ws + WS_MG8), (const void*)(F.ws + WS_WOUT_T), D, D, D};
        pg8::StaticOrder So; So.init(T, D, F.G, (int)blockIdx.x);
        pg8::EpiResid E{(bf16_t*)(F.ws + WS_DELTA), (const float*)(F.ws + WS_RS2), 1.0f / I8_SB};
        pg8::gemm_phase<pg8::DenseProbT<2>, pg8::EpiResid, pg8::StaticOrder, true>(F.lds, P, So, E);
    }
    SEAM(9);
    if (IN(10)) {
#if EN_MOE
        for (int it = F.vcu; it < T / 128; it += F.G) router_iter(F, it);
#endif
    }
    SEAM(10);
#if EN_MOE
    LAS int* tpre = (LAS int*)(F.lds + TAB_OFF); LAS int* ecnt = tpre + 40;
    if (IN(11) || IN(12)) {
        if (F.tid == 0) { int a = 0; for (int e = 0; e < NE; ++e) { const int c = (int)F.ctl[CW_ECNT + e]; ecnt[e] = c; tpre[e] = a; a += (c + 255) >> 8; } tpre[NE] = a; }
        __syncthreads();
    }
#endif
    if (IN(11)) {
#if EN_MOE
        pg8::MoeUpProbT<QM_UP> P{(const void*)(F.ws + WS_H2), (const void*)(F.ws + WS_WGU_T), (const int*)(F.ws + WS_MTOK), D, D, D};
        pg8::GroupedOrder So{tpre, ecnt, 4, F.G, F.vcu};
        pg8::EpiHid E{(const float*)(F.ws + WS_MRS), (void*)(F.ws + WS_HID), QM_UP ? 1.0f / (Q_SA_UP * Q_SB_UP) : 1.0f};
        pg8::gemm_phase<pg8::MoeUpProbT<QM_UP>, pg8::EpiHid, pg8::GroupedOrder, true>(F.lds, P, So, E);
#endif
    }
    SEAM(11);
    if (IN(12)) {
#if EN_MOE
        pg8::MoeDownProbT<QM_DOWN> P{(const void*)(F.ws + WS_HID), (const void*)(F.ws + WS_WD_T), EH, EH, EH};
        pg8::GroupedOrder So{tpre, ecnt, 8, F.G, F.vcu};
        pg8::EpiDown E{(const int*)(F.ws + WS_MDST), (const float*)(F.ws + WS_MW), (unsigned char*)(F.ws + WS_Y), FP8_DOWN ? 1.0f / (FP8_SH * FP8_SD) : 1.0f};
        pg8::gemm_phase<pg8::MoeDownProbT<QM_DOWN>, pg8::EpiDown, pg8::GroupedOrder, true>(F.lds, P, So, E);
#endif
    }
    SEAM(12);
    if (IN(13)) final_norm(F);
#undef IN
#undef SEAM
}

extern "C" void kernel_launch(void* const* d_in, const int* in_sizes, int n_in, void* d_out, int out_size, void* d_ws, size_t ws_size, hipStream_t stream) {
    static int grid = 0;
    if (grid == 0) {
        if (n_in != 22 || in_sizes[0] != T * D || out_size != T * D || ws_size < WS_END) { fprintf(stderr, "kernel_launch: shape / workspace mismatch (n_in %d, ws %zu)\n", n_in, ws_size); grid = -1; return; }
        int dev = 0, cus = 0, per_cu = 0;
        if (hipGetDevice(&dev) != hipSuccess || hipDeviceGetAttribute(&cus, hipDeviceAttributeMultiprocessorCount, dev) != hipSuccess) { grid = -1; return; }
        if (hipFuncSetAttribute((const void*)fwd, hipFuncAttributeMaxDynamicSharedMemorySize, LDS_BYTES) != hipSuccess) { fprintf(stderr, "kernel_launch: hipFuncSetAttribute failed\n"); grid = -1; return; }
        if (hipOccupancyMaxActiveBlocksPerMultiprocessor(&per_cu, (const void*)fwd, NTHR, LDS_BYTES) != hipSuccess || per_cu < 1) { fprintf(stderr, "kernel_launch: occupancy query says %d blocks per CU\n", per_cu); }
        (void)hipGetLastError();
        grid = cus;
    }
    if (grid < 0) return;
    (void)hipMemsetAsync((char*)d_ws + WS_CTL, 0, CTL_ZERO_BYTES, stream);
    Args a{};
    for (int i = 0; i < 22; ++i) a.in[i] = (const float*)d_in[i];
    a.out = (float*)d_out; a.ws = (unsigned char*)d_ws; a.pad = 0;
#if MK_N_LAUNCHES == 1
    a.ph_lo = 0; a.ph_hi = N_PHASES; a.use_bar = 1;
    hipLaunchKernelGGL(fwd, dim3(grid), dim3(NTHR), LDS_BYTES, stream, a);
#else
    for (int p = 0; p < N_PHASES; ++p) { a.ph_lo = p; a.ph_hi = p + 1; a.use_bar = 0; hipLaunchKernelGGL(fwd, dim3(grid), dim3(NTHR), LDS_BYTES, stream, a); }
#endif
}
```

```cpp
#include <hip/hip_runtime.h>
#include <stdint.h>
#include <cstdio>

#ifndef MK_N_LAUNCHES
#define MK_N_LAUNCHES 1
#endif
#ifndef EN_ATTN
#define EN_ATTN 1
#endif
#ifndef EN_MOE
#define EN_MOE 1
#endif

#define LAS __attribute__((address_space(3)))
#define GAS __attribute__((address_space(1)))
typedef unsigned short bf16_t;
typedef short bf16x8 __attribute__((ext_vector_type(8)));
typedef short s16x4 __attribute__((ext_vector_type(4)));
typedef float f32x2 __attribute__((ext_vector_type(2)));
typedef float f32x4 __attribute__((ext_vector_type(4)));
typedef float f32x16 __attribute__((ext_vector_type(16)));
typedef unsigned u32x2 __attribute__((ext_vector_type(2)));
typedef unsigned u32x4 __attribute__((ext_vector_type(4)));
typedef int i32x4 __attribute__((ext_vector_type(4)));
typedef int i32x8 __attribute__((ext_vector_type(8)));

constexpr int NB = 4, S = 8192, T = NB * S, D = 2048;
constexpr int LW = 1024, NLB = 8, LBD = 128;
constexpr int NH = 8, HD = 128, AW = NH * HD, MBLK = 256, NBLK = S / MBLK;
constexpr int NE = 32, NG = 4, EPG = 8, EH = 512;
constexpr int INW = 2 * LW + 3 * AW + 2 * D;
constexpr float RMS_EPS = 1e-6f;
constexpr int NWAVES = 8, NTHR = 512;

constexpr size_t MiB = (size_t)1 << 20;
constexpr size_t WS_CTL = 0, CTL_ZERO_BYTES = 128 * 1024;
constexpr size_t WS_WA_T = 1 * MiB;
constexpr size_t WS_WX_T = WS_WA_T + 256 * 1024;
constexpr size_t WS_WR_T = WS_WX_T + 256 * 1024;
constexpr size_t WS_KMEAN = 2 * MiB;
constexpr size_t WS_SSUM = WS_KMEAN + 512 * 1024;
constexpr size_t WS_KNORM = WS_SSUM + 1024 * 1024;
constexpr size_t WS_KMH = WS_KNORM + 64 * 1024, WS_KML = WS_KMH + 256 * 1024;
constexpr size_t WS_WIN_T = 8 * MiB;
constexpr size_t WS_WP_T = 44 * MiB;
constexpr size_t WS_WOUT_T = 52 * MiB;
constexpr size_t WS_WGU_T = 60 * MiB;
constexpr size_t WS_WD_T = 188 * MiB;
constexpr size_t WS_ALIST = 252 * MiB;
constexpr size_t WS_MTOK = 268 * MiB, WS_MDST = 272 * MiB, WS_MW = 276 * MiB, WS_MRS = 280 * MiB;
constexpr size_t WS_XN = 284 * MiB;
constexpr size_t WS_YCAT = WS_XN, WS_H2 = WS_XN;
constexpr size_t WS_XREC = 412 * MiB, WS_GREC = 476 * MiB;
constexpr size_t WS_MERGED = WS_XREC;
constexpr size_t WS_LSE = 988 * MiB;
constexpr size_t WS_Q = 540 * MiB, WS_K = 604 * MiB, WS_V = 668 * MiB;
constexpr size_t WS_HID = WS_Q;
constexpr size_t WS_YC8 = WS_Q;
constexpr size_t WS_RS1 = WS_K, WS_RS2 = WS_K + 1 * MiB;
constexpr size_t WS_MG8 = WS_V;
constexpr size_t WS_SGR = 732 * MiB, WS_SGA = 860 * MiB;
constexpr size_t WS_Y = WS_SGR;
constexpr size_t WS_DELTA = WS_SGA;
constexpr size_t WS_WIN8 = 988 * MiB;
constexpr size_t WS_END = 1008 * MiB;
constexpr size_t OUT_PART = 0, OUT_LSE = 192 * MiB;
constexpr int ALIST_PER_BH = 256 * 496;
__host__ __device__ constexpr int alist_off(int n) { return 256 * (31 * n - (n * (n - 1)) / 2); }

constexpr int CW_TMO = 0;
constexpr int CW_BAR = 4096;
constexpr int CW_ACNT = 16384;
constexpr int CW_ECNT = 20480;
constexpr int CW_SFLAG = 24576;

constexpr int RING_BYTES = 131072;
constexpr int MISC_OFF = 139264;
constexpr int TAB_OFF = MISC_OFF + 256;
constexpr int LDS_BYTES = 163840;

__device__ __forceinline__ unsigned cvt_pk_bf16(float lo, float hi) { unsigned r; asm volatile("v_cvt_pk_bf16_f32 %0, %1, %2" : "=v"(r) : "v"(lo), "v"(hi)); return r; }
__device__ __forceinline__ float bf_lo(unsigned w) { return __uint_as_float(w << 16); }
__device__ __forceinline__ float bf_hi(unsigned w) { return __uint_as_float(w & 0xffff0000u); }
__device__ __forceinline__ float bf2f(bf16_t v) { return __uint_as_float(((unsigned)v) << 16); }
__device__ __forceinline__ float fsigmoid(float z) { return __builtin_amdgcn_rcpf(1.0f + __builtin_amdgcn_exp2f(-1.4426950408889634f * z)); }
__device__ __forceinline__ float gelu_tanh(float x) { const float u = 1.5957691216057308f * (x + 0.044715f * x * x * x); return x * fsigmoid(u); }
template <int CTRL> __device__ __forceinline__ float dppf(float v) { return __int_as_float(__builtin_amdgcn_update_dpp(0, __float_as_int(v), CTRL, 0xf, 0xf, true)); }
__device__ __forceinline__ void swap16(float v, float& a, float& b) { auto r = __builtin_amdgcn_permlane16_swap(__float_as_uint(v), __float_as_uint(v), false, false); a = __uint_as_float(r[0]); b = __uint_as_float(r[1]); }
__device__ __forceinline__ void swap32(float v, float& a, float& b) { auto r = __builtin_amdgcn_permlane32_swap(__float_as_uint(v), __float_as_uint(v), false, false); a = __uint_as_float(r[0]); b = __uint_as_float(r[1]); }
__device__ __forceinline__ float row_sum(float v) { v += dppf<0xB1>(v); v += dppf<0x4E>(v); v += dppf<0x141>(v); v += dppf<0x140>(v); return v; }
__device__ __forceinline__ float row_max(float v) { v = fmaxf(v, dppf<0xB1>(v)); v = fmaxf(v, dppf<0x4E>(v)); v = fmaxf(v, dppf<0x141>(v)); v = fmaxf(v, dppf<0x140>(v)); return v; }
__device__ __forceinline__ float wave_sum(float v) { float a, b; v = row_sum(v); swap16(v, a, b); v = a + b; swap32(v, a, b); return a + b; }
__device__ __forceinline__ float wave_max(float v) { float a, b; v = row_max(v); swap16(v, a, b); v = fmaxf(a, b); swap32(v, a, b); return fmaxf(a, b); }
#define LDS_WAIT() asm volatile("s_waitcnt lgkmcnt(0)" ::: "memory")
#define VM_WAIT() asm volatile("s_waitcnt vmcnt(0)" ::: "memory")

#define XB_TMO      128
#define XB_XCNT(j)  (256  + 64 * (j))
#define XB_XSUB(j)  (1280 + 64 * (j))
#define XB_XGEN(j)  (2304 + 64 * (j))
#define XB_TOP      3328
#define XB_TOPGEN   3392
#define XCD_BAR_WORDS 3456
#define XB_SPIN_CAP (1u << 18)
__device__ __forceinline__ unsigned xb_ld(unsigned* p)              { return __hip_atomic_load(p, __ATOMIC_RELAXED, __HIP_MEMORY_SCOPE_AGENT); }
__device__ __forceinline__ unsigned xb_add(unsigned* p, unsigned v) { return __hip_atomic_fetch_add(p, v, __ATOMIC_RELAXED, __HIP_MEMORY_SCOPE_AGENT); }
__device__ __forceinline__ unsigned xb_xcc_id() { return (unsigned)__builtin_amdgcn_s_getreg((3 << 11) | 20) & 0xFu; }
#define XB_SPIN(cond, bar) do { unsigned _sp = 0; while (cond) { __builtin_amdgcn_s_sleep(1); \
    if ((++_sp & 255u) == 0u) { if (xb_ld(&(bar)[XB_TMO])) break; if (_sp > XB_SPIN_CAP) { atomicAdd(&(bar)[XB_TMO], 1u); break; } } } } while (0)
struct XcdBarrier { unsigned* bar; unsigned x; volatile LAS unsigned* st; };
__device__ __forceinline__ XcdBarrier xcd_barrier_post(unsigned* bar, volatile LAS unsigned* st) {
    XcdBarrier b; b.bar = bar; b.x = xb_xcc_id(); b.st = st;
    if (threadIdx.x == 0) (void)xb_add(&bar[XB_XCNT(b.x)], 1u);
    return b;
}
__device__ __forceinline__ void xcd_barrier_complete(unsigned* bar, unsigned x, unsigned& nloc, unsigned& nx) {
    const unsigned G = gridDim.x * gridDim.y * gridDim.z;
    unsigned sum, cnt, mine, sp = 0u;
    for (;;) {
        sum = 0u; cnt = 0u; mine = 0u;
#pragma unroll
        for (unsigned j = 0; j < 16; ++j) { const unsigned c = xb_ld(&bar[XB_XCNT(j)]); sum += c; cnt += (c > 0u) ? 1u : 0u; mine = (j == x) ? c : mine; }
        if (sum == G) break;
        __builtin_amdgcn_s_sleep(1);
        if ((++sp & 255u) == 0u) { if (xb_ld(&bar[XB_TMO])) break; if (sp > XB_SPIN_CAP) { atomicAdd(&bar[XB_TMO], 1u); break; } }
    }
    nloc = mine > 0u ? mine : 1u; nx = cnt > 0u ? cnt : 1u;
}
__device__ __forceinline__ void xcd_barrier(const XcdBarrier& b) {
    asm volatile("s_waitcnt vmcnt(0)" ::: "memory");
    __syncthreads();
    if (threadIdx.x == 0) {
        unsigned* bar = b.bar;
        __builtin_amdgcn_s_waitcnt(0);
        unsigned nloc = b.st[0], nx = b.st[1];
        if (nloc == 0u) { xcd_barrier_complete(bar, b.x, nloc, nx); b.st[0] = nloc; b.st[1] = nx; }
        const unsigned old = xb_add(&bar[XB_XSUB(b.x)], 1u);
        const unsigned gen = old / nloc;
        if (old + 1u == (gen + 1u) * nloc) {
            __builtin_amdgcn_fence(__ATOMIC_RELEASE, "agent");
            asm volatile("s_waitcnt vmcnt(0)" ::: "memory");
            const unsigned og = xb_add(&bar[XB_TOP], 1u);
            const unsigned tg = og / nx;
            if (og + 1u == (tg + 1u) * nx) xb_add(&bar[XB_TOPGEN], 1u);
            else XB_SPIN(xb_ld(&bar[XB_TOPGEN]) == tg, bar);
            __builtin_amdgcn_fence(__ATOMIC_ACQUIRE, "agent");
            xb_add(&bar[XB_XGEN(b.x)], 1u);
            asm volatile("s_waitcnt vmcnt(0)" ::: "memory");
        } else {
            XB_SPIN(xb_ld(&bar[XB_XGEN(b.x)]) == gen, bar);
            __builtin_amdgcn_fence(__ATOMIC_ACQUIRE, "agent");
            asm volatile("s_waitcnt vmcnt(0)" ::: "memory");
        }
    }
    __syncthreads();
}

namespace pg8 {
constexpr int BM = 256, BK = 64, HALF = 128, HTB = HALF * BK * 2, STAGE_BYTES = 8 * HTB, NXCD = 8, WGM = 4;
__host__ __device__ __forceinline__ int lds_byte(int r, int c) { const int st = (r >> 4) * 2 + (c >> 5), rr = r & 15, cc = c & 31, ob = rr * 64 + cc * 2; return st * 1024 + (ob ^ (((ob >> 9) & 1) << 5)); }
__host__ __device__ __forceinline__ void stage_rc(int b, int& R, int& C) { const int st = b / 1024, sb = b % 1024, swz = sb ^ (((sb >> 9) & 1) << 5); R = (st >> 1) * 16 + swz / 64; C = (st & 1) * 32 + (swz % 64) / 2; }
__host__ __device__ __forceinline__ int perm32(int rho) { const int n = rho >> 4, i = rho & 15; return 8 * (i >> 2) + 4 * n + (i & 3); }

struct Unit { int pm, pn, e, n, rb; };

struct StaticOrder {
    int nM, nN, nwg, G, c, wgm;
    __device__ void init(int M, int N, int G_, int c_, int wgm_ = WGM) { nM = M / BM; nN = N / BM; nwg = nM * nN; G = G_; c = c_; wgm = wgm_; }
    __device__ bool next(int i, Unit& u) const {
        const long L = (long)i * G + c; if (L >= nwg) return false;
        int wgid = (int)L; { const int q = nwg / NXCD, r = nwg % NXCD, xcd = wgid % NXCD, off = wgid / NXCD; wgid = (xcd < r ? xcd * (q + 1) : r * (q + 1) + (xcd - r) * q) + off; }
        const int nig = wgm * nN, gid = wgid / nig, fm = gid * wgm, gsz = (nM - fm) < wgm ? (nM - fm) : wgm;
        u.pm = fm + ((wgid % nig) % gsz); u.pn = (wgid % nig) / gsz; u.e = 0; u.n = 0; u.rb = 0; return true;
    }
};
struct GroupedOrder {
    const LAS int* tpre; const LAS int* cnt; int nct, G, c;
    __device__ bool next(int i, Unit& u) const {
        const int L = i * G + c; const int rt = L / nct; if (rt >= tpre[NE]) return false;
        const int ln = (int)(threadIdx.x & 63u); const int pv = tpre[1 + (ln & 31)];
        const int e = __builtin_popcountll(__ballot(ln < NE && pv <= rt));
        u.e = e; u.pm = rt - tpre[e]; u.pn = L - rt * nct; u.n = cnt[e]; u.rb = tpre[e] * BM; return true;
    }
};

template <int QM> struct DenseProbT {
    static constexpr bool GATHER = false; static constexpr int QMODE = QM, EB = QM ? 1 : 2;
    const void* A; const void* Bt; int K, lda, ldb;
    __device__ __forceinline__ const char* a_base(const Unit& u) const { return (const char*)A + (size_t)u.pm * BM * lda * EB; }
    __device__ __forceinline__ const char* b_base(const Unit& u) const { return (const char*)Bt + (size_t)u.pn * BM * ldb * EB; }
    __device__ __forceinline__ void a_off(const Unit&, const int (&R)[2], const int (&C)[2], unsigned (&vo)[2][2]) const {
#pragma unroll
        for (int h = 0; h < 2; ++h)
#pragma unroll
            for (int i = 0; i < 2; ++i) vo[h][i] = (unsigned)((h * HALF + R[i]) * lda) * (unsigned)EB + (unsigned)C[i] * 2u;
    }
};
typedef DenseProbT<0> DenseProb;
template <int QM> struct MoeUpProbT {
    static constexpr bool GATHER = true; static constexpr int QMODE = QM, EB = QM ? 1 : 2;
    const void* A; const void* Bt; const int* tok; int K, lda, ldb;
    __device__ __forceinline__ const char* a_base(const Unit&) const { return (const char*)A; }
    __device__ __forceinline__ const char* b_base(const Unit& u) const { return (const char*)Bt + ((size_t)u.e * 1024 + (size_t)u.pn * BM) * ldb * EB; }
    __device__ __forceinline__ void a_off(const Unit& u, const int (&R)[2], const int (&C)[2], unsigned (&vo)[2][2]) const {
#pragma unroll
        for (int h = 0; h < 2; ++h)
#pragma unroll
            for (int i = 0; i < 2; ++i) { const int s = u.pm * BM + h * HALF + R[i]; const int tl = tok[(size_t)u.e * T + s]; const int t = (s < u.n) ? tl : 0; vo[h][i] = (unsigned)(t * lda) * (unsigned)EB + (unsigned)C[i] * 2u; }
    }
};
template <int QM> struct MoeDownProbT {
    static constexpr bool GATHER = false; static constexpr int QMODE = QM, EB = QM ? 1 : 2;
    const void* A; const void* Bt; int K, lda, ldb;
    __device__ __forceinline__ const char* a_base(const Unit& u) const { return (const char*)A + ((size_t)u.rb + (size_t)u.pm * BM) * lda * EB; }
    __device__ __forceinline__ const char* b_base(const Unit& u) const { return (const char*)Bt + ((size_t)u.e * 2048 + (size_t)u.pn * BM) * ldb * EB; }
    __device__ __forceinline__ void a_off(const Unit&, const int (&R)[2], const int (&C)[2], unsigned (&vo)[2][2]) const {
#pragma unroll
        for (int h = 0; h < 2; ++h)
#pragma unroll
            for (int i = 0; i < 2; ++i) vo[h][i] = (unsigned)((h * HALF + R[i]) * lda) * (unsigned)EB + (unsigned)C[i] * 2u;
    }
};

template <class Prob, class Epi, class Sched, bool ALIGN_EPI>
__device__ __forceinline__ void gemm_phase(LAS unsigned char* lds, const Prob& P, const Sched& S, const Epi& E) {
    const int tid = threadIdx.x, wid = __builtin_amdgcn_readfirstlane(tid >> 6), lane = tid & 63, wr = wid >> 2, wc = wid & 3, fr = lane & 15, fq = lane >> 4;
    constexpr bool FP8 = Prob::QMODE == 1, I8 = Prob::QMODE == 2; constexpr int EB = Prob::QMODE ? 1 : 2;
    const int K = P.K, nt = K / (Prob::QMODE ? 2 * BK : BK);
    const int sc1 = 0x7F7F7F7F;
    int Rr[2], Cc[2]; unsigned voffB[2];
#pragma unroll
    for (int i = 0; i < 2; ++i) { int R, C; stage_rc(tid * 16 + i * 8192, R, C); Rr[i] = R; Cc[i] = C; const int Rb = Epi::PERM ? ((R & ~31) + perm32(R & 31)) : R; voffB[i] = (unsigned)(Rb * P.ldb) * (unsigned)EB + (unsigned)C * 2u; }
    const size_t kstep = (size_t)(BK * 2);
    const size_t hstepB = (size_t)HALF * P.ldb * EB;
    const unsigned ldsw = (unsigned)wid * 1024u;
    const int aoff = lds_byte(wr * 64 + fr, fq * 8), boff = lds_byte(wc * 32 + fr, fq * 8);
#define PG8_SA(b, h) (((b) * 2 + (h)) * HTB)
#define PG8_SB(b, h) ((4 + (b) * 2 + (h)) * HTB)
#define PG8_STAGE(bufoff, gbase, voff) do { _Pragma("unroll") for (int _i = 0; _i < 2; ++_i) \
        __builtin_amdgcn_global_load_lds((const unsigned*)((const char*)(gbase) + (voff)[_i]), (LAS unsigned*)(lds + (bufoff) + ldsw + _i * 8192), 16, 0, 0); } while (0)
#define PG8_LDA(dst, b, h) do { _Pragma("unroll") for (int m = 0; m < 4; ++m) _Pragma("unroll") for (int k = 0; k < 2; ++k) dst[m][k] = *(const LAS bf16x8*)(lds + PG8_SA(b, h) + aoff + m * 2048 + k * 1024); } while (0)
#define PG8_LDB(dst, b, h) do { _Pragma("unroll") for (int n = 0; n < 2; ++n) _Pragma("unroll") for (int k = 0; k < 2; ++k) dst[n][k] = *(const LAS bf16x8*)(lds + PG8_SB(b, h) + boff + n * 2048 + k * 1024); } while (0)
#define PG8_MMA(ai, bj, At, Bt) do { __builtin_amdgcn_s_setprio(1); _Pragma("unroll") for (int m = 0; m < 4; ++m) _Pragma("unroll") for (int n = 0; n < 2; ++n) { \
        if constexpr (FP8) { const i32x8 fb = __builtin_shufflevector(__builtin_bit_cast(i32x4, Bt[n][0]), __builtin_bit_cast(i32x4, Bt[n][1]), 0, 1, 2, 3, 4, 5, 6, 7); \
            const i32x8 fa = __builtin_shufflevector(__builtin_bit_cast(i32x4, At[m][0]), __builtin_bit_cast(i32x4, At[m][1]), 0, 1, 2, 3, 4, 5, 6, 7); \
            asm volatile("s_nop 1\n\tv_mfma_scale_f32_16x16x128_f8f6f4 %0, %1, %2, %0, %3, %3 op_sel_hi:[0,0,0]" : "+v"(acc[ai][bj][m][n]) : "v"(fb), "v"(fa), "v"(sc1)); } \
        else if constexpr (I8) { _Pragma("unroll") for (int k = 0; k < 2; ++k) acc[ai][bj][m][n] = __builtin_bit_cast(f32x4, __builtin_amdgcn_mfma_i32_16x16x64_i8(__builtin_bit_cast(i32x4, Bt[n][k]), __builtin_bit_cast(i32x4, At[m][k]), __builtin_bit_cast(i32x4, acc[ai][bj][m][n]), 0, 0, 0)); } \
        else { _Pragma("unroll") for (int k = 0; k < 2; ++k) acc[ai][bj][m][n] = __builtin_amdgcn_mfma_f32_16x16x32_bf16(Bt[n][k], At[m][k], acc[ai][bj][m][n], 0, 0, 0); } } \
        __builtin_amdgcn_s_setprio(0); } while (0)
#define PG8_WAIT_V(n) asm volatile("s_waitcnt vmcnt(" #n ")" ::: "memory")
#define PG8_WAIT_L(n) asm volatile("s_waitcnt lgkmcnt(" #n ")" ::: "memory")
#define PG8_BAR __builtin_amdgcn_s_barrier()
#define PG8_SCHED __builtin_amdgcn_sched_barrier(0)
    Unit cur, nxt; int ui = 0;
    if (!S.next(0, cur)) return;
    f32x4 acc[2][2][4][2];
#pragma unroll
    for (int a = 0; a < 2; ++a)
#pragma unroll
        for (int b = 0; b < 2; ++b)
#pragma unroll
            for (int m = 0; m < 4; ++m)
#pragma unroll
                for (int n = 0; n < 2; ++n) acc[a][b][m][n] = (f32x4){0.f, 0.f, 0.f, 0.f};
    bf16x8 At[4][2], B0[2][2], B1[2][2];
    unsigned vA[2][2], vN[2][2];
    P.a_off(cur, Rr, Cc, vA);
#pragma unroll
    for (int h = 0; h < 2; ++h) { vN[h][0] = vA[h][0]; vN[h][1] = vA[h][1]; }
    const char* cA = P.a_base(cur); const char* cB = P.b_base(cur);
    PG8_STAGE(PG8_SB(0, 0), cB, voffB); PG8_STAGE(PG8_SB(0, 1), cB + hstepB, voffB); PG8_STAGE(PG8_SA(0, 0), cA, vA[0]); PG8_STAGE(PG8_SA(0, 1), cA, vA[1]);
    if (wr == 1) PG8_BAR;
    PG8_WAIT_V(2); PG8_BAR;
    PG8_STAGE(PG8_SB(1, 0), cB + kstep, voffB); PG8_STAGE(PG8_SA(1, 0), cA + kstep, vA[0]); PG8_STAGE(PG8_SB(1, 1), cB + hstepB + kstep, voffB);
    PG8_WAIT_V(6); PG8_BAR;
    for (;;) {
        const bool has_next = S.next(ui + 1, nxt);
        const char* nA = has_next ? P.a_base(nxt) : cA; const char* nB = has_next ? P.b_base(nxt) : cB;
        for (int t = 0; t < nt; t += 2) {
            const bool last = (t == nt - 2);
            const char* a1 = cA + (size_t)(t + 1) * kstep;
            const char* a2 = last ? nA : cA + (size_t)(t + 2) * kstep; const char* b2 = last ? nB : cB + (size_t)(t + 2) * kstep;
            const char* a3 = a2 + kstep; const char* b3 = b2 + kstep;
            if constexpr (Prob::GATHER) { if (last && has_next) P.a_off(nxt, Rr, Cc, vN); }
            unsigned vS[2][2];
#pragma unroll
            for (int h = 0; h < 2; ++h) { vS[h][0] = (Prob::GATHER && last) ? vN[h][0] : vA[h][0]; vS[h][1] = (Prob::GATHER && last) ? vN[h][1] : vA[h][1]; }
            PG8_LDB(B0, 0, 0); PG8_LDB(B1, 0, 1); PG8_SCHED; PG8_LDA(At, 0, 0); PG8_STAGE(PG8_SA(1, 1), a1, vA[1]);
            PG8_WAIT_V(8); PG8_WAIT_L(0); PG8_BAR; PG8_MMA(0, 0, At, B0); PG8_MMA(0, 1, At, B1); PG8_BAR; PG8_SCHED;
            PG8_LDA(At, 0, 1); PG8_STAGE(PG8_SB(0, 0), b2, voffB); PG8_STAGE(PG8_SB(0, 1), b2 + hstepB, voffB); PG8_STAGE(PG8_SA(0, 0), a2, vS[0]);
            PG8_WAIT_V(8); PG8_WAIT_L(0); PG8_BAR; PG8_MMA(1, 0, At, B0); PG8_MMA(1, 1, At, B1); PG8_BAR; PG8_SCHED;
            PG8_LDB(B0, 1, 0); PG8_LDB(B1, 1, 1); PG8_SCHED; PG8_LDA(At, 1, 0); PG8_STAGE(PG8_SA(0, 1), a2, vS[1]);
            PG8_WAIT_V(8); PG8_WAIT_L(0); PG8_BAR; PG8_MMA(0, 0, At, B0); PG8_MMA(0, 1, At, B1); PG8_BAR; PG8_SCHED;
            PG8_LDA(At, 1, 1); PG8_STAGE(PG8_SB(1, 0), b3, voffB); PG8_STAGE(PG8_SB(1, 1), b3 + hstepB, voffB); PG8_STAGE(PG8_SA(1, 0), a3, vS[0]);
            PG8_WAIT_V(8); PG8_WAIT_L(0); PG8_BAR; PG8_MMA(1, 0, At, B0); PG8_MMA(1, 1, At, B1); PG8_BAR; PG8_SCHED;
        }
        if constexpr (ALIGN_EPI) { if (wr == 0) PG8_BAR; }
        if constexpr (FP8) asm volatile("s_nop 15\n\ts_nop 15" ::: "memory");
        if constexpr (I8) {
#pragma unroll
            for (int a = 0; a < 2; ++a)
#pragma unroll
                for (int b = 0; b < 2; ++b)
#pragma unroll
                    for (int m = 0; m < 4; ++m)
#pragma unroll
                        for (int n = 0; n < 2; ++n) { const i32x4 iv = __builtin_bit_cast(i32x4, acc[a][b][m][n]); acc[a][b][m][n] = (f32x4){(float)iv[0], (float)iv[1], (float)iv[2], (float)iv[3]}; } }
        E(acc, cur, wr, wc, fr, fq);
        if constexpr (Epi::SIDE) E.side_work(ui, wid, lane);
        if (!has_next) break;
#pragma unroll
        for (int a = 0; a < 2; ++a)
#pragma unroll
            for (int b = 0; b < 2; ++b)
#pragma unroll
                for (int m = 0; m < 4; ++m)
#pragma unroll
                    for (int n = 0; n < 2; ++n) acc[a][b][m][n] = (f32x4){0.f, 0.f, 0.f, 0.f};
        cur = nxt; cA = nA; cB = nB; ++ui;
        if constexpr (Prob::GATHER) {
#pragma unroll
            for (int h = 0; h < 2; ++h) { vA[h][0] = vN[h][0]; vA[h][1] = vN[h][1]; }
        }
        if constexpr (ALIGN_EPI) { if (wr == 1) PG8_BAR; }
    }
    PG8_WAIT_V(0);
    if constexpr (!ALIGN_EPI) { if (wr == 0) PG8_BAR; }
    PG8_BAR;
#undef PG8_SA
#undef PG8_SB
#undef PG8_STAGE
#undef PG8_LDA
#undef PG8_LDB
#undef PG8_MMA
#undef PG8_WAIT_V
#undef PG8_WAIT_L
#undef PG8_BAR
#undef PG8_SCHED
}
}

#ifndef Q_MASK
#define Q_MASK 0xFFFFFFFFFull
#endif
#ifndef QM_IN
#define QM_IN 2
#endif
#ifndef QM_UP
#define QM_UP 2
#endif
#ifndef QM_DOWN
#define QM_DOWN 1
#endif
constexpr unsigned long long IN_F8 = Q_MASK & 0xFFFFFFFFFull, IN_BF = ~IN_F8 & 0xFFFFFFFFFull;
constexpr int IN_NF8 = __builtin_popcountll(IN_F8), IN_NBF = 36 - IN_NF8;
constexpr float FP8_SA = 32.f, FP8_SB = 1024.f;
constexpr float I8_SA = 32.f, I8_SB = 1448.f, I8_SH2 = 26.f;
__device__ __forceinline__ unsigned pk4_fp8(float a, float b, float c, float d) {
    a = fminf(fmaxf(a, -448.f), 448.f); b = fminf(fmaxf(b, -448.f), 448.f); c = fminf(fmaxf(c, -448.f), 448.f); d = fminf(fmaxf(d, -448.f), 448.f);
    int w = __builtin_amdgcn_cvt_pk_fp8_f32(a, b, 0, false); w = __builtin_amdgcn_cvt_pk_fp8_f32(c, d, w, true); return (unsigned)w;
}
__device__ __forceinline__ unsigned pk4_i8(float a, float b, float c, float d) {
    unsigned r = __builtin_amdgcn_cvt_pk_u8_f32(a + 128.f, 0, 0u); r = __builtin_amdgcn_cvt_pk_u8_f32(b + 128.f, 1, r);
    r = __builtin_amdgcn_cvt_pk_u8_f32(c + 128.f, 2, r); r = __builtin_amdgcn_cvt_pk_u8_f32(d + 128.f, 3, r);
    return r ^ 0x80808080u;
}
__device__ __forceinline__ unsigned pk4_u8(float a, float b, float c, float d) {
    unsigned r = __builtin_amdgcn_cvt_pk_u8_f32(a, 0, 0u); r = __builtin_amdgcn_cvt_pk_u8_f32(b, 1, r);
    r = __builtin_amdgcn_cvt_pk_u8_f32(c, 2, r); return __builtin_amdgcn_cvt_pk_u8_f32(d, 3, r);
}
template <int QM> __device__ __forceinline__ unsigned pk4_q(float a, float b, float c, float d) { if (QM == 2) return pk4_i8(a, b, c, d); else return pk4_fp8(a, b, c, d); }
constexpr float I8_SP = 1024.f;
constexpr float Q_SA_IN = QM_IN == 2 ? I8_SA : FP8_SA, Q_SB_IN = QM_IN == 2 ? I8_SB : FP8_SB;
constexpr float Q_SA_UP = QM_UP == 2 ? I8_SH2 : FP8_SA, Q_SB_UP = QM_UP == 2 ? I8_SB : FP8_SB;
#define FP8_UP (QM_UP != 0)
#define FP8_DOWN (QM_DOWN != 0)
constexpr float FP8_SH = 16.f, FP8_SD = 512.f, FP8_SY = 64.f;
struct TrDesc { const float* W; unsigned char* WT; int ldw, k0, n0, ldt, drow0, dk0, qm; float sc; };
constexpr int TR_I_IN = 32 * 144, TR_I_PR = 16 * 32, TR_I_OUT = 32 * 32, TR_I_EXG = NE * 32 * 8, TR_I_EXD = NE * 8 * 32;
constexpr int TR_NITEMS = TR_I_IN + 2 * TR_I_PR + TR_I_OUT + 2 * TR_I_EXG + TR_I_EXD;
struct TrSrc { const float *w_in, *p_rec, *p_attn, *w_out, *w_gate, *w_up, *w_down; unsigned char* ws; };
__device__ __forceinline__ TrDesc tr_decode(const TrSrc& F, int r) {
    TrDesc d; d.dk0 = 0;
    if (r < TR_I_IN) { d.n0 = 64 * (r % 144); d.k0 = 64 * (r / 144); d.W = F.w_in; d.ldw = INW; d.ldt = 2048; d.qm = QM_IN; d.sc = Q_SB_IN; d.WT = F.ws + WS_WIN8; d.drow0 = d.n0; return d; } r -= TR_I_IN;
    if (r < 2 * TR_I_PR) { const int at = r >= TR_I_PR; if (at) r -= TR_I_PR; d.W = at ? F.p_attn : F.p_rec; d.ldw = 2048; d.k0 = 64 * (r / 32); d.n0 = 64 * (r % 32); d.WT = F.ws + WS_WP_T; d.ldt = 2048; d.drow0 = d.n0; d.dk0 = at ? 1024 : 0; d.qm = 2; d.sc = I8_SP; return d; } r -= 2 * TR_I_PR;
    if (r < TR_I_OUT) { d.W = F.w_out; d.ldw = 2048; d.k0 = 64 * (r / 32); d.n0 = 64 * (r % 32); d.WT = F.ws + WS_WOUT_T; d.ldt = 2048; d.drow0 = d.n0; d.qm = 2; d.sc = I8_SB; return d; } r -= TR_I_OUT;
    if (r < 2 * TR_I_EXG) { const int up = r >= TR_I_EXG; if (up) r -= TR_I_EXG; const int e = r / 256, rr = r % 256; d.n0 = 64 * (rr % 8); d.k0 = 64 * (rr / 8);
        d.W = (up ? F.w_up : F.w_gate) + (size_t)e * D * EH; d.ldw = EH; d.ldt = 2048; d.drow0 = (d.n0 >> 7) * 256 + (d.n0 & 127) + (up ? 128 : 0);
        d.qm = QM_UP; d.sc = Q_SB_UP; d.WT = F.ws + WS_WGU_T + (size_t)e * 1024 * 2048; return d; } r -= 2 * TR_I_EXG;
    { const int e = r / 256, rr = r % 256; d.W = F.w_down + (size_t)e * EH * D; d.ldw = D; d.k0 = 64 * (rr / 32); d.n0 = 64 * (rr % 32); d.ldt = 512; d.drow0 = d.n0;
      d.qm = QM_DOWN; d.sc = FP8_SD; d.WT = F.ws + WS_WD_T + (size_t)e * 2048 * 512; }
    return d;
}
__device__ __forceinline__ void tr_load(const TrDesc& d, f32x4 (&v)[16], int lane) {
    const float* p = d.W + (size_t)(d.k0 + 16 * (lane >> 4)) * d.ldw + d.n0 + 4 * (lane & 15);
#pragma unroll
    for (int i = 0; i < 16; ++i) v[i] = *(const f32x4*)(p + (size_t)i * d.ldw);
}
__device__ __forceinline__ void tr_store(const TrDesc& d, const f32x4 (&v)[16], int lane) {
    unsigned char* q = d.WT + (size_t)(d.drow0 + 4 * (lane & 15)) * d.ldt + d.dk0 + d.k0 + 16 * (lane >> 4); const float sc = d.sc;
#pragma unroll
    for (int c = 0; c < 4; ++c) { u32x4 o;
        if (d.qm == 2) { o.x = pk4_i8(v[0][c] * sc, v[1][c] * sc, v[2][c] * sc, v[3][c] * sc); o.y = pk4_i8(v[4][c] * sc, v[5][c] * sc, v[6][c] * sc, v[7][c] * sc); o.z = pk4_i8(v[8][c] * sc, v[9][c] * sc, v[10][c] * sc, v[11][c] * sc); o.w = pk4_i8(v[12][c] * sc, v[13][c] * sc, v[14][c] * sc, v[15][c] * sc); }
        else { o.x = pk4_fp8(v[0][c] * sc, v[1][c] * sc, v[2][c] * sc, v[3][c] * sc); o.y = pk4_fp8(v[4][c] * sc, v[5][c] * sc, v[6][c] * sc, v[7][c] * sc); o.z = pk4_fp8(v[8][c] * sc, v[9][c] * sc, v[10][c] * sc, v[11][c] * sc); o.w = pk4_fp8(v[12][c] * sc, v[13][c] * sc, v[14][c] * sc, v[15][c] * sc); }
        *(u32x4*)(q + (size_t)c * d.ldt) = o; }
}

namespace pg8 {
struct EpiIn {
    static constexpr bool PERM = true, SIDE = true;
    bf16_t *xrec, *grec, *q, *k, *v, *sgr, *sga; float osc; unsigned long long mask; TrSrc src; int side_c, side_stride;
    __device__ __forceinline__ void side_work(int ui, int wid, int lane) const {
        const int item = TR_I_IN + side_c + (ui * 8 + wid) * side_stride; if (item >= TR_NITEMS) return;
        const TrDesc d = tr_decode(src, item); f32x4 v[16]; tr_load(d, v, lane); tr_store(d, v, lane); }
    __device__ __forceinline__ void operator()(const f32x4 (&acc)[2][2][4][2], const Unit& u, int wr, int wc, int fr, int fq) const {
        int pn = u.pn;
        if (mask != 0xFFFFFFFFFull) { int left = u.pn; unsigned long long mm = mask; for (;;) { const int b = __builtin_ctzll(mm); if (left == 0) { pn = b; break; } mm &= mm - 1; --left; } }
        bf16_t* base; int ldc, ct, act; bool hm = false;
        if (pn < 4) { base = xrec; ldc = 1024; ct = pn; act = 0; }
        else if (pn < 8) { base = grec; ldc = 1024; ct = pn - 4; act = 1; }
        else if (pn < 12) { base = q; ldc = 1024; ct = pn - 8; act = 0; hm = true; }
        else if (pn < 16) { base = k; ldc = 1024; ct = pn - 12; act = 0; hm = true; }
        else if (pn < 20) { base = v; ldc = 1024; ct = pn - 16; act = 0; hm = true; }
        else if (pn < 28) { base = sgr; ldc = 2048; ct = pn - 20; act = 2; }
        else { base = sga; ldc = 2048; ct = pn - 28; act = 2; }
        const int row0 = u.pm * BM + wr * 64 + fr, col0 = ct * BM + wc * 32 + 8 * fq;
        if (act == 2) body<2>(acc, base, ldc, row0, col0); else if (act == 1) body<1>(acc, base, ldc, row0, col0); else if (hm) body_hm(acc, base, row0, 2 * ct, wc * 32 + 8 * fq); else body<0>(acc, base, ldc, row0, col0);
    }
    __device__ __forceinline__ void body_hm(const f32x4 (&acc)[2][2][4][2], bf16_t* base, int row0, int h0, int dcol) const {
#pragma unroll
        for (int ai = 0; ai < 2; ++ai)
#pragma unroll
            for (int m = 0; m < 4; ++m) { const int row = row0 + ai * HALF + m * 16; const int bb = row / S, tt = row % S;
#pragma unroll
                for (int bj = 0; bj < 2; ++bj) { const f32x4 v0 = acc[ai][bj][m][0] * osc, v1 = acc[ai][bj][m][1] * osc;
                    u32x4 w; w.x = cvt_pk_bf16(v0[0], v0[1]); w.y = cvt_pk_bf16(v0[2], v0[3]); w.z = cvt_pk_bf16(v1[0], v1[1]); w.w = cvt_pk_bf16(v1[2], v1[3]);
                    *(u32x4*)(base + (((size_t)bb * NH + (h0 + bj)) * S + tt) * HD + dcol) = w; } }
    }
    template <int ACT> __device__ __forceinline__ void body(const f32x4 (&acc)[2][2][4][2], bf16_t* base, int ldc, int row0, int col0) const {
#pragma unroll
        for (int ai = 0; ai < 2; ++ai)
#pragma unroll
            for (int m = 0; m < 4; ++m) { bf16_t* rowp = base + (size_t)(row0 + ai * HALF + m * 16) * ldc + col0;
#pragma unroll
                for (int bj = 0; bj < 2; ++bj) { f32x4 v0 = acc[ai][bj][m][0] * osc, v1 = acc[ai][bj][m][1] * osc;
                    if (ACT == 1) {
#pragma unroll
                        for (int j = 0; j < 4; ++j) { v0[j] = gelu_tanh(v0[j]); v1[j] = gelu_tanh(v1[j]); } }
                    if (ACT == 2) {
#pragma unroll
                        for (int j = 0; j < 4; ++j) { v0[j] = 255.f * fsigmoid(v0[j]); v1[j] = 255.f * fsigmoid(v1[j]); }
                        u32x2 w; w.x = pk4_u8(v0[0], v0[1], v0[2], v0[3]); w.y = pk4_u8(v1[0], v1[1], v1[2], v1[3]);
                        *(u32x2*)((unsigned char*)base + (size_t)(row0 + ai * HALF + m * 16) * 2048 + col0 + bj * HALF) = w; }
                    else { u32x4 w; w.x = cvt_pk_bf16(v0[0], v0[1]); w.y = cvt_pk_bf16(v0[2], v0[3]); w.z = cvt_pk_bf16(v1[0], v1[1]); w.w = cvt_pk_bf16(v1[2], v1[3]);
                        *(u32x4*)(rowp + bj * HALF) = w; } } }
    }
};
template <bool ADD> struct EpiGate {
    static constexpr bool PERM = true, SIDE = false;
    const unsigned char* gate; bf16_t* out; const float* rs; int rss; float osc;
    __device__ __forceinline__ void operator()(const f32x4 (&acc)[2][2][4][2], const Unit& u, int wr, int wc, int fr, int fq) const {
        const int row0 = u.pm * BM + wr * 64 + fr, col0 = u.pn * BM + wc * 32 + 8 * fq;
#pragma unroll
        for (int ai = 0; ai < 2; ++ai) {
            u32x2 gv[4][2]; u32x4 pv[4]; float scv[4];
#pragma unroll
            for (int m = 0; m < 4; ++m) { scv[m] = rs[(size_t)(row0 + ai * HALF + m * 16) * rss];
#pragma unroll
                for (int bj = 0; bj < 2; ++bj) gv[m][bj] = *(const u32x2*)(gate + ((unsigned)(row0 + ai * HALF + m * 16) * 2048u + (unsigned)(col0 + bj * HALF))); }
#pragma unroll
            for (int bj = 0; bj < 2; ++bj) {
                if (ADD) {
#pragma unroll
                    for (int m = 0; m < 4; ++m) pv[m] = *(const u32x4*)(out + ((unsigned)(row0 + ai * HALF + m * 16) * 2048u + (unsigned)(col0 + bj * HALF))); }
                __builtin_amdgcn_sched_barrier(0);
#pragma unroll
                for (int m = 0; m < 4; ++m) { const unsigned off = (unsigned)(row0 + ai * HALF + m * 16) * 2048u + (unsigned)(col0 + bj * HALF); const float sc = scv[m] * osc;
                    const f32x4 a0 = acc[ai][bj][m][0] * sc, a1 = acc[ai][bj][m][1] * sc;
                    const u32x2 g = gv[m][bj];
                    float r[8];
                    r[0] = (float)(g.x & 0xffu) * a0[0]; r[1] = (float)((g.x >> 8) & 0xffu) * a0[1]; r[2] = (float)((g.x >> 16) & 0xffu) * a0[2]; r[3] = (float)(g.x >> 24) * a0[3];
                    r[4] = (float)(g.y & 0xffu) * a1[0]; r[5] = (float)((g.y >> 8) & 0xffu) * a1[1]; r[6] = (float)((g.y >> 16) & 0xffu) * a1[2]; r[7] = (float)(g.y >> 24) * a1[3];
                    if (ADD) { const u32x4 p = pv[m];
                        r[0] += bf_lo(p.x); r[1] += bf_hi(p.x); r[2] += bf_lo(p.y); r[3] += bf_hi(p.y); r[4] += bf_lo(p.z); r[5] += bf_hi(p.z); r[6] += bf_lo(p.w); r[7] += bf_hi(p.w); }
                    u32x4 w; w.x = cvt_pk_bf16(r[0], r[1]); w.y = cvt_pk_bf16(r[2], r[3]); w.z = cvt_pk_bf16(r[4], r[5]); w.w = cvt_pk_bf16(r[6], r[7]);
                    *(u32x4*)(out + off) = w; } } }
    }
};
struct EpiResid {
    static constexpr bool PERM = true, SIDE = false;
    bf16_t* out; const float* rs; float osc;
    __device__ __forceinline__ void operator()(const f32x4 (&acc)[2][2][4][2], const Unit& u, int wr, int wc, int fr, int fq) const {
        const int row0 = u.pm * BM + wr * 64 + fr, col0 = u.pn * BM + wc * 32 + 8 * fq;
        float scv[2][4];
#pragma unroll
        for (int ai = 0; ai < 2; ++ai)
#pragma unroll
            for (int m = 0; m < 4; ++m) scv[ai][m] = rs[row0 + ai * HALF + m * 16] * osc;
        __builtin_amdgcn_sched_barrier(0);
#pragma unroll
        for (int ai = 0; ai < 2; ++ai)
#pragma unroll
            for (int m = 0; m < 4; ++m) { const int row = row0 + ai * HALF + m * 16; const float sc = scv[ai][m]; bf16_t* rowp = out + (size_t)row * D + col0;
#pragma unroll
                for (int bj = 0; bj < 2; ++bj) { const f32x4 v0 = acc[ai][bj][m][0] * sc, v1 = acc[ai][bj][m][1] * sc;
                    u32x4 w; w.x = cvt_pk_bf16(v0[0], v0[1]); w.y = cvt_pk_bf16(v0[2], v0[3]); w.z = cvt_pk_bf16(v1[0], v1[1]); w.w = cvt_pk_bf16(v1[2], v1[3]);
                    *(u32x4*)(rowp + bj * HALF) = w; } }
    }
};
struct EpiHid {
    static constexpr bool PERM = true, SIDE = false;
    const float* rs; void* hid; float osc;
    __device__ __forceinline__ void operator()(const f32x4 (&acc)[2][2][4][2], const Unit& u, int wr, int wc, int fr, int fq) const {
        const int s0 = u.pm * BM + wr * 64 + fr, col0 = u.pn * HALF + wc * 32 + 8 * fq;
        float sclv[2][4];
#pragma unroll
        for (int ai = 0; ai < 2; ++ai)
#pragma unroll
            for (int m = 0; m < 4; ++m) sclv[ai][m] = rs[(size_t)u.e * T + s0 + ai * HALF + m * 16];
        __builtin_amdgcn_sched_barrier(0);
#pragma unroll
        for (int ai = 0; ai < 2; ++ai)
#pragma unroll
            for (int m = 0; m < 4; ++m) { const int s = s0 + ai * HALF + m * 16; const float scl = sclv[ai][m]; const float sc = (s < u.n) ? scl * osc : 0.f;
                float r[8];
#pragma unroll
                for (int n = 0; n < 2; ++n)
#pragma unroll
                    for (int j = 0; j < 4; ++j) { const float g = acc[ai][0][m][n][j] * sc, up = acc[ai][1][m][n][j] * sc; r[n * 4 + j] = g * fsigmoid(g) * up; }
#if FP8_DOWN
                u32x2 w; w.x = pk4_fp8(r[0] * FP8_SH, r[1] * FP8_SH, r[2] * FP8_SH, r[3] * FP8_SH); w.y = pk4_fp8(r[4] * FP8_SH, r[5] * FP8_SH, r[6] * FP8_SH, r[7] * FP8_SH);
                *(u32x2*)((unsigned char*)hid + (size_t)(u.rb + s) * EH + col0) = w;
#else
                u32x4 w; w.x = cvt_pk_bf16(r[0], r[1]); w.y = cvt_pk_bf16(r[2], r[3]); w.z = cvt_pk_bf16(r[4], r[5]); w.w = cvt_pk_bf16(r[6], r[7]);
                *(u32x4*)((bf16_t*)hid + (size_t)(u.rb + s) * EH + col0) = w;
#endif
            }
    }
};
struct EpiDown {
    static constexpr bool PERM = true, SIDE = false;
    const int* dst; const float* w; unsigned char* y; float osc;
    __device__ __forceinline__ void operator()(const f32x4 (&acc)[2][2][4][2], const Unit& u, int wr, int wc, int fr, int fq) const {
        const int s0 = u.pm * BM + wr * 64 + fr, col0 = u.pn * BM + wc * 32 + 8 * fq;
        int dlv[2][4]; float scv[2][4];
#pragma unroll
        for (int ai = 0; ai < 2; ++ai)
#pragma unroll
            for (int m = 0; m < 4; ++m) { const int s = s0 + ai * HALF + m * 16; dlv[ai][m] = dst[(size_t)u.e * T + s]; scv[ai][m] = w[(size_t)u.e * T + s] * osc * FP8_SY; }
        __builtin_amdgcn_sched_barrier(0);
#pragma unroll
        for (int ai = 0; ai < 2; ++ai)
#pragma unroll
            for (int m = 0; m < 4; ++m) asm volatile("" : "+v"(dlv[ai][m]), "+v"(scv[ai][m]));
#pragma unroll
        for (int ai = 0; ai < 2; ++ai)
#pragma unroll
            for (int m = 0; m < 4; ++m) { const int s = s0 + ai * HALF + m * 16;
                const int dl = dlv[ai][m]; const float sc = scv[ai][m];
                if (s < u.n) { unsigned char* rowp = y + (size_t)dl * D + col0;
#pragma unroll
                    for (int bj = 0; bj < 2; ++bj) { const f32x4 v0 = acc[ai][bj][m][0] * sc, v1 = acc[ai][bj][m][1] * sc;
                        u32x2 o; o.x = pk4_fp8(v0[0], v0[1], v0[2], v0[3]); o.y = pk4_fp8(v1[0], v1[1], v1[2], v1[3]);
                        *(u32x2*)(rowp + bj * HALF) = o; } } }
    }
};
}

struct Frame {
    LAS unsigned char* lds; volatile LAS unsigned* MISC; unsigned* ctl;
    int tid, lane, wave, vcu, G;
    const float* in[22]; float* out; unsigned char* ws;
};

__device__ __forceinline__ void tr_item(const float* W, int ldw, int k0, int n0, bf16_t* WT, int ldt, int drow0, int dk0, LAS float* scr, int lane) {
#pragma unroll 8
    for (int i = 0; i < 32; ++i) { const int kk = 2 * i + (lane >> 5); scr[kk * 33 + (lane & 31)] = W[(size_t)(k0 + kk) * ldw + n0 + (lane & 31)]; }
    LDS_WAIT(); asm volatile("" ::: "memory");
    const int c = lane & 7;
#pragma unroll
    for (int j = 0; j < 4; ++j) { const int n = (lane >> 3) + 8 * j; const LAS float* s = scr + (8 * c) * 33 + n;
        u32x4 o; o.x = cvt_pk_bf16(s[0 * 33], s[1 * 33]); o.y = cvt_pk_bf16(s[2 * 33], s[3 * 33]); o.z = cvt_pk_bf16(s[4 * 33], s[5 * 33]); o.w = cvt_pk_bf16(s[6 * 33], s[7 * 33]);
        *(u32x4*)(WT + (size_t)(drow0 + n) * ldt + dk0 + k0 + 8 * c) = o; }
    LDS_WAIT(); asm volatile("" ::: "memory");
}

__device__ __forceinline__ void tr_item8(const float* W, int ldw, int k0, int n0, unsigned char* WT, int ldt, int drow0, int dk0, float sc, LAS float* scr, int lane) {
#pragma unroll 8
    for (int i = 0; i < 32; ++i) { const int kk = 2 * i + (lane >> 5); scr[kk * 33 + (lane & 31)] = W[(size_t)(k0 + kk) * ldw + n0 + (lane & 31)] * sc; }
    LDS_WAIT(); asm volatile("" ::: "memory");
    const int c = lane & 3;
#pragma unroll
    for (int j = 0; j < 2; ++j) { const int n = (lane >> 2) + 16 * j; const LAS float* s = scr + (16 * c) * 33 + n;
        u32x4 o; o.x = pk4_fp8(s[0 * 33], s[1 * 33], s[2 * 33], s[3 * 33]); o.y = pk4_fp8(s[4 * 33], s[5 * 33], s[6 * 33], s[7 * 33]);
        o.z = pk4_fp8(s[8 * 33], s[9 * 33], s[10 * 33], s[11 * 33]); o.w = pk4_fp8(s[12 * 33], s[13 * 33], s[14 * 33], s[15 * 33]);
        *(u32x4*)(WT + (size_t)(drow0 + n) * ldt + dk0 + k0 + 16 * c) = o; }
    LDS_WAIT(); asm volatile("" ::: "memory");
}

__device__ __forceinline__ void p0_prologue(Frame& F) {
    LAS float* scr = (LAS float*)(F.lds + F.wave * 16384);
    const int gw = F.vcu * NWAVES + F.wave, NGW = F.G * NWAVES, lane = F.lane;
    bf16_t* WIN_T = (bf16_t*)(F.ws + WS_WIN_T); bf16_t* WP_T = (bf16_t*)(F.ws + WS_WP_T); bf16_t* WOUT_T = (bf16_t*)(F.ws + WS_WOUT_T);
    bf16_t* WGU_T = (bf16_t*)(F.ws + WS_WGU_T); bf16_t* WD_T = (bf16_t*)(F.ws + WS_WD_T); bf16_t* WA_T = (bf16_t*)(F.ws + WS_WA_T); bf16_t* WX_T = (bf16_t*)(F.ws + WS_WX_T);
    constexpr int I_IN = 32 * 288, I_PR = 16 * 64, I_OUT = 32 * 64, I_EX = 512 * NE, I_LRU = 128;
    constexpr int NITEMS = I_IN + 2 * I_PR + I_OUT + 3 * I_EX + I_LRU;
    const TrSrc src{F.in[2], F.in[10], F.in[11], F.in[12], F.in[18], F.in[19], F.in[20], F.ws};
    for (int it = gw; it < TR_I_IN; it += 2 * NGW) {
        const int it2 = it + NGW; const bool two = it2 < TR_I_IN;
        TrDesc d0 = tr_decode(src, it), d1 = d0; f32x4 v0[16], v1[16];
        tr_load(d0, v0, lane);
        if (two) { d1 = tr_decode(src, it2); tr_load(d1, v1, lane); }
        tr_store(d0, v0, lane);
        if (two) tr_store(d1, v1, lane);
    }
    for (int r = gw; r < 128; r += NGW) { const int which = r / 64, rr = r % 64, nb = rr / 8, r8 = rr % 8;
        tr_item(F.in[which ? 7 : 5] + (size_t)nb * LBD * LBD, LBD, 64 * (r8 / 4), 32 * (r8 % 4), (which ? WX_T : WA_T) + (size_t)nb * LBD * LBD, LBD, 32 * (r8 % 4), 0, scr, lane); }
    { float* WR_T = (float*)(F.ws + WS_WR_T); const float* gf = F.in[13]; const float* wg = F.in[14]; const float* we = F.in[16];
      for (int i = (F.vcu * NTHR + F.tid); i < 64 * D; i += F.G * NTHR) { const int col = i / D, k = i % D;
          float v = 0.f; if (col < 32) v = we[(size_t)k * NE + col] * gf[k]; else if (col < 36) v = wg[(size_t)k * NG + (col - 32)] * gf[k];
          WR_T[i] = v; } }
    { const float* x = F.in[0]; const float* g = F.in[1]; bf16_t* XN = (bf16_t*)(F.ws + WS_XN);
      f32x4 gv[8];
#pragma unroll
      for (int j = 0; j < 8; ++j) gv[j] = ((const f32x4*)g)[lane + 64 * j];
      for (int m0 = gw; m0 < T; m0 += 2 * NGW) {
          f32x4 va[8], vb[8];
          { const f32x4* xa = (const f32x4*)(x + (size_t)m0 * D) + lane; const f32x4* xb = (const f32x4*)(x + (size_t)(m0 + NGW) * D) + lane;
#pragma unroll
            for (int j = 0; j < 8; ++j) va[j] = xa[64 * j];
#pragma unroll
            for (int j = 0; j < 8; ++j) vb[j] = xb[64 * j]; }
#pragma unroll
          for (int half = 0; half < 2; ++half) { const int m = m0 + half * NGW; f32x4 (&v)[8] = half ? vb : va; float s = 0.f;
#pragma unroll
              for (int j = 0; j < 8; ++j) s += (v[j].x * v[j].x + v[j].y * v[j].y) + (v[j].z * v[j].z + v[j].w * v[j].w);
              const float r = rsqrtf(wave_sum(s) * (1.f / D) + RMS_EPS);
              if (IN_NF8 > 0) { unsigned* o = (unsigned*)((unsigned char*)F.out + (size_t)m * D) + lane; const float r8 = r * Q_SA_IN;
#pragma unroll
                  for (int j = 0; j < 8; ++j) o[64 * j] = pk4_q<QM_IN>(v[j].x * r8 * gv[j].x, v[j].y * r8 * gv[j].y, v[j].z * r8 * gv[j].z, v[j].w * r8 * gv[j].w); }
              if (IN_NBF > 0) { u32x2* o = (u32x2*)(XN + (size_t)m * D) + lane;
#pragma unroll
                  for (int j = 0; j < 8; ++j) { u32x2 w; w.x = cvt_pk_bf16(v[j].x * r * gv[j].x, v[j].y * r * gv[j].y); w.y = cvt_pk_bf16(v[j].z * r * gv[j].z, v[j].w * r * gv[j].w); o[64 * j] = w; } }
          }
      } }
}


template <bool SPLIT> __device__ __forceinline__ void quant_row(Frame& F, const bf16_t* src, unsigned char* dst, float* rs, int t) {
    const int lane = F.lane; const u32x4* p = (const u32x4*)(src + (size_t)t * 2048) + lane; u32x4 v[4];
#pragma unroll
    for (int j = 0; j < 4; ++j) v[j] = p[64 * j];
    float mx[2] = {0.f, 0.f};
#pragma unroll
    for (int j = 0; j < 4; ++j) { const unsigned w[4] = {v[j].x, v[j].y, v[j].z, v[j].w}; float m = 0.f;
#pragma unroll
        for (int e = 0; e < 4; ++e) m = fmaxf(m, fmaxf(fabsf(bf_lo(w[e])), fabsf(bf_hi(w[e]))));
        mx[j >> 1] = fmaxf(mx[j >> 1], m); }
    mx[0] = wave_max(mx[0]); mx[1] = wave_max(mx[1]);
    if (!SPLIT) { mx[0] = fmaxf(mx[0], mx[1]); mx[1] = mx[0]; }
    const float q0 = 127.f / fmaxf(mx[0], 1e-30f), q1 = 127.f / fmaxf(mx[1], 1e-30f);
    if (lane == 0) { if (SPLIT) { rs[2 * (size_t)t] = mx[0] * (1.f / 127.f); rs[2 * (size_t)t + 1] = mx[1] * (1.f / 127.f); } else rs[t] = mx[0] * (1.f / 127.f); }
    u32x2* o = (u32x2*)(dst + (size_t)t * 2048) + lane;
#pragma unroll
    for (int j = 0; j < 4; ++j) { const float q = (j >> 1) ? q1 : q0; u32x2 w;
        w.x = pk4_i8(bf_lo(v[j].x) * q, bf_hi(v[j].x) * q, bf_lo(v[j].y) * q, bf_hi(v[j].y) * q); w.y = pk4_i8(bf_lo(v[j].z) * q, bf_hi(v[j].z) * q, bf_lo(v[j].w) * q, bf_hi(v[j].w) * q);
        o[64 * j] = w; }
}

__device__ __forceinline__ void final_norm(Frame& F) {
    const int gw = F.vcu * NWAVES + F.wave, NGW = F.G * NWAVES, lane = F.lane;
    const float* g = F.in[21]; const bf16_t* Y = (const bf16_t*)(F.ws + WS_Y);
    f32x4 gv[8];
#pragma unroll
    for (int j = 0; j < 8; ++j) gv[j] = ((const f32x4*)g)[lane + 64 * j];
    for (int m = gw; m < T; m += NGW) {
        f32x4* xr = (f32x4*)(F.out + (size_t)m * D) + lane; f32x4 v[8]; float s = 0.f;
        { const u32x2* dl = (const u32x2*)((const bf16_t*)(F.ws + WS_DELTA) + (size_t)m * D) + lane;
#pragma unroll
          for (int j = 0; j < 8; ++j) { const u32x2 dd = dl[64 * j]; v[j].x = bf_lo(dd.x); v[j].y = bf_hi(dd.x); v[j].z = bf_lo(dd.y); v[j].w = bf_hi(dd.y); } }
#if EN_MOE
        const unsigned* y0 = (const unsigned*)((const unsigned char*)Y + (size_t)m * D) + lane; const unsigned* y1 = (const unsigned*)((const unsigned char*)Y + (size_t)(T + m) * D) + lane;
#pragma unroll
        for (int j = 0; j < 8; ++j) { const int a = (int)y0[64 * j], b = (int)y1[64 * j];
            const f32x2 al = __builtin_amdgcn_cvt_pk_f32_fp8(a, false), ah = __builtin_amdgcn_cvt_pk_f32_fp8(a, true), bl = __builtin_amdgcn_cvt_pk_f32_fp8(b, false), bh = __builtin_amdgcn_cvt_pk_f32_fp8(b, true);
            v[j].x += (al.x + bl.x) * (1.f / FP8_SY); v[j].y += (al.y + bl.y) * (1.f / FP8_SY); v[j].z += (ah.x + bh.x) * (1.f / FP8_SY); v[j].w += (ah.y + bh.y) * (1.f / FP8_SY); }
#endif
#pragma unroll
        for (int j = 0; j < 8; ++j) s += (v[j].x * v[j].x + v[j].y * v[j].y) + (v[j].z * v[j].z + v[j].w * v[j].w);
        const float r = rsqrtf(wave_sum(s) * (1.f / D) + RMS_EPS);
#pragma unroll
        for (int j = 0; j < 8; ++j) { f32x4 o; o.x = v[j].x * r * gv[j].x; o.y = v[j].y * r * gv[j].y; o.z = v[j].z * r * gv[j].z; o.w = v[j].w * r * gv[j].w; xr[64 * j] = o; }
    }
}
__device__ __forceinline__ int xc_addr(int bl, int row, int c16) { return bl * 65536 + row * 256 + ((c16 ^ (row & 15)) << 4); }
template <bool FINAL>
__device__ __forceinline__ void scan_unit(Frame& F, int b, int chunk, int cq) {
    const int tid = F.tid, lane = F.lane, wave = F.wave;
    const bf16_t* XREC = (const bf16_t*)(F.ws + WS_XREC);
    const size_t t0 = (size_t)b * S + (size_t)chunk * 256; const int ch0 = cq * 256;
    {
        const int cg = tid & 31, tg = tid >> 5, ch = ch0 + 8 * cg, r0 = 16 * tg;
        const float* cw = F.in[3]; const float* cb = F.in[4];
        float w[4][8], bias[8];
#pragma unroll
        for (int k = 0; k < 4; ++k) { const f32x4 a = *(const f32x4*)(cw + k * LW + ch), c = *(const f32x4*)(cw + k * LW + ch + 4);
            w[k][0] = a.x; w[k][1] = a.y; w[k][2] = a.z; w[k][3] = a.w; w[k][4] = c.x; w[k][5] = c.y; w[k][6] = c.z; w[k][7] = c.w; }
        { const f32x4 a = *(const f32x4*)(cb + ch), c = *(const f32x4*)(cb + ch + 4); bias[0] = a.x; bias[1] = a.y; bias[2] = a.z; bias[3] = a.w; bias[4] = c.x; bias[5] = c.y; bias[6] = c.z; bias[7] = c.w; }
        float xm[3][8];
#pragma unroll
        for (int i = 0; i < 3; ++i) { const int rr = r0 - 3 + i; u32x4 v = (u32x4){0u, 0u, 0u, 0u};
            if (chunk > 0 || rr >= 0) v = *(const u32x4*)(XREC + (size_t)((long)t0 + rr) * LW + ch);
            xm[i][0] = bf_lo(v.x); xm[i][1] = bf_hi(v.x); xm[i][2] = bf_lo(v.y); xm[i][3] = bf_hi(v.y); xm[i][4] = bf_lo(v.z); xm[i][5] = bf_hi(v.z); xm[i][6] = bf_lo(v.w); xm[i][7] = bf_hi(v.w); }
        const int bl = cg >> 4, c16 = cg & 15;
        u32x4 xv[16];
#pragma unroll
        for (int r = 0; r < 16; ++r) xv[r] = *(const u32x4*)(XREC + (t0 + r0 + r) * LW + ch);
#pragma unroll
        for (int r = 0; r < 16; ++r) {
            const u32x4 v = xv[r];
            float x0[8]; x0[0] = bf_lo(v.x); x0[1] = bf_hi(v.x); x0[2] = bf_lo(v.y); x0[3] = bf_hi(v.y); x0[4] = bf_lo(v.z); x0[5] = bf_hi(v.z); x0[6] = bf_lo(v.w); x0[7] = bf_hi(v.w);
            float y[8];
#pragma unroll
            for (int c = 0; c < 8; ++c) { y[c] = bias[c] + w[0][c] * xm[0][c] + w[1][c] * xm[1][c] + w[2][c] * xm[2][c] + w[3][c] * x0[c]; xm[0][c] = xm[1][c]; xm[1][c] = xm[2][c]; xm[2][c] = x0[c]; }
            u32x4 o; o.x = cvt_pk_bf16(y[0], y[1]); o.y = cvt_pk_bf16(y[2], y[3]); o.z = cvt_pk_bf16(y[4], y[5]); o.w = cvt_pk_bf16(y[6], y[7]);
            *(LAS u32x4*)(F.lds + xc_addr(bl, r0 + r, c16)) = o;
        }
    }
    __syncthreads();
    {
        const int r32 = lane & 31, hi = lane >> 5, bl = wave >> 2, nb = 2 * cq + bl, dl = 32 * (wave & 3) + r32, d = nb * LBD + dl;
        const bf16_t* WA_T = (const bf16_t*)(F.ws + WS_WA_T); const bf16_t* WX_T = (const bf16_t*)(F.ws + WS_WX_T);
        bf16x8 wa[8], wx[8];
#pragma unroll
        for (int ks = 0; ks < 8; ++ks) { wa[ks] = *(const bf16x8*)(WA_T + ((size_t)nb * LBD + dl) * LBD + 16 * ks + 8 * hi); wx[ks] = *(const bf16x8*)(WX_T + ((size_t)nb * LBD + dl) * LBD + 16 * ks + 8 * hi); }
        const float ba = F.in[6][d], bx = F.in[8][d], lam = F.in[9][d];
        const float cl = -8.0f * log1pf(expf(-lam));
        float hc = 0.f, Atot = 1.f;
        float* SSUM = (float*)(F.ws + WS_SSUM);
        if (FINAL) {
#pragma unroll 1
            for (int j0 = 0; j0 < chunk; j0 += 8) { f32x2 sv[8];
#pragma unroll
                for (int j = 0; j < 8; ++j) sv[j] = *(const f32x2*)(SSUM + (((size_t)b * NBLK + j0 + j) * LW + d) * 2);
#pragma unroll
                for (int j = 0; j < 8; ++j) { const bool ok = (j0 + j) < chunk; hc = ok ? (sv[j].x * hc + sv[j].y) : hc; } } }
        const bf16_t* GREC = (const bf16_t*)(F.ws + WS_GREC); bf16_t* YCAT = (bf16_t*)(F.ws + WS_YCAT);
#pragma unroll 1
        for (int tt = 0; tt < 8; ++tt) {
            f32x16 ar = {}, ai = {};
            bf16x8 am[8]; bf16_t xcr[16];
#pragma unroll
            for (int ks = 0; ks < 8; ++ks) am[ks] = *(const LAS bf16x8*)(F.lds + xc_addr(bl, 32 * tt + r32, 2 * ks + hi));
#pragma unroll
            for (int r = 0; r < 16; ++r) { const int row = 32 * tt + (r & 3) + 8 * (r >> 2) + 4 * hi; xcr[r] = *(const LAS bf16_t*)(F.lds + xc_addr(bl, row, dl >> 3) + (dl & 7) * 2); }
            __builtin_amdgcn_sched_barrier(0);
#pragma unroll
            for (int ks = 0; ks < 8; ++ks) { ar = __builtin_amdgcn_mfma_f32_32x32x16_bf16(am[ks], wa[ks], ar, 0, 0, 0); ai = __builtin_amdgcn_mfma_f32_32x32x16_bf16(am[ks], wx[ks], ai, 0, 0, 0); }
            float av[16], bv[16], lav[16];
#pragma unroll
            for (int r = 0; r < 16; ++r) {
                const float xc = bf2f(xcr[r]);
                const float rg = fsigmoid(ar[r] + ba), ig = fsigmoid(ai[r] + bx);
                const float la = cl * rg; av[r] = __builtin_amdgcn_exp2f(la * 1.4426950408889634f); lav[r] = la; const float x2 = 2.0f * la;
                const float em = -x2 * (1.0f + x2 * (0.5f + x2 * (0.16666667f + x2 * (0.041666668f + x2 * 0.0083333338f))));
                bv[r] = __builtin_amdgcn_sqrtf(em) * ig * xc; }
            if (!FINAL) {
                int ttv = tt; asm volatile("" : "+v"(ttv));
                u32x4* AB = (u32x4*)((unsigned*)F.out + (size_t)F.vcu * 65536 + (size_t)wave * 8192) + ((unsigned)ttv * 64u + (unsigned)lane) * 4u;
#pragma unroll
                for (int q = 0; q < 4; ++q) { u32x4 w; w.x = cvt_pk_bf16(lav[4 * q], bv[4 * q]); w.y = cvt_pk_bf16(lav[4 * q + 1], bv[4 * q + 1]); w.z = cvt_pk_bf16(lav[4 * q + 2], bv[4 * q + 2]); w.w = cvt_pk_bf16(lav[4 * q + 3], bv[4 * q + 3]); AB[q] = w; }
            }
            float Ag[4], Hg[4], hl[16], Ac[16];
#pragma unroll
            for (int g = 0; g < 4; ++g) { float A = 1.f, H = 0.f;
#pragma unroll
                for (int j = 0; j < 4; ++j) { const int r = 4 * g + j; H = av[r] * H + bv[r]; A *= av[r]; hl[r] = H; Ac[r] = A; }
                Ag[g] = A; Hg[g] = H; }
            float hin[4];
#pragma unroll
            for (int g = 0; g < 4; ++g) { float A0, A1, H0, H1; swap32(Ag[g], A0, A1); swap32(Hg[g], H0, H1);
                const float h0 = hc; hc = A0 * hc + H0; const float h1 = hc; hc = A1 * hc + H1; hin[g] = hi ? h1 : h0; Atot *= A0 * A1; }
            if (FINAL) {
                int ttv = tt; asm volatile("" : "+v"(ttv));
                const unsigned rb = (unsigned)t0 + 32u * (unsigned)ttv + 4u * (unsigned)hi;
#pragma unroll
                for (int r = 0; r < 16; ++r) { const unsigned t = rb + (unsigned)((r & 3) + 8 * (r >> 2)); const float hf = hl[r] + Ac[r] * hin[r >> 2];
                    const float gr = bf2f(GREC[t * (unsigned)LW + (unsigned)d]);
                    YCAT[t * 2048u + (unsigned)d] = (bf16_t)(cvt_pk_bf16(hf * gr, 0.f) & 0xffffu);
                    if ((r & 3) == 3) asm volatile("" ::: "memory"); }
            }
        }
        if (!FINAL && hi == 0) {
            const unsigned long long sv = ((unsigned long long)__float_as_uint(hc) << 32) | (unsigned long long)__float_as_uint(Atot);
            __hip_atomic_store((unsigned long long*)(SSUM + (((size_t)b * NBLK + chunk) * LW + d) * 2), sv, __ATOMIC_RELAXED, __HIP_MEMORY_SCOPE_AGENT); }
    }
    __syncthreads();
}


__device__ __forceinline__ void scan_fix(Frame& F, int task) {
    const int lane = F.lane, r32 = lane & 31, hi = lane >> 5;
    const int cg = task & 31, chunk = (task >> 5) & 31, b = task >> 10, d = cg * 32 + r32;
    const size_t t0 = (size_t)b * S + (size_t)chunk * 256;
    const float* SSUM = (const float*)(F.ws + WS_SSUM);
    const u32x4* AB = (const u32x4*)((const unsigned*)F.out + (size_t)F.vcu * 65536 + (size_t)F.wave * 8192) + (unsigned)lane * 4u;
    const bf16_t* GREC = (const bf16_t*)(F.ws + WS_GREC); bf16_t* YCAT = (bf16_t*)(F.ws + WS_YCAT);
    float hc = 0.f;
#define SF_LOAD(TT, ABV, GRV) do { const unsigned rb = (unsigned)t0 + 32u * (unsigned)(TT) + 4u * (unsigned)hi; \
        _Pragma("unroll") for (int q = 0; q < 4; ++q) ABV[q] = AB[(TT) * 256 + q]; \
        _Pragma("unroll") for (int r = 0; r < 16; ++r) { const unsigned t = rb + (unsigned)((r & 3) + 8 * (r >> 2)); GRV[r] = GREC[t * (unsigned)LW + (unsigned)d]; } } while (0)
#define SF_STEP(TT, ABV, GRV) do { const unsigned rb = (unsigned)t0 + 32u * (unsigned)(TT) + 4u * (unsigned)hi; \
        float av[16], bv[16]; \
        _Pragma("unroll") for (int r = 0; r < 16; ++r) { const unsigned w = ABV[r >> 2][r & 3]; av[r] = __builtin_amdgcn_exp2f(bf_lo(w) * 1.4426950408889634f); bv[r] = bf_hi(w); } \
        float Ag[4], Hg[4], hl[16], Ac[16]; \
        _Pragma("unroll") for (int g = 0; g < 4; ++g) { float A = 1.f, H = 0.f; \
            _Pragma("unroll") for (int j = 0; j < 4; ++j) { const int r = 4 * g + j; H = av[r] * H + bv[r]; A *= av[r]; hl[r] = H; Ac[r] = A; } \
            Ag[g] = A; Hg[g] = H; } \
        float hin[4]; \
        _Pragma("unroll") for (int g = 0; g < 4; ++g) { float A0, A1, H0, H1; swap32(Ag[g], A0, A1); swap32(Hg[g], H0, H1); \
            const float h0 = hc; hc = A0 * hc + H0; const float h1 = hc; hc = A1 * hc + H1; hin[g] = hi ? h1 : h0; } \
        _Pragma("unroll") for (int r = 0; r < 16; ++r) { const unsigned t = rb + (unsigned)((r & 3) + 8 * (r >> 2)); const float hf = hl[r] + Ac[r] * hin[r >> 2]; \
            YCAT[t * 2048u + (unsigned)d] = (bf16_t)(cvt_pk_bf16(hf * bf2f(GRV[r]), 0.f) & 0xffffu); } } while (0)
    u32x4 abA[4], abB[4], abC[4]; bf16_t grA[16], grB[16], grC[16];
    SF_LOAD(0, abA, grA); SF_LOAD(1, abB, grB);
#pragma unroll 1
    for (int j0 = 0; j0 < chunk; j0 += 8) { f32x2 sv[8];
#pragma unroll
        for (int j = 0; j < 8; ++j) { const unsigned long long q = __hip_atomic_load((const unsigned long long*)(SSUM + (((size_t)b * NBLK + j0 + j) * LW + d) * 2), __ATOMIC_RELAXED, __HIP_MEMORY_SCOPE_AGENT);
            sv[j].x = __uint_as_float((unsigned)q); sv[j].y = __uint_as_float((unsigned)(q >> 32)); }
#pragma unroll
        for (int j = 0; j < 8; ++j) { const bool ok = (j0 + j) < chunk; hc = ok ? (sv[j].x * hc + sv[j].y) : hc; } }
    SF_LOAD(2, abC, grC); SF_STEP(0, abA, grA);
    SF_LOAD(3, abA, grA); SF_STEP(1, abB, grB);
    SF_LOAD(4, abB, grB); SF_STEP(2, abC, grC);
    SF_LOAD(5, abC, grC); SF_STEP(3, abA, grA);
    SF_LOAD(6, abA, grA); SF_STEP(4, abB, grB);
    SF_LOAD(7, abB, grB); SF_STEP(5, abC, grC);
    SF_STEP(6, abA, grA);
    SF_STEP(7, abB, grB);
#undef SF_LOAD
#undef SF_STEP
}

__device__ __forceinline__ void kmean_unit(Frame& F, int u) {
    const int tid = F.tid; const int bh = u >> 5, n = u & 31, b = bh >> 3, h = bh & 7;
    const bf16_t* Kp = (const bf16_t*)(F.ws + WS_K) + (((size_t)b * NH + h) * S + (size_t)n * 256) * HD;
    const int rg = tid >> 4, cc = tid & 15; float s[8] = {0.f, 0.f, 0.f, 0.f, 0.f, 0.f, 0.f, 0.f}; float sq[8][8];
#pragma unroll
    for (int i = 0; i < 8; ++i) { const u32x4 v = *(const u32x4*)(Kp + (size_t)(rg + 32 * i) * HD + 8 * cc);
        const float e[8] = {bf_lo(v.x), bf_hi(v.x), bf_lo(v.y), bf_hi(v.y), bf_lo(v.z), bf_hi(v.z), bf_lo(v.w), bf_hi(v.w)};
#pragma unroll
        for (int c = 0; c < 8; ++c) { s[c] += e[c]; sq[i][c] = e[c] * e[c]; } }
    LAS float* part = (LAS float*)F.lds; LAS float* nmx = part + 32 * 128;
#pragma unroll
    for (int c = 0; c < 8; ++c) part[rg * 128 + 8 * cc + c] = s[c];
    { float mx = 0.f;
#pragma unroll
      for (int i = 0; i < 8; ++i) { float q = 0.f;
#pragma unroll
          for (int c = 0; c < 8; ++c) q += sq[i][c];
          q = row_sum(q); mx = fmaxf(mx, q); }
      if (cc == 0) nmx[rg] = mx; }
    __syncthreads();
    if (tid == 0) { float m = 0.f; for (int r = 0; r < 32; ++r) m = fmaxf(m, nmx[r]); ((float*)(F.ws + WS_KNORM))[u] = m; }
    if (tid < 128) { float a = 0.f;
#pragma unroll 8
        for (int r = 0; r < 32; ++r) a += part[r * 128 + tid];
        const float mean = a * (1.f / 256.f); ((float*)(F.ws + WS_KMEAN))[(size_t)u * 128 + tid] = mean;
        const unsigned hb = cvt_pk_bf16(mean, 0.f) & 0xffffu; const float lo = mean - __uint_as_float(hb << 16);
        ((bf16_t*)(F.ws + WS_KMH))[(size_t)u * 128 + tid] = (bf16_t)hb; ((bf16_t*)(F.ws + WS_KML))[(size_t)u * 128 + tid] = (bf16_t)(cvt_pk_bf16(lo, 0.f) & 0xffffu); }
    __syncthreads();
}

__device__ __forceinline__ void route_phase(Frame& F) {
    const int tid = F.tid, lane = F.lane, wave = F.wave, r32 = lane & 31, hi = lane >> 5;
    constexpr int NU = NB * NH * 16;
    LAS int* lcnt = (LAS int*)(F.lds + 16384); LAS int* lbase = lcnt + 32; LAS float* knl = (LAS float*)(lbase + 32);
    constexpr int GPP = 35;
    LAS float* gp = (LAS float*)(F.lds + 32768);
    bf16x8 qa[2][8], ka[2][8], bhv[8], blv[8]; float knv = 0.f;
#define ROUTE_LOAD(U) do { const int _bh = (U) >> 4, _j0 = 1 + 2 * ((U) & 15), _b = _bh >> 3, _h = _bh & 7; \
        const bf16_t* mh = (const bf16_t*)(F.ws + WS_KMH) + ((size_t)_bh * 32 + r32) * 128 + 8 * hi; const bf16_t* ml = (const bf16_t*)(F.ws + WS_KML) + ((size_t)_bh * 32 + r32) * 128 + 8 * hi; \
        _Pragma("unroll") for (int hf = 0; hf < 2; ++hf) { const int _jj = (_j0 + hf <= 31) ? _j0 + hf : _j0; \
            const size_t trow = ((size_t)_b * NH + _h) * S + (size_t)_jj * 256 + wave * 32 + r32;              \
            const bf16_t* qp = (const bf16_t*)(F.ws + WS_Q) + trow * HD + 8 * hi; const bf16_t* kp = (const bf16_t*)(F.ws + WS_K) + trow * HD + 8 * hi; \
            _Pragma("unroll") for (int ks = 0; ks < 8; ++ks) { qa[hf][ks] = *(const bf16x8*)(qp + 16 * ks); ka[hf][ks] = *(const bf16x8*)(kp + 16 * ks); } } \
        _Pragma("unroll") for (int ks = 0; ks < 8; ++ks) { bhv[ks] = *(const bf16x8*)(mh + 16 * ks); blv[ks] = *(const bf16x8*)(ml + 16 * ks); } \
        knv = ((const float*)(F.ws + WS_KNORM))[_bh * 32 + r32]; } while (0)
    int u = F.vcu; if (u >= NU) return;
    ROUTE_LOAD(u);
    for (;;) {
        const int un = u + F.G; const int bh = u >> 4, j0 = 1 + 2 * (u & 15), b = bh >> 3, h = bh & 7; const int jmax = (j0 + 1 <= 31) ? j0 + 1 : j0;
        if (tid < 32) { lcnt[tid] = 0; knl[tid] = knv; }
#pragma unroll
        for (int hf = 0; hf < 2; ++hf) {
            f32x16 acc = {};
#pragma unroll
            for (int ks = 0; ks < 8; ++ks) { acc = __builtin_amdgcn_mfma_f32_32x32x16_bf16(qa[hf][ks], bhv[ks], acc, 0, 0, 0); acc = __builtin_amdgcn_mfma_f32_32x32x16_bf16(qa[hf][ks], blv[ks], acc, 0, 0, 0); }
            float qq = 0.f, qk = 0.f;
#pragma unroll
            for (int ks = 0; ks < 8; ++ks)
#pragma unroll
                for (int e = 0; e < 8; ++e) { const float qv = bf2f((bf16_t)qa[hf][ks][e]), kv = bf2f((bf16_t)ka[hf][ks][e]); qq += qv * qv; qk += qv * kv; }
            { float a, b2; swap32(qq, a, b2); qq = a + b2; swap32(qk, a, b2); qk = a + b2; }
            const int qb = hf * 256 + wave * 32;
#pragma unroll
            for (int r = 0; r < 16; ++r) gp[(qb + (r & 3) + 8 * (r >> 2) + 4 * hi) * GPP + r32] = acc[r];
            if (hi == 0) { gp[(qb + r32) * GPP + 32] = qq; gp[(qb + r32) * GPP + 33] = qk; }
        }
        __syncthreads();
        if (un < NU) ROUTE_LOAD(un);
        int sel[3] = {-1, -1, -1}, slot[3] = {0, 0, 0};
        const int j = j0 + (tid >> 8), qi = tid & 255; const bool live = j <= 31;
        if (live) {
            float bv[3] = {-3.0e38f, -3.0e38f, -3.0e38f};
#pragma unroll 1
            for (int n0 = 0; n0 < j; n0 += 8) { float gq[8];
#pragma unroll
                for (int i = 0; i < 8; ++i) gq[i] = gp[tid * GPP + n0 + i];
#pragma unroll
                for (int i = 0; i < 8; ++i) { const int n = n0 + i; const float g = (n < j) ? gq[i] : -3.0e38f;
                    if (g > bv[0]) { bv[2] = bv[1]; sel[2] = sel[1]; bv[1] = bv[0]; sel[1] = sel[0]; bv[0] = g; sel[0] = n; }
                    else if (g > bv[1]) { bv[2] = bv[1]; sel[2] = sel[1]; bv[1] = g; sel[1] = n; }
                    else if (g > bv[2]) { bv[2] = g; sel[2] = n; } }
            }
            { const float qn = sqrtf(gp[tid * GPP + 32]), sself = 0.088388347648318440f * gp[tid * GPP + 33];
              const float slope = exp2f(-(float)(h + 1)); float* LSE = (float*)(F.ws + WS_LSE);
#pragma unroll
              for (int k = 0; k < 3; ++k) if (sel[k] >= 0) { const int n = sel[k]; const float dmin = (float)((j - n - 1) * 256 + qi + 1);
                  const float ub = 0.088388347648318440f * qn * sqrtf(knl[n]) * 1.0001f - slope * dmin;
                  if (ub < sself - 110.f) { LSE[(((size_t)b * S + (size_t)j * 256 + qi) * NH + h) * 4 + k] = -3.0e38f; sel[k] = -1 - n; } } }
#pragma unroll
            for (int k = 0; k < 3; ++k) if (sel[k] >= 0) slot[k] = __hip_atomic_fetch_add(lcnt + sel[k], 1, __ATOMIC_RELAXED, __HIP_MEMORY_SCOPE_WORKGROUP);
        }
        __syncthreads();
        if (tid < jmax) lbase[tid] = (int)atomicAdd(F.ctl + CW_ACNT + bh * 32 + tid, (unsigned)lcnt[tid]);
        __syncthreads();
        if (live) { unsigned* AL = (unsigned*)(F.ws + WS_ALIST) + (size_t)bh * ALIST_PER_BH;
#pragma unroll
            for (int k = 0; k < 3; ++k) if (sel[k] >= 0) AL[alist_off(sel[k]) + lbase[sel[k]] + slot[k]] = ((unsigned)(j * 256 + qi) << 2) | (unsigned)k; }
        __syncthreads();
        if (un >= NU) break;
        u = un;
    }
#undef ROUTE_LOAD
}
namespace att {
constexpr int KVBLK = 64, LDK = AW;
constexpr float SCALE = 0.088388347648318440f;
constexpr float THR = 8.f;
constexpr size_t SHM_V = KVBLK * HD * 2, SHM_K = KVBLK * HD * 2;
#define KSWZ(row, colB) ((row) * 256 + ((colB) ^ (((row) & 7) << 4)))
#define SBAR() __builtin_amdgcn_sched_barrier(0)
__device__ __forceinline__ int crow(int r, int hi) { return (r & 3) + 8 * (r >> 2) + 4 * hi; }
__device__ __forceinline__ void partialSM(f32x16& p0, f32x16& p1, float& m_reg, float& mn, float& alpha) {
  constexpr float C = SCALE * 1.4426950408889634f;
  float pmax = p0[0];
#pragma unroll
  for (int r = 1; r < 16; ++r) pmax = fmaxf(pmax, p0[r]);
#pragma unroll
  for (int r = 0; r < 16; ++r) pmax = fmaxf(pmax, p1[r]);
  { auto rr = __builtin_amdgcn_permlane32_swap(__float_as_uint(pmax), __float_as_uint(pmax), false, false);
    pmax = fmaxf(__uint_as_float(rr[0]), __uint_as_float(rr[1])); }
  if (__builtin_expect(__all(pmax - m_reg <= THR / SCALE), 1)) { mn = m_reg; alpha = 1.f; }
  else { mn = fmaxf(m_reg, pmax); alpha = __builtin_amdgcn_exp2f((m_reg - mn) * C); m_reg = mn; }
  const float mnC = -mn * C;
#pragma unroll
  for (int r = 0; r < 16; ++r) p0[r] = fmaf(p0[r], C, mnC);
#pragma unroll
  for (int r = 0; r < 16; ++r) p1[r] = fmaf(p1[r], C, mnC);
#pragma unroll
  for (int r = 0; r < 16; ++r) p0[r] = __builtin_amdgcn_exp2f(p0[r]);
}
__device__ __forceinline__ void finishSM(f32x16& p0, f32x16& p1, float alpha, float& l_reg, bf16x8& pa0, bf16x8& pa1, bf16x8& pa2, bf16x8& pa3) {
#pragma unroll
  for (int r = 0; r < 16; ++r) p1[r] = __builtin_amdgcn_exp2f(p1[r]);
  float ps = 0;
#pragma unroll
  for (int r = 0; r < 16; ++r) ps += p0[r];
#pragma unroll
  for (int r = 0; r < 16; ++r) ps += p1[r];
  { auto rr = __builtin_amdgcn_permlane32_swap(__float_as_uint(ps), __float_as_uint(ps), false, false);
    ps = __uint_as_float(rr[0]) + __uint_as_float(rr[1]); }
  l_reg = l_reg * alpha + ps;
#define PK4(P, BASE, OUT) do { unsigned a0 = cvt_pk_bf16(P[BASE + 0], P[BASE + 1]), a1 = cvt_pk_bf16(P[BASE + 2], P[BASE + 3]);   \
    unsigned b0 = cvt_pk_bf16(P[BASE + 4], P[BASE + 5]), b1 = cvt_pk_bf16(P[BASE + 6], P[BASE + 7]);                              \
    auto r0 = __builtin_amdgcn_permlane32_swap(a0, b0, false, false); auto r1 = __builtin_amdgcn_permlane32_swap(a1, b1, false, false); \
    u32x4 w = {r0[0], r1[0], r0[1], r1[1]}; OUT = *reinterpret_cast<bf16x8*>(&w); } while (0)
  PK4(p0, 0, pa0); PK4(p0, 8, pa1); PK4(p1, 0, pa2); PK4(p1, 8, pa3);
#undef PK4
}
__device__ __forceinline__ void qkt_init(f32x16& p0, f32x16& p1, float bq, float slr) {
#pragma unroll
  for (int r = 0; r < 16; ++r) { const int c0 = (r & 3) + 8 * (r >> 2); p0[r] = fmaf(slr, (float)c0, bq); p1[r] = fmaf(slr, (float)(c0 + 32), bq); }
}
__device__ __forceinline__ void qkt_mask(f32x16& p0, f32x16& p1, int lim) {
#pragma unroll
  for (int r = 0; r < 16; ++r) { const int c0 = (r & 3) + 8 * (r >> 2); if (c0 > lim) p0[r] = -1e30f; if (c0 + 32 > lim) p1[r] = -1e30f; }
}
__device__ __forceinline__ void qkt_mma(f32x16& p0, f32x16& p1, const char* Ks, const bf16x8* qr, int r32, int hi) {
#pragma unroll
  for (int d0 = 0; d0 < 8; ++d0) { const int cb = (d0 * 16 + hi * 8) * 2;
    const bf16x8 b0 = *reinterpret_cast<const bf16x8*>(Ks + KSWZ(r32, cb));
    const bf16x8 b1 = *reinterpret_cast<const bf16x8*>(Ks + KSWZ(32 + r32, cb));
    p0 = __builtin_amdgcn_mfma_f32_32x32x16_bf16(b0, qr[d0], p0, 0, 0, 0);
    p1 = __builtin_amdgcn_mfma_f32_32x32x16_bf16(b1, qr[d0], p1, 0, 0, 0); }
}
template <bool OWN>
__device__ __forceinline__ void qkt(f32x16& p0, f32x16& p1, const char* Ks, const bf16x8* qr, int r32, int hi, float bq, float slr, int lim) {
  qkt_init(p0, p1, bq, slr); if (OWN) qkt_mask(p0, p1, lim); qkt_mma(p0, p1, Ks, qr, r32, hi);
}
__device__ __forceinline__ int v_st(int k, int c) { const int kk = (k & ~0xC) | ((k & 4) << 1) | ((k & 8) >> 1); return ((kk >> 3) * 4 + (c >> 5)) * 512 + ((kk & 7) * 32 + (c & 31)) * 2; }
__device__ __forceinline__ int v_rd_base(int lane) { return ((lane & 3) << 3) | (((lane >> 2) & 3) << 6) | (((lane >> 4) & 1) << 5) | (((lane >> 5) & 1) << 8); }
constexpr int v_rd_off(int d0, int ks, int half) { return d0 * 512 + ks * 4096 + half * 2048; }
template <int OFF> __device__ __forceinline__ s16x4 tr_read(int vb) {
  s16x4 r; asm volatile("ds_read_b64_tr_b16 %0, %1 offset:%2" : "=&v"(r) : "v"(vb), "i"(OFF) : "memory"); return r;
}
template <int D0> __device__ __forceinline__ void pv_one(f32x16& od, int vb, bf16x8 pa0, bf16x8 pa1, bf16x8 pa2, bf16x8 pa3) {
  const s16x4 l0 = tr_read<v_rd_off(D0, 0, 0)>(vb), h0 = tr_read<v_rd_off(D0, 0, 1)>(vb), l1 = tr_read<v_rd_off(D0, 1, 0)>(vb), h1 = tr_read<v_rd_off(D0, 1, 1)>(vb);
  const s16x4 l2 = tr_read<v_rd_off(D0, 2, 0)>(vb), h2 = tr_read<v_rd_off(D0, 2, 1)>(vb), l3 = tr_read<v_rd_off(D0, 3, 0)>(vb), h3 = tr_read<v_rd_off(D0, 3, 1)>(vb);
  asm volatile("s_waitcnt lgkmcnt(0)" ::: "memory"); SBAR();
#define PK(L, H) (bf16x8){L[0], L[1], L[2], L[3], H[0], H[1], H[2], H[3]}
  od = __builtin_amdgcn_mfma_f32_32x32x16_bf16(pa0, PK(l0, h0), od, 0, 0, 0);
  od = __builtin_amdgcn_mfma_f32_32x32x16_bf16(pa1, PK(l1, h1), od, 0, 0, 0);
  od = __builtin_amdgcn_mfma_f32_32x32x16_bf16(pa2, PK(l2, h2), od, 0, 0, 0);
  od = __builtin_amdgcn_mfma_f32_32x32x16_bf16(pa3, PK(l3, h3), od, 0, 0, 0);
#undef PK
}
__device__ __forceinline__ void pv_d0(f32x16* o, int vb, bf16x8 pa0, bf16x8 pa1, bf16x8 pa2, bf16x8 pa3) {
  pv_one<0>(o[0], vb, pa0, pa1, pa2, pa3); pv_one<1>(o[1], vb, pa0, pa1, pa2, pa3); pv_one<2>(o[2], vb, pa0, pa1, pa2, pa3); pv_one<3>(o[3], vb, pa0, pa1, pa2, pa3);
}

}
namespace att {
struct Desc { int b, h, n, chunk, cnt, own; };
__device__ __forceinline__ Desc decode(int i, const LAS int* ipre, int nsel, const unsigned* ac) {
  Desc d; int bhn;
  { int lo = 0, hi = 1024; while (hi - lo > 1) { const int mid = (lo + hi) >> 1; if (ipre[mid] <= i) lo = mid; else hi = mid; } bhn = lo; d.chunk = i - ipre[lo]; d.cnt = (int)ac[bhn]; d.own = 0;
    if (d.chunk == ((d.cnt + 255) >> 8)) { d.chunk = 0; d.cnt = 256; d.own = 1; } }
  d.b = bhn >> 8; d.h = (bhn >> 5) & 7; d.n = bhn & 31; return d;
}
__device__ __forceinline__ void phase(Frame& F, const LAS int* ipre, int nsel, const unsigned* ac) {
  char* lds = (char*)(unsigned char*)F.lds;
  const int tid = F.tid, wid = F.wave, lane = F.lane, r32 = lane & 31, hi = lane >> 5;
  const int ntot = nsel;
  int it = F.vcu; if (it >= ntot) return;
  const bf16_t* Qg = (const bf16_t*)(F.ws + WS_Q); const bf16_t* Kg = (const bf16_t*)(F.ws + WS_K); const bf16_t* Vg = (const bf16_t*)(F.ws + WS_V);
  const unsigned* AL = (const unsigned*)(F.ws + WS_ALIST);
  bf16_t* PART = (bf16_t*)((unsigned char*)F.out); float* LSE = (float*)(F.ws + WS_LSE);
  bf16_t* V_lds = (bf16_t*)lds; bf16_t* K_lds = (bf16_t*)(lds + 2 * SHM_V);
  float* wsf = (float*)(lds + 2 * SHM_V + 2 * SHM_K) + wid * 64; float* li_l = wsf; float* al_l = wsf + 32;
  const int sr = tid >> 4, sc = (tid & 15) * 8, vst0 = v_st(sr, sc), vst1 = v_st(32 + sr, sc);
  const int vb0 = (int)(uintptr_t)V_lds + v_rd_base(lane);
  struct { bf16x8 vs0, vs1, ks0, ks1; } sr_[2];
  constexpr float C = SCALE * 1.4426950408889634f;
#define SLOADX(i, d, j) do { const size_t _o = ((((size_t)(d).b * NH + (d).h) * S) + (size_t)(d).n * 256 + 64 * (j) + sr) * HD + sc;     \
    sr_[i].vs0 = *(const bf16x8*)(Vg + _o); sr_[i].vs1 = *(const bf16x8*)(Vg + _o + (size_t)32 * HD); sr_[i].ks0 = *(const bf16x8*)(Kg + _o); sr_[i].ks1 = *(const bf16x8*)(Kg + _o + (size_t)32 * HD); } while (0)
#define SWRITE(bb, i) do { *(bf16x8*)((char*)V_lds + (bb) * SHM_V + vst0) = sr_[i].vs0;          \
    *(bf16x8*)((char*)V_lds + (bb) * SHM_V + vst1) = sr_[i].vs1; const int kc = sc * 2;               \
    *(bf16x8*)((char*)K_lds + (bb) * SHM_K + KSWZ(sr, kc)) = sr_[i].ks0;                       \
    *(bf16x8*)((char*)K_lds + (bb) * SHM_K + KSWZ(32 + sr, kc)) = sr_[i].ks1; } while (0)
#define RESC(a) do { if (__any((a) < 1.f)) { if (hi == 0) al_l[r32] = (a); asm volatile("s_waitcnt lgkmcnt(0)" ::: "memory"); \
    _Pragma("unroll") for (int d = 0; d < 4; ++d) _Pragma("unroll") for (int r = 0; r < 16; ++r) o[d][r] *= al_l[crow(r, hi)]; } } while (0)
#define LANEQ(d, tq, prow) do { int _ks = 3; bool _v = true; \
    if ((d).own) tq = (d).n * 256 + wid * 32 + r32; \
    else { const int _idx = (d).chunk * 256 + wid * 32 + r32; _v = _idx < (d).cnt; \
      const unsigned _e = AL[(size_t)((d).b * NH + (d).h) * ALIST_PER_BH + alist_off((d).n) + (_v ? _idx : (d).chunk * 256)]; tq = (int)(_e >> 2); _ks = (int)(_e & 3u); } \
    prow = _v ? (int)((((size_t)(d).b * S + tq) * NH + (d).h) * 4 + _ks) : -1; } while (0)
#define QLOAD(d, tq) do { const bf16_t* _q = Qg + ((((size_t)(d).b * NH + (d).h) * S) + (size_t)(tq)) * HD + hi * 8; \
    _Pragma("unroll") for (int d0 = 0; d0 < 8; ++d0) qr[d0] = *(const bf16x8*)(_q + d0 * 16); } while (0)
#define SLR(d) (exp2f(-(float)((d).h + 1)) / SCALE)
#define TJ(d, j) ((d).own ? (j) : 3 - (j))
#define BQ(j) (slr * (float)(dc.n * 256 + 64 * TJ(dc, j) + 4 * hi - tq_c))
#define LIM(j) (wid * 32 + r32 - 64 * (j) - 4 * hi)
#define QKT(p0, p1, buf, j) do { qkt_init(p0, p1, BQ(j), slr); if (dc.own) { int _lim = LIM(j); asm volatile("" : "+v"(_lim)); qkt_mask(p0, p1, _lim); } qkt_mma(p0, p1, buf, qr, r32, hi); } while (0)
#define EPILOGUE() do { const float _lse = m_reg * C + __builtin_amdgcn_logf(l_reg); int* dst_l = (int*)al_l; \
    if (hi == 0) { li_l[r32] = l_reg; dst_l[r32] = prow_p; if (prow_p >= 0) LSE[prow_p] = _lse; } \
    asm volatile("s_waitcnt lgkmcnt(0)" ::: "memory"); \
    _Pragma("unroll") for (int r0 = 0; r0 < 16; r0 += 8) { float _lv[8]; int _pv[8];     \
      _Pragma("unroll") for (int q = 0; q < 8; ++q) { const int rr = crow(r0 + q, hi); _lv[q] = li_l[rr]; _pv[q] = dst_l[rr]; } \
      _Pragma("unroll") for (int q = 0; q < 8; ++q) asm volatile("" : "+v"(_lv[q]), "+v"(_pv[q])); \
      _Pragma("unroll") for (int q = 0; q < 8; ++q) { const int r = r0 + q; const float rl = __builtin_amdgcn_rcpf(_lv[q]); const int pr = _pv[q]; \
        if (pr >= 0) { _Pragma("unroll") for (int d0 = 0; d0 < 4; ++d0) PART[(size_t)pr * HD + d0 * 32 + r32] = (bf16_t)cvt_pk_bf16(o[d0][r] * rl, 0.f); } } } \
    asm volatile("s_waitcnt lgkmcnt(0)" ::: "memory"); \
    m_reg = -1e30f; l_reg = 0.f; _Pragma("unroll") for (int d = 0; d < 4; ++d) _Pragma("unroll") for (int r = 0; r < 16; ++r) o[d][r] = 0.f; } while (0)

  LAS int* dtab = (LAS int*)ipre + 1664;
  if (tid < 64) { const int i = F.vcu + tid * F.G; if (i < ntot) { const Desc d = decode(i, ipre, nsel, ac); *(LAS i32x4*)(dtab + 4 * tid) = (i32x4){(d.b << 8) | (d.h << 5) | d.n, d.chunk, d.cnt, d.own}; } }
  __syncthreads();
#define DESC_AT(K, D) do { const i32x4 _q = *(const LAS i32x4*)(dtab + 4 * (K)); (D).b = _q[0] >> 8; (D).h = (_q[0] >> 5) & 7; (D).n = _q[0] & 31; (D).chunk = _q[1]; (D).cnt = _q[2]; (D).own = _q[3]; } while (0)
  int kit = 0;
  Desc dc; DESC_AT(0, dc); Desc dn = dc;
  int tq_c, prow_c, tq_n = 0, prow_n = -1, prow_p = -1;
  LANEQ(dc, tq_c, prow_c);
  float m_reg = -1e30f, l_reg = 0.f; f32x16 o[4] = {}; bf16x8 qr[8];
  QLOAD(dc, tq_c);
  float slr = SLR(dc);
  f32x16 pA0, pA1, pB0, pB1; float mnA, mnB, alA = 1.f, alB = 1.f; bf16x8 pa0, pa1, pa2, pa3;
  constexpr int SE = 0, SO = 1;
  SLOADX(SE, dc, TJ(dc, 0)); SLOADX(SO, dc, TJ(dc, 1));
  SWRITE(0, SE); __syncthreads();
  bool first = true;
  for (;;) {
    const bool has_next = (it + F.G) < ntot;
    SBAR(); QKT(pA0, pA1, (const char*)K_lds, 0);
    if (!first) finishSM(pB0, pB1, alB, l_reg, pa0, pa1, pa2, pa3);
    SBAR(); SLOADX(SE, dc, TJ(dc, 2)); SBAR();
    if (!first) { pv_d0(o, vb0 + (int)SHM_V, pa0, pa1, pa2, pa3); EPILOGUE(); }
    partialSM(pA0, pA1, m_reg, mnA, alA);
    __syncthreads(); SWRITE(1, SO);
    __syncthreads();
    SBAR(); QKT(pB0, pB1, (const char*)K_lds + SHM_K, 1);
    finishSM(pA0, pA1, alA, l_reg, pa0, pa1, pa2, pa3);
    SBAR(); SLOADX(SO, dc, TJ(dc, 3));
    if (has_next) { DESC_AT(kit + 1, dn); LANEQ(dn, tq_n, prow_n); }
    SBAR();
    pv_d0(o, vb0, pa0, pa1, pa2, pa3); partialSM(pB0, pB1, m_reg, mnB, alB);
    __syncthreads(); SWRITE(0, SE);
    RESC(alB); __syncthreads();
    SBAR(); QKT(pA0, pA1, (const char*)K_lds, 2);
    finishSM(pB0, pB1, alB, l_reg, pa0, pa1, pa2, pa3);
    SBAR(); if (has_next) SLOADX(SE, dn, TJ(dn, 0)); SBAR();
    pv_d0(o, vb0 + (int)SHM_V, pa0, pa1, pa2, pa3); partialSM(pA0, pA1, m_reg, mnA, alA);
    __syncthreads(); SWRITE(1, SO);
    RESC(alA); __syncthreads();
    SBAR(); QKT(pB0, pB1, (const char*)K_lds + SHM_K, 3);
    finishSM(pA0, pA1, alA, l_reg, pa0, pa1, pa2, pa3);
    SBAR(); if (has_next) { SLOADX(SO, dn, TJ(dn, 1)); QLOAD(dn, tq_n); } SBAR();
    pv_d0(o, vb0, pa0, pa1, pa2, pa3); partialSM(pB0, pB1, m_reg, mnB, alB);
    __syncthreads(); if (has_next) SWRITE(0, SE);
    RESC(alB); __syncthreads();
    prow_p = prow_c;
    if (!has_next) break;
    dc = dn; tq_c = tq_n; prow_c = prow_n; slr = SLR(dc); first = false; it += F.G; ++kit;
  }
  finishSM(pB0, pB1, alB, l_reg, pa0, pa1, pa2, pa3); SBAR();
  pv_d0(o, vb0 + (int)SHM_V, pa0, pa1, pa2, pa3);
  EPILOGUE();
  __syncthreads();
#undef DESC_AT
#undef SLOADX
#undef SWRITE
#undef RESC
#undef LANEQ
#undef QLOAD
#undef SLR
#undef BQ
#undef LIM
#undef TJ
#undef QKT
#undef EPILOGUE
}

__device__ __forceinline__ void combine_token(Frame& F, int t, const f32x4 ls, const float* lse_next, f32x4& lsn) {
  const int lane = F.lane, h = lane >> 3, c8 = lane & 7;
  const bf16_t* PART = (const bf16_t*)((unsigned char*)F.out) + ((size_t)t * NH + h) * 4 * HD + 16 * c8;
  const int j = (t & (S - 1)) >> 8;
  float l[4]; bool ok[4]; float M = -3.0e38f;
#pragma unroll
  for (int k = 0; k < 4; ++k) { ok[k] = ((k == 3) || (k < j)) && ls[k] > -1.0e37f; l[k] = ok[k] ? ls[k] : -3.0e38f; M = fmaxf(M, l[k]); }
  u32x4 v[4][2];
#pragma unroll
  for (int k = 0; k < 4; ++k) { v[k][0] = (u32x4){0u, 0u, 0u, 0u}; v[k][1] = (u32x4){0u, 0u, 0u, 0u}; if (ok[k]) { v[k][0] = *(const u32x4*)(PART + (size_t)k * HD); v[k][1] = *(const u32x4*)(PART + (size_t)k * HD + 8); } }
  const u32x4* yr = (const u32x4*)((const bf16_t*)(F.ws + WS_YCAT) + (size_t)t * 2048) + lane; const u32x4 r0 = yr[0], r1 = yr[64];
  lsn = *(const f32x4*)lse_next;
  float acc[16]; float den = 0.f;
#pragma unroll
  for (int e = 0; e < 16; ++e) acc[e] = 0.f;
#pragma unroll
  for (int k = 0; k < 4; ++k) { const float w = ok[k] ? __builtin_amdgcn_exp2f(l[k] - M) : 0.f; den += w;
    const u32x4 a = v[k][0], b = v[k][1];
    acc[0] += w * bf_lo(a.x); acc[1] += w * bf_hi(a.x); acc[2] += w * bf_lo(a.y); acc[3] += w * bf_hi(a.y); acc[4] += w * bf_lo(a.z); acc[5] += w * bf_hi(a.z); acc[6] += w * bf_lo(a.w); acc[7] += w * bf_hi(a.w);
    acc[8] += w * bf_lo(b.x); acc[9] += w * bf_hi(b.x); acc[10] += w * bf_lo(b.y); acc[11] += w * bf_hi(b.y); acc[12] += w * bf_lo(b.z); acc[13] += w * bf_hi(b.z); acc[14] += w * bf_lo(b.w); acc[15] += w * bf_hi(b.w); }
  const float rd = __builtin_amdgcn_rcpf(den); float mxa = 0.f;
#pragma unroll
  for (int e = 0; e < 16; ++e) { acc[e] *= rd; mxa = fmaxf(mxa, fabsf(acc[e])); }
  float mxr = 0.f;
  { const unsigned w[8] = {r0.x, r0.y, r0.z, r0.w, r1.x, r1.y, r1.z, r1.w};
#pragma unroll
    for (int e = 0; e < 8; ++e) mxr = fmaxf(mxr, fmaxf(fabsf(bf_lo(w[e])), fabsf(bf_hi(w[e])))); }
  mxa = wave_max(mxa); mxr = wave_max(mxr);
  const float qa = 127.f / fmaxf(mxa, 1e-30f), qr = 127.f / fmaxf(mxr, 1e-30f);
  unsigned char* yc = F.ws + WS_YC8 + (size_t)t * 2048; float* rs = (float*)(F.ws + WS_RS1) + 2 * (size_t)t;
  if (lane == 0) { rs[0] = mxr * (1.f / 127.f); rs[1] = mxa * (1.f / 127.f); }
  { u32x2 w; w.x = pk4_i8(bf_lo(r0.x) * qr, bf_hi(r0.x) * qr, bf_lo(r0.y) * qr, bf_hi(r0.y) * qr); w.y = pk4_i8(bf_lo(r0.z) * qr, bf_hi(r0.z) * qr, bf_lo(r0.w) * qr, bf_hi(r0.w) * qr); *((u32x2*)yc + lane) = w;
    w.x = pk4_i8(bf_lo(r1.x) * qr, bf_hi(r1.x) * qr, bf_lo(r1.y) * qr, bf_hi(r1.y) * qr); w.y = pk4_i8(bf_lo(r1.z) * qr, bf_hi(r1.z) * qr, bf_lo(r1.w) * qr, bf_hi(r1.w) * qr); *((u32x2*)yc + 64 + lane) = w; }
  { u32x4 w; w.x = pk4_i8(acc[0] * qa, acc[1] * qa, acc[2] * qa, acc[3] * qa); w.y = pk4_i8(acc[4] * qa, acc[5] * qa, acc[6] * qa, acc[7] * qa);
    w.z = pk4_i8(acc[8] * qa, acc[9] * qa, acc[10] * qa, acc[11] * qa); w.w = pk4_i8(acc[12] * qa, acc[13] * qa, acc[14] * qa, acc[15] * qa);
    *(u32x4*)(yc + 1024 + h * HD + 16 * c8) = w; }
}
}
__device__ __forceinline__ void router_iter(Frame& F, int it) {
    const int lane = F.lane, wave = F.wave, r16 = lane & 15, q4 = lane >> 4;
    const int tok0 = it * 128 + wave * 16, tok = tok0 + r16;
    const float* WR = (const float*)(F.ws + WS_WR_T); const float* gf = F.in[13];
    LAS float* stg = (LAS float*)(F.lds + wave * 8192);
    constexpr int WRB_OFF = 65536, WRB_BYTES = 48 * 512;
    f32x4 c0 = {0.f, 0.f, 0.f, 0.f}, c1 = c0, c2 = c0; float ss = 0.f;
    const int hrow = lane >> 5, u32i = lane & 31;
    f32x4 xv[8]; u32x2 dv[8]; f32x4 gq;
#define RT_ROWS(C) do { _Pragma("unroll") for (int j = 0; j < 8; ++j) { const size_t off = (size_t)(tok0 + 2 * j + hrow) * D + 128 * (C) + 4 * u32i; \
        xv[j] = *(const f32x4*)(F.in[0] + off); dv[j] = *(const u32x2*)((const bf16_t*)(F.ws + WS_DELTA) + off); } gq = *(const f32x4*)(gf + 128 * (C) + 4 * u32i); } while (0)
#define RT_WDMA(C, BUF) do { _Pragma("unroll") for (int i = 0; i < 3; ++i) { const int q = wave * 3 + i, p = 64 * q + lane, row = p >> 5, c16 = p & 31; \
        __builtin_amdgcn_global_load_lds((const unsigned*)(WR + (size_t)row * D + 128 * (C) + 4 * (c16 ^ (row & 15))), (LAS unsigned*)(F.lds + WRB_OFF + (BUF) * WRB_BYTES + q * 1024), 16, 0, 0); } } while (0)
    RT_ROWS(0); RT_WDMA(0, 0);
#pragma unroll 1
    for (int c = 0; c < 16; ++c) {
        asm volatile("s_waitcnt vmcnt(0)" ::: "memory");
        __syncthreads();
        const f32x4 g = gq;
#pragma unroll
        for (int j = 0; j < 8; ++j) { const int r = 2 * j + hrow; const size_t off = (size_t)(tok0 + r) * D + 128 * c + 4 * u32i;
            f32x4 a = xv[j]; a.x += bf_lo(dv[j].x); a.y += bf_hi(dv[j].x); a.z += bf_lo(dv[j].y); a.w += bf_hi(dv[j].y);
            u32x2 xw; xw.x = cvt_pk_bf16(a.x, a.y); xw.y = cvt_pk_bf16(a.z, a.w);
            *(u32x2*)((bf16_t*)(F.ws + WS_DELTA) + off) = xw;
            *(unsigned*)((unsigned char*)(F.ws + WS_H2) + off) = pk4_q<QM_UP>(a.x * g.x * Q_SA_UP, a.y * g.y * Q_SA_UP, a.z * g.z * Q_SA_UP, a.w * g.w * Q_SA_UP);
            *(LAS f32x4*)(stg + r * 128 + 4 * (u32i ^ (r & 15))) = a; }
        { const int cn = (c < 15) ? c + 1 : 15; RT_ROWS(cn); RT_WDMA(cn, (c + 1) & 1); }
        __builtin_amdgcn_sched_barrier(0);
        const LAS float* wb = (const LAS float*)(F.lds + WRB_OFF + (c & 1) * WRB_BYTES);
#pragma unroll
        for (int s4 = 0; s4 < 4; ++s4) { const int u = 8 * s4 + 2 * q4, ua = 4 * (u ^ r16), ub = 4 * ((u + 1) ^ r16);
            const f32x4 a0 = *(const LAS f32x4*)(stg + r16 * 128 + ua), a1 = *(const LAS f32x4*)(stg + r16 * 128 + ub);
            ss += (a0.x * a0.x + a0.y * a0.y) + (a0.z * a0.z + a0.w * a0.w) + (a1.x * a1.x + a1.y * a1.y) + (a1.z * a1.z + a1.w * a1.w);
            const f32x4 w00 = *(const LAS f32x4*)(wb + r16 * 128 + ua), w01 = *(const LAS f32x4*)(wb + r16 * 128 + ub);
            const f32x4 w10 = *(const LAS f32x4*)(wb + (16 + r16) * 128 + ua), w11 = *(const LAS f32x4*)(wb + (16 + r16) * 128 + ub);
            const f32x4 w20 = *(const LAS f32x4*)(wb + (32 + r16) * 128 + ua), w21 = *(const LAS f32x4*)(wb + (32 + r16) * 128 + ub);
#pragma unroll
            for (int e = 0; e < 4; ++e) { c0 = __builtin_amdgcn_mfma_f32_16x16x4f32(a0[e], w00[e], c0, 0, 0, 0); c1 = __builtin_amdgcn_mfma_f32_16x16x4f32(a0[e], w10[e], c1, 0, 0, 0); c2 = __builtin_amdgcn_mfma_f32_16x16x4f32(a0[e], w20[e], c2, 0, 0, 0); }
#pragma unroll
            for (int e = 0; e < 4; ++e) { c0 = __builtin_amdgcn_mfma_f32_16x16x4f32(a1[e], w01[e], c0, 0, 0, 0); c1 = __builtin_amdgcn_mfma_f32_16x16x4f32(a1[e], w11[e], c1, 0, 0, 0); c2 = __builtin_amdgcn_mfma_f32_16x16x4f32(a1[e], w21[e], c2, 0, 0, 0); } }
    }
    asm volatile("s_waitcnt vmcnt(0)" ::: "memory");
    __syncthreads();
#undef RT_ROWS
#undef RT_WDMA
    { float a, b2; swap16(ss, a, b2); ss = a + b2; swap32(ss, a, b2); ss = a + b2; }
    const float rinv = rsqrtf(ss * (1.f / D) + RMS_EPS);
    LAS float* lg = stg; LAS int* hist = (LAS int*)(F.lds + TAB_OFF); LAS int* gbase = hist + 32;
    if (F.tid < 32) hist[F.tid] = 0;
#pragma unroll
    for (int r = 0; r < 4; ++r) { const int trow = 4 * q4 + r; lg[trow * 40 + r16] = c0[r]; lg[trow * 40 + 16 + r16] = c1[r]; if (r16 < 4) lg[trow * 40 + 32 + r16] = c2[r]; }
    __syncthreads();
    int ex[2] = {0, 0}, sl[2] = {0, 0}; float wt[2] = {0.f, 0.f};
    if (lane < 16) {
        const float* bg = F.in[15]; const float* be = F.in[17];
        float gl[4]; int gi = 0;
#pragma unroll
        for (int g = 0; g < 4; ++g) gl[g] = rinv * lg[lane * 40 + 32 + g] + bg[g];
        float gm = gl[0];
#pragma unroll
        for (int g = 1; g < 4; ++g) if (gl[g] > gm) { gm = gl[g]; gi = g; }
        float gs = 0.f;
#pragma unroll
        for (int g = 0; g < 4; ++g) gs += __expf(gl[g] - gm);
        const float gw = 1.0f / gs;
        float el[8];
#pragma unroll
        for (int e = 0; e < 8; ++e) el[e] = rinv * lg[lane * 40 + gi * 8 + e] + be[gi * 8 + e];
        int i1 = 0; float m1 = el[0];
#pragma unroll
        for (int e = 1; e < 8; ++e) if (el[e] > m1) { m1 = el[e]; i1 = e; }
        int i2 = -1; float m2 = -3.0e38f;
#pragma unroll
        for (int e = 0; e < 8; ++e) if (e != i1 && el[e] > m2) { m2 = el[e]; i2 = e; }
        const float e2 = __expf(m2 - m1), w1 = 1.0f / (1.0f + e2), w2 = e2 * w1;
        ex[0] = gi * 8 + i1; ex[1] = gi * 8 + i2; wt[0] = gw * w1; wt[1] = gw * w2;
        sl[0] = __hip_atomic_fetch_add(hist + ex[0], 1, __ATOMIC_RELAXED, __HIP_MEMORY_SCOPE_WORKGROUP);
        sl[1] = __hip_atomic_fetch_add(hist + ex[1], 1, __ATOMIC_RELAXED, __HIP_MEMORY_SCOPE_WORKGROUP);
    }
    __syncthreads();
    if (F.tid < 32) gbase[F.tid] = (int)atomicAdd(F.ctl + CW_ECNT + F.tid, (unsigned)hist[F.tid]);
    __syncthreads();
    if (lane < 16) {
        int* MTOK = (int*)(F.ws + WS_MTOK); int* MDST = (int*)(F.ws + WS_MDST); float* MW = (float*)(F.ws + WS_MW); float* MRS = (float*)(F.ws + WS_MRS);
#pragma unroll
        for (int k = 0; k < 2; ++k) { const size_t p = (size_t)ex[k] * T + gbase[ex[k]] + sl[k]; MTOK[p] = tok; MDST[p] = k * T + tok; MW[p] = wt[k]; MRS[p] = rinv; }
    }
    __syncthreads();
}
constexpr int N_PHASES = 14;
struct Args { const float* in[22]; float* out; unsigned char* ws; int ph_lo, ph_hi, use_bar, pad; };
__global__ void __launch_bounds__(NTHR, 2) fwd(Args args) {
    extern __shared__ __attribute__((aligned(16))) unsigned char lds[];
    Frame F;
    F.lds = (LAS unsigned char*)lds; F.MISC = (volatile LAS unsigned*)(F.lds + MISC_OFF);
    F.tid = threadIdx.x; F.lane = F.tid & 63; F.wave = __builtin_amdgcn_readfirstlane(F.tid >> 6);
    F.G = gridDim.x; { const int bx = blockIdx.x; F.vcu = (F.G % 8 == 0) ? (bx % 8) * (F.G / 8) + bx / 8 : bx; }
    F.ws = args.ws; F.out = args.out; F.ctl = (unsigned*)(args.ws + WS_CTL);
#pragma unroll
    for (int i = 0; i < 22; ++i) F.in[i] = args.in[i];
    if (F.tid < 64) F.MISC[F.tid] = 0u;
    __syncthreads();
    XcdBarrier bar; bar.bar = F.ctl + CW_BAR; bar.x = 0; bar.st = nullptr;
    if (args.use_bar) bar = xcd_barrier_post(F.ctl + CW_BAR, F.MISC + 8);
    const int lo = args.ph_lo, hi = args.ph_hi;
#define IN(k) (lo <= (k) && (k) < hi)
#define SEAM(k) do { if (IN(k) && IN((k) + 1)) xcd_barrier(bar); } while (0)

    if (IN(0)) { p0_prologue(F); __syncthreads(); }
    SEAM(0);
    if (IN(1)) {
        const pg8::EpiIn E0{(bf16_t*)(F.ws + WS_XREC), (bf16_t*)(F.ws + WS_GREC), (bf16_t*)(F.ws + WS_Q), (bf16_t*)(F.ws + WS_K), (bf16_t*)(F.ws + WS_V), (bf16_t*)(F.ws + WS_SGR), (bf16_t*)(F.ws + WS_SGA), 1.0f, IN_BF,
            TrSrc{F.in[2], F.in[10], F.in[11], F.in[12], F.in[18], F.in[19], F.in[20], F.ws}, F.vcu, F.G};
        if (IN_NBF > 0) {
            pg8::DenseProbT<0> P{(const void*)(F.ws + WS_XN), (const void*)(F.ws + WS_WIN_T), D, D, D};
            pg8::StaticOrder So; So.init(T, IN_NBF * 256, F.G, (int)blockIdx.x);
            pg8::gemm_phase<pg8::DenseProbT<0>, pg8::EpiIn, pg8::StaticOrder, true>(F.lds, P, So, E0);
        }
        if (IN_NF8 > 0) {
            pg8::DenseProbT<QM_IN> P{(const void*)F.out, (const void*)(F.ws + WS_WIN8), D, D, D};
            pg8::StaticOrder So; So.init(T, IN_NF8 * 256, F.G, (int)blockIdx.x, 6);
            pg8::EpiIn E = E0; E.osc = 1.0f / (Q_SA_IN * Q_SB_IN); E.mask = IN_F8;
            pg8::gemm_phase<pg8::DenseProbT<QM_IN>, pg8::EpiIn, pg8::StaticOrder, true>(F.lds, P, So, E);
        }
    }
    SEAM(1);
    if (IN(2)) {
#if EN_ATTN
        for (int u = F.vcu; u < NB * NH * NBLK; u += F.G) kmean_unit(F, u);
#endif
        for (int u = F.vcu; u < NB * NBLK * 4; u += F.G) { const int b = u >> 7, chunk = (u >> 2) & 31, cq = u & 3;
            scan_unit<false>(F, b, chunk, cq);
            asm volatile("s_waitcnt vmcnt(0)" ::: "memory");
            __syncthreads();
            unsigned* fl = F.ctl + CW_SFLAG + (b * NBLK) * 4 + cq;
            if (F.tid == 0) (void)xb_add(fl + chunk * 4, 1u);
            if (F.lane < chunk) { unsigned sp = 0u; while (xb_ld(fl + F.lane * 4) == 0u) { __builtin_amdgcn_s_sleep(1); if (++sp > (1u << 22)) break; } }
            asm volatile("s_waitcnt vmcnt(0)" ::: "memory");
            scan_fix(F, (((b * NBLK) + chunk) << 5) | (cq * 8 + F.wave));
            asm volatile("s_waitcnt vmcnt(0)" ::: "memory"); __syncthreads();
        }
    }
    SEAM(2);
    if (IN(3)) {
#if EN_ATTN
        route_phase(F);
#endif
        __syncthreads();
    }
    SEAM(3);
    if (IN(4)) {
#if EN_ATTN
        LAS int* ipre = (LAS int*)(F.lds + TAB_OFF); LAS int* tmp = ipre + 1040; LAS int* lb = tmp + 512;
        const int t = F.tid; const unsigned* ac = F.ctl + CW_ACNT;
        const int v0 = (((int)ac[2 * t] + 255) >> 8) + 1, v1 = (((int)ac[2 * t + 1] + 255) >> 8) + 1;
        tmp[t] = v0 + v1;
        __syncthreads();
        if (t < 64) { int w = 0;
#pragma unroll
            for (int i = 0; i < 8; ++i) w += tmp[t * 8 + i];
            int inc = w;
#pragma unroll
            for (int o = 1; o < 64; o <<= 1) { const int y = __shfl_up(inc, o); if (t >= o) inc += y; }
            lb[t] = inc - w; }
        __syncthreads();
        { int base = lb[t >> 3]; for (int u2 = (t & ~7); u2 < t; ++u2) base += tmp[u2];
          ipre[2 * t] = base; ipre[2 * t + 1] = base + v0; if (t == NTHR - 1) ipre[1024] = base + v0 + v1; }
        __syncthreads();
        const int nitems = ipre[1024];
        att::phase(F, ipre, nitems, ac);
#endif
    }
    SEAM(4);
    if (IN(5)) {
#if EN_ATTN
        { const float* LSE = (const float*)(F.ws + WS_LSE) + (size_t)(F.lane >> 3) * 4; int t = F.vcu * NWAVES + F.wave;
          f32x4 ls = *(const f32x4*)(LSE + (size_t)t * NH * 4); asm volatile("" : "+v"(ls));
          for (; t < T; t += F.G * NWAVES) { const int tn = (t + F.G * NWAVES < T) ? t + F.G * NWAVES : t; f32x4 lsn; att::combine_token(F, t, ls, LSE + (size_t)tn * NH * 4, lsn); ls = lsn; } }
#endif
    }
    SEAM(5);
    if (IN(7)) {
        pg8::StaticOrder So; So.init(T, D, F.G, (int)blockIdx.x, 8);
        { pg8::DenseProbT<2> P{(const void*)(F.ws + WS_YC8), (const void*)(F.ws + WS_WP_T), 1024, 2048, 2048};
          pg8::EpiGate<false> E{(const unsigned char*)(F.ws + WS_SGR), (bf16_t*)(F.ws + WS_MERGED), (const float*)(F.ws + WS_RS1), 2, 1.0f / (I8_SP * 255.f)};
          pg8::gemm_phase<pg8::DenseProbT<2>, pg8::EpiGate<false>, pg8::StaticOrder, false>(F.lds, P, So, E); }
#if EN_ATTN
        { pg8::DenseProbT<2> P{(const void*)(F.ws + WS_YC8 + 1024), (const void*)(F.ws + WS_WP_T + 1024), 1024, 2048, 2048};
          pg8::EpiGate<true> E{(const unsigned char*)(F.ws + WS_SGA), (bf16_t*)(F.ws + WS_MERGED), (const float*)(F.ws + WS_RS1) + 1, 2, 1.0f / (I8_SP * 255.f)};
          pg8::gemm_phase<pg8::DenseProbT<2>, pg8::EpiGate<true>, pg8::StaticOrder, false>(F.lds, P, So, E); }
#endif
    }
    SEAM(7);
    if (IN(8)) {
        for (int t = F.vcu * NWAVES + F.wave; t < T; t += F.G * NWAVES) quant_row<false>(F, (const bf16_t*)(F.ws + WS_MERGED), F.ws + WS_MG8, (float*)(F.ws + WS_RS2), t);
    }
    SEAM(8);
    if (IN(9)) {
        pg8::DenseProbT<2> P{(const void*)(F.ws + WS_MG8), (const void*)(F.ws + WS_WOUT_T), D, D, D};
        pg8::StaticOrder So; So.init(T, D, F.G, (int)blockIdx.x, 8);
        pg8::EpiResid E{(bf16_t*)(F.ws + WS_DELTA), (const float*)(F.ws + WS_RS2), 1.0f / I8_SB};
        pg8::gemm_phase<pg8::DenseProbT<2>, pg8::EpiResid, pg8::StaticOrder, true>(F.lds, P, So, E);
    }
    SEAM(9);
    if (IN(10)) {
#if EN_MOE
        for (int it = F.vcu; it < T / 128; it += F.G) router_iter(F, it);
#endif
    }
    SEAM(10);
#if EN_MOE
    LAS int* tpre = (LAS int*)(F.lds + TAB_OFF); LAS int* ecnt = tpre + 40;
    if (IN(11) || IN(12)) {
        if (F.tid == 0) { int a = 0; for (int e = 0; e < NE; ++e) { const int c = (int)F.ctl[CW_ECNT + e]; ecnt[e] = c; tpre[e] = a; a += (c + 255) >> 8; } tpre[NE] = a; }
        __syncthreads();
    }
#endif
    if (IN(11)) {
#if EN_MOE
        pg8::MoeUpProbT<QM_UP> P{(const void*)(F.ws + WS_H2), (const void*)(F.ws + WS_WGU_T), (const int*)(F.ws + WS_MTOK), D, D, D};
        pg8::GroupedOrder So{tpre, ecnt, 4, F.G, F.vcu};
        pg8::EpiHid E{(const float*)(F.ws + WS_MRS), (void*)(F.ws + WS_HID), QM_UP ? 1.0f / (Q_SA_UP * Q_SB_UP) : 1.0f};
        pg8::gemm_phase<pg8::MoeUpProbT<QM_UP>, pg8::EpiHid, pg8::GroupedOrder, true>(F.lds, P, So, E);
#endif
    }
    SEAM(11);
    if (IN(12)) {
#if EN_MOE
        pg8::MoeDownProbT<QM_DOWN> P{(const void*)(F.ws + WS_HID), (const void*)(F.ws + WS_WD_T), EH, EH, EH};
        pg8::GroupedOrder So{tpre, ecnt, 8, F.G, F.vcu};
        pg8::EpiDown E{(const int*)(F.ws + WS_MDST), (const float*)(F.ws + WS_MW), (unsigned char*)(F.ws + WS_Y), FP8_DOWN ? 1.0f / (FP8_SH * FP8_SD) : 1.0f};
        pg8::gemm_phase<pg8::MoeDownProbT<QM_DOWN>, pg8::EpiDown, pg8::GroupedOrder, true>(F.lds, P, So, E);
#endif
    }
    SEAM(12);
    if (IN(13)) final_norm(F);
#undef IN
#undef SEAM
}

extern "C" void kernel_launch(void* const* d_in, const int* in_sizes, int n_in, void* d_out, int out_size, void* d_ws, size_t ws_size, hipStream_t stream) {
    static int grid = 0;
    if (grid == 0) {
        if (n_in != 22 || in_sizes[0] != T * D || out_size != T * D || ws_size < WS_END) { fprintf(stderr, "kernel_launch: shape / workspace mismatch (n_in %d, ws %zu)\n", n_in, ws_size); grid = -1; return; }
        int dev = 0, cus = 0, per_cu = 0;
        if (hipGetDevice(&dev) != hipSuccess || hipDeviceGetAttribute(&cus, hipDeviceAttributeMultiprocessorCount, dev) != hipSuccess) { grid = -1; return; }
        if (hipFuncSetAttribute((const void*)fwd, hipFuncAttributeMaxDynamicSharedMemorySize, LDS_BYTES) != hipSuccess) { fprintf(stderr, "kernel_launch: hipFuncSetAttribute failed\n"); grid = -1; return; }
        if (hipOccupancyMaxActiveBlocksPerMultiprocessor(&per_cu, (const void*)fwd, NTHR, LDS_BYTES) != hipSuccess || per_cu < 1) { fprintf(stderr, "kernel_launch: occupancy query says %d blocks per CU\n", per_cu); }
        (void)hipGetLastError();
        grid = cus;
    }
    if (grid < 0) return;
    (void)hipMemsetAsync((char*)d_ws + WS_CTL, 0, CTL_ZERO_BYTES, stream);
    Args a{};
    for (int i = 0; i < 22; ++i) a.in[i] = (const float*)d_in[i];
    a.out = (float*)d_out; a.ws = (unsigned char*)d_ws; a.pad = 0;
#if MK_N_LAUNCHES == 1
    a.ph_lo = 0; a.ph_hi = N_PHASES; a.use_bar = 1;
    hipLaunchKernelGGL(fwd, dim3(grid), dim3(NTHR), LDS_BYTES, stream, a);
#else
    for (int p = 0; p < N_PHASES; ++p) { a.ph_lo = p; a.ph_hi = p + 1; a.use_bar = 0; hipLaunchKernelGGL(fwd, dim3(grid), dim3(NTHR), LDS_BYTES, stream, a); }
#endif
}
```
